# Optimizing an MI355X kernel written in HIP

```python
import jax, jax.numpy as jnp
from jax import lax
import numpy as np

D_MODEL = 1024
BATCH = 16
SEQ = 4096
DEPTH = 4

MIX_WIDTH = D_MODEL
HGRN_WIDTH = MIX_WIDTH // 2
HGRN_HEADS = 4
HGRN_HEAD_DIM = HGRN_WIDTH // HGRN_HEADS
GLA_VAL = MIX_WIDTH - HGRN_WIDTH
GLA_HEADS = 4
GLA_KEY = GLA_VAL // 2
GLA_DK = GLA_KEY // GLA_HEADS
GLA_DV = GLA_VAL // GLA_HEADS
GLA_RANK = 16
GLA_GATE_NORM = 16.0
IN_SIZES = (HGRN_WIDTH, HGRN_WIDTH, HGRN_WIDTH, HGRN_WIDTH,
            GLA_KEY, GLA_KEY, GLA_VAL, GLA_VAL, GLA_RANK)
IN_DIM = sum(IN_SIZES)
CHUNK = 64
D_FF = 2816
CONV_W = 3
N_MOD = 6
EPS = 1e-6

kernel_name = "hybrid_hgrn2_gla_convffn_adaln"


def rms_norm(x, g):
    xf = x.astype(jnp.float32)
    y = xf * lax.rsqrt(jnp.mean(xf * xf, axis=-1, keepdims=True) + EPS)
    return (y * g.astype(jnp.float32)).astype(x.dtype)


def chunk_gated_linear_attention(q, k, v, log_a):
    B, S, H, DK = q.shape
    DV = v.shape[-1]
    N = S // CHUNK

    def to_chunks(t):
        return t.astype(jnp.float32).reshape(B, N, CHUNK, H, t.shape[-1]).transpose(0, 3, 1, 2, 4)

    q, k, v, g = to_chunks(q), to_chunks(k), to_chunks(v), to_chunks(log_a)
    b = jnp.cumsum(g, axis=3)
    b_last = b[:, :, :, -1:, :]
    ref = b[:, :, :, CHUNK // 2:CHUNK // 2 + 1, :]
    scores = jnp.einsum('bhncd,bhnsd->bhncs', q * jnp.exp(b - ref), k * jnp.exp(ref - b))
    causal = jnp.tril(jnp.ones((CHUNK, CHUNK), dtype=bool))
    scores = jnp.where(causal, scores, 0.0)
    o = jnp.einsum('bhncs,bhnse->bhnce', scores, v)
    u = jnp.einsum('bhncd,bhnce->nbhde', k * jnp.exp(b_last - b), v)
    decay = jnp.exp(b_last[:, :, :, 0, :]).transpose(2, 0, 1, 3)

    def step(state, inp):
        a_n, u_n = inp
        return a_n[..., None] * state + u_n, state

    s0 = jnp.zeros((B, H, DK, DV), jnp.float32)
    _, s_prev = lax.scan(step, s0, (decay, u))
    o = o + jnp.einsum('bhncd,nbhde->bhnce', q * jnp.exp(b), s_prev)
    return o.transpose(0, 2, 3, 1, 4).reshape(B, S, H, DV)


def gated_head_norm(o, gate, g):
    B, S = o.shape[:2]
    o = rms_norm(o, g).reshape(B, S, -1)
    return o * jax.nn.silu(gate.astype(jnp.float32))


def causal_dwconv(u, w, bias):
    S = u.shape[1]
    up = jnp.pad(u, ((0, 0), (CONV_W - 1, 0), (0, 0)))
    y = bias
    for j in range(CONV_W):
        y = y + up[:, j:j + S, :] * w[j]
    return y


def setup_inputs(seed: int = 0) -> dict:
    key = jax.random.key(seed)
    ks = jax.random.split(key, 20)
    f32 = jnp.float32
    nrm = lambda k, shape, s: jax.random.normal(k, shape, f32) * s
    L, D = DEPTH, D_MODEL
    return {
        "x": nrm(ks[0], (BATCH, SEQ, D), 1.0),
        "c": nrm(ks[1], (BATCH, D), 1.0),
        "ln1_g": 1.0 + nrm(ks[2], (L, D), 0.02),
        "ln2_g": 1.0 + nrm(ks[3], (L, D), 0.02),
        "w_ada": nrm(ks[4], (L, D, N_MOD * D), 0.5 * D ** -0.5),
        "b_ada": nrm(ks[5], (L, N_MOD * D), 0.01),
        "w_in": nrm(ks[6], (L, D, IN_DIM), D ** -0.5),
        "lb_params": nrm(ks[7], (L, HGRN_WIDTH), 0.1),
        "w_gk": nrm(ks[8], (L, GLA_RANK, GLA_KEY), GLA_RANK ** -0.5),
        "b_gk": nrm(ks[9], (L, GLA_KEY), 0.01),
        "gn_a": 1.0 + nrm(ks[10], (L, HGRN_HEAD_DIM), 0.02),
        "gn_b": 1.0 + nrm(ks[11], (L, GLA_DV), 0.02),
        "w_out": nrm(ks[12], (L, MIX_WIDTH, D), MIX_WIDTH ** -0.5),
        "w_up": nrm(ks[13], (L, D, 2 * D_FF), D ** -0.5),
        "conv_w": nrm(ks[14], (L, CONV_W, 2 * D_FF), CONV_W ** -0.5),
        "conv_b": nrm(ks[15], (L, 2 * D_FF), 0.01),
        "w_down": nrm(ks[16], (L, D_FF, D), D_FF ** -0.5),
        "lnf_g": 1.0 + nrm(ks[17], (D,), 0.02),
    }


def reference(x, c, ln1_g, ln2_g, w_ada, b_ada, w_in, lb_params, w_gk, b_gk,
              gn_a, gn_b, w_out, w_up, conv_w, conv_b, w_down, lnf_g):
    B, S, _ = x.shape
    split_idx = np.cumsum(IN_SIZES)[:-1].tolist()
    sm = jax.nn.softmax(lb_params.astype(jnp.float32), axis=0)
    lower_bounds = jnp.cumsum(sm, axis=0) - sm[0]
    cond = jax.nn.silu(c)
    for l in range(DEPTH):
        mod = jnp.einsum('bd,de->be', cond, w_ada[l]) + b_ada[l]
        sh1, sc1, gt1, sh2, sc2, gt2 = jnp.split(mod[:, None, :], N_MOD, axis=-1)

        h = rms_norm(x, ln1_g[l]) * (1.0 + sc1) + sh1
        p = jnp.einsum('bsd,de->bse', h, w_in[l])
        qa, fa, ia, ga, qb, kb, vb, gb, rb = jnp.split(p, split_idx, axis=-1)

        fa = fa.astype(jnp.float32)
        lb = lower_bounds[l]
        log_f = jnp.log(lb + (1.0 - lb) * jax.nn.sigmoid(fa))
        k_a = (1.0 - lb) * jax.nn.sigmoid(-fa)
        hs = (B, S, HGRN_HEADS, HGRN_HEAD_DIM)
        o_a = chunk_gated_linear_attention(qa.reshape(hs), k_a.reshape(hs), ia.reshape(hs), log_f.reshape(hs))
        o_a = gated_head_norm(o_a, ga, gn_a[l])

        gk = jnp.einsum('bsr,rk->bsk', rb.astype(jnp.float32), w_gk[l].astype(jnp.float32)) + b_gk[l]
        log_alpha = jax.nn.log_sigmoid(gk) / GLA_GATE_NORM
        ks_ = (B, S, GLA_HEADS, GLA_DK)
        q_b = qb.astype(jnp.float32) * GLA_DK ** -0.5
        o_b = chunk_gated_linear_attention(q_b.reshape(ks_), kb.reshape(ks_),
                                           vb.reshape(B, S, GLA_HEADS, GLA_DV), log_alpha.reshape(ks_))
        o_b = gated_head_norm(o_b, gb, gn_b[l])

        o = jnp.concatenate([o_a, o_b], axis=-1).astype(x.dtype)
        x = x + gt1 * jnp.einsum('bse,ed->bsd', o, w_out[l])

        h = rms_norm(x, ln2_g[l]) * (1.0 + sc2) + sh2
        u = jnp.einsum('bsd,df->bsf', h, w_up[l])
        u = causal_dwconv(u, conv_w[l], conv_b[l])
        a, v = jnp.split(u, 2, axis=-1)
        x = x + gt2 * jnp.einsum('bsf,fd->bsd', jax.nn.silu(a) * v, w_down[l])
    return rms_norm(x, lnf_g)
```

```cpp
#include <hip/hip_runtime.h>
#include <cstdio>
#include <cstdint>
namespace pg8 {
#define PG8_LAS __attribute__((address_space(3)))
typedef unsigned short bf16_t;
typedef short bf16x8 __attribute__((ext_vector_type(8)));
typedef float f32x4 __attribute__((ext_vector_type(4)));
typedef unsigned u32x4 __attribute__((ext_vector_type(4)));
constexpr int BM = 256, BK = 64, HALF = 128, HTB = HALF * BK * 2  , STAGE_BYTES = 8 * HTB, NXCD = 8, WGM = 8;

__host__ __device__ __forceinline__ int lds_byte(int r, int c) { const int st = (r >> 4) * 2 + (c >> 5), rr = r & 15, cc = c & 31, ob = rr * 64 + cc * 2; return st * 1024 + (ob ^ (((ob >> 9) & 1) << 5)); }
__host__ __device__ __forceinline__ void stage_rc(int b, int& R, int& C) { const int st = b / 1024, sb = b % 1024, swz = sb ^ (((sb >> 9) & 1) << 5); R = (st >> 1) * 16 + swz / 64; C = (st & 1) * 32 + (swz % 64) / 2; }
__host__ __device__ __forceinline__ int perm32(int rho) { const int n = rho >> 4, i = rho & 15; return 8 * (i >> 2) + 4 * n + (i & 3); }

struct Unit { int pm, pn; };
struct Gemm { const bf16_t* A; const bf16_t* Bt; int M, N, K; };

struct StaticOrder {
    int nM, nN, nwg, G, c;
    __host__ __device__ void init(int M, int N, int G_, int c_) { nM = M / BM; nN = N / BM; nwg = nM * nN; G = G_; c = c_; }
    __host__ __device__ bool next(int i, Unit& u) const {
        const long L = (long)i * G + c; if (L >= nwg) return false;
        int wgid = (int)L; { const int q = nwg / NXCD, r = nwg % NXCD, xcd = wgid % NXCD, off = wgid / NXCD; wgid = (xcd < r ? xcd * (q + 1) : r * (q + 1) + (xcd - r) * q) + off; }
        const int nig = WGM * nN, gid = wgid / nig, fm = gid * WGM, gsz = (nM - fm) < WGM ? (nM - fm) : WGM;
        u.pm = fm + ((wgid % nig) % gsz); u.pn = (wgid % nig) / gsz; return true;
    }
    __device__ __forceinline__ void a_ready(const Unit&) const {}
    __device__ __forceinline__ void done(const Unit&) const {}
};

__device__ __forceinline__ unsigned cvt_pk_bf16(float lo, float hi) { unsigned r; asm volatile("v_cvt_pk_bf16_f32 %0, %1, %2" : "=v"(r) : "v"(lo), "v"(hi)); return r; }
typedef unsigned u32x2 __attribute__((ext_vector_type(2)));
constexpr int ROWS_PER_SEQ_TILES = 16;
constexpr float RMS_EPS = 1e-6f;
constexpr int D_MODEL = 1024, N_IN = 3840, N_UP = 5632, N_FF = 2816;

__device__ __forceinline__ float row_rscale(const float* stat, int row, int fq) {
    const f32x4 sp = *(const f32x4*)(stat + (size_t)row * 16 + 4 * fq);
    float s = (sp[0] + sp[1]) + (sp[2] + sp[3]);
    s += __shfl_xor(s, 16); s += __shfl_xor(s, 32);
    return 1.0f / sqrtf(s * (1.0f / (float)D_MODEL) + RMS_EPS);
}

struct EpiIn {
    static constexpr bool PERM = true, AFTER_DRAIN = false;
    bf16_t* P; const float* bias; const float* stat;
    __device__ __forceinline__ void operator()(f32x4 (&acc)[2][2][4][2], const Unit& u, int wr, int wc, int fr, int fq) const {
        const int row0 = u.pm * BM + wr * 64 + fr, b = u.pm / ROWS_PER_SEQ_TILES, col0 = u.pn * BM + wc * 32 + 8 * fq;
        const float* bp = bias + (size_t)b * N_IN + col0;
        f32x4 bv[2][2];
#pragma unroll
        for (int bj = 0; bj < 2; ++bj)
#pragma unroll
            for (int n = 0; n < 2; ++n) bv[bj][n] = *(const f32x4*)(bp + bj * HALF + 4 * n);
#pragma unroll
        for (int ai = 0; ai < 2; ++ai)
#pragma unroll
            for (int m = 0; m < 4; ++m) { const int row = row0 + ai * HALF + m * 16; const float r = row_rscale(stat, row, fq);
                bf16_t* rowp = P + (size_t)row * N_IN + col0;
#pragma unroll
                for (int bj = 0; bj < 2; ++bj) { const f32x4 v0 = acc[ai][bj][m][0] * r + bv[bj][0], v1 = acc[ai][bj][m][1] * r + bv[bj][1];
                    u32x4 w; w.x = cvt_pk_bf16(v0[0], v0[1]); w.y = cvt_pk_bf16(v0[2], v0[3]); w.z = cvt_pk_bf16(v1[0], v1[1]); w.w = cvt_pk_bf16(v1[2], v1[3]);
                    *(u32x4*)(rowp + bj * HALF) = w; } }
    }
};

struct EpiXUpd {
    static constexpr bool PERM = true, AFTER_DRAIN = false;
    const float* xold; float* xnew; bf16_t* XN; const float* gt; const float* gsn; float* stat;
    __device__ __forceinline__ void operator()(f32x4 (&acc)[2][2][4][2], const Unit& u, int wr, int wc, int fr, int fq) const {
        const int row0 = u.pm * BM + wr * 64 + fr, b = u.pm / ROWS_PER_SEQ_TILES, col0 = u.pn * BM + wc * 32 + 8 * fq;
        f32x4 g[2][2], s[2][2];
#pragma unroll
        for (int bj = 0; bj < 2; ++bj)
#pragma unroll
            for (int n = 0; n < 2; ++n) { g[bj][n] = *(const f32x4*)(gt + (size_t)b * D_MODEL + col0 + bj * HALF + 4 * n);
                s[bj][n] = XN ? *(const f32x4*)(gsn + (size_t)b * D_MODEL + col0 + bj * HALF + 4 * n) : (f32x4){0.f, 0.f, 0.f, 0.f}; }
#pragma unroll
        for (int ai = 0; ai < 2; ++ai)
#pragma unroll
            for (int m = 0; m < 4; ++m) { const int row = row0 + ai * HALF + m * 16; const size_t off = (size_t)row * D_MODEL + col0; float ss = 0.f;
#pragma unroll
                for (int bj = 0; bj < 2; ++bj) {
                    const f32x4 x0 = *(const f32x4*)(xold + off + bj * HALF) + g[bj][0] * acc[ai][bj][m][0], x1 = *(const f32x4*)(xold + off + bj * HALF + 4) + g[bj][1] * acc[ai][bj][m][1];
                    *(f32x4*)(xnew + off + bj * HALF) = x0; *(f32x4*)(xnew + off + bj * HALF + 4) = x1;
                    ss += (x0[0] * x0[0] + x0[1] * x0[1]) + (x0[2] * x0[2] + x0[3] * x0[3]) + (x1[0] * x1[0] + x1[1] * x1[1]) + (x1[2] * x1[2] + x1[3] * x1[3]);
                    if (XN) { const f32x4 y0 = x0 * s[bj][0], y1 = x1 * s[bj][1];
                        u32x4 w; w.x = cvt_pk_bf16(y0[0], y0[1]); w.y = cvt_pk_bf16(y0[2], y0[3]); w.z = cvt_pk_bf16(y1[0], y1[1]); w.w = cvt_pk_bf16(y1[2], y1[3]);
                        *(u32x4*)(XN + off + bj * HALF) = w; } }
                ss += __shfl_xor(ss, 16); ss += __shfl_xor(ss, 32);
                if (fq == 0) stat[(size_t)row * 16 + u.pn * 4 + wc] = ss; }
    }
};

__device__ __forceinline__ float dpp_ror1(float v) { return __builtin_bit_cast(float, __builtin_amdgcn_update_dpp(0, __builtin_bit_cast(int, v), 0x121, 0xf, 0xf, false)); }
__device__ __forceinline__ float dpp_ror2(float v) { return __builtin_bit_cast(float, __builtin_amdgcn_update_dpp(0, __builtin_bit_cast(int, v), 0x122, 0xf, 0xf, false)); }
__device__ __forceinline__ float silu_f(float x) { return x / (1.0f + __expf(-x)); }
struct EpiUp {
    static constexpr bool PERM = true, AFTER_DRAIN = false;
    bf16_t* G; const float* bias; const float* stat; const float* cw; const float* cb; float* rawh; float* rawt; PG8_LAS float* halo;
    __device__ __forceinline__ void operator()(f32x4 (&acc)[2][2][4][2], const Unit& u, int wr, int wc, int fr, int fq) const {
        const int row0 = u.pm * BM + wr * 64 + fr, b = u.pm / ROWS_PER_SEQ_TILES, tc0 = wc * 32 + 8 * fq, col0 = u.pn * BM + tc0;
        {   f32x4 bv[2][2];
#pragma unroll
            for (int bj = 0; bj < 2; ++bj)
#pragma unroll
                for (int n = 0; n < 2; ++n) bv[bj][n] = *(const f32x4*)(bias + (size_t)b * N_UP + col0 + bj * HALF + 4 * n);
#pragma unroll
            for (int ai = 0; ai < 2; ++ai)
#pragma unroll
                for (int m = 0; m < 4; ++m) { const float r = row_rscale(stat, row0 + ai * HALF + m * 16, fq);
#pragma unroll
                    for (int bj = 0; bj < 2; ++bj)
#pragma unroll
                        for (int n = 0; n < 2; ++n) acc[ai][bj][m][n] = acc[ai][bj][m][n] * r + bv[bj][n];
                    asm volatile("" : "+v"(acc[ai][0][m][0]), "+v"(acc[ai][0][m][1]), "+v"(acc[ai][1][m][0]), "+v"(acc[ai][1][m][1]));
                    if (m & 1) asm volatile("" ::: "memory"); } }
#pragma unroll
        for (int ai = 0; ai < 2; ++ai) {
            if (fr >= 14) {
                PG8_LAS float* hp = halo + ((ai * 2 + wr) * 2 + (fr - 14)) * 256 + tc0;
#pragma unroll
                for (int bj = 0; bj < 2; ++bj)
#pragma unroll
                    for (int n = 0; n < 2; ++n) *(PG8_LAS f32x4*)(hp + bj * HALF + 4 * n) = acc[ai][bj][3][n];
            }
        }
        if (wr == 0 && fr < 2) { float* hp = rawh + ((size_t)u.pm * 2 + fr) * N_UP + col0;
#pragma unroll
            for (int bj = 0; bj < 2; ++bj)
#pragma unroll
                for (int n = 0; n < 2; ++n) *(f32x4*)(hp + bj * HALF + 4 * n) = acc[0][bj][0][n]; }
        if (wr == 1 && fr >= 14) { float* tp = rawt + ((size_t)u.pm * 2 + (fr - 14)) * N_UP + col0;
#pragma unroll
            for (int bj = 0; bj < 2; ++bj)
#pragma unroll
                for (int n = 0; n < 2; ++n) *(f32x4*)(tp + bj * HALF + 4 * n) = acc[1][bj][3][n]; }
        asm volatile("s_waitcnt lgkmcnt(0)" ::: "memory"); __builtin_amdgcn_s_barrier(); asm volatile("" ::: "memory");
        const bool f0 = (fr == 0), f01 = (fr < 2);
#pragma unroll
        for (int n = 0; n < 2; ++n) {
            f32x4 w0[2], w1[2], w2[2], cbv[2];
#pragma unroll
            for (int bj = 0; bj < 2; ++bj) { const int c = col0 + bj * HALF + 4 * n;
                w0[bj] = *(const f32x4*)(cw + c); w1[bj] = *(const f32x4*)(cw + N_UP + c); w2[bj] = *(const f32x4*)(cw + 2 * N_UP + c); cbv[bj] = *(const f32x4*)(cb + c); }
#pragma unroll
            for (int ai = 0; ai < 2; ++ai) {
                f32x4 prev[2];
                {   const int pai = (wr == 1) ? ai : ai - 1, pwr = (wr == 1) ? 0 : 1;
                    const bool has = (pai >= 0);
                    const PG8_LAS float* hp = halo + ((pai * 2 + pwr) * 2 + (fr & 1)) * 256 + tc0 + 4 * n;
#pragma unroll
                    for (int bj = 0; bj < 2; ++bj) prev[bj] = (has && fr >= 14) ? *(const PG8_LAS f32x4*)(hp + bj * HALF) : (f32x4){0.f, 0.f, 0.f, 0.f}; }
#pragma unroll
                for (int m = 0; m < 4; ++m) {
                    f32x4 cu[2];
#pragma unroll
                    for (int bj = 0; bj < 2; ++bj) { const f32x4 cur = acc[ai][bj][m][n], pv = prev[bj]; f32x4 o;
#pragma unroll
                        for (int j = 0; j < 4; ++j) { const float c1 = dpp_ror1(cur[j]), p1 = dpp_ror1(pv[j]), c2 = dpp_ror2(cur[j]), p2 = dpp_ror2(pv[j]);
                            const float s1 = f0 ? p1 : c1, s2 = f01 ? p2 : c2;
                            o[j] = cbv[bj][j] + w0[bj][j] * s2 + w1[bj][j] * s1 + w2[bj][j] * cur[j]; }
                        cu[bj] = o; prev[bj] = cur; }
                    f32x4 g;
#pragma unroll
                    for (int j = 0; j < 4; ++j) g[j] = silu_f(cu[0][j]) * cu[1][j];
                    u32x2 w; w.x = cvt_pk_bf16(g[0], g[1]); w.y = cvt_pk_bf16(g[2], g[3]);
                    *(u32x2*)(G + (size_t)(row0 + ai * HALF + m * 16) * N_FF + u.pn * HALF + tc0 + 4 * n) = w;
                }
            }
            asm volatile("" ::: "memory");
        }
    }
};
template <class Epi, class Sched, bool ALIGN_EPI = false, bool SP2 = false>
__device__ __forceinline__ void gemm_phase(PG8_LAS unsigned char* lds, const Gemm g, const Sched& S, const Epi& E, const int tid) {
    const int wid = __builtin_amdgcn_readfirstlane(tid >> 6), lane = tid & 63, wr = wid >> 2, wc = wid & 3, fr = lane & 15, fq = lane >> 4;
    const int K = g.K, nt = K / BK;
    unsigned voffA[2], voffB[2];
#pragma unroll
    for (int i = 0; i < 2; ++i) { int R, C; stage_rc(tid * 16 + i * 8192, R, C); const int Rb = Epi::PERM ? ((R & ~31) + perm32(R & 31)) : R;
        voffA[i] = (unsigned)(R * K + C) * 2u; voffB[i] = (unsigned)(Rb * K + C) * 2u; }
    const size_t kstep = (size_t)(BK * 2);
    const size_t hstep = (size_t)HALF * K * 2;
    const size_t tstep = 2 * hstep;
    const unsigned ldsw = (unsigned)wid * 1024u;
    const int aoff = lds_byte(wr * 64 + fr, fq * 8), boff = lds_byte(wc * 32 + fr, fq * 8);
#define PG8_SA(b, h) (((b) * 2 + (h)) * HTB)
#define PG8_SB(b, h) ((4 + (b) * 2 + (h)) * HTB)
#define PG8_STAGE(bufoff, gbase, voff) do { _Pragma("unroll") for (int _i = 0; _i < 2; ++_i) \
        __builtin_amdgcn_global_load_lds((const unsigned*)((const char*)(gbase) + (voff)[_i]), (PG8_LAS unsigned*)(lds + (bufoff) + ldsw + _i * 8192), 16, 0, 0); } while (0)
#define PG8_LDA(dst, b, h) do { _Pragma("unroll") for (int m = 0; m < 4; ++m) _Pragma("unroll") for (int k = 0; k < 2; ++k) dst[m][k] = *(const PG8_LAS bf16x8*)(lds + PG8_SA(b, h) + aoff + m * 2048 + k * 1024); } while (0)
#define PG8_LDB(dst, b, h) do { _Pragma("unroll") for (int n = 0; n < 2; ++n) _Pragma("unroll") for (int k = 0; k < 2; ++k) dst[n][k] = *(const PG8_LAS bf16x8*)(lds + PG8_SB(b, h) + boff + n * 2048 + k * 1024); } while (0)
#define PG8_MMA(ai, bj, At, Bt) do { __builtin_amdgcn_s_setprio(1); _Pragma("unroll") for (int m = 0; m < 4; ++m) _Pragma("unroll") for (int n = 0; n < 2; ++n) _Pragma("unroll") for (int k = 0; k < 2; ++k) \
        acc[ai][bj][m][n] = __builtin_amdgcn_mfma_f32_16x16x32_bf16(Bt[n][k], At[m][k], acc[ai][bj][m][n], 0, 0, 0); __builtin_amdgcn_s_setprio(0); } while (0)
#define PG8_WAIT_V(n) asm volatile("s_waitcnt vmcnt(" #n ")" ::: "memory")
#define PG8_WAIT_L(n) asm volatile("s_waitcnt lgkmcnt(" #n ")" ::: "memory")
#define PG8_BAR __builtin_amdgcn_s_barrier()
#define PG8_SCHED __builtin_amdgcn_sched_barrier(0)
    Unit cur, nxt; int ui = 0;
    if (!S.next(0, cur)) return;
    f32x4 acc[2][2][4][2];
#pragma unroll
    for (int a = 0; a < 2; ++a)
#pragma unroll
        for (int b = 0; b < 2; ++b)
#pragma unroll
            for (int m = 0; m < 4; ++m)
#pragma unroll
                for (int n = 0; n < 2; ++n) acc[a][b][m][n] = (f32x4){0.f, 0.f, 0.f, 0.f};
    bf16x8 At[4][2], B0[2][2], B1[2][2];
    const char* cA = (const char*)g.A + (size_t)cur.pm * tstep; const char* cB = (const char*)g.Bt + (size_t)cur.pn * tstep;
    S.a_ready(cur);
    if constexpr (SP2) {
        PG8_STAGE(PG8_SB(0, 0), cB, voffB); PG8_STAGE(PG8_SB(0, 1), cB + hstep, voffB); PG8_STAGE(PG8_SA(0, 0), cA, voffA); PG8_STAGE(PG8_SA(0, 1), cA + hstep, voffA);
        if (wr == 1) PG8_BAR;
        PG8_WAIT_V(2); PG8_BAR;
        PG8_STAGE(PG8_SB(1, 0), cB + kstep, voffB); PG8_STAGE(PG8_SA(1, 0), cA + kstep, voffA); PG8_STAGE(PG8_SB(1, 1), cB + hstep + kstep, voffB);
        PG8_WAIT_V(6); PG8_BAR;
    } else {
        PG8_STAGE(PG8_SB(0, 0), cB, voffB); PG8_STAGE(PG8_SA(0, 0), cA, voffA); PG8_STAGE(PG8_SB(0, 1), cB + hstep, voffB); PG8_STAGE(PG8_SA(0, 1), cA + hstep, voffA);
        if (wr == 1) PG8_BAR;
        PG8_WAIT_V(4); PG8_BAR;
        PG8_STAGE(PG8_SB(1, 0), cB + kstep, voffB); PG8_STAGE(PG8_SA(1, 0), cA + kstep, voffA); PG8_STAGE(PG8_SB(1, 1), cB + hstep + kstep, voffB);
        PG8_WAIT_V(6); PG8_BAR;
    }
    for (;;) {
        const bool has_next = S.next(ui + 1, nxt);
        const char* nA = has_next ? (const char*)g.A + (size_t)nxt.pm * tstep : cA; const char* nB = has_next ? (const char*)g.Bt + (size_t)nxt.pn * tstep : cB;
        for (int t = 0; t < nt; t += 2) {
            const bool last = (t == nt - 2);
            const char* a1 = cA + (size_t)(t + 1) * kstep;
            const char* a2 = last ? nA : cA + (size_t)(t + 2) * kstep; const char* b2 = last ? nB : cB + (size_t)(t + 2) * kstep;
            const char* a3 = a2 + kstep; const char* b3 = b2 + kstep;
            if (last && has_next) S.a_ready(nxt);
            if constexpr (SP2) {
            PG8_LDB(B0, 0, 0); PG8_LDB(B1, 0, 1); PG8_SCHED; PG8_LDA(At, 0, 0); PG8_STAGE(PG8_SA(1, 1), a1 + hstep, voffA);
            PG8_WAIT_V(8); PG8_WAIT_L(0); PG8_BAR; PG8_MMA(0, 0, At, B0); PG8_MMA(0, 1, At, B1); PG8_BAR; PG8_SCHED;
            PG8_LDA(At, 0, 1); PG8_STAGE(PG8_SB(0, 0), b2, voffB); PG8_STAGE(PG8_SB(0, 1), b2 + hstep, voffB); PG8_STAGE(PG8_SA(0, 0), a2, voffA);
            PG8_WAIT_V(8); PG8_WAIT_L(0); PG8_BAR; PG8_MMA(1, 0, At, B0); PG8_MMA(1, 1, At, B1); PG8_BAR; PG8_SCHED;
            PG8_LDB(B0, 1, 0); PG8_LDB(B1, 1, 1); PG8_SCHED; PG8_LDA(At, 1, 0); PG8_STAGE(PG8_SA(0, 1), a2 + hstep, voffA);
            PG8_WAIT_V(8); PG8_WAIT_L(0); PG8_BAR; PG8_MMA(0, 0, At, B0); PG8_MMA(0, 1, At, B1); PG8_BAR; PG8_SCHED;
            PG8_LDA(At, 1, 1); PG8_STAGE(PG8_SB(1, 0), b3, voffB); PG8_STAGE(PG8_SB(1, 1), b3 + hstep, voffB); PG8_STAGE(PG8_SA(1, 0), a3, voffA);
            PG8_WAIT_V(8); PG8_WAIT_L(0); PG8_BAR; PG8_MMA(1, 0, At, B0); PG8_MMA(1, 1, At, B1); PG8_BAR; PG8_SCHED;
            } else {
            PG8_LDB(B0, 0, 0); PG8_SCHED; PG8_LDA(At, 0, 0); PG8_STAGE(PG8_SA(1, 1), a1 + hstep, voffA);
            PG8_WAIT_L(8); PG8_BAR; PG8_WAIT_L(0); PG8_MMA(0, 0, At, B0); PG8_BAR; PG8_SCHED;
            PG8_LDB(B1, 0, 1); PG8_STAGE(PG8_SB(0, 0), b2, voffB);
            PG8_BAR; PG8_WAIT_L(0); PG8_MMA(0, 1, At, B1); PG8_BAR;
            PG8_LDA(At, 0, 1); PG8_STAGE(PG8_SA(0, 0), a2, voffA);
            PG8_BAR; PG8_WAIT_L(0); PG8_MMA(1, 0, At, B0); PG8_BAR; PG8_SCHED;
            PG8_STAGE(PG8_SB(0, 1), b2 + hstep, voffB);
            PG8_WAIT_V(6); PG8_BAR; PG8_MMA(1, 1, At, B1); PG8_BAR;
            PG8_LDB(B0, 1, 0); PG8_SCHED; PG8_LDA(At, 1, 0); PG8_STAGE(PG8_SA(0, 1), a2 + hstep, voffA);
            PG8_WAIT_L(8); PG8_BAR; PG8_WAIT_L(0); PG8_MMA(0, 0, At, B0); PG8_BAR; PG8_SCHED;
            PG8_LDB(B1, 1, 1); PG8_STAGE(PG8_SB(1, 0), b3, voffB);
            PG8_BAR; PG8_WAIT_L(0); PG8_MMA(0, 1, At, B1); PG8_BAR;
            PG8_LDA(At, 1, 1); PG8_STAGE(PG8_SA(1, 0), a3, voffA);
            PG8_BAR; PG8_WAIT_L(0); PG8_MMA(1, 0, At, B0); PG8_BAR; PG8_SCHED;
            PG8_STAGE(PG8_SB(1, 1), b3 + hstep, voffB);
            PG8_WAIT_V(6); PG8_BAR; PG8_MMA(1, 1, At, B1); PG8_BAR;
            }
        }
        if constexpr (ALIGN_EPI) { if (wr == 0) PG8_BAR; }
        if constexpr (!Epi::AFTER_DRAIN) { int lane_e; asm volatile("v_mbcnt_lo_u32_b32 %0, -1, 0\n\tv_mbcnt_hi_u32_b32 %0, -1, %0" : "=v"(lane_e));
            const int fr_e = lane_e & 15, fq_e = lane_e >> 4; int wr_e = wr, wc_e = wc; asm volatile("" : "+s"(wr_e), "+s"(wc_e));
            E(acc, cur, wr_e, wc_e, fr_e, fq_e); S.done(cur); }
        if (!has_next) break;
#pragma unroll
        for (int a = 0; a < 2; ++a)
#pragma unroll
            for (int b = 0; b < 2; ++b)
#pragma unroll
                for (int m = 0; m < 4; ++m)
#pragma unroll
                    for (int n = 0; n < 2; ++n) acc[a][b][m][n] = (f32x4){0.f, 0.f, 0.f, 0.f};
        cur = nxt; cA = nA; cB = nB; ++ui;
        if constexpr (ALIGN_EPI) { if (wr == 1) PG8_BAR; }
    }
    PG8_WAIT_V(0);
    if constexpr (!ALIGN_EPI) { if (wr == 0) PG8_BAR; }
    PG8_BAR;
    if constexpr (Epi::AFTER_DRAIN) { E.fused(acc, cur, wr, wc, fr, fq, lds, wid, lane); S.done(cur); }
#undef PG8_SA
#undef PG8_SB
#undef PG8_STAGE
#undef PG8_LDA
#undef PG8_LDB
#undef PG8_MMA
#undef PG8_WAIT_V
#undef PG8_WAIT_L
#undef PG8_BAR
#undef PG8_SCHED
}
}

constexpr int NWAVES = 8;
#ifndef MK_PER_PHASE
#define MK_PER_PHASE 0
#endif
constexpr int NB = 16, SEQ = 4096, D = 1024, DEPTH = 4, M = NB * SEQ;
constexpr int NIN = 3840, NINW = 3584, FF = 2816, NUP = 5632, NMOD = 6144;
constexpr float EPS = 1e-6f;
constexpr int N_PHASES = 2 + 6 * DEPTH + 1;

constexpr size_t MiB = 1u << 20;
constexpr size_t WS_CTL = 0, CTL_ZERO_BYTES = 4 * MiB;
constexpr size_t WS_MOD = 2 * MiB;
constexpr size_t WS_SMALL = 4 * MiB;
constexpr size_t WS_STAT = 12 * MiB;
constexpr size_t WS_RAWH = 16 * MiB, WS_RAWT = 28 * MiB;
constexpr size_t WS_WIN = 40 * MiB;
constexpr size_t WS_WOUT = 70 * MiB;
constexpr size_t WS_WUP = 78 * MiB;
constexpr size_t WS_WDN = 122 * MiB;
constexpr size_t WS_XN = 144 * MiB;
constexpr size_t WS_O = 272 * MiB;
constexpr size_t WS_P = 400 * MiB;
constexpr size_t WS_END = 880 * MiB;
constexpr int SM_LB = 0;
constexpr int SM_CW = SM_LB + 4 * 512;
constexpr int SM_CB = SM_CW + 4 * 3 * NUP;
constexpr int SM_GS1 = SM_CB + 4 * NUP;
constexpr int SM_GS2 = SM_GS1 + 4 * 16 * D;
constexpr int SM_GT1 = SM_GS2 + 4 * 16 * D;
constexpr int SM_GT2 = SM_GT1 + 4 * 16 * D;
constexpr int SM_B1 = SM_GT2 + 4 * 16 * D;
constexpr int SM_B2 = SM_B1 + 4 * 16 * NIN;
constexpr int SM_END = SM_B2 + 4 * 16 * NUP;
static_assert((size_t)SM_END * 4 <= 8 * MiB, "small vectors fit");
constexpr int CW_BAR = 4096;

constexpr int RING_BYTES = 131072, HALO_OFF = RING_BYTES, HALO_BYTES = 8192, LDSCTL_OFF = HALO_OFF + HALO_BYTES, MISC_OFF = LDSCTL_OFF + 320;
constexpr int LDS_BYTES = 147456;
static_assert(MISC_OFF + 128 <= LDS_BYTES, "LDS map");

#define GAS __attribute__((address_space(1)))
#define LAS __attribute__((address_space(3)))
typedef unsigned short bf16;
typedef unsigned v4u __attribute__((ext_vector_type(4)));
typedef unsigned v2u __attribute__((ext_vector_type(2)));
typedef float f32x4 __attribute__((ext_vector_type(4)));
#define LDS_WAIT() asm volatile("s_waitcnt lgkmcnt(0)" ::: "memory")
__device__ __forceinline__ unsigned f2bf(float f) { unsigned u = __builtin_bit_cast(unsigned, f); return (u + 0x7fffu + ((u >> 16) & 1u)) >> 16; }
__device__ __forceinline__ unsigned pk2(float lo, float hi) { return f2bf(lo) | (f2bf(hi) << 16); }
__device__ __forceinline__ float bf2f(unsigned h) { return __builtin_bit_cast(float, h << 16); }
__device__ __forceinline__ float wave_sum(float v) {
#pragma unroll
    for (int o = 1; o < 64; o <<= 1) v += __shfl_xor(v, o);
    return v;
}
__device__ __forceinline__ float sigmoid_f(float x) { return 1.0f / (1.0f + __expf(-x)); }
#define XB_TMO      128
#define XB_XCNT(j)  (256  + 64 * (j))
#define XB_XSUB(j)  (1280 + 64 * (j))
#define XB_XGEN(j)  (2304 + 64 * (j))
#define XB_TOP      3328
#define XB_TOPGEN   3392
#define XCD_BAR_WORDS 3456
#define XB_SPIN_CAP (1u << 18)

__device__ __forceinline__ unsigned xb_ld(unsigned* p)              { return __hip_atomic_load(p, __ATOMIC_RELAXED, __HIP_MEMORY_SCOPE_AGENT); }
__device__ __forceinline__ unsigned xb_add(unsigned* p, unsigned v) { return __hip_atomic_fetch_add(p, v, __ATOMIC_RELAXED, __HIP_MEMORY_SCOPE_AGENT); }
__device__ __forceinline__ unsigned xb_xcc_id() { return (unsigned)__builtin_amdgcn_s_getreg((3 << 11) | 20) & 0xFu; }
#define XB_SPIN(cond, bar) do { unsigned _sp = 0; while (cond) { __builtin_amdgcn_s_sleep(1); \
    if ((++_sp & 255u) == 0u) { if (xb_ld(&(bar)[XB_TMO])) break; if (_sp > XB_SPIN_CAP) { atomicAdd(&(bar)[XB_TMO], 1u); break; } } } } while (0)

struct XcdBarrier {
    unsigned* bar; unsigned x;
    volatile LAS unsigned* st;
};

__device__ __forceinline__ XcdBarrier xcd_barrier_post(unsigned* bar, volatile LAS unsigned* st) {
    XcdBarrier b; b.bar = bar; b.x = xb_xcc_id(); b.st = st;
    if (threadIdx.x == 0) (void)xb_add(&bar[XB_XCNT(b.x)], 1u);
    return b;
}
__device__ __forceinline__ void xcd_barrier_complete(unsigned* bar, unsigned x, unsigned& nloc, unsigned& nx) {
    const unsigned G = gridDim.x * gridDim.y * gridDim.z;
    unsigned sum, cnt, mine, sp = 0u;
    for (;;) {
        sum = 0u; cnt = 0u; mine = 0u;
#pragma unroll
        for (unsigned j = 0; j < 16; ++j) { const unsigned c = xb_ld(&bar[XB_XCNT(j)]); sum += c; cnt += (c > 0u) ? 1u : 0u; mine = (j == x) ? c : mine; }
        if (sum == G) break;
        __builtin_amdgcn_s_sleep(1);
        if ((++sp & 255u) == 0u) { if (xb_ld(&bar[XB_TMO])) break; if (sp > XB_SPIN_CAP) { atomicAdd(&bar[XB_TMO], 1u); break; } }
    }
    nloc = mine > 0u ? mine : 1u; nx = cnt > 0u ? cnt : 1u;
}

__device__ __forceinline__ void xcd_barrier(const XcdBarrier& b) {
    asm volatile("s_waitcnt vmcnt(0)" ::: "memory");
    __syncthreads();
    if (threadIdx.x == 0) {
        unsigned* bar = b.bar;
        __builtin_amdgcn_s_waitcnt(0);
        unsigned nloc = b.st[0], nx = b.st[1];
        if (nloc == 0u) { xcd_barrier_complete(bar, b.x, nloc, nx); b.st[0] = nloc; b.st[1] = nx; }
        const unsigned old = xb_add(&bar[XB_XSUB(b.x)], 1u);
        const unsigned gen = old / nloc;
        if (old + 1u == (gen + 1u) * nloc) {
            __builtin_amdgcn_fence(__ATOMIC_RELEASE, "agent");
            asm volatile("s_waitcnt vmcnt(0)" ::: "memory");
            const unsigned og = xb_add(&bar[XB_TOP], 1u);
            const unsigned tg = og / nx;
            if (og + 1u == (tg + 1u) * nx) xb_add(&bar[XB_TOPGEN], 1u);
            else XB_SPIN(xb_ld(&bar[XB_TOPGEN]) == tg, bar);
            __builtin_amdgcn_fence(__ATOMIC_ACQUIRE, "agent");
            xb_add(&bar[XB_XGEN(b.x)], 1u);
            asm volatile("s_waitcnt vmcnt(0)" ::: "memory");
        } else {
            XB_SPIN(xb_ld(&bar[XB_XGEN(b.x)]) == gen, bar);
            __builtin_amdgcn_fence(__ATOMIC_ACQUIRE, "agent");
            asm volatile("s_waitcnt vmcnt(0)" ::: "memory");
        }
    }
    __syncthreads();
}

struct Frame {
    LAS unsigned char* lds;
    volatile LAS unsigned* MISC;
    unsigned* ctl;
    int tid, lane, wave, vcu, G;
    const float *x, *c, *ln1_g, *ln2_g, *w_ada, *b_ada, *w_in, *lb_params, *w_gk, *b_gk, *gn_a, *gn_b, *w_out, *w_up, *conv_w, *conv_b, *w_down, *lnf_g;
    float* out;
    float *MOD, *SMALL, *STAT, *RAWH, *RAWT;
    bf16 *WIN, *WOUT, *WUP, *WDN, *XN, *O, *P, *Gb;
};

__device__ __forceinline__ void tr_item(const float* W, int Nsrc, int K, bf16* WT, int kb, int sn0, int dn0, float scale, LAS float* scr, int lane) {
    const int k0 = 64 * kb;
#pragma unroll 8
    for (int i = 0; i < 32; ++i) { const int kk = 2 * i + (lane >> 5); scr[kk * 33 + (lane & 31)] = W[(size_t)(k0 + kk) * Nsrc + sn0 + (lane & 31)]; }
    LDS_WAIT(); asm volatile("" ::: "memory");
    const int c = lane & 7;
#pragma unroll
    for (int j = 0; j < 4; ++j) { const int n = (lane >> 3) + 8 * j; const LAS float* s = scr + (8 * c) * 33 + n;
        v4u o; o.x = pk2(s[0 * 33] * scale, s[1 * 33] * scale); o.y = pk2(s[2 * 33] * scale, s[3 * 33] * scale); o.z = pk2(s[4 * 33] * scale, s[5 * 33] * scale); o.w = pk2(s[6 * 33] * scale, s[7 * 33] * scale);
        *(GAS v4u*)(WT + (size_t)(dn0 + n) * K + k0 + 8 * c) = o; }
    LDS_WAIT(); asm volatile("" ::: "memory");
}
__host__ __device__ __forceinline__ int up_orig(int np) { return ((np & 255) >> 7) * FF + 128 * (np >> 8) + (np & 127); }

__device__ __forceinline__ void p0a(Frame& F) {
    const int gw = F.vcu * NWAVES + F.wave, NGW = F.G * NWAVES, gt = F.vcu * (NWAVES * 64) + F.tid, NGT = F.G * NWAVES * 64;
    {
        LAS float* cond = (LAS float*)F.lds;
        for (int e = F.tid; e < 16 * 1024; e += NWAVES * 64) { const int b = e >> 10, d = e & 1023; const float cv = F.c[b * 1024 + d]; cond[d * 16 + b] = cv * sigmoid_f(cv); }
        __syncthreads();
        for (int it = gw; it < DEPTH * 96 * 8; it += NGW) {
            const int seg = it & 7, cb = (it >> 3) % 96, l = it / 768, e = cb * 64 + F.lane;
            const float* w = F.w_ada + ((size_t)l * 1024 + seg * 128) * NMOD + e;
            float acc[16];
#pragma unroll
            for (int b = 0; b < 16; ++b) acc[b] = 0.f;
#pragma unroll 4
            for (int dd = 0; dd < 128; ++dd) {
                const float wv = w[(size_t)dd * NMOD];
                const LAS f32x4* cp = (const LAS f32x4*)(cond + (seg * 128 + dd) * 16);
#pragma unroll
                for (int q = 0; q < 4; ++q) { const f32x4 cq = cp[q]; acc[4 * q] += cq[0] * wv; acc[4 * q + 1] += cq[1] * wv; acc[4 * q + 2] += cq[2] * wv; acc[4 * q + 3] += cq[3] * wv; }
            }
            const float bb = (seg == 0) ? F.b_ada[l * NMOD + e] : 0.f;
#pragma unroll
            for (int b = 0; b < 16; ++b) unsafeAtomicAdd(F.MOD + (size_t)(l * 16 + b) * NMOD + e, acc[b] + bb);
        }
        __syncthreads();
    }
    for (int i = gt; i < 512; i += NGT) {
        const float p0 = F.lb_params[i], p1 = F.lb_params[512 + i], p2 = F.lb_params[1024 + i], p3 = F.lb_params[1536 + i];
        const float mx = fmaxf(fmaxf(p0, p1), fmaxf(p2, p3)); const float e0 = __expf(p0 - mx), e1 = __expf(p1 - mx), e2 = __expf(p2 - mx), e3 = __expf(p3 - mx);
        const float inv = 1.0f / (e0 + e1 + e2 + e3);
        F.SMALL[SM_LB + i] = 0.f; F.SMALL[SM_LB + 512 + i] = e1 * inv; F.SMALL[SM_LB + 1024 + i] = (e1 + e2) * inv; F.SMALL[SM_LB + 1536 + i] = (e1 + e2 + e3) * inv;
    }
    for (int i = gt; i < DEPTH * 3 * NUP; i += NGT) { const int np = i % NUP, lj = i / NUP; F.SMALL[SM_CW + i] = F.conv_w[(size_t)lj * NUP + up_orig(np)]; }
    for (int i = gt; i < DEPTH * NUP; i += NGT) { const int np = i % NUP, l = i / NUP; F.SMALL[SM_CB + i] = F.conv_b[(size_t)l * NUP + up_orig(np)]; }
    for (int i = gt; i < DEPTH * 256 * 1024; i += NGT) {
        const int k = i & 1023, n = (i >> 10) & 255, l = i >> 18;
        const float* wi = F.w_in + ((size_t)l * 1024 + k) * 3600 + NINW; const float* wg = F.w_gk + (size_t)l * 16 * 256 + n;
        float s = 0.f;
#pragma unroll
        for (int r = 0; r < 16; ++r) s += wi[r] * wg[r * 256];
        F.WIN[((size_t)l * NIN + NINW + n) * 1024 + k] = (bf16)f2bf(s);
    }
    {   LAS float* scr = (LAS float*)(F.lds + F.wave * 16384);
        constexpr int I_IN = 16 * 112, I_OUT = 16 * 32, I_UP = 16 * 176, I_DN = 44 * 32, I_L = I_IN + I_OUT + I_UP + I_DN;
        for (int it = gw; it < DEPTH * I_L; it += NGW) {
            const int l = it / I_L; int r = it % I_L;
            if (r < I_IN) { const int kb = r / 112, nb = r % 112; tr_item(F.w_in + (size_t)l * 1024 * 3600, 3600, 1024, F.WIN + (size_t)l * NIN * 1024, kb, 32 * nb, 32 * nb, (nb >= 64 && nb < 72) ? 0.125f : 1.0f, scr, F.lane); continue; } r -= I_IN;
            if (r < I_OUT) { const int kb = r / 32, nb = r % 32; tr_item(F.w_out + (size_t)l * 1024 * 1024, 1024, 1024, F.WOUT + (size_t)l * 1024 * 1024, kb, 32 * nb, 32 * nb, 1.0f, scr, F.lane); continue; } r -= I_OUT;
            if (r < I_UP) { const int kb = r / 176, nb = r % 176; tr_item(F.w_up + (size_t)l * 1024 * NUP, NUP, 1024, F.WUP + (size_t)l * NUP * 1024, kb, up_orig(32 * nb), 32 * nb, 1.0f, scr, F.lane); continue; } r -= I_UP;
            { const int kb = r / 32, nb = r % 32; tr_item(F.w_down + (size_t)l * FF * 1024, 1024, FF, F.WDN + (size_t)l * 1024 * FF, kb, 32 * nb, 32 * nb, 1.0f, scr, F.lane); }
        }
    }
}

__device__ __forceinline__ void p0b(Frame& F) {
    const int gw = F.vcu * NWAVES + F.wave, NGW = F.G * NWAVES, gt = F.vcu * (NWAVES * 64) + F.tid, NGT = F.G * NWAVES * 64;
    LAS float* shL = (LAS float*)F.lds;
    for (int combo = 0; combo < 2 * DEPTH; ++combo) {
        const int l = combo >> 1, which = combo & 1;
        __syncthreads();
        for (int e = F.tid; e < 16 * 1024; e += NWAVES * 64) { const int b = e >> 10, d = e & 1023; shL[e] = F.MOD[(size_t)(l * 16 + b) * NMOD + (which ? 3072 : 0) + d]; }
        __syncthreads();
        const bf16* Wt = which ? F.WUP + (size_t)l * NUP * 1024 : F.WIN + (size_t)l * NIN * 1024; const int ncols = which ? NUP : NIN;
        float* outp = F.SMALL + (which ? SM_B2 + l * 16 * NUP : SM_B1 + l * 16 * NIN);
        for (int n = gw; n < ncols; n += NGW) {
            const GAS v2u* wr = (const GAS v2u*)(Wt + (size_t)n * 1024) + F.lane;
            float w[16];
#pragma unroll
            for (int i = 0; i < 4; ++i) { const v2u p = wr[64 * i]; w[4 * i] = bf2f(p.x & 0xffffu); w[4 * i + 1] = bf2f(p.x >> 16); w[4 * i + 2] = bf2f(p.y & 0xffffu); w[4 * i + 3] = bf2f(p.y >> 16); }
            float res = 0.f;
#pragma unroll 1
            for (int b = 0; b < 16; ++b) { float s = 0.f;
#pragma unroll
                for (int i = 0; i < 4; ++i) { const f32x4 sh = *(const LAS f32x4*)(shL + b * 1024 + 256 * i + 4 * F.lane); s += sh[0] * w[4 * i] + sh[1] * w[4 * i + 1] + sh[2] * w[4 * i + 2] + sh[3] * w[4 * i + 3]; }
                s = wave_sum(s); res = (F.lane == b) ? s : res; }
            if (F.lane < 16) outp[F.lane * ncols + n] = res + ((which == 0 && n >= NINW) ? F.b_gk[l * 256 + n - NINW] : 0.f);
        }
    }
    for (int i = gt; i < DEPTH * 16 * D; i += NGT) { const int d = i & 1023, lb = i >> 10, l = lb >> 4; const float* mod = F.MOD + (size_t)lb * NMOD;
        F.SMALL[SM_GS1 + i] = F.ln1_g[l * D + d] * (1.0f + mod[1024 + d]); F.SMALL[SM_GT1 + i] = mod[2048 + d];
        F.SMALL[SM_GS2 + i] = F.ln2_g[l * D + d] * (1.0f + mod[4096 + d]); F.SMALL[SM_GT2 + i] = mod[5120 + d]; }
    for (int row = gw; row < M; row += NGW) {
        const int b = row / SEQ; const GAS f32x4* xr = (const GAS f32x4*)(F.x + (size_t)row * D) + F.lane; const float* mod = F.MOD + (size_t)b * NMOD + 1024;
        GAS v2u* o8 = (GAS v2u*)(F.XN + (size_t)row * D) + F.lane; float ss = 0.f;
#pragma unroll
        for (int j = 0; j < 4; ++j) { const f32x4 v = xr[64 * j]; const int d = 256 * j + 4 * F.lane; const f32x4 g = *(const f32x4*)(F.ln1_g + d), sc = *(const f32x4*)(mod + d);
            ss += (v[0] * v[0] + v[1] * v[1]) + (v[2] * v[2] + v[3] * v[3]);
            v2u w; w.x = pk2(v[0] * g[0] * (1.0f + sc[0]), v[1] * g[1] * (1.0f + sc[1])); w.y = pk2(v[2] * g[2] * (1.0f + sc[2]), v[3] * g[3] * (1.0f + sc[3])); o8[64 * j] = w; }
        ss = wave_sum(ss);
        if (F.lane < 16) F.STAT[(size_t)row * 16 + F.lane] = (F.lane == 0) ? ss : 0.f;
    }
}

template <int DK, bool IS_A>
__device__ __forceinline__ void mixer_stream(Frame& F, int l, int b, int h) {
    constexpr int DKS = DK / 4, TB = 16;
    LAS float* aL = (LAS float*)F.lds; LAS float* kL = aL + TB * 128; LAS float* qL = kL + TB * 128; LAS float* vL = qL + TB * 128; LAS float* gL = vL + TB * 128;
    LAS float* part = gL + TB * 128;
    LAS float* red = part + TB * 4 * 128;
    const int tid = F.tid, j = tid & 127, sl = tid >> 7;
    const int qc = IS_A ? 128 * h : 2048 + 64 * h, fc = IS_A ? 512 + 128 * h : 2304 + 64 * h, gkc = 3584 + 64 * h;
    const int vc = IS_A ? 1024 + 128 * h : 2560 + 128 * h, gc = IS_A ? 1536 + 128 * h : 3072 + 128 * h, oc = IS_A ? 128 * h : 512 + 128 * h;
    const float* lbp = F.SMALL + SM_LB + l * 512 + 128 * h;
    const float gn = (IS_A ? F.gn_a : F.gn_b)[l * 128 + j];
    float S[DKS];
#pragma unroll
    for (int i = 0; i < DKS; ++i) S[i] = 0.f;
    for (int t0 = 0; t0 < SEQ; t0 += TB) {
        const size_t rowb = (size_t)b * SEQ + t0;
        for (int e = tid; e < TB * DK; e += NWAVES * 64) { const int tt = e / DK, i = e % DK; const bf16* pr = F.P + (rowb + tt) * NIN;
            const float q = bf2f(pr[qc + i]); float a, k;
            if (IS_A) { const float fa = bf2f(pr[fc + i]), lb = lbp[i], sg = sigmoid_f(fa); a = lb + (1.0f - lb) * sg; k = (1.0f - lb) * (1.0f - sg); }
            else { k = bf2f(pr[fc + i]); const float gk = bf2f(pr[gkc + i]); const float ls = fminf(gk, 0.f) - __logf(1.0f + __expf(-fabsf(gk))); a = __expf(ls * (1.0f / 16.0f)); }
            aL[tt * 128 + i] = a; kL[tt * 128 + i] = k; qL[tt * 128 + i] = q; }
        for (int e = tid; e < TB * 128; e += NWAVES * 64) { const int tt = e >> 7, jj = e & 127; const bf16* pr = F.P + (rowb + tt) * NIN; vL[e] = bf2f(pr[vc + jj]); gL[e] = bf2f(pr[gc + jj]); }
        __syncthreads();
#pragma unroll 1
        for (int tt = 0; tt < TB; ++tt) { const float v = vL[tt * 128 + j]; float acc = 0.f;
#pragma unroll
            for (int i4 = 0; i4 < DKS / 4; ++i4) { const f32x4 a4 = *(const LAS f32x4*)(aL + tt * 128 + sl * DKS + 4 * i4), k4 = *(const LAS f32x4*)(kL + tt * 128 + sl * DKS + 4 * i4), q4 = *(const LAS f32x4*)(qL + tt * 128 + sl * DKS + 4 * i4);
#pragma unroll
                for (int r = 0; r < 4; ++r) { S[4 * i4 + r] = a4[r] * S[4 * i4 + r] + k4[r] * v; acc += q4[r] * S[4 * i4 + r]; } }
            part[(tt * 4 + sl) * 128 + j] = acc; }
        __syncthreads();
        float o[4];
#pragma unroll
        for (int r = 0; r < 4; ++r) { const int tt = sl * 4 + r; o[r] = (part[(tt * 4 + 0) * 128 + j] + part[(tt * 4 + 1) * 128 + j]) + (part[(tt * 4 + 2) * 128 + j] + part[(tt * 4 + 3) * 128 + j]);
            const float ss = wave_sum(o[r] * o[r]); if (F.lane == 0) red[tt * 2 + ((tid >> 6) & 1)] = ss; }
        __syncthreads();
#pragma unroll
        for (int r = 0; r < 4; ++r) { const int tt = sl * 4 + r; const float tot = red[tt * 2] + red[tt * 2 + 1]; const float rn = 1.0f / sqrtf(tot * (1.0f / 128.0f) + EPS);
            const float g = gL[tt * 128 + j]; F.O[(rowb + tt) * D + oc + j] = (bf16)f2bf(o[r] * rn * gn * (g * sigmoid_f(g))); }
        __syncthreads();
    }
}
__device__ __forceinline__ void mixer_phase(Frame& F, int l) {
    for (int s = blockIdx.x; s < NB * 8; s += F.G) { const int b = s >> 3, hh = s & 7;
        if (hh < 4) mixer_stream<128, true>(F, l, b, hh); else mixer_stream<64, false>(F, l, b, hh - 4); }
}

__device__ __forceinline__ void fix_phase(Frame& F, int l) {
    const int gt = F.vcu * (NWAVES * 64) + F.tid, NGT = F.G * NWAVES * 64;
    const float* cw = F.SMALL + SM_CW + l * 3 * NUP; const float* cb = F.SMALL + SM_CB + l * NUP;
    for (int i = gt; i < 256 * FF; i += NGT) { const int pm = i / FF, f = i % FF; if ((pm & 15) == 0) continue;
        const int ca = 256 * (f >> 7) + (f & 127), cv = ca + 128;
        const float* T = F.RAWT + (size_t)(pm - 1) * 2 * NUP; const float* H = F.RAWH + (size_t)pm * 2 * NUP;
        const float a_m2 = T[ca], a_m1 = T[NUP + ca], a_0 = H[ca], a_1 = H[NUP + ca], v_m2 = T[cv], v_m1 = T[NUP + cv], v_0 = H[cv], v_1 = H[NUP + cv];
        const float wa0 = cw[ca], wa1 = cw[NUP + ca], wa2 = cw[2 * NUP + ca], wv0 = cw[cv], wv1 = cw[NUP + cv], wv2 = cw[2 * NUP + cv], ba = cb[ca], bv = cb[cv];
        const float ca0 = ba + wa0 * a_m2 + wa1 * a_m1 + wa2 * a_0, cv0 = bv + wv0 * v_m2 + wv1 * v_m1 + wv2 * v_0;
        const float ca1 = ba + wa0 * a_m1 + wa1 * a_0 + wa2 * a_1, cv1 = bv + wv0 * v_m1 + wv1 * v_0 + wv2 * v_1;
        bf16* g = F.Gb + (size_t)pm * 256 * FF + f;
        g[0] = (bf16)f2bf(ca0 * sigmoid_f(ca0) * cv0); g[FF] = (bf16)f2bf(ca1 * sigmoid_f(ca1) * cv1); }
}

__device__ __forceinline__ void final_phase(Frame& F) {
    const int gw = F.vcu * NWAVES + F.wave, NGW = F.G * NWAVES;
    for (int row = gw; row < M; row += NGW) {
        GAS f32x4* xr = (GAS f32x4*)(F.out + (size_t)row * D) + F.lane;
        float ss = (F.lane < 16) ? F.STAT[(size_t)row * 16 + F.lane] : 0.f; ss = wave_sum(ss);
        const float r = 1.0f / sqrtf(ss * (1.0f / (float)D) + EPS);
#pragma unroll
        for (int j = 0; j < 4; ++j) { const f32x4 v = xr[64 * j]; const f32x4 g = *(const f32x4*)(F.lnf_g + 256 * j + 4 * F.lane); xr[64 * j] = v * r * g; }
    }
}

struct Args { const float* in[18]; float* out; unsigned char* ws; int ph_lo, ph_hi; };
__global__ void __launch_bounds__(NWAVES * 64, 2) fwd(Args args) {
    extern __shared__ __attribute__((aligned(16))) unsigned char lds[];
    Frame F;
    F.lds = (LAS unsigned char*)lds; F.MISC = (volatile LAS unsigned*)(F.lds + MISC_OFF);
    F.tid = threadIdx.x; F.lane = F.tid & 63; F.wave = __builtin_amdgcn_readfirstlane(F.tid >> 6);
    F.G = gridDim.x; { const int bx = blockIdx.x; F.vcu = (F.G % 8 == 0) ? (bx % 8) * (F.G / 8) + bx / 8 : bx; }
    unsigned char* ws = args.ws;
    F.ctl = (unsigned*)(ws + WS_CTL);
    F.x = args.in[0]; F.c = args.in[1]; F.ln1_g = args.in[2]; F.ln2_g = args.in[3]; F.w_ada = args.in[4]; F.b_ada = args.in[5]; F.w_in = args.in[6]; F.lb_params = args.in[7];
    F.w_gk = args.in[8]; F.b_gk = args.in[9]; F.gn_a = args.in[10]; F.gn_b = args.in[11]; F.w_out = args.in[12]; F.w_up = args.in[13]; F.conv_w = args.in[14]; F.conv_b = args.in[15];
    F.w_down = args.in[16]; F.lnf_g = args.in[17]; F.out = args.out;
    F.MOD = (float*)(ws + WS_MOD); F.SMALL = (float*)(ws + WS_SMALL); F.STAT = (float*)(ws + WS_STAT); F.RAWH = (float*)(ws + WS_RAWH); F.RAWT = (float*)(ws + WS_RAWT);
    F.WIN = (bf16*)(ws + WS_WIN); F.WOUT = (bf16*)(ws + WS_WOUT); F.WUP = (bf16*)(ws + WS_WUP); F.WDN = (bf16*)(ws + WS_WDN);
    F.XN = (bf16*)(ws + WS_XN); F.O = (bf16*)(ws + WS_O); F.P = (bf16*)(ws + WS_P); F.Gb = (bf16*)(ws + WS_P);
    for (int u = F.tid; u < (LDS_BYTES - LDSCTL_OFF) / 4; u += NWAVES * 64) ((LAS unsigned*)(F.lds + LDSCTL_OFF))[u] = 0u;
    __syncthreads();
    const int lo = args.ph_lo, hi = args.ph_hi;
    XcdBarrier bar; bar.bar = F.ctl + CW_BAR; bar.x = 0; bar.st = nullptr;
    if (hi - lo > 1) bar = xcd_barrier_post(F.ctl + CW_BAR, F.MISC + 8);
#define IN(k) (lo <= (k) && (k) < hi)
#ifndef PH_MASK
#define PH_MASK 0x1ff
#endif
#define PHM(b) ((PH_MASK >> (b)) & 1)
#define SEAM(k) do { if (IN(k) && IN((k) + 1)) xcd_barrier(bar); } while (0)
    if (PHM(0) && IN(0)) p0a(F);
    SEAM(0);
    if (PHM(1) && IN(1)) p0b(F);
    SEAM(1);
    for (int l = 0; l < DEPTH; ++l) {
        const int pb = 2 + 6 * l;
#define LAUNDER_TID() do { int l_; asm volatile("v_mbcnt_lo_u32_b32 %0, -1, 0\n\tv_mbcnt_hi_u32_b32 %0, -1, %0" : "=v"(l_)); F.lane = l_; F.tid = F.wave * 64 + l_; } while (0)
        if (PHM(2) && IN(pb)) {
            LAUNDER_TID();
            pg8::Gemm g{F.XN, F.WIN + (size_t)l * NIN * 1024, M, NIN, D}; pg8::StaticOrder S; S.init(M, NIN, F.G, (int)blockIdx.x);
            pg8::EpiIn E{F.P, F.SMALL + SM_B1 + l * 16 * NIN, F.STAT};
            pg8::gemm_phase<pg8::EpiIn, pg8::StaticOrder, true, true>(F.lds, g, S, E, F.tid);
        }
        SEAM(pb);
        if (PHM(3) && IN(pb + 1)) { LAUNDER_TID(); mixer_phase(F, l); }
        SEAM(pb + 1);
        if (PHM(4) && IN(pb + 2)) {
            LAUNDER_TID();
            pg8::Gemm g{F.O, F.WOUT + (size_t)l * 1024 * 1024, M, D, D}; pg8::StaticOrder S; S.init(M, D, F.G, (int)blockIdx.x);
            pg8::EpiXUpd E{l == 0 ? F.x : F.out, F.out, F.XN, F.SMALL + SM_GT1 + l * 16 * D, F.SMALL + SM_GS2 + l * 16 * D, F.STAT};
            pg8::gemm_phase<pg8::EpiXUpd, pg8::StaticOrder, true, true>(F.lds, g, S, E, F.tid);
        }
        SEAM(pb + 2);
        if (PHM(5) && IN(pb + 3)) {
            LAUNDER_TID();
            pg8::Gemm g{F.XN, F.WUP + (size_t)l * NUP * 1024, M, NUP, D}; pg8::StaticOrder S; S.init(M, NUP, F.G, (int)blockIdx.x);
            pg8::EpiUp E{F.Gb, F.SMALL + SM_B2 + l * 16 * NUP, F.STAT, F.SMALL + SM_CW + l * 3 * NUP, F.SMALL + SM_CB + l * NUP, F.RAWH, F.RAWT, (LAS float*)(F.lds + HALO_OFF)};
            pg8::gemm_phase<pg8::EpiUp, pg8::StaticOrder, true, true>(F.lds, g, S, E, F.tid);
        }
        SEAM(pb + 3);
        if (PHM(6) && IN(pb + 4)) { LAUNDER_TID(); fix_phase(F, l); }
        SEAM(pb + 4);
        if (PHM(7) && IN(pb + 5)) {
            LAUNDER_TID();
            pg8::Gemm g{F.Gb, F.WDN + (size_t)l * 1024 * FF, M, D, FF}; pg8::StaticOrder S; S.init(M, D, F.G, (int)blockIdx.x);
            pg8::EpiXUpd E{F.out, F.out, l + 1 < DEPTH ? F.XN : (bf16*)nullptr, F.SMALL + SM_GT2 + l * 16 * D, F.SMALL + SM_GS1 + (l + 1 < DEPTH ? l + 1 : l) * 16 * D, F.STAT};
            pg8::gemm_phase<pg8::EpiXUpd, pg8::StaticOrder, true, true>(F.lds, g, S, E, F.tid);
        }
        SEAM(pb + 5);
    }
    if (PHM(8) && IN(N_PHASES - 1)) { LAUNDER_TID(); final_phase(F); }
#undef IN
#undef SEAM
}

extern "C" void kernel_launch(void* const* d_in, const int* in_sizes, int n_in, void* d_out, int out_size, void* d_ws, size_t ws_size, hipStream_t stream) {
    static int grid = 0;
    if (grid == 0) {
        if (n_in != 18 || in_sizes[0] != M * D || out_size != M * D || ws_size < WS_END) { fprintf(stderr, "kernel_launch: unexpected shapes / workspace (n_in %d, in0 %d, out %d, ws %zu < %zu); nothing launched\n", n_in, n_in > 0 ? in_sizes[0] : -1, out_size, ws_size, (size_t)WS_END); grid = -1; return; }
        int dev = 0, cus = 0, per_cu = 0;
        if (hipGetDevice(&dev) != hipSuccess || hipDeviceGetAttribute(&cus, hipDeviceAttributeMultiprocessorCount, dev) != hipSuccess) { grid = -1; return; }
        if (hipFuncSetAttribute((const void*)fwd, hipFuncAttributeMaxDynamicSharedMemorySize, LDS_BYTES) != hipSuccess) { fprintf(stderr, "kernel_launch: hipFuncSetAttribute failed\n"); grid = -1; return; }
        if (hipOccupancyMaxActiveBlocksPerMultiprocessor(&per_cu, (const void*)fwd, NWAVES * 64, LDS_BYTES) != hipSuccess || per_cu < 1) { fprintf(stderr, "kernel_launch: occupancy query says %d\n", per_cu); }
        (void)hipGetLastError();
        grid = cus;
    }
    if (grid < 0) return;
    if (hipMemsetAsync((char*)d_ws + WS_CTL, 0, CTL_ZERO_BYTES, stream) != hipSuccess) return;
    Args a{};
    for (int i = 0; i < 18; ++i) a.in[i] = (const float*)d_in[i];
    a.out = (float*)d_out; a.ws = (unsigned char*)d_ws;
#if MK_PER_PHASE
    for (int p = 0; p < N_PHASES; ++p) { a.ph_lo = p; a.ph_hi = p + 1; hipLaunchKernelGGL(fwd, dim3(grid), dim3(NWAVES * 64), LDS_BYTES, stream, a); }
#else
    a.ph_lo = 0; a.ph_hi = N_PHASES; hipLaunchKernelGGL(fwd, dim3(grid), dim3(NWAVES * 64), LDS_BYTES, stream, a);
#endif
}
```

```cpp
#include <hip/hip_runtime.h>
#include <cstdio>
#include <cstdint>
namespace pg8 {
#define PG8_LAS __attribute__((address_space(3)))
typedef unsigned short bf16_t;
typedef short bf16x8 __attribute__((ext_vector_type(8)));
typedef float f32x4 __attribute__((ext_vector_type(4)));
typedef unsigned u32x4 __attribute__((ext_vector_type(4)));
constexpr int BM = 256, BK = 64, HALF = 128, HTB = HALF * BK * 2  , STAGE_BYTES = 8 * HTB, NXCD = 8, WGM = 8;

__host__ __device__ __forceinline__ int lds_byte(int r, int c) { const int st = (r >> 4) * 2 + (c >> 5), rr = r & 15, cc = c & 31, ob = rr * 64 + cc * 2; return st * 1024 + (ob ^ (((ob >> 9) & 1) << 5)); }
__host__ __device__ __forceinline__ void stage_rc(int b, int& R, int& C) { const int st = b / 1024, sb = b % 1024, swz = sb ^ (((sb >> 9) & 1) << 5); R = (st >> 1) * 16 + swz / 64; C = (st & 1) * 32 + (swz % 64) / 2; }
__host__ __device__ __forceinline__ int perm32(int rho) { const int n = rho >> 4, i = rho & 15; return 8 * (i >> 2) + 4 * n + (i & 3); }

struct Unit { int pm, pn; };
struct Gemm { const bf16_t* A; const bf16_t* Bt; int M, N, K; };

struct StaticOrder {
    int nM, nN, nwg, G, c;
    __host__ __device__ void init(int M, int N, int G_, int c_) { nM = M / BM; nN = N / BM; nwg = nM * nN; G = G_; c = c_; }
    __host__ __device__ bool next(int i, Unit& u) const {
        const long L = (long)i * G + c; if (L >= nwg) return false;
        int wgid = (int)L; { const int q = nwg / NXCD, r = nwg % NXCD, xcd = wgid % NXCD, off = wgid / NXCD; wgid = (xcd < r ? xcd * (q + 1) : r * (q + 1) + (xcd - r) * q) + off; }
        const int nig = WGM * nN, gid = wgid / nig, fm = gid * WGM, gsz = (nM - fm) < WGM ? (nM - fm) : WGM;
        u.pm = fm + ((wgid % nig) % gsz); u.pn = (wgid % nig) / gsz; return true;
    }
    __device__ __forceinline__ void a_ready(const Unit&) const {}
    __device__ __forceinline__ void done(const Unit&) const {}
};

__device__ __forceinline__ unsigned cvt_pk_bf16(float lo, float hi) { unsigned r; asm volatile("v_cvt_pk_bf16_f32 %0, %1, %2" : "=v"(r) : "v"(lo), "v"(hi)); return r; }
typedef unsigned u32x2 __attribute__((ext_vector_type(2)));
constexpr int ROWS_PER_SEQ_TILES = 16;
constexpr float RMS_EPS = 1e-6f;
constexpr int D_MODEL = 1024, N_IN = 3840, N_UP = 5632, N_FF = 2816;

__device__ __forceinline__ float row_rscale(const float* stat, int row, int fq) {
    const f32x4 sp = *(const f32x4*)(stat + (size_t)row * 16 + 4 * fq);
    float s = (sp[0] + sp[1]) + (sp[2] + sp[3]);
    s += __shfl_xor(s, 16); s += __shfl_xor(s, 32);
    return 1.0f / sqrtf(s * (1.0f / (float)D_MODEL) + RMS_EPS);
}

struct EpiIn {
    static constexpr bool PERM = true, AFTER_DRAIN = false;
    bf16_t* P; const float* bias; const float* stat;
    __device__ __forceinline__ void operator()(f32x4 (&acc)[2][2][4][2], const Unit& u, int wr, int wc, int fr, int fq) const {
        const int row0 = u.pm * BM + wr * 64 + fr, b = u.pm / ROWS_PER_SEQ_TILES, col0 = u.pn * BM + wc * 32 + 8 * fq;
        const float* bp = bias + (size_t)b * N_IN + col0;
        f32x4 bv[2][2];
#pragma unroll
        for (int bj = 0; bj < 2; ++bj)
#pragma unroll
            for (int n = 0; n < 2; ++n) bv[bj][n] = *(const f32x4*)(bp + bj * HALF + 4 * n);
#pragma unroll
        for (int ai = 0; ai < 2; ++ai)
#pragma unroll
            for (int m = 0; m < 4; ++m) { const int row = row0 + ai * HALF + m * 16; const float r = row_rscale(stat, row, fq);
                bf16_t* rowp = P + (size_t)row * N_IN + col0;
#pragma unroll
                for (int bj = 0; bj < 2; ++bj) { const f32x4 v0 = acc[ai][bj][m][0] * r + bv[bj][0], v1 = acc[ai][bj][m][1] * r + bv[bj][1];
                    u32x4 w; w.x = cvt_pk_bf16(v0[0], v0[1]); w.y = cvt_pk_bf16(v0[2], v0[3]); w.z = cvt_pk_bf16(v1[0], v1[1]); w.w = cvt_pk_bf16(v1[2], v1[3]);
                    *(u32x4*)(rowp + bj * HALF) = w; } }
    }
};

struct EpiXUpd {
    static constexpr bool PERM = true, AFTER_DRAIN = false;
    const float* xold; float* xnew; bf16_t* XN; const float* gt; const float* gsn; float* stat;
    __device__ __forceinline__ void operator()(f32x4 (&acc)[2][2][4][2], const Unit& u, int wr, int wc, int fr, int fq) const {
        const int row0 = u.pm * BM + wr * 64 + fr, b = u.pm / ROWS_PER_SEQ_TILES, col0 = u.pn * BM + wc * 32 + 8 * fq;
        f32x4 g[2][2], s[2][2];
#pragma unroll
        for (int bj = 0; bj < 2; ++bj)
#pragma unroll
            for (int n = 0; n < 2; ++n) { g[bj][n] = *(const f32x4*)(gt + (size_t)b * D_MODEL + col0 + bj * HALF + 4 * n);
                s[bj][n] = XN ? *(const f32x4*)(gsn + (size_t)b * D_MODEL + col0 + bj * HALF + 4 * n) : (f32x4){0.f, 0.f, 0.f, 0.f}; }
#pragma unroll
        for (int ai = 0; ai < 2; ++ai)
#pragma unroll
            for (int m = 0; m < 4; ++m) { const int row = row0 + ai * HALF + m * 16; const size_t off = (size_t)row * D_MODEL + col0; float ss = 0.f;
#pragma unroll
                for (int bj = 0; bj < 2; ++bj) {
                    const f32x4 x0 = *(const f32x4*)(xold + off + bj * HALF) + g[bj][0] * acc[ai][bj][m][0], x1 = *(const f32x4*)(xold + off + bj * HALF + 4) + g[bj][1] * acc[ai][bj][m][1];
                    *(f32x4*)(xnew + off + bj * HALF) = x0; *(f32x4*)(xnew + off + bj * HALF + 4) = x1;
                    ss += (x0[0] * x0[0] + x0[1] * x0[1]) + (x0[2] * x0[2] + x0[3] * x0[3]) + (x1[0] * x1[0] + x1[1] * x1[1]) + (x1[2] * x1[2] + x1[3] * x1[3]);
                    if (XN) { const f32x4 y0 = x0 * s[bj][0], y1 = x1 * s[bj][1];
                        u32x4 w; w.x = cvt_pk_bf16(y0[0], y0[1]); w.y = cvt_pk_bf16(y0[2], y0[3]); w.z = cvt_pk_bf16(y1[0], y1[1]); w.w = cvt_pk_bf16(y1[2], y1[3]);
                        *(u32x4*)(XN + off + bj * HALF) = w; } }
                ss += __shfl_xor(ss, 16); ss += __shfl_xor(ss, 32);
                if (fq == 0) stat[(size_t)row * 16 + u.pn * 4 + wc] = ss; }
    }
};

__device__ __forceinline__ float dpp_ror1(float v) { return __builtin_bit_cast(float, __builtin_amdgcn_update_dpp(0, __builtin_bit_cast(int, v), 0x121, 0xf, 0xf, false)); }
__device__ __forceinline__ float dpp_ror2(float v) { return __builtin_bit_cast(float, __builtin_amdgcn_update_dpp(0, __builtin_bit_cast(int, v), 0x122, 0xf, 0xf, false)); }
__device__ __forceinline__ float silu_f(float x) { return x / (1.0f + __expf(-x)); }
struct EpiUp {
    static constexpr bool PERM = true, AFTER_DRAIN = false;
    bf16_t* G; const float* bias; const float* stat; const float* cw; const float* cb; float* rawh; float* rawt; PG8_LAS float* halo;
    __device__ __forceinline__ void operator()(f32x4 (&acc)[2][2][4][2], const Unit& u, int wr, int wc, int fr, int fq) const {
        const int row0 = u.pm * BM + wr * 64 + fr, b = u.pm / ROWS_PER_SEQ_TILES, tc0 = wc * 32 + 8 * fq, col0 = u.pn * BM + tc0;
        {   f32x4 bv[2][2];
#pragma unroll
            for (int bj = 0; bj < 2; ++bj)
#pragma unroll
                for (int n = 0; n < 2; ++n) bv[bj][n] = *(const f32x4*)(bias + (size_t)b * N_UP + col0 + bj * HALF + 4 * n);
#pragma unroll
            for (int ai = 0; ai < 2; ++ai)
#pragma unroll
                for (int m = 0; m < 4; ++m) { const float r = row_rscale(stat, row0 + ai * HALF + m * 16, fq);
#pragma unroll
                    for (int bj = 0; bj < 2; ++bj)
#pragma unroll
                        for (int n = 0; n < 2; ++n) acc[ai][bj][m][n] = acc[ai][bj][m][n] * r + bv[bj][n];
                    asm volatile("" : "+v"(acc[ai][0][m][0]), "+v"(acc[ai][0][m][1]), "+v"(acc[ai][1][m][0]), "+v"(acc[ai][1][m][1]));
                    if (m & 1) asm volatile("" ::: "memory"); } }
#pragma unroll
        for (int ai = 0; ai < 2; ++ai) {
            if (fr >= 14) {
                PG8_LAS float* hp = halo + ((ai * 2 + wr) * 2 + (fr - 14)) * 256 + tc0;
#pragma unroll
                for (int bj = 0; bj < 2; ++bj)
#pragma unroll
                    for (int n = 0; n < 2; ++n) *(PG8_LAS f32x4*)(hp + bj * HALF + 4 * n) = acc[ai][bj][3][n];
            }
        }
        if (wr == 0 && fr < 2) { float* hp = rawh + ((size_t)u.pm * 2 + fr) * N_UP + col0;
#pragma unroll
            for (int bj = 0; bj < 2; ++bj)
#pragma unroll
                for (int n = 0; n < 2; ++n) *(f32x4*)(hp + bj * HALF + 4 * n) = acc[0][bj][0][n]; }
        if (wr == 1 && fr >= 14) { float* tp = rawt + ((size_t)u.pm * 2 + (fr - 14)) * N_UP + col0;
#pragma unroll
            for (int bj = 0; bj < 2; ++bj)
#pragma unroll
                for (int n = 0; n < 2; ++n) *(f32x4*)(tp + bj * HALF + 4 * n) = acc[1][bj][3][n]; }
        asm volatile("s_waitcnt lgkmcnt(0)" ::: "memory"); __builtin_amdgcn_s_barrier(); asm volatile("" ::: "memory");
        const bool f0 = (fr == 0), f01 = (fr < 2);
#pragma unroll
        for (int n = 0; n < 2; ++n) {
            f32x4 w0[2], w1[2], w2[2], cbv[2];
#pragma unroll
            for (int bj = 0; bj < 2; ++bj) { const int c = col0 + bj * HALF + 4 * n;
                w0[bj] = *(const f32x4*)(cw + c); w1[bj] = *(const f32x4*)(cw + N_UP + c); w2[bj] = *(const f32x4*)(cw + 2 * N_UP + c); cbv[bj] = *(const f32x4*)(cb + c); }
#pragma unroll
            for (int ai = 0; ai < 2; ++ai) {
                f32x4 prev[2];
                {   const int pai = (wr == 1) ? ai : ai - 1, pwr = (wr == 1) ? 0 : 1;
                    const bool has = (pai >= 0);
                    const PG8_LAS float* hp = halo + ((pai * 2 + pwr) * 2 + (fr & 1)) * 256 + tc0 + 4 * n;
#pragma unroll
                    for (int bj = 0; bj < 2; ++bj) prev[bj] = (has && fr >= 14) ? *(const PG8_LAS f32x4*)(hp + bj * HALF) : (f32x4){0.f, 0.f, 0.f, 0.f}; }
#pragma unroll
                for (int m = 0; m < 4; ++m) {
                    f32x4 cu[2];
#pragma unroll
                    for (int bj = 0; bj < 2; ++bj) { const f32x4 cur = acc[ai][bj][m][n], pv = prev[bj]; f32x4 o;
#pragma unroll
                        for (int j = 0; j < 4; ++j) { const float c1 = dpp_ror1(cur[j]), p1 = dpp_ror1(pv[j]), c2 = dpp_ror2(cur[j]), p2 = dpp_ror2(pv[j]);
                            const float s1 = f0 ? p1 : c1, s2 = f01 ? p2 : c2;
                            o[j] = cbv[bj][j] + w0[bj][j] * s2 + w1[bj][j] * s1 + w2[bj][j] * cur[j]; }
                        cu[bj] = o; prev[bj] = cur; }
                    f32x4 g;
#pragma unroll
                    for (int j = 0; j < 4; ++j) g[j] = silu_f(cu[0][j]) * cu[1][j];
                    u32x2 w; w.x = cvt_pk_bf16(g[0], g[1]); w.y = cvt_pk_bf16(g[2], g[3]);
                    *(u32x2*)(G + (size_t)(row0 + ai * HALF + m * 16) * N_FF + u.pn * HALF + tc0 + 4 * n) = w;
                }
            }
            asm volatile("" ::: "memory");
        }
    }
};
template <class Epi, class Sched, bool ALIGN_EPI = false, bool SP2 = false>
__device__ __forceinline__ void gemm_phase(PG8_LAS unsigned char* lds, const Gemm g, const Sched& S, const Epi& E, const int tid) {
    const int wid = __builtin_amdgcn_readfirstlane(tid >> 6), lane = tid & 63, wr = wid >> 2, wc = wid & 3, fr = lane & 15, fq = lane >> 4;
    const int K = g.K, nt = K / BK;
    unsigned voffA[2], voffB[2];
#pragma unroll
    for (int i = 0; i < 2; ++i) { int R, C; stage_rc(tid * 16 + i * 8192, R, C); const int Rb = Epi::PERM ? ((R & ~31) + perm32(R & 31)) : R;
        voffA[i] = (unsigned)(R * K + C) * 2u; voffB[i] = (unsigned)(Rb * K + C) * 2u; }
    const size_t kstep = (size_t)(BK * 2);
    const size_t hstep = (size_t)HALF * K * 2;
    const size_t tstep = 2 * hstep;
    const unsigned ldsw = (unsigned)wid * 1024u;
    const int aoff = lds_byte(wr * 64 + fr, fq * 8), boff = lds_byte(wc * 32 + fr, fq * 8);
#define PG8_SA(b, h) (((b) * 2 + (h)) * HTB)
#define PG8_SB(b, h) ((4 + (b) * 2 + (h)) * HTB)
#define PG8_STAGE(bufoff, gbase, voff) do { _Pragma("unroll") for (int _i = 0; _i < 2; ++_i) \
        __builtin_amdgcn_global_load_lds((const unsigned*)((const char*)(gbase) + (voff)[_i]), (PG8_LAS unsigned*)(lds + (bufoff) + ldsw + _i * 8192), 16, 0, 0); } while (0)
#define PG8_LDA(dst, b, h) do { _Pragma("unroll") for (int m = 0; m < 4; ++m) _Pragma("unroll") for (int k = 0; k < 2; ++k) dst[m][k] = *(const PG8_LAS bf16x8*)(lds + PG8_SA(b, h) + aoff + m * 2048 + k * 1024); } while (0)
#define PG8_LDB(dst, b, h) do { _Pragma("unroll") for (int n = 0; n < 2; ++n) _Pragma("unroll") for (int k = 0; k < 2; ++k) dst[n][k] = *(const PG8_LAS bf16x8*)(lds + PG8_SB(b, h) + boff + n * 2048 + k * 1024); } while (0)
#define PG8_MMA(ai, bj, At, Bt) do { __builtin_amdgcn_s_setprio(1); _Pragma("unroll") for (int m = 0; m < 4; ++m) _Pragma("unroll") for (int n = 0; n < 2; ++n) _Pragma("unroll") for (int k = 0; k < 2; ++k) \
        acc[ai][bj][m][n] = __builtin_amdgcn_mfma_f32_16x16x32_bf16(Bt[n][k], At[m][k], acc[ai][bj][m][n], 0, 0, 0); __builtin_amdgcn_s_setprio(0); } while (0)
#define PG8_WAIT_V(n) asm volatile("s_waitcnt vmcnt(" #n ")" ::: "memory")
#define PG8_WAIT_L(n) asm volatile("s_waitcnt lgkmcnt(" #n ")" ::: "memory")
#define PG8_BAR __builtin_amdgcn_s_barrier()
#define PG8_SCHED __builtin_amdgcn_sched_barrier(0)
    Unit cur, nxt; int ui = 0;
    if (!S.next(0, cur)) return;
    f32x4 acc[2][2][4][2];
#pragma unroll
    for (int a = 0; a < 2; ++a)
#pragma unroll
        for (int b = 0; b < 2; ++b)
#pragma unroll
            for (int m = 0; m < 4; ++m)
#pragma unroll
                for (int n = 0; n < 2; ++n) acc[a][b][m][n] = (f32x4){0.f, 0.f, 0.f, 0.f};
    bf16x8 At[4][2], B0[2][2], B1[2][2];
    const char* cA = (const char*)g.A + (size_t)cur.pm * tstep; const char* cB = (const char*)g.Bt + (size_t)cur.pn * tstep;
    S.a_ready(cur);
    if constexpr (SP2) {
        PG8_STAGE(PG8_SB(0, 0), cB, voffB); PG8_STAGE(PG8_SB(0, 1), cB + hstep, voffB); PG8_STAGE(PG8_SA(0, 0), cA, voffA); PG8_STAGE(PG8_SA(0, 1), cA + hstep, voffA);
        if (wr == 1) PG8_BAR;
        PG8_WAIT_V(2); PG8_BAR;
        PG8_STAGE(PG8_SB(1, 0), cB + kstep, voffB); PG8_STAGE(PG8_SA(1, 0), cA + kstep, voffA); PG8_STAGE(PG8_SB(1, 1), cB + hstep + kstep, voffB);
        PG8_WAIT_V(6); PG8_BAR;
    } else {
        PG8_STAGE(PG8_SB(0, 0), cB, voffB); PG8_STAGE(PG8_SA(0, 0), cA, voffA); PG8_STAGE(PG8_SB(0, 1), cB + hstep, voffB); PG8_STAGE(PG8_SA(0, 1), cA + hstep, voffA);
        if (wr == 1) PG8_BAR;
        PG8_WAIT_V(4); PG8_BAR;
        PG8_STAGE(PG8_SB(1, 0), cB + kstep, voffB); PG8_STAGE(PG8_SA(1, 0), cA + kstep, voffA); PG8_STAGE(PG8_SB(1, 1), cB + hstep + kstep, voffB);
        PG8_WAIT_V(6); PG8_BAR;
    }
    for (;;) {
        const bool has_next = S.next(ui + 1, nxt);
        const char* nA = has_next ? (const char*)g.A + (size_t)nxt.pm * tstep : cA; const char* nB = has_next ? (const char*)g.Bt + (size_t)nxt.pn * tstep : cB;
        for (int t = 0; t < nt; t += 2) {
            const bool last = (t == nt - 2);
            const char* a1 = cA + (size_t)(t + 1) * kstep;
            const char* a2 = last ? nA : cA + (size_t)(t + 2) * kstep; const char* b2 = last ? nB : cB + (size_t)(t + 2) * kstep;
            const char* a3 = a2 + kstep; const char* b3 = b2 + kstep;
            if (last && has_next) S.a_ready(nxt);
            if constexpr (SP2) {
            PG8_LDB(B0, 0, 0); PG8_LDB(B1, 0, 1); PG8_SCHED; PG8_LDA(At, 0, 0); PG8_STAGE(PG8_SA(1, 1), a1 + hstep, voffA);
            PG8_WAIT_V(8); PG8_WAIT_L(0); PG8_BAR; PG8_MMA(0, 0, At, B0); PG8_MMA(0, 1, At, B1); PG8_BAR; PG8_SCHED;
            PG8_LDA(At, 0, 1); PG8_STAGE(PG8_SB(0, 0), b2, voffB); PG8_STAGE(PG8_SB(0, 1), b2 + hstep, voffB); PG8_STAGE(PG8_SA(0, 0), a2, voffA);
            PG8_WAIT_V(8); PG8_WAIT_L(0); PG8_BAR; PG8_MMA(1, 0, At, B0); PG8_MMA(1, 1, At, B1); PG8_BAR; PG8_SCHED;
            PG8_LDB(B0, 1, 0); PG8_LDB(B1, 1, 1); PG8_SCHED; PG8_LDA(At, 1, 0); PG8_STAGE(PG8_SA(0, 1), a2 + hstep, voffA);
            PG8_WAIT_V(8); PG8_WAIT_L(0); PG8_BAR; PG8_MMA(0, 0, At, B0); PG8_MMA(0, 1, At, B1); PG8_BAR; PG8_SCHED;
            PG8_LDA(At, 1, 1); PG8_STAGE(PG8_SB(1, 0), b3, voffB); PG8_STAGE(PG8_SB(1, 1), b3 + hstep, voffB); PG8_STAGE(PG8_SA(1, 0), a3, voffA);
            PG8_WAIT_V(8); PG8_WAIT_L(0); PG8_BAR; PG8_MMA(1, 0, At, B0); PG8_MMA(1, 1, At, B1); PG8_BAR; PG8_SCHED;
            } else {
            PG8_LDB(B0, 0, 0); PG8_SCHED; PG8_LDA(At, 0, 0); PG8_STAGE(PG8_SA(1, 1), a1 + hstep, voffA);
            PG8_WAIT_L(8); PG8_BAR; PG8_WAIT_L(0); PG8_MMA(0, 0, At, B0); PG8_BAR; PG8_SCHED;
            PG8_LDB(B1, 0, 1); PG8_STAGE(PG8_SB(0, 0), b2, voffB);
            PG8_BAR; PG8_WAIT_L(0); PG8_MMA(0, 1, At, B1); PG8_BAR;
            PG8_LDA(At, 0, 1); PG8_STAGE(PG8_SA(0, 0), a2, voffA);
            PG8_BAR; PG8_WAIT_L(0); PG8_MMA(1, 0, At, B0); PG8_BAR; PG8_SCHED;
            PG8_STAGE(PG8_SB(0, 1), b2 + hstep, voffB);
            PG8_WAIT_V(6); PG8_BAR; PG8_MMA(1, 1, At, B1); PG8_BAR;
            PG8_LDB(B0, 1, 0); PG8_SCHED; PG8_LDA(At, 1, 0); PG8_STAGE(PG8_SA(0, 1), a2 + hstep, voffA);
            PG8_WAIT_L(8); PG8_BAR; PG8_WAIT_L(0); PG8_MMA(0, 0, At, B0); PG8_BAR; PG8_SCHED;
            PG8_LDB(B1, 1, 1); PG8_STAGE(PG8_SB(1, 0), b3, voffB);
            PG8_BAR; PG8_WAIT_L(0); PG8_MMA(0, 1, At, B1); PG8_BAR;
            PG8_LDA(At, 1, 1); PG8_STAGE(PG8_SA(1, 0), a3, voffA);
            PG8_BAR; PG8_WAIT_L(0); PG8_MMA(1, 0, At, B0); PG8_BAR; PG8_SCHED;
            PG8_STAGE(PG8_SB(1, 1), b3 + hstep, voffB);
            PG8_WAIT_V(6); PG8_BAR; PG8_MMA(1, 1, At, B1); PG8_BAR;
            }
        }
        if constexpr (ALIGN_EPI) { if (wr == 0) PG8_BAR; }
        if constexpr (!Epi::AFTER_DRAIN) { int lane_e; asm volatile("v_mbcnt_lo_u32_b32 %0, -1, 0\n\tv_mbcnt_hi_u32_b32 %0, -1, %0" : "=v"(lane_e));
            const int fr_e = lane_e & 15, fq_e = lane_e >> 4; int wr_e = wr, wc_e = wc; asm volatile("" : "+s"(wr_e), "+s"(wc_e));
            E(acc, cur, wr_e, wc_e, fr_e, fq_e); S.done(cur); }
        if (!has_next) break;
#pragma unroll
        for (int a = 0; a < 2; ++a)
#pragma unroll
            for (int b = 0; b < 2; ++b)
#pragma unroll
                for (int m = 0; m < 4; ++m)
#pragma unroll
                    for (int n = 0; n < 2; ++n) acc[a][b][m][n] = (f32x4){0.f, 0.f, 0.f, 0.f};
        cur = nxt; cA = nA; cB = nB; ++ui;
        if constexpr (ALIGN_EPI) { if (wr == 1) PG8_BAR; }
    }
    PG8_WAIT_V(0);
    if constexpr (!ALIGN_EPI) { if (wr == 0) PG8_BAR; }
    PG8_BAR;
    if constexpr (Epi::AFTER_DRAIN) { E.fused(acc, cur, wr, wc, fr, fq, lds, wid, lane); S.done(cur); }
#undef PG8_SA
#undef PG8_SB
#undef PG8_STAGE
#undef PG8_LDA
#undef PG8_LDB
#undef PG8_MMA
#undef PG8_WAIT_V
#undef PG8_WAIT_L
#undef PG8_BAR
#undef PG8_SCHED
}
}

constexpr int NWAVES = 8;
#ifndef MK_PER_PHASE
#define MK_PER_PHASE 0
#endif
constexpr int NB = 16, SEQ = 4096, D = 1024, DEPTH = 4, M = NB * SEQ;
constexpr int NIN = 3840, NINW = 3584, FF = 2816, NUP = 5632, NMOD = 6144;
constexpr float EPS = 1e-6f;
constexpr int N_PHASES = 2 + 6 * DEPTH + 1;

constexpr size_t MiB = 1u << 20;
constexpr size_t WS_CTL = 0, CTL_ZERO_BYTES = 4 * MiB;
constexpr size_t WS_MOD = 2 * MiB;
constexpr size_t WS_SMALL = 4 * MiB;
constexpr size_t WS_STAT = 12 * MiB;
constexpr size_t WS_RAWH = 16 * MiB, WS_RAWT = 28 * MiB;
constexpr size_t WS_WIN = 40 * MiB;
constexpr size_t WS_WOUT = 70 * MiB;
constexpr size_t WS_WUP = 78 * MiB;
constexpr size_t WS_WDN = 122 * MiB;
constexpr size_t WS_XN = 144 * MiB;
constexpr size_t WS_O = 272 * MiB;
constexpr size_t WS_P = 400 * MiB;
constexpr size_t WS_END = 880 * MiB;
constexpr int SM_LB = 0;
constexpr int SM_CW = SM_LB + 4 * 512;
constexpr int SM_CB = SM_CW + 4 * 3 * NUP;
constexpr int SM_GS1 = SM_CB + 4 * NUP;
constexpr int SM_GS2 = SM_GS1 + 4 * 16 * D;
constexpr int SM_GT1 = SM_GS2 + 4 * 16 * D;
constexpr int SM_GT2 = SM_GT1 + 4 * 16 * D;
constexpr int SM_B1 = SM_GT2 + 4 * 16 * D;
constexpr int SM_B2 = SM_B1 + 4 * 16 * NIN;
constexpr int SM_END = SM_B2 + 4 * 16 * NUP;
static_assert((size_t)SM_END * 4 <= 8 * MiB, "small vectors fit");
constexpr int CW_BAR = 4096;

constexpr int RING_BYTES = 131072, HALO_OFF = RING_BYTES, HALO_BYTES = 8192, LDSCTL_OFF = HALO_OFF + HALO_BYTES, MISC_OFF = LDSCTL_OFF + 320;
constexpr int LDS_BYTES = 147456;
static_assert(MISC_OFF + 128 <= LDS_BYTES, "LDS map");

#define GAS __attribute__((address_space(1)))
#define LAS __attribute__((address_space(3)))
typedef unsigned short bf16;
typedef unsigned v4u __attribute__((ext_vector_type(4)));
typedef unsigned v2u __attribute__((ext_vector_type(2)));
typedef float f32x4 __attribute__((ext_vector_type(4)));
#define LDS_WAIT() asm volatile("s_waitcnt lgkmcnt(0)" ::: "memory")
__device__ __forceinline__ unsigned f2bf(float f) { unsigned u = __builtin_bit_cast(unsigned, f); return (u + 0x7fffu + ((u >> 16) & 1u)) >> 16; }
__device__ __forceinline__ unsigned pk2(float lo, float hi) { return f2bf(lo) | (f2bf(hi) << 16); }
__device__ __forceinline__ float bf2f(unsigned h) { return __builtin_bit_cast(float, h << 16); }
__device__ __forceinline__ float wave_sum(float v) {
#pragma unroll
    for (int o = 1; o < 64; o <<= 1) v += __shfl_xor(v, o);
    return v;
}
__device__ __forceinline__ float sigmoid_f(float x) { return 1.0f / (1.0f + __expf(-x)); }
#define XB_TMO      128
#define XB_XCNT(j)  (256  + 64 * (j))
#define XB_XSUB(j)  (1280 + 64 * (j))
#define XB_XGEN(j)  (2304 + 64 * (j))
#define XB_TOP      3328
#define XB_TOPGEN   3392
#define XCD_BAR_WORDS 3456
#define XB_SPIN_CAP (1u << 18)

__device__ __forceinline__ unsigned xb_ld(unsigned* p)              { return __hip_atomic_load(p, __ATOMIC_RELAXED, __HIP_MEMORY_SCOPE_AGENT); }
__device__ __forceinline__ unsigned xb_add(unsigned* p, unsigned v) { return __hip_atomic_fetch_add(p, v, __ATOMIC_RELAXED, __HIP_MEMORY_SCOPE_AGENT); }
__device__ __forceinline__ unsigned xb_xcc_id() { return (unsigned)__builtin_amdgcn_s_getreg((3 << 11) | 20) & 0xFu; }
#define XB_SPIN(cond, bar) do { unsigned _sp = 0; while (cond) { __builtin_amdgcn_s_sleep(1); \
    if ((++_sp & 255u) == 0u) { if (xb_ld(&(bar)[XB_TMO])) break; if (_sp > XB_SPIN_CAP) { atomicAdd(&(bar)[XB_TMO], 1u); break; } } } } while (0)

struct XcdBarrier {
    unsigned* bar; unsigned x;
    volatile LAS unsigned* st;
};

__device__ __forceinline__ XcdBarrier xcd_barrier_post(unsigned* bar, volatile LAS unsigned* st) {
    XcdBarrier b; b.bar = bar; b.x = xb_xcc_id(); b.st = st;
    if (threadIdx.x == 0) (void)xb_add(&bar[XB_XCNT(b.x)], 1u);
    return b;
}
__device__ __forceinline__ void xcd_barrier_complete(unsigned* bar, unsigned x, unsigned& nloc, unsigned& nx) {
    const unsigned G = gridDim.x * gridDim.y * gridDim.z;
    unsigned sum, cnt, mine, sp = 0u;
    for (;;) {
        sum = 0u; cnt = 0u; mine = 0u;
#pragma unroll
        for (unsigned j = 0; j < 16; ++j) { const unsigned c = xb_ld(&bar[XB_XCNT(j)]); sum += c; cnt += (c > 0u) ? 1u : 0u; mine = (j == x) ? c : mine; }
        if (sum == G) break;
        __builtin_amdgcn_s_sleep(1);
        if ((++sp & 255u) == 0u) { if (xb_ld(&bar[XB_TMO])) break; if (sp > XB_SPIN_CAP) { atomicAdd(&bar[XB_TMO], 1u); break; } }
    }
    nloc = mine > 0u ? mine : 1u; nx = cnt > 0u ? cnt : 1u;
}

__device__ __forceinline__ void xcd_barrier(const XcdBarrier& b) {
    asm volatile("s_waitcnt vmcnt(0)" ::: "memory");
    __syncthreads();
    if (threadIdx.x == 0) {
        unsigned* bar = b.bar;
        __builtin_amdgcn_s_waitcnt(0);
        unsigned nloc = b.st[0], nx = b.st[1];
        if (nloc == 0u) { xcd_barrier_complete(bar, b.x, nloc, nx); b.st[0] = nloc; b.st[1] = nx; }
        const unsigned old = xb_add(&bar[XB_XSUB(b.x)], 1u);
        const unsigned gen = old / nloc;
        if (old + 1u == (gen + 1u) * nloc) {
            __builtin_amdgcn_fence(__ATOMIC_RELEASE, "agent");
            asm volatile("s_waitcnt vmcnt(0)" ::: "memory");
            const unsigned og = xb_add(&bar[XB_TOP], 1u);
            const unsigned tg = og / nx;
            if (og + 1u == (tg + 1u) * nx) xb_add(&bar[XB_TOPGEN], 1u);
            else XB_SPIN(xb_ld(&bar[XB_TOPGEN]) == tg, bar);
            __builtin_amdgcn_fence(__ATOMIC_ACQUIRE, "agent");
            xb_add(&bar[XB_XGEN(b.x)], 1u);
            asm volatile("s_waitcnt vmcnt(0)" ::: "memory");
        } else {
            XB_SPIN(xb_ld(&bar[XB_XGEN(b.x)]) == gen, bar);
            __builtin_amdgcn_fence(__ATOMIC_ACQUIRE, "agent");
            asm volatile("s_waitcnt vmcnt(0)" ::: "memory");
        }
    }
    __syncthreads();
}

struct Frame {
    LAS unsigned char* lds;
    volatile LAS unsigned* MISC;
    unsigned* ctl;
    int tid, lane, wave, vcu, G;
    const float *x, *c, *ln1_g, *ln2_g, *w_ada, *b_ada, *w_in, *lb_params, *w_gk, *b_gk, *gn_a, *gn_b, *w_out, *w_up, *conv_w, *conv_b, *w_down, *lnf_g;
    float* out;
    float *MOD, *SMALL, *STAT, *RAWH, *RAWT;
    bf16 *WIN, *WOUT, *WUP, *WDN, *XN, *O, *P, *Gb;
};

__device__ __forceinline__ void tr_item(const float* W, int Nsrc, int K, bf16* WT, int kb, int sn0, int dn0, float scale, LAS float* scr, int lane) {
    const int k0 = 64 * kb;
#pragma unroll 8
    for (int i = 0; i < 32; ++i) { const int kk = 2 * i + (lane >> 5); scr[kk * 33 + (lane & 31)] = W[(size_t)(k0 + kk) * Nsrc + sn0 + (lane & 31)]; }
    LDS_WAIT(); asm volatile("" ::: "memory");
    const int c = lane & 7;
#pragma unroll
    for (int j = 0; j < 4; ++j) { const int n = (lane >> 3) + 8 * j; const LAS float* s = scr + (8 * c) * 33 + n;
        v4u o; o.x = pk2(s[0 * 33] * scale, s[1 * 33] * scale); o.y = pk2(s[2 * 33] * scale, s[3 * 33] * scale); o.z = pk2(s[4 * 33] * scale, s[5 * 33] * scale); o.w = pk2(s[6 * 33] * scale, s[7 * 33] * scale);
        *(GAS v4u*)(WT + (size_t)(dn0 + n) * K + k0 + 8 * c) = o; }
    LDS_WAIT(); asm volatile("" ::: "memory");
}
__host__ __device__ __forceinline__ int up_orig(int np) { return ((np & 255) >> 7) * FF + 128 * (np >> 8) + (np & 127); }

__device__ __forceinline__ void p0a(Frame& F) {
    const int gw = F.vcu * NWAVES + F.wave, NGW = F.G * NWAVES, gt = F.vcu * (NWAVES * 64) + F.tid, NGT = F.G * NWAVES * 64;
    {
        LAS float* cond = (LAS float*)F.lds;
        for (int e = F.tid; e < 16 * 1024; e += NWAVES * 64) { const int b = e >> 10, d = e & 1023; const float cv = F.c[b * 1024 + d]; cond[d * 16 + b] = cv * sigmoid_f(cv); }
        __syncthreads();
        for (int it = gw; it < DEPTH * 384; it += NGW) {
            const int cb = it % 384, l = it / 384, e = cb * 16 + (F.lane & 15), dq = F.lane >> 4;
            const float* w = F.w_ada + ((size_t)l * 1024 + dq) * NMOD + e;
            float acc[16];
#pragma unroll
            for (int b = 0; b < 16; ++b) acc[b] = 0.f;
#pragma unroll 4
            for (int dd = 0; dd < 256; ++dd) {
                const float wv = w[(size_t)(4 * dd) * NMOD];
                const LAS f32x4* cp = (const LAS f32x4*)(cond + (4 * dd + dq) * 16);
#pragma unroll
                for (int q = 0; q < 4; ++q) { const f32x4 cq = cp[q]; acc[4 * q] += cq[0] * wv; acc[4 * q + 1] += cq[1] * wv; acc[4 * q + 2] += cq[2] * wv; acc[4 * q + 3] += cq[3] * wv; }
            }
            const float bb = F.b_ada[l * NMOD + e];
#pragma unroll
            for (int b = 0; b < 16; ++b) { float v = acc[b]; v += __shfl_xor(v, 16); v += __shfl_xor(v, 32); if (dq == 0) F.MOD[(size_t)(l * 16 + b) * NMOD + e] = v + bb; }
        }
        __syncthreads();
    }
    for (int i = gt; i < 512; i += NGT) {
        const float p0 = F.lb_params[i], p1 = F.lb_params[512 + i], p2 = F.lb_params[1024 + i], p3 = F.lb_params[1536 + i];
        const float mx = fmaxf(fmaxf(p0, p1), fmaxf(p2, p3)); const float e0 = __expf(p0 - mx), e1 = __expf(p1 - mx), e2 = __expf(p2 - mx), e3 = __expf(p3 - mx);
        const float inv = 1.0f / (e0 + e1 + e2 + e3);
        F.SMALL[SM_LB + i] = 0.f; F.SMALL[SM_LB + 512 + i] = e1 * inv; F.SMALL[SM_LB + 1024 + i] = (e1 + e2) * inv; F.SMALL[SM_LB + 1536 + i] = (e1 + e2 + e3) * inv;
    }
    for (int i = gt; i < DEPTH * 3 * NUP; i += NGT) { const int np = i % NUP, lj = i / NUP; F.SMALL[SM_CW + i] = F.conv_w[(size_t)lj * NUP + up_orig(np)]; }
    for (int i = gt; i < DEPTH * NUP; i += NGT) { const int np = i % NUP, l = i / NUP; F.SMALL[SM_CB + i] = F.conv_b[(size_t)l * NUP + up_orig(np)]; }
    for (int i = gt; i < DEPTH * 256 * 1024; i += NGT) {
        const int k = i & 1023, n = (i >> 10) & 255, l = i >> 18;
        const float* wi = F.w_in + ((size_t)l * 1024 + k) * 3600 + NINW; const float* wg = F.w_gk + (size_t)l * 16 * 256 + n;
        float s = 0.f;
#pragma unroll
        for (int r = 0; r < 16; ++r) s += wi[r] * wg[r * 256];
        F.WIN[((size_t)l * NIN + NINW + n) * 1024 + k] = (bf16)f2bf(s);
    }
    {   LAS float* scr = (LAS float*)(F.lds + F.wave * 16384);
        constexpr int I_IN = 16 * 112, I_OUT = 16 * 32, I_UP = 16 * 176, I_DN = 44 * 32, I_L = I_IN + I_OUT + I_UP + I_DN;
        for (int it = gw; it < DEPTH * I_L; it += NGW) {
            const int l = it / I_L; int r = it % I_L;
            if (r < I_IN) { const int kb = r / 112, nb = r % 112; tr_item(F.w_in + (size_t)l * 1024 * 3600, 3600, 1024, F.WIN + (size_t)l * NIN * 1024, kb, 32 * nb, 32 * nb, (nb >= 64 && nb < 72) ? 0.125f : 1.0f, scr, F.lane); continue; } r -= I_IN;
            if (r < I_OUT) { const int kb = r / 32, nb = r % 32; tr_item(F.w_out + (size_t)l * 1024 * 1024, 1024, 1024, F.WOUT + (size_t)l * 1024 * 1024, kb, 32 * nb, 32 * nb, 1.0f, scr, F.lane); continue; } r -= I_OUT;
            if (r < I_UP) { const int kb = r / 176, nb = r % 176; tr_item(F.w_up + (size_t)l * 1024 * NUP, NUP, 1024, F.WUP + (size_t)l * NUP * 1024, kb, up_orig(32 * nb), 32 * nb, 1.0f, scr, F.lane); continue; } r -= I_UP;
            { const int kb = r / 32, nb = r % 32; tr_item(F.w_down + (size_t)l * FF * 1024, 1024, FF, F.WDN + (size_t)l * 1024 * FF, kb, 32 * nb, 32 * nb, 1.0f, scr, F.lane); }
        }
    }
}

__device__ __forceinline__ void p0b(Frame& F) {
    const int gw = F.vcu * NWAVES + F.wave, NGW = F.G * NWAVES, gt = F.vcu * (NWAVES * 64) + F.tid, NGT = F.G * NWAVES * 64;
    LAS float* shL = (LAS float*)F.lds;
    for (int combo = 0; combo < 2 * DEPTH; ++combo) {
        const int l = combo >> 1, which = combo & 1;
        __syncthreads();
        for (int e = F.tid; e < 16 * 1024; e += NWAVES * 64) { const int b = e >> 10, d = e & 1023; shL[e] = F.MOD[(size_t)(l * 16 + b) * NMOD + (which ? 3072 : 0) + d]; }
        __syncthreads();
        const bf16* Wt = which ? F.WUP + (size_t)l * NUP * 1024 : F.WIN + (size_t)l * NIN * 1024; const int ncols = which ? NUP : NIN;
        float* outp = F.SMALL + (which ? SM_B2 + l * 16 * NUP : SM_B1 + l * 16 * NIN);
        for (int n = gw; n < ncols; n += NGW) {
            const GAS v2u* wr = (const GAS v2u*)(Wt + (size_t)n * 1024) + F.lane;
            float w[16];
#pragma unroll
            for (int i = 0; i < 4; ++i) { const v2u p = wr[64 * i]; w[4 * i] = bf2f(p.x & 0xffffu); w[4 * i + 1] = bf2f(p.x >> 16); w[4 * i + 2] = bf2f(p.y & 0xffffu); w[4 * i + 3] = bf2f(p.y >> 16); }
            float res = 0.f;
#pragma unroll 1
            for (int b = 0; b < 16; ++b) { float s = 0.f;
#pragma unroll
                for (int i = 0; i < 4; ++i) { const f32x4 sh = *(const LAS f32x4*)(shL + b * 1024 + 256 * i + 4 * F.lane); s += sh[0] * w[4 * i] + sh[1] * w[4 * i + 1] + sh[2] * w[4 * i + 2] + sh[3] * w[4 * i + 3]; }
                s = wave_sum(s); res = (F.lane == b) ? s : res; }
            if (F.lane < 16) outp[F.lane * ncols + n] = res + ((which == 0 && n >= NINW) ? F.b_gk[l * 256 + n - NINW] : 0.f);
        }
    }
    for (int i = gt; i < DEPTH * 16 * D; i += NGT) { const int d = i & 1023, lb = i >> 10, l = lb >> 4; const float* mod = F.MOD + (size_t)lb * NMOD;
        F.SMALL[SM_GS1 + i] = F.ln1_g[l * D + d] * (1.0f + mod[1024 + d]); F.SMALL[SM_GT1 + i] = mod[2048 + d];
        F.SMALL[SM_GS2 + i] = F.ln2_g[l * D + d] * (1.0f + mod[4096 + d]); F.SMALL[SM_GT2 + i] = mod[5120 + d]; }
    for (int row = gw; row < M; row += NGW) {
        const int b = row / SEQ; const GAS f32x4* xr = (const GAS f32x4*)(F.x + (size_t)row * D) + F.lane; const float* mod = F.MOD + (size_t)b * NMOD + 1024;
        GAS v2u* o8 = (GAS v2u*)(F.XN + (size_t)row * D) + F.lane; float ss = 0.f;
#pragma unroll
        for (int j = 0; j < 4; ++j) { const f32x4 v = xr[64 * j]; const int d = 256 * j + 4 * F.lane; const f32x4 g = *(const f32x4*)(F.ln1_g + d), sc = *(const f32x4*)(mod + d);
            ss += (v[0] * v[0] + v[1] * v[1]) + (v[2] * v[2] + v[3] * v[3]);
            v2u w; w.x = pk2(v[0] * g[0] * (1.0f + sc[0]), v[1] * g[1] * (1.0f + sc[1])); w.y = pk2(v[2] * g[2] * (1.0f + sc[2]), v[3] * g[3] * (1.0f + sc[3])); o8[64 * j] = w; }
        ss = wave_sum(ss);
        if (F.lane < 16) F.STAT[(size_t)row * 16 + F.lane] = (F.lane == 0) ? ss : 0.f;
    }
}

template <int DK, bool IS_A>
__device__ __forceinline__ void mixer_stream(Frame& F, int l, int b, int h) {
    constexpr int DKS = DK / 4, TB = 16;
    LAS float* aL = (LAS float*)F.lds; LAS float* kL = aL + TB * 128; LAS float* qL = kL + TB * 128; LAS float* vL = qL + TB * 128; LAS float* gL = vL + TB * 128;
    LAS float* part = gL + TB * 128;
    LAS float* red = part + TB * 4 * 128;
    const int tid = F.tid, j = tid & 127, sl = tid >> 7;
    const int qc = IS_A ? 128 * h : 2048 + 64 * h, fc = IS_A ? 512 + 128 * h : 2304 + 64 * h, gkc = 3584 + 64 * h;
    const int vc = IS_A ? 1024 + 128 * h : 2560 + 128 * h, gc = IS_A ? 1536 + 128 * h : 3072 + 128 * h, oc = IS_A ? 128 * h : 512 + 128 * h;
    const float* lbp = F.SMALL + SM_LB + l * 512 + 128 * h;
    const float gn = (IS_A ? F.gn_a : F.gn_b)[l * 128 + j];
    float S[DKS];
#pragma unroll
    for (int i = 0; i < DKS; ++i) S[i] = 0.f;
    for (int t0 = 0; t0 < SEQ; t0 += TB) {
        const size_t rowb = (size_t)b * SEQ + t0;
        for (int e = tid; e < TB * DK; e += NWAVES * 64) { const int tt = e / DK, i = e % DK; const bf16* pr = F.P + (rowb + tt) * NIN;
            const float q = bf2f(pr[qc + i]); float a, k;
            if (IS_A) { const float fa = bf2f(pr[fc + i]), lb = lbp[i], sg = sigmoid_f(fa); a = lb + (1.0f - lb) * sg; k = (1.0f - lb) * (1.0f - sg); }
            else { k = bf2f(pr[fc + i]); const float gk = bf2f(pr[gkc + i]); const float ls = fminf(gk, 0.f) - __logf(1.0f + __expf(-fabsf(gk))); a = __expf(ls * (1.0f / 16.0f)); }
            aL[tt * 128 + i] = a; kL[tt * 128 + i] = k; qL[tt * 128 + i] = q; }
        for (int e = tid; e < TB * 128; e += NWAVES * 64) { const int tt = e >> 7, jj = e & 127; const bf16* pr = F.P + (rowb + tt) * NIN; vL[e] = bf2f(pr[vc + jj]); gL[e] = bf2f(pr[gc + jj]); }
        __syncthreads();
#pragma unroll 1
        for (int tt = 0; tt < TB; ++tt) { const float v = vL[tt * 128 + j]; float acc = 0.f;
#pragma unroll
            for (int i4 = 0; i4 < DKS / 4; ++i4) { const f32x4 a4 = *(const LAS f32x4*)(aL + tt * 128 + sl * DKS + 4 * i4), k4 = *(const LAS f32x4*)(kL + tt * 128 + sl * DKS + 4 * i4), q4 = *(const LAS f32x4*)(qL + tt * 128 + sl * DKS + 4 * i4);
#pragma unroll
                for (int r = 0; r < 4; ++r) { S[4 * i4 + r] = a4[r] * S[4 * i4 + r] + k4[r] * v; acc += q4[r] * S[4 * i4 + r]; } }
            part[(tt * 4 + sl) * 128 + j] = acc; }
        __syncthreads();
        float o[4];
#pragma unroll
        for (int r = 0; r < 4; ++r) { const int tt = sl * 4 + r; o[r] = (part[(tt * 4 + 0) * 128 + j] + part[(tt * 4 + 1) * 128 + j]) + (part[(tt * 4 + 2) * 128 + j] + part[(tt * 4 + 3) * 128 + j]);
            const float ss = wave_sum(o[r] * o[r]); if (F.lane == 0) red[tt * 2 + ((tid >> 6) & 1)] = ss; }
        __syncthreads();
#pragma unroll
        for (int r = 0; r < 4; ++r) { const int tt = sl * 4 + r; const float tot = red[tt * 2] + red[tt * 2 + 1]; const float rn = 1.0f / sqrtf(tot * (1.0f / 128.0f) + EPS);
            const float g = gL[tt * 128 + j]; F.O[(rowb + tt) * D + oc + j] = (bf16)f2bf(o[r] * rn * gn * (g * sigmoid_f(g))); }
        __syncthreads();
    }
}
__device__ __forceinline__ void mixer_phase(Frame& F, int l) {
    for (int s = blockIdx.x; s < NB * 8; s += F.G) { const int b = s >> 3, hh = s & 7;
        if (hh < 4) mixer_stream<128, true>(F, l, b, hh); else mixer_stream<64, false>(F, l, b, hh - 4); }
}

#ifndef MIXER_NAIVE
#define MIXER_NAIVE 0
#endif
#if MIXER_NAIVE
#define MIXER_PHASE mixer_phase
#else
#define MIXER_PHASE mixer_phase_chunked
#endif


typedef short bf16x8_t __attribute__((ext_vector_type(8)));
typedef short s16x4_t __attribute__((ext_vector_type(4)));
typedef float f32x2_t __attribute__((ext_vector_type(2)));
typedef __bf16 bf16x2_t __attribute__((ext_vector_type(2)));
#define MFMA16(a, b, c) __builtin_amdgcn_mfma_f32_16x16x32_bf16((a), (b), (c), 0, 0, 0)
#ifdef MX_FULLSYNC
#define LBAR() __syncthreads()
#else
#define LBAR() do { asm volatile("s_waitcnt lgkmcnt(0)" ::: "memory"); __builtin_amdgcn_s_barrier(); asm volatile("" ::: "memory"); } while (0)
#endif
__device__ __forceinline__ unsigned cvtpk(float lo, float hi) { f32x2_t v = {lo, hi}; bf16x2_t r = __builtin_convertvector(v, bf16x2_t); return __builtin_bit_cast(unsigned, r); }
__device__ __forceinline__ float bflo(unsigned u) { return __builtin_bit_cast(float, u << 16); }
__device__ __forceinline__ float bfhi(unsigned u) { return __builtin_bit_cast(float, u & 0xffff0000u); }
__device__ __forceinline__ s16x4_t tr16(const LAS unsigned char* p) { return __builtin_bit_cast(s16x4_t, __builtin_amdgcn_ds_read_tr16_b64_v4i16((LAS s16x4_t*)p)); }
constexpr float L2E = 1.4426950408889634f;

template <int DK, bool IS_A>
__device__ __forceinline__ void mixer_chunked_stream(Frame& F, int l, int b, int h) {
    constexpr int CP = DK / 2, TS = 512 / CP, R = 64 / TS, TSREF = 32 / R, NKS = DK / 32, NMT = DK / 16, NCH = SEQ / 64;
    constexpr int PQ = DK * 2 + 16, PT = 144, PV = 272, PO = 528;
    constexpr int L_QH = 0, L_KH = L_QH + 64 * PQ, L_QT = L_KH + 64 * PQ, L_KT = L_QT + 64 * PQ, L_VV = L_KT + DK * PT, L_SC = L_VV + 64 * PV,
                  L_SEG = L_SC + 64 * PT, L_G32 = L_SEG + TS * DK * 4, L_DEC = L_G32 + DK * 4, L_END = L_DEC + DK * 4, L_OB = IS_A ? 0 : L_END;
    static_assert(L_END <= RING_BYTES && L_OB + 64 * PO <= RING_BYTES && (!IS_A || 64 * PO <= L_QT), "mixer LDS map");
    LAS unsigned char* const lds = F.lds;
    const int tid = F.tid, lane = F.lane, w = F.wave, m = lane & 15, g = lane >> 4, q4 = (lane & 15) >> 2, p4 = lane & 3;
    const int cp = tid % CP, ts = tid / CP;
    const int qc = IS_A ? 128 * h : 2048 + 64 * h, fc = IS_A ? 512 + 128 * h : 2304 + 64 * h, gkc = 3584 + 64 * h;
    const int vc = IS_A ? 1024 + 128 * h : 2560 + 128 * h, gc = IS_A ? 1536 + 128 * h : 3072 + 128 * h, oc = IS_A ? 128 * h : 512 + 128 * h;
    float lb0 = 0.f, lb1 = 0.f;
    if (IS_A) { lb0 = F.SMALL[SM_LB + l * 512 + 128 * h + 2 * cp]; lb1 = F.SMALL[SM_LB + l * 512 + 128 * h + 2 * cp + 1]; }
    const float* gnp = (IS_A ? F.gn_a : F.gn_b) + l * 128;
    const int nt = tid >> 3, ndq = tid & 7;
    const int vr0 = tid >> 4, vq = tid & 15;

    f32x4 S[NMT];
#pragma unroll
    for (int i = 0; i < NMT; ++i) S[i] = (f32x4){0.f, 0.f, 0.f, 0.f};
    unsigned q2[R], f2[R], k2[R];
    v4u vreg[2], ogreg[2];
    float cum[2][R], kk[2][R];

#define MX_LOAD_RAW(n) do { const size_t row0_ = (size_t)b * SEQ + (size_t)(n) * 64; \
        _Pragma("unroll") for (int j = 0; j < R; ++j) { const unsigned* pr = (const unsigned*)(F.P + (row0_ + ts * R + j) * NIN); \
            q2[j] = pr[(qc >> 1) + cp]; if (IS_A) { f2[j] = pr[(fc >> 1) + cp]; } else { k2[j] = pr[(fc >> 1) + cp]; f2[j] = pr[(gkc >> 1) + cp]; } } \
        _Pragma("unroll") for (int i = 0; i < 2; ++i) vreg[i] = *(const v4u*)(F.P + (row0_ + vr0 + 32 * i) * NIN + vc + 8 * vq); } while (0)
#define MX_E1() do { \
        _Pragma("unroll") for (int c = 0; c < 2; ++c) { float run = 0.f; const float lb = c ? lb1 : lb0; \
            _Pragma("unroll") for (int j = 0; j < R; ++j) { const float x = c ? bfhi(f2[j]) : bflo(f2[j]); float gl; \
                if (IS_A) { const float sg = __builtin_amdgcn_rcpf(1.0f + __builtin_amdgcn_exp2f(-x * L2E)); gl = __builtin_amdgcn_logf(lb + (1.0f - lb) * sg); kk[c][j] = (1.0f - lb) * (1.0f - sg); } \
                else { gl = (fminf(x, 0.f) * L2E - __builtin_amdgcn_logf(1.0f + __builtin_amdgcn_exp2f(-fabsf(x) * L2E))) * (1.0f / 16.0f); kk[c][j] = c ? bfhi(k2[j]) : bflo(k2[j]); } \
                run += gl; cum[c][j] = run; } } \
        *(LAS f32x2_t*)(lds + L_SEG + (ts * DK + 2 * cp) * 4) = (f32x2_t){cum[0][R - 1], cum[1][R - 1]}; \
        if (ts == TSREF) *(LAS f32x2_t*)(lds + L_G32 + 2 * cp * 4) = (f32x2_t){cum[0][0], cum[1][0]}; } while (0)

    MX_LOAD_RAW(0);
    MX_E1();
#pragma unroll 1
    for (int n = 0; n < NCH; ++n) {
        const size_t row0 = (size_t)b * SEQ + (size_t)n * 64;
        LBAR();
        {   float base[2] = {0.f, 0.f}, tot[2] = {0.f, 0.f}, refv[2];
            {   const f32x2_t g32 = *(const LAS f32x2_t*)(lds + L_G32 + 2 * cp * 4); refv[0] = g32[0]; refv[1] = g32[1]; }
#pragma unroll
            for (int t2 = 0; t2 < TS; ++t2) { const f32x2_t sv = *(const LAS f32x2_t*)(lds + L_SEG + (t2 * DK + 2 * cp) * 4);
                tot[0] += sv[0]; tot[1] += sv[1]; if (t2 < ts) { base[0] += sv[0]; base[1] += sv[1]; } if (t2 < TSREF) { refv[0] += sv[0]; refv[1] += sv[1]; } }
            if (ts == 0) *(LAS f32x2_t*)(lds + L_DEC + 2 * cp * 4) = (f32x2_t){__builtin_amdgcn_exp2f(tot[0]), __builtin_amdgcn_exp2f(tot[1])};
            const float eref0 = __builtin_amdgcn_exp2f(refv[0]), eref1 = __builtin_amdgcn_exp2f(refv[1]), elr0 = __builtin_amdgcn_exp2f(tot[0] - refv[0]), elr1 = __builtin_amdgcn_exp2f(tot[1] - refv[1]);
            float ktv[2][R];
#pragma unroll
            for (int j = 0; j < R; ++j) { const int t = ts * R + j;
                const float b0 = base[0] + cum[0][j], b1 = base[1] + cum[1][j];
                const float e10 = __builtin_amdgcn_exp2f(b0 - refv[0]), e11 = __builtin_amdgcn_exp2f(b1 - refv[1]), e20 = __builtin_amdgcn_exp2f(refv[0] - b0), e21 = __builtin_amdgcn_exp2f(refv[1] - b1);
                const float qh0 = bflo(q2[j]) * e10, qh1 = bfhi(q2[j]) * e11, kh0 = kk[0][j] * e20, kh1 = kk[1][j] * e21;
                *(LAS unsigned*)(lds + L_QH + t * PQ + 4 * cp) = cvtpk(qh0, qh1);
                *(LAS unsigned*)(lds + L_KH + t * PQ + 4 * cp) = cvtpk(kh0, kh1);
                *(LAS unsigned*)(lds + L_QT + t * PQ + 4 * cp) = cvtpk(qh0 * eref0, qh1 * eref1);
                ktv[0][j] = kh0 * elr0; ktv[1][j] = kh1 * elr1;
            }
#pragma unroll
            for (int c = 0; c < 2; ++c) {
                if constexpr (R == 8) *(LAS v4u*)(lds + L_KT + (2 * cp + c) * PT + 2 * (ts * R)) = (v4u){cvtpk(ktv[c][0], ktv[c][1]), cvtpk(ktv[c][2], ktv[c][3]), cvtpk(ktv[c][4], ktv[c][5]), cvtpk(ktv[c][6], ktv[c][7])};
                else *(LAS v2u*)(lds + L_KT + (2 * cp + c) * PT + 2 * (ts * R)) = (v2u){cvtpk(ktv[c][0], ktv[c][1]), cvtpk(ktv[c][2], ktv[c][3])}; }
#pragma unroll
            for (int i = 0; i < 2; ++i) *(LAS v4u*)(lds + L_VV + (vr0 + 32 * i) * PV + 16 * vq) = vreg[i];
        }
#pragma unroll
        for (int i = 0; i < 2; ++i) ogreg[i] = *(const v4u*)(F.P + (row0 + nt) * NIN + gc + 16 * ndq + 8 * i);
        if (n + 1 < NCH) MX_LOAD_RAW(n + 1);
        LBAR();
        {   const int tb = w >> 1;
#pragma unroll
            for (int si = 0; si < 2; ++si) { const int sb = 2 * (w & 1) + si; f32x4 acc = {0.f, 0.f, 0.f, 0.f};
#pragma unroll
                for (int ks = 0; ks < NKS; ++ks) { const bf16x8_t a = *(const LAS bf16x8_t*)(lds + L_QH + (16 * tb + m) * PQ + 64 * ks + 16 * g), bb = *(const LAS bf16x8_t*)(lds + L_KH + (16 * sb + m) * PQ + 64 * ks + 16 * g);
                    acc = MFMA16(a, bb, acc); }
#pragma unroll
                for (int j = 0; j < 4; ++j) { const int t = 16 * tb + 4 * g + j, s = 16 * sb + m; const float val = (s <= t) ? acc[j] : 0.f;
                    *(LAS unsigned short*)(lds + L_SC + t * PT + 2 * s) = (unsigned short)f2bf(val); } }
        }
        LBAR();
        {   const int dv0 = 16 * w;
            bf16x8_t vB[2];
#pragma unroll
            for (int ks2 = 0; ks2 < 2; ++ks2) { const LAS unsigned char* vp = lds + L_VV + (32 * ks2 + 8 * g + q4) * PV + 2 * (dv0 + 4 * p4);
                const s16x4_t lo = tr16(vp), hi = tr16(vp + 4 * PV); vB[ks2] = __builtin_shufflevector(lo, hi, 0, 1, 2, 3, 4, 5, 6, 7); }
            f32x4 o[4];
#pragma unroll
            for (int mt = 0; mt < 4; ++mt) { o[mt] = (f32x4){0.f, 0.f, 0.f, 0.f};
#pragma unroll
                for (int ks2 = 0; ks2 < 2; ++ks2) { const bf16x8_t a = *(const LAS bf16x8_t*)(lds + L_SC + (16 * mt + m) * PT + 64 * ks2 + 16 * g); o[mt] = MFMA16(a, vB[ks2], o[mt]); } }
#pragma unroll
            for (int sg = 0; sg < NKS; ++sg) {
                const unsigned s0 = cvtpk(S[2 * sg][0], S[2 * sg][1]), s1 = cvtpk(S[2 * sg][2], S[2 * sg][3]), s2 = cvtpk(S[2 * sg + 1][0], S[2 * sg + 1][1]), s3 = cvtpk(S[2 * sg + 1][2], S[2 * sg + 1][3]);
                const bf16x8_t sB = __builtin_bit_cast(bf16x8_t, (v4u){s0, s1, s2, s3});
#pragma unroll
                for (int mt = 0; mt < 4; ++mt) { const LAS unsigned char* qp = lds + L_QT + (16 * mt + m) * PQ + 2 * (32 * sg + 4 * g);
                    const s16x4_t lo = *(const LAS s16x4_t*)qp, hi = *(const LAS s16x4_t*)(qp + 32);
                    o[mt] = MFMA16(__builtin_shufflevector(lo, hi, 0, 1, 2, 3, 4, 5, 6, 7), sB, o[mt]); } }
#pragma unroll
            for (int mtile = 0; mtile < NMT; ++mtile) { const f32x4 d4 = *(const LAS f32x4*)(lds + L_DEC + 4 * (16 * mtile + 4 * g)); S[mtile] = S[mtile] * d4;
#pragma unroll
                for (int ks2 = 0; ks2 < 2; ++ks2) { const bf16x8_t a = *(const LAS bf16x8_t*)(lds + L_KT + (16 * mtile + m) * PT + 64 * ks2 + 16 * g); S[mtile] = MFMA16(a, vB[ks2], S[mtile]); } }
#pragma unroll
            for (int mt = 0; mt < 4; ++mt)
#pragma unroll
                for (int j = 0; j < 4; ++j) *(LAS float*)(lds + L_OB + (16 * mt + 4 * g + j) * PO + 4 * (dv0 + m)) = o[mt][j];
        }
        LBAR();
        {   f32x4 ov[4]; float ss = 0.f;
#pragma unroll
            for (int i = 0; i < 4; ++i) { ov[i] = *(const LAS f32x4*)(lds + L_OB + nt * PO + 64 * ndq + 16 * i); ss += (ov[i][0] * ov[i][0] + ov[i][1] * ov[i][1]) + (ov[i][2] * ov[i][2] + ov[i][3] * ov[i][3]); }
            ss += __shfl_xor(ss, 1); ss += __shfl_xor(ss, 2); ss += __shfl_xor(ss, 4);
            const float rn = 1.0f / sqrtf(ss * (1.0f / 128.0f) + EPS);
            unsigned ow[8];
#pragma unroll
            for (int i = 0; i < 4; ++i) { const f32x4 gn4 = *(const f32x4*)(gnp + 16 * ndq + 4 * i); const unsigned g01 = ogreg[i >> 1][2 * (i & 1)], g23 = ogreg[i >> 1][2 * (i & 1) + 1];
                const float ga = bflo(g01), gb = bfhi(g01), gcc = bflo(g23), gd = bfhi(g23);
                const float r0 = ov[i][0] * rn * gn4[0] * (ga * __builtin_amdgcn_rcpf(1.0f + __builtin_amdgcn_exp2f(-ga * L2E))), r1 = ov[i][1] * rn * gn4[1] * (gb * __builtin_amdgcn_rcpf(1.0f + __builtin_amdgcn_exp2f(-gb * L2E)));
                const float r2 = ov[i][2] * rn * gn4[2] * (gcc * __builtin_amdgcn_rcpf(1.0f + __builtin_amdgcn_exp2f(-gcc * L2E))), r3 = ov[i][3] * rn * gn4[3] * (gd * __builtin_amdgcn_rcpf(1.0f + __builtin_amdgcn_exp2f(-gd * L2E)));
                ow[2 * i] = cvtpk(r0, r1); ow[2 * i + 1] = cvtpk(r2, r3); }
            bf16* op = F.O + (row0 + nt) * D + oc + 16 * ndq;
            *(v4u*)op = (v4u){ow[0], ow[1], ow[2], ow[3]}; *(v4u*)(op + 8) = (v4u){ow[4], ow[5], ow[6], ow[7]};
        }
        if (n + 1 < NCH) MX_E1();
    }
    LBAR();
#undef MX_LOAD_RAW
#undef MX_E1
}
__device__ __forceinline__ void mixer_phase_chunked(Frame& F, int l) {
    for (int s = blockIdx.x; s < NB * 8; s += F.G) { const int b = s >> 3, hh = s & 7;
        if (hh < 4) mixer_chunked_stream<128, true>(F, l, b, hh); else mixer_chunked_stream<64, false>(F, l, b, hh - 4); }
}
__device__ __forceinline__ void fix_phase(Frame& F, int l) {
    const int gt = F.vcu * (NWAVES * 64) + F.tid, NGT = F.G * NWAVES * 64;
    const float* cw = F.SMALL + SM_CW + l * 3 * NUP; const float* cb = F.SMALL + SM_CB + l * NUP;
    for (int i = gt; i < 256 * FF; i += NGT) { const int pm = i / FF, f = i % FF; if ((pm & 15) == 0) continue;
        const int ca = 256 * (f >> 7) + (f & 127), cv = ca + 128;
        const float* T = F.RAWT + (size_t)(pm - 1) * 2 * NUP; const float* H = F.RAWH + (size_t)pm * 2 * NUP;
        const float a_m2 = T[ca], a_m1 = T[NUP + ca], a_0 = H[ca], a_1 = H[NUP + ca], v_m2 = T[cv], v_m1 = T[NUP + cv], v_0 = H[cv], v_1 = H[NUP + cv];
        const float wa0 = cw[ca], wa1 = cw[NUP + ca], wa2 = cw[2 * NUP + ca], wv0 = cw[cv], wv1 = cw[NUP + cv], wv2 = cw[2 * NUP + cv], ba = cb[ca], bv = cb[cv];
        const float ca0 = ba + wa0 * a_m2 + wa1 * a_m1 + wa2 * a_0, cv0 = bv + wv0 * v_m2 + wv1 * v_m1 + wv2 * v_0;
        const float ca1 = ba + wa0 * a_m1 + wa1 * a_0 + wa2 * a_1, cv1 = bv + wv0 * v_m1 + wv1 * v_0 + wv2 * v_1;
        bf16* g = F.Gb + (size_t)pm * 256 * FF + f;
        g[0] = (bf16)f2bf(ca0 * sigmoid_f(ca0) * cv0); g[FF] = (bf16)f2bf(ca1 * sigmoid_f(ca1) * cv1); }
}

__device__ __forceinline__ void final_phase(Frame& F) {
    const int gw = F.vcu * NWAVES + F.wave, NGW = F.G * NWAVES;
    for (int row = gw; row < M; row += NGW) {
        GAS f32x4* xr = (GAS f32x4*)(F.out + (size_t)row * D) + F.lane;
        float ss = (F.lane < 16) ? F.STAT[(size_t)row * 16 + F.lane] : 0.f; ss = wave_sum(ss);
        const float r = 1.0f / sqrtf(ss * (1.0f / (float)D) + EPS);
#pragma unroll
        for (int j = 0; j < 4; ++j) { const f32x4 v = xr[64 * j]; const f32x4 g = *(const f32x4*)(F.lnf_g + 256 * j + 4 * F.lane); xr[64 * j] = v * r * g; }
    }
}

struct Args { const float* in[18]; float* out; unsigned char* ws; int ph_lo, ph_hi; };
__global__ void __launch_bounds__(NWAVES * 64, 2) fwd(Args args) {
    extern __shared__ __attribute__((aligned(16))) unsigned char lds[];
    Frame F;
    F.lds = (LAS unsigned char*)lds; F.MISC = (volatile LAS unsigned*)(F.lds + MISC_OFF);
    F.tid = threadIdx.x; F.lane = F.tid & 63; F.wave = __builtin_amdgcn_readfirstlane(F.tid >> 6);
    F.G = gridDim.x; { const int bx = blockIdx.x; F.vcu = (F.G % 8 == 0) ? (bx % 8) * (F.G / 8) + bx / 8 : bx; }
    unsigned char* ws = args.ws;
    F.ctl = (unsigned*)(ws + WS_CTL);
    F.x = args.in[0]; F.c = args.in[1]; F.ln1_g = args.in[2]; F.ln2_g = args.in[3]; F.w_ada = args.in[4]; F.b_ada = args.in[5]; F.w_in = args.in[6]; F.lb_params = args.in[7];
    F.w_gk = args.in[8]; F.b_gk = args.in[9]; F.gn_a = args.in[10]; F.gn_b = args.in[11]; F.w_out = args.in[12]; F.w_up = args.in[13]; F.conv_w = args.in[14]; F.conv_b = args.in[15];
    F.w_down = args.in[16]; F.lnf_g = args.in[17]; F.out = args.out;
    F.MOD = (float*)(ws + WS_MOD); F.SMALL = (float*)(ws + WS_SMALL); F.STAT = (float*)(ws + WS_STAT); F.RAWH = (float*)(ws + WS_RAWH); F.RAWT = (float*)(ws + WS_RAWT);
    F.WIN = (bf16*)(ws + WS_WIN); F.WOUT = (bf16*)(ws + WS_WOUT); F.WUP = (bf16*)(ws + WS_WUP); F.WDN = (bf16*)(ws + WS_WDN);
    F.XN = (bf16*)(ws + WS_XN); F.O = (bf16*)(ws + WS_O); F.P = (bf16*)(ws + WS_P); F.Gb = (bf16*)(ws + WS_P);
#ifdef PROBE_ZERO_ALL
    for (int u = F.tid; u < LDSCTL_OFF / 4; u += NWAVES * 64) ((LAS unsigned*)(F.lds))[u] = 0u;
#endif
    for (int u = F.tid; u < (LDS_BYTES - LDSCTL_OFF) / 4; u += NWAVES * 64) ((LAS unsigned*)(F.lds + LDSCTL_OFF))[u] = 0u;
    __syncthreads();
    const int lo = args.ph_lo, hi = args.ph_hi;
    XcdBarrier bar; bar.bar = F.ctl + CW_BAR; bar.x = 0; bar.st = nullptr;
    if (hi - lo > 1) bar = xcd_barrier_post(F.ctl + CW_BAR, F.MISC + 8);
#define IN(k) (lo <= (k) && (k) < hi)
#ifndef PH_MASK
#define PH_MASK 0x1ff
#endif
#define PHM(b) ((PH_MASK >> (b)) & 1)
#define SEAM(k) do { if (IN(k) && IN((k) + 1)) xcd_barrier(bar); } while (0)
    if (PHM(0) && IN(0)) p0a(F);
    SEAM(0);
    if (PHM(1) && IN(1)) p0b(F);
    SEAM(1);
    for (int l = 0; l < DEPTH; ++l) {
        const int pb = 2 + 6 * l;
#define LAUNDER_TID() do { int l_; asm volatile("v_mbcnt_lo_u32_b32 %0, -1, 0\n\tv_mbcnt_hi_u32_b32 %0, -1, %0" : "=v"(l_)); F.lane = l_; F.tid = F.wave * 64 + l_; } while (0)
        if (PHM(2) && IN(pb)) {
            LAUNDER_TID();
            pg8::Gemm g{F.XN, F.WIN + (size_t)l * NIN * 1024, M, NIN, D}; pg8::StaticOrder S; S.init(M, NIN, F.G, (int)blockIdx.x);
            pg8::EpiIn E{F.P, F.SMALL + SM_B1 + l * 16 * NIN, F.STAT};
            pg8::gemm_phase<pg8::EpiIn, pg8::StaticOrder, true, true>(F.lds, g, S, E, F.tid);
        }
        SEAM(pb);
        if (PHM(3) && IN(pb + 1)) { LAUNDER_TID(); MIXER_PHASE(F, l);
#ifdef PROBE_MIX2
            __syncthreads(); LAUNDER_TID(); MIXER_PHASE(F, l);
#endif
        }
        SEAM(pb + 1);
        if (PHM(4) && IN(pb + 2)) {
            LAUNDER_TID();
            pg8::Gemm g{F.O, F.WOUT + (size_t)l * 1024 * 1024, M, D, D}; pg8::StaticOrder S; S.init(M, D, F.G, (int)blockIdx.x);
            pg8::EpiXUpd E{l == 0 ? F.x : F.out, F.out, F.XN, F.SMALL + SM_GT1 + l * 16 * D, F.SMALL + SM_GS2 + l * 16 * D, F.STAT};
            pg8::gemm_phase<pg8::EpiXUpd, pg8::StaticOrder, true, true>(F.lds, g, S, E, F.tid);
        }
        SEAM(pb + 2);
        if (PHM(5) && IN(pb + 3)) {
            LAUNDER_TID();
            pg8::Gemm g{F.XN, F.WUP + (size_t)l * NUP * 1024, M, NUP, D}; pg8::StaticOrder S; S.init(M, NUP, F.G, (int)blockIdx.x);
            pg8::EpiUp E{F.Gb, F.SMALL + SM_B2 + l * 16 * NUP, F.STAT, F.SMALL + SM_CW + l * 3 * NUP, F.SMALL + SM_CB + l * NUP, F.RAWH, F.RAWT, (LAS float*)(F.lds + HALO_OFF)};
            pg8::gemm_phase<pg8::EpiUp, pg8::StaticOrder, true, true>(F.lds, g, S, E, F.tid);
        }
        SEAM(pb + 3);
        if (PHM(6) && IN(pb + 4)) { LAUNDER_TID(); fix_phase(F, l); }
        SEAM(pb + 4);
        if (PHM(7) && IN(pb + 5)) {
            LAUNDER_TID();
            pg8::Gemm g{F.Gb, F.WDN + (size_t)l * 1024 * FF, M, D, FF}; pg8::StaticOrder S; S.init(M, D, F.G, (int)blockIdx.x);
            pg8::EpiXUpd E{F.out, F.out, l + 1 < DEPTH ? F.XN : (bf16*)nullptr, F.SMALL + SM_GT2 + l * 16 * D, F.SMALL + SM_GS1 + (l + 1 < DEPTH ? l + 1 : l) * 16 * D, F.STAT};
            pg8::gemm_phase<pg8::EpiXUpd, pg8::StaticOrder, true, true>(F.lds, g, S, E, F.tid);
        }
        SEAM(pb + 5);
    }
    if (PHM(8) && IN(N_PHASES - 1)) { LAUNDER_TID(); final_phase(F); }
#undef IN
#undef SEAM
}

extern "C" void kernel_launch(void* const* d_in, const int* in_sizes, int n_in, void* d_out, int out_size, void* d_ws, size_t ws_size, hipStream_t stream) {
    static int grid = 0;
    if (grid == 0) {
        if (n_in != 18 || in_sizes[0] != M * D || out_size != M * D || ws_size < WS_END) { fprintf(stderr, "kernel_launch: unexpected shapes / workspace (n_in %d, in0 %d, out %d, ws %zu < %zu); nothing launched\n", n_in, n_in > 0 ? in_sizes[0] : -1, out_size, ws_size, (size_t)WS_END); grid = -1; return; }
        int dev = 0, cus = 0, per_cu = 0;
        if (hipGetDevice(&dev) != hipSuccess || hipDeviceGetAttribute(&cus, hipDeviceAttributeMultiprocessorCount, dev) != hipSuccess) { grid = -1; return; }
        if (hipFuncSetAttribute((const void*)fwd, hipFuncAttributeMaxDynamicSharedMemorySize, LDS_BYTES) != hipSuccess) { fprintf(stderr, "kernel_launch: hipFuncSetAttribute failed\n"); grid = -1; return; }
        if (hipOccupancyMaxActiveBlocksPerMultiprocessor(&per_cu, (const void*)fwd, NWAVES * 64, LDS_BYTES) != hipSuccess || per_cu < 1) { fprintf(stderr, "kernel_launch: occupancy query says %d\n", per_cu); }
        (void)hipGetLastError();
        grid = cus;
    }
    if (grid < 0) return;
#ifdef PROBE_ZERO_ALL
    if (hipMemsetAsync((char*)d_ws, 0, WS_END, stream) != hipSuccess) return;
#endif
    if (hipMemsetAsync((char*)d_ws + WS_CTL, 0, CTL_ZERO_BYTES, stream) != hipSuccess) return;
    Args a{};
    for (int i = 0; i < 18; ++i) a.in[i] = (const float*)d_in[i];
    a.out = (float*)d_out; a.ws = (unsigned char*)d_ws;
#if MK_PER_PHASE
    for (int p = 0; p < N_PHASES; ++p) { a.ph_lo = p; a.ph_hi = p + 1; hipLaunchKernelGGL(fwd, dim3(grid), dim3(NWAVES * 64), LDS_BYTES, stream, a); }
#else
    a.ph_lo = 0; a.ph_hi = N_PHASES; hipLaunchKernelGGL(fwd, dim3(grid), dim3(NWAVES * 64), LDS_BYTES, stream, a);
#endif
}
```

```cpp
#include <hip/hip_runtime.h>
#include <cstdio>
#include <cstdint>
namespace pg8 {
#define PG8_LAS __attribute__((address_space(3)))
typedef unsigned short bf16_t;
typedef short bf16x8 __attribute__((ext_vector_type(8)));
typedef float f32x4 __attribute__((ext_vector_type(4)));
typedef unsigned u32x4 __attribute__((ext_vector_type(4)));
constexpr int BM = 256, BK = 64, HALF = 128, HTB = HALF * BK * 2  , STAGE_BYTES = 8 * HTB, NXCD = 8, WGM = 8;

__host__ __device__ __forceinline__ int lds_byte(int r, int c) { const int st = (r >> 4) * 2 + (c >> 5), rr = r & 15, cc = c & 31, ob = rr * 64 + cc * 2; return st * 1024 + (ob ^ (((ob >> 9) & 1) << 5)); }
__host__ __device__ __forceinline__ void stage_rc(int b, int& R, int& C) { const int st = b / 1024, sb = b % 1024, swz = sb ^ (((sb >> 9) & 1) << 5); R = (st >> 1) * 16 + swz / 64; C = (st & 1) * 32 + (swz % 64) / 2; }
__host__ __device__ __forceinline__ int perm32(int rho) { const int n = rho >> 4, i = rho & 15; return 8 * (i >> 2) + 4 * n + (i & 3); }

struct Unit { int pm, pn; };
struct Gemm { const bf16_t* A; const bf16_t* Bt; int M, N, K; };

struct StaticOrder {
    static constexpr bool DUP = false;
    int nM, nN, nwg, G, c;
    __host__ __device__ void init(int M, int N, int G_, int c_) { nM = M / BM; nN = N / BM; nwg = nM * nN; G = G_; c = c_; }
    __host__ __device__ bool next(int i, Unit& u) const {
        const long L = (long)i * G + c; if (L >= nwg) return false;
        int wgid = (int)L; { const int q = nwg / NXCD, r = nwg % NXCD, xcd = wgid % NXCD, off = wgid / NXCD; wgid = (xcd < r ? xcd * (q + 1) : r * (q + 1) + (xcd - r) * q) + off; }
        const int nig = WGM * nN, gid = wgid / nig, fm = gid * WGM, gsz = (nM - fm) < WGM ? (nM - fm) : WGM;
        u.pm = fm + ((wgid % nig) % gsz); u.pn = (wgid % nig) / gsz; return true;
    }
    __device__ __forceinline__ void a_ready(const Unit&) const {}
    __device__ __forceinline__ void done(const Unit&) const {}
};

struct DupOrder : StaticOrder {
    static constexpr bool DUP = true;
    __host__ __device__ bool next(int i, Unit& u) const { return StaticOrder::next(i >> 1, u); }
};

__device__ __forceinline__ unsigned cvt_pk_bf16(float lo, float hi) { unsigned r; asm volatile("v_cvt_pk_bf16_f32 %0, %1, %2" : "=v"(r) : "v"(lo), "v"(hi)); return r; }
typedef unsigned u32x2 __attribute__((ext_vector_type(2)));
constexpr int ROWS_PER_SEQ_TILES = 16;
constexpr float RMS_EPS = 1e-6f;
constexpr int D_MODEL = 1024, N_IN = 3840, N_UP = 5632, N_FF = 2816;

__device__ __forceinline__ float row_rscale(const float* stat, int row, int fq) {
    const f32x4 sp = *(const f32x4*)(stat + (size_t)row * 16 + 4 * fq);
    float s = (sp[0] + sp[1]) + (sp[2] + sp[3]);
    s += __shfl_xor(s, 16); s += __shfl_xor(s, 32);
    return 1.0f / sqrtf(s * (1.0f / (float)D_MODEL) + RMS_EPS);
}

struct EpiNull {
    static constexpr bool PERM = true, AFTER_DRAIN = false, IDEMPOTENT = false;
    __device__ __forceinline__ void operator()(f32x4 (&acc)[2][2][4][2], const Unit&, int, int, int, int) const {
#pragma unroll
        for (int a = 0; a < 2; ++a)
#pragma unroll
            for (int b = 0; b < 2; ++b)
#pragma unroll
                for (int m = 0; m < 4; ++m) asm volatile("" :: "v"(acc[a][b][m][0]), "v"(acc[a][b][m][1]));
    }
};

struct EpiIn {
    static constexpr bool PERM = true, AFTER_DRAIN = false, IDEMPOTENT = true;
    bf16_t* P; const float* bias; const float* stat;
    __device__ __forceinline__ void operator()(f32x4 (&acc)[2][2][4][2], const Unit& u, int wr, int wc, int fr, int fq) const {
        const int row0 = u.pm * BM + wr * 64 + fr, b = u.pm / ROWS_PER_SEQ_TILES, col0 = u.pn * BM + wc * 32 + 8 * fq;
        const float* bp = bias + (size_t)b * N_IN + col0;
        f32x4 bv[2][2];
#pragma unroll
        for (int bj = 0; bj < 2; ++bj)
#pragma unroll
            for (int n = 0; n < 2; ++n) bv[bj][n] = *(const f32x4*)(bp + bj * HALF + 4 * n);
#pragma unroll
        for (int ai = 0; ai < 2; ++ai)
#pragma unroll
            for (int m = 0; m < 4; ++m) { const int row = row0 + ai * HALF + m * 16; const float r = row_rscale(stat, row, fq);
                bf16_t* rowp = P + (size_t)row * N_IN + col0;
#pragma unroll
                for (int bj = 0; bj < 2; ++bj) { const f32x4 v0 = acc[ai][bj][m][0] * r + bv[bj][0], v1 = acc[ai][bj][m][1] * r + bv[bj][1];
                    u32x4 w; w.x = cvt_pk_bf16(v0[0], v0[1]); w.y = cvt_pk_bf16(v0[2], v0[3]); w.z = cvt_pk_bf16(v1[0], v1[1]); w.w = cvt_pk_bf16(v1[2], v1[3]);
                    *(u32x4*)(rowp + bj * HALF) = w; } }
    }
};

struct EpiXUpd {
    static constexpr bool PERM = true, AFTER_DRAIN = false, IDEMPOTENT = false;
    const float* xold; float* xnew; bf16_t* XN; const float* gt; const float* gsn; float* stat;
    __device__ __forceinline__ void operator()(f32x4 (&acc)[2][2][4][2], const Unit& u, int wr, int wc, int fr, int fq) const {
        const int row0 = u.pm * BM + wr * 64 + fr, b = u.pm / ROWS_PER_SEQ_TILES, col0 = u.pn * BM + wc * 32 + 8 * fq;
        f32x4 g[2][2], s[2][2];
#pragma unroll
        for (int bj = 0; bj < 2; ++bj)
#pragma unroll
            for (int n = 0; n < 2; ++n) { g[bj][n] = *(const f32x4*)(gt + (size_t)b * D_MODEL + col0 + bj * HALF + 4 * n);
                s[bj][n] = XN ? *(const f32x4*)(gsn + (size_t)b * D_MODEL + col0 + bj * HALF + 4 * n) : (f32x4){0.f, 0.f, 0.f, 0.f}; }
#pragma unroll
        for (int ai = 0; ai < 2; ++ai)
#pragma unroll
            for (int m = 0; m < 4; ++m) { const int row = row0 + ai * HALF + m * 16; const size_t off = (size_t)row * D_MODEL + col0; float ss = 0.f;
#pragma unroll
                for (int bj = 0; bj < 2; ++bj) {
                    const f32x4 x0 = *(const f32x4*)(xold + off + bj * HALF) + g[bj][0] * acc[ai][bj][m][0], x1 = *(const f32x4*)(xold + off + bj * HALF + 4) + g[bj][1] * acc[ai][bj][m][1];
                    *(f32x4*)(xnew + off + bj * HALF) = x0; *(f32x4*)(xnew + off + bj * HALF + 4) = x1;
                    ss += (x0[0] * x0[0] + x0[1] * x0[1]) + (x0[2] * x0[2] + x0[3] * x0[3]) + (x1[0] * x1[0] + x1[1] * x1[1]) + (x1[2] * x1[2] + x1[3] * x1[3]);
                    if (XN) { const f32x4 y0 = x0 * s[bj][0], y1 = x1 * s[bj][1];
                        u32x4 w; w.x = cvt_pk_bf16(y0[0], y0[1]); w.y = cvt_pk_bf16(y0[2], y0[3]); w.z = cvt_pk_bf16(y1[0], y1[1]); w.w = cvt_pk_bf16(y1[2], y1[3]);
                        *(u32x4*)(XN + off + bj * HALF) = w; } }
                ss += __shfl_xor(ss, 16); ss += __shfl_xor(ss, 32);
                if (fq == 0) stat[(size_t)row * 16 + u.pn * 4 + wc] = ss; }
    }
};

__device__ __forceinline__ float dpp_ror1(float v) { return __builtin_bit_cast(float, __builtin_amdgcn_update_dpp(0, __builtin_bit_cast(int, v), 0x121, 0xf, 0xf, false)); }
__device__ __forceinline__ float dpp_ror2(float v) { return __builtin_bit_cast(float, __builtin_amdgcn_update_dpp(0, __builtin_bit_cast(int, v), 0x122, 0xf, 0xf, false)); }
__device__ __forceinline__ float silu_f(float x) { return x / (1.0f + __expf(-x)); }
struct EpiUp {
    static constexpr bool PERM = true, AFTER_DRAIN = false, IDEMPOTENT = false;
    bf16_t* G; const float* bias; const float* stat; const float* cw; const float* cb; float* rawh; float* rawt; PG8_LAS float* halo;
    __device__ __forceinline__ void operator()(f32x4 (&acc)[2][2][4][2], const Unit& u, int wr, int wc, int fr, int fq) const {
        const int row0 = u.pm * BM + wr * 64 + fr, b = u.pm / ROWS_PER_SEQ_TILES, tc0 = wc * 32 + 8 * fq, col0 = u.pn * BM + tc0;
        PG8_LAS float* vecs = halo + 2048;
        const int tid = (wr * 4 + wc) * 64 + fq * 16 + fr;
        f32x4 vecv = {0.f, 0.f, 0.f, 0.f};
        if (tid < 256) { const int which = tid >> 6, ch = tid & 63; vecv = *(const f32x4*)((which < 3 ? cw + which * N_UP : cb) + u.pn * BM + 4 * ch); }
        f32x4 sp[2][4], bv[2][2];
#pragma unroll
        for (int ai = 0; ai < 2; ++ai)
#pragma unroll
            for (int m = 0; m < 4; ++m) sp[ai][m] = *(const f32x4*)(stat + (size_t)(row0 + ai * HALF + m * 16) * 16 + 4 * fq);
#pragma unroll
        for (int bj = 0; bj < 2; ++bj)
#pragma unroll
            for (int n = 0; n < 2; ++n) bv[bj][n] = *(const f32x4*)(bias + (size_t)b * N_UP + col0 + bj * HALF + 4 * n);
#pragma unroll
        for (int ai = 0; ai < 2; ++ai)
#pragma unroll
            for (int m = 0; m < 4; ++m) { float s = (sp[ai][m][0] + sp[ai][m][1]) + (sp[ai][m][2] + sp[ai][m][3]); s += __shfl_xor(s, 16); s += __shfl_xor(s, 32);
                const float r = 1.0f / sqrtf(s * (1.0f / (float)D_MODEL) + RMS_EPS);
#pragma unroll
                for (int bj = 0; bj < 2; ++bj)
#pragma unroll
                    for (int n = 0; n < 2; ++n) acc[ai][bj][m][n] = acc[ai][bj][m][n] * r + bv[bj][n];
                asm volatile("" : "+v"(acc[ai][0][m][0]), "+v"(acc[ai][0][m][1]), "+v"(acc[ai][1][m][0]), "+v"(acc[ai][1][m][1])); }
        if (tid < 256) *(PG8_LAS f32x4*)(vecs + 4 * tid) = vecv;
#pragma unroll
        for (int ai = 0; ai < 2; ++ai) {
            if (fr >= 14) {
                PG8_LAS float* hp = halo + ((ai * 2 + wr) * 2 + (fr - 14)) * 256 + tc0;
#pragma unroll
                for (int bj = 0; bj < 2; ++bj)
#pragma unroll
                    for (int n = 0; n < 2; ++n) *(PG8_LAS f32x4*)(hp + bj * HALF + 4 * n) = acc[ai][bj][3][n];
            }
        }
        if (wr == 0 && fr < 2) { float* hp = rawh + ((size_t)u.pm * 2 + fr) * N_UP + col0;
#pragma unroll
            for (int bj = 0; bj < 2; ++bj)
#pragma unroll
                for (int n = 0; n < 2; ++n) *(f32x4*)(hp + bj * HALF + 4 * n) = acc[0][bj][0][n]; }
        if (wr == 1 && fr >= 14) { float* tp = rawt + ((size_t)u.pm * 2 + (fr - 14)) * N_UP + col0;
#pragma unroll
            for (int bj = 0; bj < 2; ++bj)
#pragma unroll
                for (int n = 0; n < 2; ++n) *(f32x4*)(tp + bj * HALF + 4 * n) = acc[1][bj][3][n]; }
        asm volatile("s_waitcnt lgkmcnt(0)" ::: "memory"); __builtin_amdgcn_s_barrier(); asm volatile("" ::: "memory");
        const bool f0 = (fr == 0), f01 = (fr < 2);
        unsigned gp[2][4][2];
#pragma unroll
        for (int n = 0; n < 2; ++n) {
            f32x4 w0[2], w1[2], w2[2], cbv[2];
#pragma unroll
            for (int bj = 0; bj < 2; ++bj) { const int c = tc0 + bj * HALF + 4 * n;
                w0[bj] = *(const PG8_LAS f32x4*)(vecs + c); w1[bj] = *(const PG8_LAS f32x4*)(vecs + 256 + c); w2[bj] = *(const PG8_LAS f32x4*)(vecs + 512 + c); cbv[bj] = *(const PG8_LAS f32x4*)(vecs + 768 + c); }
#pragma unroll
            for (int ai = 0; ai < 2; ++ai) {
                f32x4 prev[2];
                {   const int pai = (wr == 1) ? ai : ai - 1, pwr = (wr == 1) ? 0 : 1;
                    const bool has = (pai >= 0);
                    const PG8_LAS float* hp = halo + ((pai * 2 + pwr) * 2 + (fr & 1)) * 256 + tc0 + 4 * n;
#pragma unroll
                    for (int bj = 0; bj < 2; ++bj) prev[bj] = (has && fr >= 14) ? *(const PG8_LAS f32x4*)(hp + bj * HALF) : (f32x4){0.f, 0.f, 0.f, 0.f}; }
#pragma unroll
                for (int m = 0; m < 4; ++m) {
                    f32x4 cu[2];
#pragma unroll
                    for (int bj = 0; bj < 2; ++bj) { const f32x4 cur = acc[ai][bj][m][n], pv = prev[bj]; f32x4 o;
#pragma unroll
                        for (int j = 0; j < 4; ++j) { const float c1 = dpp_ror1(cur[j]), p1 = dpp_ror1(pv[j]), c2 = dpp_ror2(cur[j]), p2 = dpp_ror2(pv[j]);
                            const float s1 = f0 ? p1 : c1, s2 = f01 ? p2 : c2;
                            o[j] = cbv[bj][j] + w0[bj][j] * s2 + w1[bj][j] * s1 + w2[bj][j] * cur[j]; }
                        cu[bj] = o; prev[bj] = cur; }
                    f32x4 g;
#pragma unroll
                    for (int j = 0; j < 4; ++j) g[j] = silu_f(cu[0][j]) * cu[1][j];
                    const unsigned p0 = cvt_pk_bf16(g[0], g[1]), p1 = cvt_pk_bf16(g[2], g[3]);
                    if (n == 0) { gp[ai][m][0] = p0; gp[ai][m][1] = p1; }
                    else { u32x4 w; w.x = gp[ai][m][0]; w.y = gp[ai][m][1]; w.z = p0; w.w = p1;
                        *(u32x4*)(G + (size_t)(row0 + ai * HALF + m * 16) * N_FF + u.pn * HALF + tc0) = w; }
                }
            }
        }
    }
};
template <class Epi, class Sched, bool ALIGN_EPI = false, bool SP2 = false>
__device__ __forceinline__ void gemm_phase(PG8_LAS unsigned char* lds, const Gemm g, const Sched& S, const Epi& E, const int tid) {
    const int wid = __builtin_amdgcn_readfirstlane(tid >> 6), lane = tid & 63, wr = wid >> 2, wc = wid & 3, fr = lane & 15, fq = lane >> 4;
    const int K = g.K, nt = K / BK;
    unsigned voffA[2], voffB[2];
#pragma unroll
    for (int i = 0; i < 2; ++i) { int R, C; stage_rc(tid * 16 + i * 8192, R, C); const int Rb = Epi::PERM ? ((R & ~31) + perm32(R & 31)) : R;
        voffA[i] = (unsigned)(R * K + C) * 2u; voffB[i] = (unsigned)(Rb * K + C) * 2u; }
    const size_t kstep = (size_t)(BK * 2);
    const size_t hstep = (size_t)HALF * K * 2;
    const size_t tstep = 2 * hstep;
    const unsigned ldsw = (unsigned)wid * 1024u;
    const int aoff = lds_byte(wr * 64 + fr, fq * 8), boff = lds_byte(wc * 32 + fr, fq * 8);
#define PG8_SA(b, h) (((b) * 2 + (h)) * HTB)
#define PG8_SB(b, h) ((4 + (b) * 2 + (h)) * HTB)
#define PG8_STAGE(bufoff, gbase, voff) do { _Pragma("unroll") for (int _i = 0; _i < 2; ++_i) \
        __builtin_amdgcn_global_load_lds((const unsigned*)((const char*)(gbase) + (voff)[_i]), (PG8_LAS unsigned*)(lds + (bufoff) + ldsw + _i * 8192), 16, 0, 0); } while (0)
#define PG8_LDA(dst, b, h) do { _Pragma("unroll") for (int m = 0; m < 4; ++m) _Pragma("unroll") for (int k = 0; k < 2; ++k) dst[m][k] = *(const PG8_LAS bf16x8*)(lds + PG8_SA(b, h) + aoff + m * 2048 + k * 1024); } while (0)
#define PG8_LDB(dst, b, h) do { _Pragma("unroll") for (int n = 0; n < 2; ++n) _Pragma("unroll") for (int k = 0; k < 2; ++k) dst[n][k] = *(const PG8_LAS bf16x8*)(lds + PG8_SB(b, h) + boff + n * 2048 + k * 1024); } while (0)
#define PG8_MMA(ai, bj, At, Bt) do { __builtin_amdgcn_s_setprio(1); _Pragma("unroll") for (int m = 0; m < 4; ++m) _Pragma("unroll") for (int n = 0; n < 2; ++n) _Pragma("unroll") for (int k = 0; k < 2; ++k) \
        acc[ai][bj][m][n] = __builtin_amdgcn_mfma_f32_16x16x32_bf16(Bt[n][k], At[m][k], acc[ai][bj][m][n], 0, 0, 0); __builtin_amdgcn_s_setprio(0); } while (0)
#define PG8_WAIT_V(n) asm volatile("s_waitcnt vmcnt(" #n ")" ::: "memory")
#define PG8_WAIT_L(n) asm volatile("s_waitcnt lgkmcnt(" #n ")" ::: "memory")
#define PG8_BAR __builtin_amdgcn_s_barrier()
#define PG8_SCHED __builtin_amdgcn_sched_barrier(0)
    Unit cur, nxt; int ui = 0;
    if (!S.next(0, cur)) return;
    f32x4 acc[2][2][4][2];
#pragma unroll
    for (int a = 0; a < 2; ++a)
#pragma unroll
        for (int b = 0; b < 2; ++b)
#pragma unroll
            for (int m = 0; m < 4; ++m)
#pragma unroll
                for (int n = 0; n < 2; ++n) acc[a][b][m][n] = (f32x4){0.f, 0.f, 0.f, 0.f};
    bf16x8 At[4][2], B0[2][2], B1[2][2];
    const char* cA = (const char*)g.A + (size_t)cur.pm * tstep; const char* cB = (const char*)g.Bt + (size_t)cur.pn * tstep;
    S.a_ready(cur);
    if constexpr (SP2) {
        PG8_STAGE(PG8_SB(0, 0), cB, voffB); PG8_STAGE(PG8_SB(0, 1), cB + hstep, voffB); PG8_STAGE(PG8_SA(0, 0), cA, voffA); PG8_STAGE(PG8_SA(0, 1), cA + hstep, voffA);
        if (wr == 1) PG8_BAR;
        PG8_WAIT_V(2); PG8_BAR;
        PG8_STAGE(PG8_SB(1, 0), cB + kstep, voffB); PG8_STAGE(PG8_SA(1, 0), cA + kstep, voffA); PG8_STAGE(PG8_SB(1, 1), cB + hstep + kstep, voffB);
        PG8_WAIT_V(6); PG8_BAR;
    } else {
        PG8_STAGE(PG8_SB(0, 0), cB, voffB); PG8_STAGE(PG8_SA(0, 0), cA, voffA); PG8_STAGE(PG8_SB(0, 1), cB + hstep, voffB); PG8_STAGE(PG8_SA(0, 1), cA + hstep, voffA);
        if (wr == 1) PG8_BAR;
        PG8_WAIT_V(4); PG8_BAR;
        PG8_STAGE(PG8_SB(1, 0), cB + kstep, voffB); PG8_STAGE(PG8_SA(1, 0), cA + kstep, voffA); PG8_STAGE(PG8_SB(1, 1), cB + hstep + kstep, voffB);
        PG8_WAIT_V(6); PG8_BAR;
    }
    for (;;) {
        const bool has_next = S.next(ui + 1, nxt);
        const char* nA = has_next ? (const char*)g.A + (size_t)nxt.pm * tstep : cA; const char* nB = has_next ? (const char*)g.Bt + (size_t)nxt.pn * tstep : cB;
        for (int t = 0; t < nt; t += 2) {
            const bool last = (t == nt - 2);
            const char* a1 = cA + (size_t)(t + 1) * kstep;
            const char* a2 = last ? nA : cA + (size_t)(t + 2) * kstep; const char* b2 = last ? nB : cB + (size_t)(t + 2) * kstep;
            const char* a3 = a2 + kstep; const char* b3 = b2 + kstep;
            if (last && has_next) S.a_ready(nxt);
            if constexpr (SP2) {
            PG8_LDB(B0, 0, 0); PG8_LDB(B1, 0, 1); PG8_SCHED; PG8_LDA(At, 0, 0); PG8_STAGE(PG8_SA(1, 1), a1 + hstep, voffA);
            PG8_WAIT_V(8); PG8_WAIT_L(0); PG8_BAR; PG8_MMA(0, 0, At, B0); PG8_MMA(0, 1, At, B1); PG8_BAR; PG8_SCHED;
            PG8_LDA(At, 0, 1); PG8_STAGE(PG8_SB(0, 0), b2, voffB); PG8_STAGE(PG8_SB(0, 1), b2 + hstep, voffB); PG8_STAGE(PG8_SA(0, 0), a2, voffA);
            PG8_WAIT_V(8); PG8_WAIT_L(0); PG8_BAR; PG8_MMA(1, 0, At, B0); PG8_MMA(1, 1, At, B1); PG8_BAR; PG8_SCHED;
            PG8_LDB(B0, 1, 0); PG8_LDB(B1, 1, 1); PG8_SCHED; PG8_LDA(At, 1, 0); PG8_STAGE(PG8_SA(0, 1), a2 + hstep, voffA);
            PG8_WAIT_V(8); PG8_WAIT_L(0); PG8_BAR; PG8_MMA(0, 0, At, B0); PG8_MMA(0, 1, At, B1); PG8_BAR; PG8_SCHED;
            PG8_LDA(At, 1, 1); PG8_STAGE(PG8_SB(1, 0), b3, voffB); PG8_STAGE(PG8_SB(1, 1), b3 + hstep, voffB); PG8_STAGE(PG8_SA(1, 0), a3, voffA);
            PG8_WAIT_V(8); PG8_WAIT_L(0); PG8_BAR; PG8_MMA(1, 0, At, B0); PG8_MMA(1, 1, At, B1); PG8_BAR; PG8_SCHED;
            } else {
            PG8_LDB(B0, 0, 0); PG8_SCHED; PG8_LDA(At, 0, 0); PG8_STAGE(PG8_SA(1, 1), a1 + hstep, voffA);
            PG8_WAIT_L(8); PG8_BAR; PG8_WAIT_L(0); PG8_MMA(0, 0, At, B0); PG8_BAR; PG8_SCHED;
            PG8_LDB(B1, 0, 1); PG8_STAGE(PG8_SB(0, 0), b2, voffB);
            PG8_BAR; PG8_WAIT_L(0); PG8_MMA(0, 1, At, B1); PG8_BAR;
            PG8_LDA(At, 0, 1); PG8_STAGE(PG8_SA(0, 0), a2, voffA);
            PG8_BAR; PG8_WAIT_L(0); PG8_MMA(1, 0, At, B0); PG8_BAR; PG8_SCHED;
            PG8_STAGE(PG8_SB(0, 1), b2 + hstep, voffB);
            PG8_WAIT_V(6); PG8_BAR; PG8_MMA(1, 1, At, B1); PG8_BAR;
            PG8_LDB(B0, 1, 0); PG8_SCHED; PG8_LDA(At, 1, 0); PG8_STAGE(PG8_SA(0, 1), a2 + hstep, voffA);
            PG8_WAIT_L(8); PG8_BAR; PG8_WAIT_L(0); PG8_MMA(0, 0, At, B0); PG8_BAR; PG8_SCHED;
            PG8_LDB(B1, 1, 1); PG8_STAGE(PG8_SB(1, 0), b3, voffB);
            PG8_BAR; PG8_WAIT_L(0); PG8_MMA(0, 1, At, B1); PG8_BAR;
            PG8_LDA(At, 1, 1); PG8_STAGE(PG8_SA(1, 0), a3, voffA);
            PG8_BAR; PG8_WAIT_L(0); PG8_MMA(1, 0, At, B0); PG8_BAR; PG8_SCHED;
            PG8_STAGE(PG8_SB(1, 1), b3 + hstep, voffB);
            PG8_WAIT_V(6); PG8_BAR; PG8_MMA(1, 1, At, B1); PG8_BAR;
            }
        }
        if constexpr (ALIGN_EPI) { if (wr == 0) PG8_BAR; }
        if constexpr (!Epi::AFTER_DRAIN) { int lane_e; asm volatile("v_mbcnt_lo_u32_b32 %0, -1, 0\n\tv_mbcnt_hi_u32_b32 %0, -1, %0" : "=v"(lane_e));
            const int fr_e = lane_e & 15, fq_e = lane_e >> 4; int wr_e = wr, wc_e = wc; asm volatile("" : "+s"(wr_e), "+s"(wc_e));
#ifdef PROBE_KDUP
            if (!Sched::DUP || (ui & 1))
#endif
            E(acc, cur, wr_e, wc_e, fr_e, fq_e);
#ifdef PROBE_EPI2
            if constexpr (Epi::IDEMPOTENT) { asm volatile("" ::: "memory"); E(acc, cur, wr_e, wc_e, fr_e, fq_e); }
#endif
            S.done(cur); }
        if (!has_next) break;
#pragma unroll
        for (int a = 0; a < 2; ++a)
#pragma unroll
            for (int b = 0; b < 2; ++b)
#pragma unroll
                for (int m = 0; m < 4; ++m)
#pragma unroll
                    for (int n = 0; n < 2; ++n) acc[a][b][m][n] = (f32x4){0.f, 0.f, 0.f, 0.f};
        cur = nxt; cA = nA; cB = nB; ++ui;
        if constexpr (ALIGN_EPI) { if (wr == 1) PG8_BAR; }
    }
    PG8_WAIT_V(0);
    if constexpr (!ALIGN_EPI) { if (wr == 0) PG8_BAR; }
    PG8_BAR;
    if constexpr (Epi::AFTER_DRAIN) { E.fused(acc, cur, wr, wc, fr, fq, lds, wid, lane); S.done(cur); }
#undef PG8_SA
#undef PG8_SB
#undef PG8_STAGE
#undef PG8_LDA
#undef PG8_LDB
#undef PG8_MMA
#undef PG8_WAIT_V
#undef PG8_WAIT_L
#undef PG8_BAR
#undef PG8_SCHED
}
}

constexpr int NWAVES = 8;
#ifndef MK_PER_PHASE
#define MK_PER_PHASE 0
#endif
constexpr int NB = 16, SEQ = 4096, D = 1024, DEPTH = 4, M = NB * SEQ;
constexpr int NIN = 3840, NINW = 3584, FF = 2816, NUP = 5632, NMOD = 6144;
constexpr float EPS = 1e-6f;
constexpr int N_PHASES = 2 + 6 * DEPTH + 1;

constexpr size_t MiB = 1u << 20;
constexpr size_t WS_CTL = 0, CTL_ZERO_BYTES = 4 * MiB;
constexpr size_t WS_MOD = 2 * MiB;
constexpr size_t WS_SMALL = 4 * MiB;
constexpr size_t WS_STAT = 12 * MiB;
constexpr size_t WS_RAWH = 16 * MiB, WS_RAWT = 28 * MiB;
constexpr size_t WS_WIN = 40 * MiB;
constexpr size_t WS_WOUT = 70 * MiB;
constexpr size_t WS_WUP = 78 * MiB;
constexpr size_t WS_WDN = 122 * MiB;
constexpr size_t WS_XN = 144 * MiB;
constexpr size_t WS_O = 272 * MiB;
constexpr size_t WS_P = 400 * MiB;
constexpr size_t WS_END = 880 * MiB;
constexpr int SM_LB = 0;
constexpr int SM_CW = SM_LB + 4 * 512;
constexpr int SM_CB = SM_CW + 4 * 3 * NUP;
constexpr int SM_GS1 = SM_CB + 4 * NUP;
constexpr int SM_GS2 = SM_GS1 + 4 * 16 * D;
constexpr int SM_GT1 = SM_GS2 + 4 * 16 * D;
constexpr int SM_GT2 = SM_GT1 + 4 * 16 * D;
constexpr int SM_B1 = SM_GT2 + 4 * 16 * D;
constexpr int SM_B2 = SM_B1 + 4 * 16 * NIN;
constexpr int SM_END = SM_B2 + 4 * 16 * NUP;
static_assert((size_t)SM_END * 4 <= 8 * MiB, "small vectors fit");
constexpr int CW_BAR = 4096;

constexpr int RING_BYTES = 131072, HALO_OFF = RING_BYTES, HALO_BYTES = 12288, LDSCTL_OFF = HALO_OFF + HALO_BYTES, MISC_OFF = LDSCTL_OFF + 320;
constexpr int LDS_BYTES = 147456;
static_assert(MISC_OFF + 128 <= LDS_BYTES, "LDS map");

#define GAS __attribute__((address_space(1)))
#define LAS __attribute__((address_space(3)))
typedef unsigned short bf16;
typedef unsigned v4u __attribute__((ext_vector_type(4)));
typedef unsigned v2u __attribute__((ext_vector_type(2)));
typedef float f32x4 __attribute__((ext_vector_type(4)));
#define LDS_WAIT() asm volatile("s_waitcnt lgkmcnt(0)" ::: "memory")
__device__ __forceinline__ unsigned f2bf(float f) { unsigned u = __builtin_bit_cast(unsigned, f); return (u + 0x7fffu + ((u >> 16) & 1u)) >> 16; }
__device__ __forceinline__ unsigned pk2(float lo, float hi) { return f2bf(lo) | (f2bf(hi) << 16); }
__device__ __forceinline__ float bf2f(unsigned h) { return __builtin_bit_cast(float, h << 16); }
__device__ __forceinline__ float wave_sum(float v) {
#pragma unroll
    for (int o = 1; o < 64; o <<= 1) v += __shfl_xor(v, o);
    return v;
}
__device__ __forceinline__ float sigmoid_f(float x) { return 1.0f / (1.0f + __expf(-x)); }
#define XB_TMO      128
#define XB_XCNT(j)  (256  + 64 * (j))
#define XB_XSUB(j)  (1280 + 64 * (j))
#define XB_XGEN(j)  (2304 + 64 * (j))
#define XB_TOP      3328
#define XB_TOPGEN   3392
#define XCD_BAR_WORDS 3456
#define XB_SPIN_CAP (1u << 18)

__device__ __forceinline__ unsigned xb_ld(unsigned* p)              { return __hip_atomic_load(p, __ATOMIC_RELAXED, __HIP_MEMORY_SCOPE_AGENT); }
__device__ __forceinline__ unsigned xb_add(unsigned* p, unsigned v) { return __hip_atomic_fetch_add(p, v, __ATOMIC_RELAXED, __HIP_MEMORY_SCOPE_AGENT); }
__device__ __forceinline__ unsigned xb_xcc_id() { return (unsigned)__builtin_amdgcn_s_getreg((3 << 11) | 20) & 0xFu; }
#define XB_SPIN(cond, bar) do { unsigned _sp = 0; while (cond) { __builtin_amdgcn_s_sleep(1); \
    if ((++_sp & 255u) == 0u) { if (xb_ld(&(bar)[XB_TMO])) break; if (_sp > XB_SPIN_CAP) { atomicAdd(&(bar)[XB_TMO], 1u); break; } } } } while (0)

struct XcdBarrier {
    unsigned* bar; unsigned x;
    volatile LAS unsigned* st;
};

__device__ __forceinline__ XcdBarrier xcd_barrier_post(unsigned* bar, volatile LAS unsigned* st) {
    XcdBarrier b; b.bar = bar; b.x = xb_xcc_id(); b.st = st;
    if (threadIdx.x == 0) (void)xb_add(&bar[XB_XCNT(b.x)], 1u);
    return b;
}
__device__ __forceinline__ void xcd_barrier_complete(unsigned* bar, unsigned x, unsigned& nloc, unsigned& nx) {
    const unsigned G = gridDim.x * gridDim.y * gridDim.z;
    unsigned sum, cnt, mine, sp = 0u;
    for (;;) {
        sum = 0u; cnt = 0u; mine = 0u;
#pragma unroll
        for (unsigned j = 0; j < 16; ++j) { const unsigned c = xb_ld(&bar[XB_XCNT(j)]); sum += c; cnt += (c > 0u) ? 1u : 0u; mine = (j == x) ? c : mine; }
        if (sum == G) break;
        __builtin_amdgcn_s_sleep(1);
        if ((++sp & 255u) == 0u) { if (xb_ld(&bar[XB_TMO])) break; if (sp > XB_SPIN_CAP) { atomicAdd(&bar[XB_TMO], 1u); break; } }
    }
    nloc = mine > 0u ? mine : 1u; nx = cnt > 0u ? cnt : 1u;
}

__device__ __forceinline__ void xcd_barrier(const XcdBarrier& b, const bool is_t0  ) {
    asm volatile("s_waitcnt vmcnt(0)" ::: "memory");
    __syncthreads();
    if (is_t0) {
        unsigned* bar = b.bar;
        __builtin_amdgcn_s_waitcnt(0);
        unsigned nloc = b.st[0], nx = b.st[1];
        if (nloc == 0u) { xcd_barrier_complete(bar, b.x, nloc, nx); b.st[0] = nloc; b.st[1] = nx; }
        const unsigned old = xb_add(&bar[XB_XSUB(b.x)], 1u);
        const unsigned gen = old / nloc;
        if (old + 1u == (gen + 1u) * nloc) {
            __builtin_amdgcn_fence(__ATOMIC_RELEASE, "agent");
            asm volatile("s_waitcnt vmcnt(0)" ::: "memory");
            const unsigned og = xb_add(&bar[XB_TOP], 1u);
            const unsigned tg = og / nx;
            if (og + 1u == (tg + 1u) * nx) xb_add(&bar[XB_TOPGEN], 1u);
            else XB_SPIN(xb_ld(&bar[XB_TOPGEN]) == tg, bar);
            __builtin_amdgcn_fence(__ATOMIC_ACQUIRE, "agent");
            xb_add(&bar[XB_XGEN(b.x)], 1u);
            asm volatile("s_waitcnt vmcnt(0)" ::: "memory");
        } else {
            XB_SPIN(xb_ld(&bar[XB_XGEN(b.x)]) == gen, bar);
            __builtin_amdgcn_fence(__ATOMIC_ACQUIRE, "agent");
            asm volatile("s_waitcnt vmcnt(0)" ::: "memory");
        }
    }
    __syncthreads();
}

struct Frame {
    LAS unsigned char* lds;
    volatile LAS unsigned* MISC;
    unsigned* ctl;
    int tid, lane, wave, vcu, G;
    const float *x, *c, *ln1_g, *ln2_g, *w_ada, *b_ada, *w_in, *lb_params, *w_gk, *b_gk, *gn_a, *gn_b, *w_out, *w_up, *conv_w, *conv_b, *w_down, *lnf_g;
    float* out;
    float *MOD, *SMALL, *STAT, *RAWH, *RAWT;
    bf16 *WIN, *WOUT, *WUP, *WDN, *XN, *O, *P, *Gb;
};

__device__ __forceinline__ void tr_item(const float* W, int Nsrc, int K, bf16* WT, int kb, int sn0, int dn0, float scale, LAS float* scr, int lane) {
    const int k0 = 64 * kb;
#pragma unroll 8
    for (int i = 0; i < 32; ++i) { const int kk = 2 * i + (lane >> 5); scr[kk * 33 + (lane & 31)] = W[(size_t)(k0 + kk) * Nsrc + sn0 + (lane & 31)]; }
    LDS_WAIT(); asm volatile("" ::: "memory");
    const int c = lane & 7;
#pragma unroll
    for (int j = 0; j < 4; ++j) { const int n = (lane >> 3) + 8 * j; const LAS float* s = scr + (8 * c) * 33 + n;
        v4u o; o.x = pk2(s[0 * 33] * scale, s[1 * 33] * scale); o.y = pk2(s[2 * 33] * scale, s[3 * 33] * scale); o.z = pk2(s[4 * 33] * scale, s[5 * 33] * scale); o.w = pk2(s[6 * 33] * scale, s[7 * 33] * scale);
        *(GAS v4u*)(WT + (size_t)(dn0 + n) * K + k0 + 8 * c) = o; }
    LDS_WAIT(); asm volatile("" ::: "memory");
}
__host__ __device__ __forceinline__ int up_orig(int np) { return ((np & 255) >> 7) * FF + 128 * (np >> 8) + (np & 127); }

__device__ __forceinline__ void p0a(Frame& F) {
    const int gw = F.vcu * NWAVES + F.wave, NGW = F.G * NWAVES, gt = F.vcu * (NWAVES * 64) + F.tid, NGT = F.G * NWAVES * 64;
    {
        LAS float* cond = (LAS float*)F.lds;
        for (int e = F.tid; e < 16 * 1024; e += NWAVES * 64) { const int b = e >> 10, d = e & 1023; const float cv = F.c[b * 1024 + d]; cond[d * 16 + b] = cv * sigmoid_f(cv); }
        __syncthreads();
        for (int it = gw; it < DEPTH * 384; it += NGW) {
            const int cb = it % 384, l = it / 384, e = cb * 16 + (F.lane & 15), dq = F.lane >> 4;
            const float* w = F.w_ada + ((size_t)l * 1024 + dq) * NMOD + e;
            float acc[16];
#pragma unroll
            for (int b = 0; b < 16; ++b) acc[b] = 0.f;
#pragma unroll 4
            for (int dd = 0; dd < 256; ++dd) {
                const float wv = w[(size_t)(4 * dd) * NMOD];
                const LAS f32x4* cp = (const LAS f32x4*)(cond + (4 * dd + dq) * 16);
#pragma unroll
                for (int q = 0; q < 4; ++q) { const f32x4 cq = cp[q]; acc[4 * q] += cq[0] * wv; acc[4 * q + 1] += cq[1] * wv; acc[4 * q + 2] += cq[2] * wv; acc[4 * q + 3] += cq[3] * wv; }
            }
            const float bb = F.b_ada[l * NMOD + e];
#pragma unroll
            for (int b = 0; b < 16; ++b) { float v = acc[b]; v += __shfl_xor(v, 16); v += __shfl_xor(v, 32); if (dq == 0) F.MOD[(size_t)(l * 16 + b) * NMOD + e] = v + bb; }
        }
        __syncthreads();
    }
    for (int i = gt; i < 512; i += NGT) {
        const float p0 = F.lb_params[i], p1 = F.lb_params[512 + i], p2 = F.lb_params[1024 + i], p3 = F.lb_params[1536 + i];
        const float mx = fmaxf(fmaxf(p0, p1), fmaxf(p2, p3)); const float e0 = __expf(p0 - mx), e1 = __expf(p1 - mx), e2 = __expf(p2 - mx), e3 = __expf(p3 - mx);
        const float inv = 1.0f / (e0 + e1 + e2 + e3);
        F.SMALL[SM_LB + i] = 0.f; F.SMALL[SM_LB + 512 + i] = e1 * inv; F.SMALL[SM_LB + 1024 + i] = (e1 + e2) * inv; F.SMALL[SM_LB + 1536 + i] = (e1 + e2 + e3) * inv;
    }
    for (int i = gt; i < DEPTH * 3 * NUP; i += NGT) { const int np = i % NUP, lj = i / NUP; F.SMALL[SM_CW + i] = F.conv_w[(size_t)lj * NUP + up_orig(np)]; }
    for (int i = gt; i < DEPTH * NUP; i += NGT) { const int np = i % NUP, l = i / NUP; F.SMALL[SM_CB + i] = F.conv_b[(size_t)l * NUP + up_orig(np)]; }
    for (int i = gt; i < DEPTH * 256 * 1024; i += NGT) {
        const int k = i & 1023, n = (i >> 10) & 255, l = i >> 18;
        const float* wi = F.w_in + ((size_t)l * 1024 + k) * 3600 + NINW; const float* wg = F.w_gk + (size_t)l * 16 * 256 + n;
        float s = 0.f;
#pragma unroll
        for (int r = 0; r < 16; ++r) s += wi[r] * wg[r * 256];
        F.WIN[((size_t)l * NIN + NINW + n) * 1024 + k] = (bf16)f2bf(s);
    }
    {   LAS float* scr = (LAS float*)(F.lds + F.wave * 16384);
        constexpr int I_IN = 16 * 112, I_OUT = 16 * 32, I_UP = 16 * 176, I_DN = 44 * 32, I_L = I_IN + I_OUT + I_UP + I_DN;
        for (int it = gw; it < DEPTH * I_L; it += NGW) {
            const int l = it / I_L; int r = it % I_L;
            if (r < I_IN) { const int kb = r / 112, nb = r % 112; tr_item(F.w_in + (size_t)l * 1024 * 3600, 3600, 1024, F.WIN + (size_t)l * NIN * 1024, kb, 32 * nb, 32 * nb, (nb >= 64 && nb < 72) ? 0.125f : 1.0f, scr, F.lane); continue; } r -= I_IN;
            if (r < I_OUT) { const int kb = r / 32, nb = r % 32; tr_item(F.w_out + (size_t)l * 1024 * 1024, 1024, 1024, F.WOUT + (size_t)l * 1024 * 1024, kb, 32 * nb, 32 * nb, 1.0f, scr, F.lane); continue; } r -= I_OUT;
            if (r < I_UP) { const int kb = r / 176, nb = r % 176; tr_item(F.w_up + (size_t)l * 1024 * NUP, NUP, 1024, F.WUP + (size_t)l * NUP * 1024, kb, up_orig(32 * nb), 32 * nb, 1.0f, scr, F.lane); continue; } r -= I_UP;
            { const int kb = r / 32, nb = r % 32; tr_item(F.w_down + (size_t)l * FF * 1024, 1024, FF, F.WDN + (size_t)l * 1024 * FF, kb, 32 * nb, 32 * nb, 1.0f, scr, F.lane); }
        }
    }
}

__device__ __forceinline__ void p0b(Frame& F) {
    const int gw = F.vcu * NWAVES + F.wave, NGW = F.G * NWAVES, gt = F.vcu * (NWAVES * 64) + F.tid, NGT = F.G * NWAVES * 64;
    LAS float* shL = (LAS float*)F.lds;
    for (int combo = 0; combo < 2 * DEPTH; ++combo) {
        const int l = combo >> 1, which = combo & 1;
        __syncthreads();
        for (int e = F.tid; e < 16 * 1024; e += NWAVES * 64) { const int b = e >> 10, d = e & 1023; shL[e] = F.MOD[(size_t)(l * 16 + b) * NMOD + (which ? 3072 : 0) + d]; }
        __syncthreads();
        const bf16* Wt = which ? F.WUP + (size_t)l * NUP * 1024 : F.WIN + (size_t)l * NIN * 1024; const int ncols = which ? NUP : NIN;
        float* outp = F.SMALL + (which ? SM_B2 + l * 16 * NUP : SM_B1 + l * 16 * NIN);
        for (int n = gw; n < ncols; n += NGW) {
            const GAS v2u* wr = (const GAS v2u*)(Wt + (size_t)n * 1024) + F.lane;
            float w[16];
#pragma unroll
            for (int i = 0; i < 4; ++i) { const v2u p = wr[64 * i]; w[4 * i] = bf2f(p.x & 0xffffu); w[4 * i + 1] = bf2f(p.x >> 16); w[4 * i + 2] = bf2f(p.y & 0xffffu); w[4 * i + 3] = bf2f(p.y >> 16); }
            float res = 0.f;
#pragma unroll 1
            for (int b = 0; b < 16; ++b) { float s = 0.f;
#pragma unroll
                for (int i = 0; i < 4; ++i) { const f32x4 sh = *(const LAS f32x4*)(shL + b * 1024 + 256 * i + 4 * F.lane); s += sh[0] * w[4 * i] + sh[1] * w[4 * i + 1] + sh[2] * w[4 * i + 2] + sh[3] * w[4 * i + 3]; }
                s = wave_sum(s); res = (F.lane == b) ? s : res; }
            if (F.lane < 16) outp[F.lane * ncols + n] = res + ((which == 0 && n >= NINW) ? F.b_gk[l * 256 + n - NINW] : 0.f);
        }
    }
    for (int i = gt; i < DEPTH * 16 * D; i += NGT) { const int d = i & 1023, lb = i >> 10, l = lb >> 4; const float* mod = F.MOD + (size_t)lb * NMOD;
        F.SMALL[SM_GS1 + i] = F.ln1_g[l * D + d] * (1.0f + mod[1024 + d]); F.SMALL[SM_GT1 + i] = mod[2048 + d];
        F.SMALL[SM_GS2 + i] = F.ln2_g[l * D + d] * (1.0f + mod[4096 + d]); F.SMALL[SM_GT2 + i] = mod[5120 + d]; }
    for (int row = gw; row < M; row += NGW) {
        const int b = row / SEQ; const GAS f32x4* xr = (const GAS f32x4*)(F.x + (size_t)row * D) + F.lane; const float* mod = F.MOD + (size_t)b * NMOD + 1024;
        GAS v2u* o8 = (GAS v2u*)(F.XN + (size_t)row * D) + F.lane; float ss = 0.f;
#pragma unroll
        for (int j = 0; j < 4; ++j) { const f32x4 v = xr[64 * j]; const int d = 256 * j + 4 * F.lane; const f32x4 g = *(const f32x4*)(F.ln1_g + d), sc = *(const f32x4*)(mod + d);
            ss += (v[0] * v[0] + v[1] * v[1]) + (v[2] * v[2] + v[3] * v[3]);
            v2u w; w.x = pk2(v[0] * g[0] * (1.0f + sc[0]), v[1] * g[1] * (1.0f + sc[1])); w.y = pk2(v[2] * g[2] * (1.0f + sc[2]), v[3] * g[3] * (1.0f + sc[3])); o8[64 * j] = w; }
        ss = wave_sum(ss);
        if (F.lane < 16) F.STAT[(size_t)row * 16 + F.lane] = (F.lane == 0) ? ss : 0.f;
    }
}

template <int DK, bool IS_A>
__device__ __forceinline__ void mixer_stream(Frame& F, int l, int b, int h) {
    constexpr int DKS = DK / 4, TB = 16;
    LAS float* aL = (LAS float*)F.lds; LAS float* kL = aL + TB * 128; LAS float* qL = kL + TB * 128; LAS float* vL = qL + TB * 128; LAS float* gL = vL + TB * 128;
    LAS float* part = gL + TB * 128;
    LAS float* red = part + TB * 4 * 128;
    const int tid = F.tid, j = tid & 127, sl = tid >> 7;
    const int qc = IS_A ? 128 * h : 2048 + 64 * h, fc = IS_A ? 512 + 128 * h : 2304 + 64 * h, gkc = 3584 + 64 * h;
    const int vc = IS_A ? 1024 + 128 * h : 2560 + 128 * h, gc = IS_A ? 1536 + 128 * h : 3072 + 128 * h, oc = IS_A ? 128 * h : 512 + 128 * h;
    const float* lbp = F.SMALL + SM_LB + l * 512 + 128 * h;
    const float gn = (IS_A ? F.gn_a : F.gn_b)[l * 128 + j];
    float S[DKS];
#pragma unroll
    for (int i = 0; i < DKS; ++i) S[i] = 0.f;
    for (int t0 = 0; t0 < SEQ; t0 += TB) {
        const size_t rowb = (size_t)b * SEQ + t0;
        for (int e = tid; e < TB * DK; e += NWAVES * 64) { const int tt = e / DK, i = e % DK; const bf16* pr = F.P + (rowb + tt) * NIN;
            const float q = bf2f(pr[qc + i]); float a, k;
            if (IS_A) { const float fa = bf2f(pr[fc + i]), lb = lbp[i], sg = sigmoid_f(fa); a = lb + (1.0f - lb) * sg; k = (1.0f - lb) * (1.0f - sg); }
            else { k = bf2f(pr[fc + i]); const float gk = bf2f(pr[gkc + i]); const float ls = fminf(gk, 0.f) - __logf(1.0f + __expf(-fabsf(gk))); a = __expf(ls * (1.0f / 16.0f)); }
            aL[tt * 128 + i] = a; kL[tt * 128 + i] = k; qL[tt * 128 + i] = q; }
        for (int e = tid; e < TB * 128; e += NWAVES * 64) { const int tt = e >> 7, jj = e & 127; const bf16* pr = F.P + (rowb + tt) * NIN; vL[e] = bf2f(pr[vc + jj]); gL[e] = bf2f(pr[gc + jj]); }
        __syncthreads();
#pragma unroll 1
        for (int tt = 0; tt < TB; ++tt) { const float v = vL[tt * 128 + j]; float acc = 0.f;
#pragma unroll
            for (int i4 = 0; i4 < DKS / 4; ++i4) { const f32x4 a4 = *(const LAS f32x4*)(aL + tt * 128 + sl * DKS + 4 * i4), k4 = *(const LAS f32x4*)(kL + tt * 128 + sl * DKS + 4 * i4), q4 = *(const LAS f32x4*)(qL + tt * 128 + sl * DKS + 4 * i4);
#pragma unroll
                for (int r = 0; r < 4; ++r) { S[4 * i4 + r] = a4[r] * S[4 * i4 + r] + k4[r] * v; acc += q4[r] * S[4 * i4 + r]; } }
            part[(tt * 4 + sl) * 128 + j] = acc; }
        __syncthreads();
        float o[4];
#pragma unroll
        for (int r = 0; r < 4; ++r) { const int tt = sl * 4 + r; o[r] = (part[(tt * 4 + 0) * 128 + j] + part[(tt * 4 + 1) * 128 + j]) + (part[(tt * 4 + 2) * 128 + j] + part[(tt * 4 + 3) * 128 + j]);
            const float ss = wave_sum(o[r] * o[r]); if (F.lane == 0) red[tt * 2 + ((tid >> 6) & 1)] = ss; }
        __syncthreads();
#pragma unroll
        for (int r = 0; r < 4; ++r) { const int tt = sl * 4 + r; const float tot = red[tt * 2] + red[tt * 2 + 1]; const float rn = 1.0f / sqrtf(tot * (1.0f / 128.0f) + EPS);
            const float g = gL[tt * 128 + j]; F.O[(rowb + tt) * D + oc + j] = (bf16)f2bf(o[r] * rn * gn * (g * sigmoid_f(g))); }
        __syncthreads();
    }
}
__device__ __forceinline__ void mixer_phase(Frame& F, int l) {
    for (int s = blockIdx.x; s < NB * 8; s += F.G) { const int b = s >> 3, hh = s & 7;
        if (hh < 4) mixer_stream<128, true>(F, l, b, hh); else mixer_stream<64, false>(F, l, b, hh - 4); }
}

#ifndef MIXER_NAIVE
#define MIXER_NAIVE 0
#endif
#if MIXER_NAIVE
#define MIXER_PHASE mixer_phase
#else
#define MIXER_PHASE mixer_phase_chunked
#endif


typedef short bf16x8_t __attribute__((ext_vector_type(8)));
typedef short s16x4_t __attribute__((ext_vector_type(4)));
typedef float f32x2_t __attribute__((ext_vector_type(2)));
typedef __bf16 bf16x2_t __attribute__((ext_vector_type(2)));
#define MFMA16(a, b, c) __builtin_amdgcn_mfma_f32_16x16x32_bf16((a), (b), (c), 0, 0, 0)
#ifdef MX_FULLSYNC
#define LBAR() __syncthreads()
#else
#define LBAR() do { asm volatile("s_waitcnt lgkmcnt(0)" ::: "memory"); __builtin_amdgcn_s_barrier(); asm volatile("" ::: "memory"); } while (0)
#endif
__device__ __forceinline__ unsigned cvtpk(float lo, float hi) { f32x2_t v = {lo, hi}; bf16x2_t r = __builtin_convertvector(v, bf16x2_t); return __builtin_bit_cast(unsigned, r); }
__device__ __forceinline__ float bflo(unsigned u) { return __builtin_bit_cast(float, u << 16); }
__device__ __forceinline__ float bfhi(unsigned u) { return __builtin_bit_cast(float, u & 0xffff0000u); }
__device__ __forceinline__ s16x4_t tr16(const LAS unsigned char* p) { return __builtin_bit_cast(s16x4_t, __builtin_amdgcn_ds_read_tr16_b64_v4i16((LAS s16x4_t*)p)); }
constexpr float L2E = 1.4426950408889634f;

template <int DK, bool IS_A>
__device__ __forceinline__ void mixer_chunked_stream(Frame& F, int l, int b, int h, const int n_lo, const int n_full, const int n_hi) {
    constexpr int CP = DK / 2, TS = 512 / CP, R = 64 / TS, TSREF = 32 / R, NKS = DK / 32, NMT = DK / 16, NCH = SEQ / 64;
    constexpr int PQ = DK * 2 + 16, PT = 144, PV = 272, PO = 528;
    constexpr int L_QH = 0, L_KH = L_QH + 64 * PQ, L_VV = L_KH + 64 * PQ, L_SC = L_VV + 64 * PV, L_SEG = L_SC + 64 * PT, L_ERF = L_SEG + TS * DK * 4, L_ELR = L_ERF + DK * 4, L_DEC = L_ELR + DK * 4,
                  L_OB = L_DEC + DK * 4, L_END = L_OB + 64 * PO;
    static_assert(L_END <= RING_BYTES, "mixer LDS map");
    LAS unsigned char* const lds = F.lds;
    const int w = F.wave;
#define MX_IDS() int lane; asm volatile("v_mbcnt_lo_u32_b32 %0, -1, 0\n\tv_mbcnt_hi_u32_b32 %0, -1, %0" : "=v"(lane)); const int tid = w * 64 + lane, m = lane & 15, g = lane >> 4, q4 = (lane & 15) >> 2, p4 = lane & 3, \
        cp = tid % CP, ts = tid / CP, nt = tid >> 3, ndq = tid & 7, vr0 = tid >> 4, vq = tid & 15; (void)m; (void)g; (void)q4; (void)p4; (void)cp; (void)ts; (void)nt; (void)ndq; (void)vr0; (void)vq
    const int qc = IS_A ? 128 * h : 2048 + 64 * h, fc = IS_A ? 512 + 128 * h : 2304 + 64 * h, gkc = 3584 + 64 * h;
    const int vc = IS_A ? 1024 + 128 * h : 2560 + 128 * h, gc = IS_A ? 1536 + 128 * h : 3072 + 128 * h, oc = IS_A ? 128 * h : 512 + 128 * h;
    float lb0 = 0.f, lb1 = 0.f;
    if (IS_A) { MX_IDS(); lb0 = F.SMALL[SM_LB + l * 512 + 128 * h + 2 * cp]; lb1 = F.SMALL[SM_LB + l * 512 + 128 * h + 2 * cp + 1]; }
    const float* gnp = (IS_A ? F.gn_a : F.gn_b) + l * 128;

    f32x4 S[NMT];
#pragma unroll
    for (int i = 0; i < NMT; ++i) S[i] = (f32x4){0.f, 0.f, 0.f, 0.f};
    unsigned q2[R], f2[R], k2[R];
    v4u vreg[2], ogreg[2];
    float cum[2][R], kk[2][R];

#define MX_LOAD_RAW(n) do { const size_t row0_ = (size_t)b * SEQ + (size_t)(n) * 64; \
        _Pragma("unroll") for (int j = 0; j < R; ++j) { const unsigned* pr = (const unsigned*)(F.P + (row0_ + ts * R + j) * NIN); \
            q2[j] = pr[(qc >> 1) + cp]; if (IS_A) { f2[j] = pr[(fc >> 1) + cp]; } else { k2[j] = pr[(fc >> 1) + cp]; f2[j] = pr[(gkc >> 1) + cp]; } } \
        _Pragma("unroll") for (int i = 0; i < 2; ++i) vreg[i] = *(const v4u*)(F.P + (row0_ + vr0 + 32 * i) * NIN + vc + 8 * vq); } while (0)
#define MX_E1() do { \
        _Pragma("unroll") for (int c = 0; c < 2; ++c) { float run = IS_A ? 1.f : 0.f; const float lb = c ? lb1 : lb0; \
            _Pragma("unroll") for (int j = 0; j < R; ++j) { const float x = c ? bfhi(f2[j]) : bflo(f2[j]); \
                if (IS_A) { const float sg = __builtin_amdgcn_rcpf(1.0f + __builtin_amdgcn_exp2f(-x * L2E)); run *= lb + (1.0f - lb) * sg; kk[c][j] = (1.0f - lb) * (1.0f - sg); } \
                else { run += (fminf(x, 0.f) * L2E - __builtin_amdgcn_logf(1.0f + __builtin_amdgcn_exp2f(-fabsf(x) * L2E))) * (1.0f / 16.0f); kk[c][j] = c ? bfhi(k2[j]) : bflo(k2[j]); } \
                cum[c][j] = run; } } \
        *(LAS f32x2_t*)(lds + L_SEG + (ts * DK + 2 * cp) * 4) = IS_A ? (f32x2_t){__builtin_amdgcn_logf(cum[0][R - 1]), __builtin_amdgcn_logf(cum[1][R - 1])} : (f32x2_t){cum[0][R - 1], cum[1][R - 1]}; } while (0)

    { MX_IDS(); MX_LOAD_RAW(n_lo); MX_E1(); }
#pragma unroll 1
    for (int n = n_lo; n < n_hi; ++n) {
        const size_t row0 = (size_t)b * SEQ + (size_t)n * 64; const bool full = (n >= n_full);
        LBAR();
        {   MX_IDS();
            float base[2] = {0.f, 0.f}, tot[2] = {0.f, 0.f}, refv[2] = {0.f, 0.f};
#pragma unroll
            for (int t2 = 0; t2 < TS; ++t2) { const f32x2_t sv = *(const LAS f32x2_t*)(lds + L_SEG + (t2 * DK + 2 * cp) * 4);
                tot[0] += sv[0]; tot[1] += sv[1]; if (t2 < ts) { base[0] += sv[0]; base[1] += sv[1]; } if (t2 < TSREF) { refv[0] += sv[0]; refv[1] += sv[1]; } }
            if (ts == 0) { *(LAS f32x2_t*)(lds + L_DEC + 2 * cp * 4) = (f32x2_t){__builtin_amdgcn_exp2f(tot[0]), __builtin_amdgcn_exp2f(tot[1])};
                *(LAS f32x2_t*)(lds + L_ERF + 2 * cp * 4) = (f32x2_t){__builtin_amdgcn_exp2f(refv[0]), __builtin_amdgcn_exp2f(refv[1])};
                *(LAS f32x2_t*)(lds + L_ELR + 2 * cp * 4) = (f32x2_t){__builtin_amdgcn_exp2f(tot[0] - refv[0]), __builtin_amdgcn_exp2f(tot[1] - refv[1])}; }
            const float eb0 = IS_A ? __builtin_amdgcn_exp2f(base[0] - refv[0]) : base[0] - refv[0], eb1 = IS_A ? __builtin_amdgcn_exp2f(base[1] - refv[1]) : base[1] - refv[1];
#pragma unroll
            for (int j = 0; j < R; ++j) { const int t = ts * R + j;
                const float e10 = IS_A ? eb0 * cum[0][j] : __builtin_amdgcn_exp2f(eb0 + cum[0][j]), e11 = IS_A ? eb1 * cum[1][j] : __builtin_amdgcn_exp2f(eb1 + cum[1][j]);
                const float e20 = __builtin_amdgcn_rcpf(e10), e21 = __builtin_amdgcn_rcpf(e11);
                *(LAS unsigned*)(lds + L_QH + t * PQ + 4 * cp) = cvtpk(bflo(q2[j]) * e10, bfhi(q2[j]) * e11);
                *(LAS unsigned*)(lds + L_KH + t * PQ + 4 * cp) = cvtpk(kk[0][j] * e20, kk[1][j] * e21);
            }
#pragma unroll
            for (int i = 0; i < 2; ++i) *(LAS v4u*)(lds + L_VV + (vr0 + 32 * i) * PV + 16 * vq) = vreg[i];
            if (full) {
#pragma unroll
                for (int i = 0; i < 2; ++i) ogreg[i] = *(const v4u*)(F.P + (row0 + nt) * NIN + gc + 16 * ndq + 8 * i); }
            if (n + 1 < n_hi) MX_LOAD_RAW(n + 1);
        }
        LBAR();
        if (full) {   MX_IDS(); const int tb = w >> 1;
#pragma unroll
            for (int si = 0; si < 2; ++si) { const int sb = 2 * (w & 1) + si;
                if (sb <= tb) { f32x4 acc = {0.f, 0.f, 0.f, 0.f};
#pragma unroll
                    for (int ks = 0; ks < NKS; ++ks) { const bf16x8_t a = *(const LAS bf16x8_t*)(lds + L_QH + (16 * tb + m) * PQ + 64 * ks + 16 * g), bb = *(const LAS bf16x8_t*)(lds + L_KH + (16 * sb + m) * PQ + 64 * ks + 16 * g);
                        acc = MFMA16(a, bb, acc); }
#pragma unroll
                    for (int j = 0; j < 4; ++j) { const int t = 16 * tb + 4 * g + j, s = 16 * sb + m; const float val = (s <= t) ? acc[j] : 0.f;
                        *(LAS unsigned short*)(lds + L_SC + t * PT + 2 * s) = (unsigned short)f2bf(val); } }
                else {
#pragma unroll
                    for (int j = 0; j < 4; ++j) *(LAS unsigned short*)(lds + L_SC + (16 * tb + 4 * g + j) * PT + 2 * (16 * sb + m)) = (unsigned short)0; } }
            LBAR();
        }
        {   MX_IDS(); const int dv0 = 16 * w;
            bf16x8_t vB[2];
#pragma unroll
            for (int ks2 = 0; ks2 < 2; ++ks2) { const LAS unsigned char* vp = lds + L_VV + (32 * ks2 + 8 * g + q4) * PV + 2 * (dv0 + 4 * p4);
                const s16x4_t lo = tr16(vp), hi = tr16(vp + 4 * PV); vB[ks2] = __builtin_shufflevector(lo, hi, 0, 1, 2, 3, 4, 5, 6, 7); }
            f32x4 o[4];
#pragma unroll
            for (int mt = 0; mt < 4; ++mt) o[mt] = (f32x4){0.f, 0.f, 0.f, 0.f};
            if (full) {
#pragma unroll
            for (int mt = 0; mt < 4; ++mt) {
#pragma unroll
                for (int ks2 = 0; ks2 < 2; ++ks2) if (2 * ks2 <= mt) { const bf16x8_t a = *(const LAS bf16x8_t*)(lds + L_SC + (16 * mt + m) * PT + 64 * ks2 + 16 * g); o[mt] = MFMA16(a, vB[ks2], o[mt]); } }
#pragma unroll
            for (int sg = 0; sg < NKS; ++sg) {
                const f32x4 ea = *(const LAS f32x4*)(lds + L_ERF + 4 * (32 * sg + 4 * g)), eb = *(const LAS f32x4*)(lds + L_ERF + 4 * (32 * sg + 16 + 4 * g));
                const f32x4 sa = S[2 * sg] * ea, sb4 = S[2 * sg + 1] * eb;
                const bf16x8_t sB = __builtin_bit_cast(bf16x8_t, (v4u){cvtpk(sa[0], sa[1]), cvtpk(sa[2], sa[3]), cvtpk(sb4[0], sb4[1]), cvtpk(sb4[2], sb4[3])});
#pragma unroll
                for (int mt = 0; mt < 4; ++mt) { const LAS unsigned char* qp = lds + L_QH + (16 * mt + m) * PQ + 2 * (32 * sg + 4 * g);
                    const s16x4_t lo = *(const LAS s16x4_t*)qp, hi = *(const LAS s16x4_t*)(qp + 32);
                    o[mt] = MFMA16(__builtin_shufflevector(lo, hi, 0, 1, 2, 3, 4, 5, 6, 7), sB, o[mt]); } asm volatile("" ::: "memory"); }
            }
#pragma unroll
            for (int mtile = 0; mtile < NMT; ++mtile) { f32x4 u4 = {0.f, 0.f, 0.f, 0.f};
#pragma unroll
                for (int ks2 = 0; ks2 < 2; ++ks2) { const LAS unsigned char* kp = lds + L_KH + (32 * ks2 + 8 * g + q4) * PQ + 2 * (16 * mtile + 4 * p4);
                    const s16x4_t lo = tr16(kp), hi = tr16(kp + 4 * PQ); u4 = MFMA16(__builtin_shufflevector(lo, hi, 0, 1, 2, 3, 4, 5, 6, 7), vB[ks2], u4); }
                const f32x4 d4 = *(const LAS f32x4*)(lds + L_DEC + 4 * (16 * mtile + 4 * g)), l4 = *(const LAS f32x4*)(lds + L_ELR + 4 * (16 * mtile + 4 * g));
                S[mtile] = S[mtile] * d4 + u4 * l4; if (mtile & 1) asm volatile("" ::: "memory"); }
            if (full) {
#pragma unroll
            for (int mt = 0; mt < 4; ++mt)
#pragma unroll
                for (int j = 0; j < 4; ++j) *(LAS float*)(lds + L_OB + (16 * mt + 4 * g + j) * PO + 4 * (dv0 + m)) = o[mt][j];
            }
        }
        if (full) {   LBAR(); MX_IDS(); f32x4 ov[4]; float ss = 0.f;
#pragma unroll
            for (int i = 0; i < 4; ++i) { ov[i] = *(const LAS f32x4*)(lds + L_OB + nt * PO + 64 * ndq + 16 * i); ss += (ov[i][0] * ov[i][0] + ov[i][1] * ov[i][1]) + (ov[i][2] * ov[i][2] + ov[i][3] * ov[i][3]); }
            ss += __shfl_xor(ss, 1); ss += __shfl_xor(ss, 2); ss += __shfl_xor(ss, 4);
            const float rn = 1.0f / sqrtf(ss * (1.0f / 128.0f) + EPS);
            unsigned ow[8];
#pragma unroll
            for (int i = 0; i < 4; ++i) { const f32x4 gn4 = *(const f32x4*)(gnp + 16 * ndq + 4 * i); const unsigned g01 = ogreg[i >> 1][2 * (i & 1)], g23 = ogreg[i >> 1][2 * (i & 1) + 1];
                const float ga = bflo(g01), gb = bfhi(g01), gcc = bflo(g23), gd = bfhi(g23);
                const float r0 = ov[i][0] * rn * gn4[0] * (ga * __builtin_amdgcn_rcpf(1.0f + __builtin_amdgcn_exp2f(-ga * L2E))), r1 = ov[i][1] * rn * gn4[1] * (gb * __builtin_amdgcn_rcpf(1.0f + __builtin_amdgcn_exp2f(-gb * L2E)));
                const float r2 = ov[i][2] * rn * gn4[2] * (gcc * __builtin_amdgcn_rcpf(1.0f + __builtin_amdgcn_exp2f(-gcc * L2E))), r3 = ov[i][3] * rn * gn4[3] * (gd * __builtin_amdgcn_rcpf(1.0f + __builtin_amdgcn_exp2f(-gd * L2E)));
                ow[2 * i] = cvtpk(r0, r1); ow[2 * i + 1] = cvtpk(r2, r3); }
            bf16* op = F.O + (row0 + nt) * D + oc + 16 * ndq;
            *(v4u*)op = (v4u){ow[0], ow[1], ow[2], ow[3]}; *(v4u*)(op + 8) = (v4u){ow[4], ow[5], ow[6], ow[7]};
        }
        if (n + 1 < n_hi) { MX_IDS(); MX_E1(); }
    }
    LBAR();
#undef MX_LOAD_RAW
#undef MX_E1
#undef MX_IDS
}
#ifndef MX_N0
#define MX_N0 42
#endif
__device__ __forceinline__ void mixer_phase_chunked(Frame& F, int l) {
    for (int it = blockIdx.x; it < 256; it += F.G) { const int s = it & 63, seg = (it >> 6) & 1;
        if (it < 128) mixer_chunked_stream<128, true>(F, l, s >> 2, s & 3, 0, seg ? MX_N0 : 0, seg ? SEQ / 64 : MX_N0);
        else mixer_chunked_stream<64, false>(F, l, s >> 2, s & 3, 0, seg ? MX_N0 : 0, seg ? SEQ / 64 : MX_N0); }
}
__device__ __forceinline__ void fix_phase(Frame& F, int l) {
    const int gt = F.vcu * (NWAVES * 64) + F.tid, NGT = F.G * NWAVES * 64;
    const float* cw = F.SMALL + SM_CW + l * 3 * NUP; const float* cb = F.SMALL + SM_CB + l * NUP;
    for (int i = gt; i < 256 * FF; i += NGT) { const int pm = i / FF, f = i % FF; if ((pm & 15) == 0) continue;
        const int ca = 256 * (f >> 7) + (f & 127), cv = ca + 128;
        const float* T = F.RAWT + (size_t)(pm - 1) * 2 * NUP; const float* H = F.RAWH + (size_t)pm * 2 * NUP;
        const float a_m2 = T[ca], a_m1 = T[NUP + ca], a_0 = H[ca], a_1 = H[NUP + ca], v_m2 = T[cv], v_m1 = T[NUP + cv], v_0 = H[cv], v_1 = H[NUP + cv];
        const float wa0 = cw[ca], wa1 = cw[NUP + ca], wa2 = cw[2 * NUP + ca], wv0 = cw[cv], wv1 = cw[NUP + cv], wv2 = cw[2 * NUP + cv], ba = cb[ca], bv = cb[cv];
        const float ca0 = ba + wa0 * a_m2 + wa1 * a_m1 + wa2 * a_0, cv0 = bv + wv0 * v_m2 + wv1 * v_m1 + wv2 * v_0;
        const float ca1 = ba + wa0 * a_m1 + wa1 * a_0 + wa2 * a_1, cv1 = bv + wv0 * v_m1 + wv1 * v_0 + wv2 * v_1;
        bf16* g = F.Gb + (size_t)pm * 256 * FF + f;
        g[0] = (bf16)f2bf(ca0 * sigmoid_f(ca0) * cv0); g[FF] = (bf16)f2bf(ca1 * sigmoid_f(ca1) * cv1); }
}

__device__ __forceinline__ void final_phase(Frame& F) {
    const int gw = F.vcu * NWAVES + F.wave, NGW = F.G * NWAVES;
    for (int row = gw; row < M; row += NGW) {
        GAS f32x4* xr = (GAS f32x4*)(F.out + (size_t)row * D) + F.lane;
        float ss = (F.lane < 16) ? F.STAT[(size_t)row * 16 + F.lane] : 0.f; ss = wave_sum(ss);
        const float r = 1.0f / sqrtf(ss * (1.0f / (float)D) + EPS);
#pragma unroll
        for (int j = 0; j < 4; ++j) { const f32x4 v = xr[64 * j]; const f32x4 g = *(const f32x4*)(F.lnf_g + 256 * j + 4 * F.lane); xr[64 * j] = v * r * g; }
    }
}

#ifndef STAGGER_US
#define STAGGER_US 0
#endif
__device__ __forceinline__ void stagger(int idx) {
    if (STAGGER_US > 0) { const unsigned long long t0 = __builtin_amdgcn_s_memrealtime(), dt = (unsigned long long)(idx & 15) * (100ull * STAGGER_US);
        while (__builtin_amdgcn_s_memrealtime() - t0 < dt) __builtin_amdgcn_s_sleep(8); }
}
struct Args { const float* in[18]; float* out; unsigned char* ws; int ph_lo, ph_hi; };
__global__ void __launch_bounds__(NWAVES * 64, 2) fwd(Args args) {
    extern __shared__ __attribute__((aligned(16))) unsigned char lds[];
    Frame F;
    F.lds = (LAS unsigned char*)lds; F.MISC = (volatile LAS unsigned*)(F.lds + MISC_OFF);
    F.tid = threadIdx.x; F.lane = F.tid & 63; F.wave = __builtin_amdgcn_readfirstlane(F.tid >> 6);
    F.G = gridDim.x; { const int bx = blockIdx.x; F.vcu = (F.G % 8 == 0) ? (bx % 8) * (F.G / 8) + bx / 8 : bx; }
    unsigned char* ws = args.ws;
    F.ctl = (unsigned*)(ws + WS_CTL);
    F.x = args.in[0]; F.c = args.in[1]; F.ln1_g = args.in[2]; F.ln2_g = args.in[3]; F.w_ada = args.in[4]; F.b_ada = args.in[5]; F.w_in = args.in[6]; F.lb_params = args.in[7];
    F.w_gk = args.in[8]; F.b_gk = args.in[9]; F.gn_a = args.in[10]; F.gn_b = args.in[11]; F.w_out = args.in[12]; F.w_up = args.in[13]; F.conv_w = args.in[14]; F.conv_b = args.in[15];
    F.w_down = args.in[16]; F.lnf_g = args.in[17]; F.out = args.out;
    F.MOD = (float*)(ws + WS_MOD); F.SMALL = (float*)(ws + WS_SMALL); F.STAT = (float*)(ws + WS_STAT); F.RAWH = (float*)(ws + WS_RAWH); F.RAWT = (float*)(ws + WS_RAWT);
    F.WIN = (bf16*)(ws + WS_WIN); F.WOUT = (bf16*)(ws + WS_WOUT); F.WUP = (bf16*)(ws + WS_WUP); F.WDN = (bf16*)(ws + WS_WDN);
    F.XN = (bf16*)(ws + WS_XN); F.O = (bf16*)(ws + WS_O); F.P = (bf16*)(ws + WS_P); F.Gb = (bf16*)(ws + WS_P);
#ifdef PROBE_ZERO_ALL
    for (int u = F.tid; u < LDSCTL_OFF / 4; u += NWAVES * 64) ((LAS unsigned*)(F.lds))[u] = 0u;
#endif
    for (int u = F.tid; u < (LDS_BYTES - LDSCTL_OFF) / 4; u += NWAVES * 64) ((LAS unsigned*)(F.lds + LDSCTL_OFF))[u] = 0u;
    __syncthreads();
    const int lo = args.ph_lo, hi = args.ph_hi;
    XcdBarrier bar; bar.bar = F.ctl + CW_BAR; bar.x = 0; bar.st = nullptr;
    if (hi - lo > 1) bar = xcd_barrier_post(F.ctl + CW_BAR, F.MISC + 8);
#define IN(k) (lo <= (k) && (k) < hi)
#ifndef PH_MASK
#define PH_MASK 0x1ff
#endif
#define PHM(b) ((PH_MASK >> (b)) & 1)
#define SEAM(k) do { if (IN(k) && IN((k) + 1)) { int l0_; asm volatile("v_mbcnt_lo_u32_b32 %0, -1, 0\n\tv_mbcnt_hi_u32_b32 %0, -1, %0" : "=v"(l0_)); xcd_barrier(bar, F.wave == 0 && l0_ == 0); } } while (0)
    if (PHM(0) && IN(0)) p0a(F);
    SEAM(0);
    if (PHM(1) && IN(1)) p0b(F);
    SEAM(1);
#ifdef PROBE_PRO2
    p0a(F); SEAM(0); p0b(F); SEAM(1);
#endif
    for (int l = 0; l < DEPTH; ++l) {
        const int pb = 2 + 6 * l;
#define LAUNDER_TID() do { int l_; asm volatile("v_mbcnt_lo_u32_b32 %0, -1, 0\n\tv_mbcnt_hi_u32_b32 %0, -1, %0" : "=v"(l_)); F.lane = l_; F.tid = F.wave * 64 + l_; } while (0)
        if (PHM(2) && IN(pb)) {
            LAUNDER_TID(); stagger((int)blockIdx.x);
#ifdef PROBE_KDUP
            typedef pg8::DupOrder InOrder;
#else
            typedef pg8::StaticOrder InOrder;
#endif
            pg8::Gemm g{F.XN, F.WIN + (size_t)l * NIN * 1024, M, NIN, D}; InOrder S; S.init(M, NIN, F.G, (int)blockIdx.x);
            pg8::EpiIn E{F.P, F.SMALL + SM_B1 + l * 16 * NIN, F.STAT};
            pg8::gemm_phase<pg8::EpiIn, InOrder, true, true>(F.lds, g, S, E, F.tid);
#ifdef PROBE_KLOOP
            { __syncthreads(); LAUNDER_TID(); pg8::EpiNull EN; pg8::gemm_phase<pg8::EpiNull, pg8::StaticOrder, true, true>(F.lds, g, S, EN, F.tid); }
#endif
#ifdef PROBE_IN2
            __syncthreads(); LAUNDER_TID(); pg8::gemm_phase<pg8::EpiIn, InOrder, true, true>(F.lds, g, S, E, F.tid);
#endif
        }
        SEAM(pb);
        if (PHM(3) && IN(pb + 1)) { LAUNDER_TID(); MIXER_PHASE(F, l);
#ifdef PROBE_MIX2
            __syncthreads(); LAUNDER_TID(); MIXER_PHASE(F, l);
#endif
        }
        SEAM(pb + 1);
        if (PHM(4) && IN(pb + 2)) {
            LAUNDER_TID(); stagger((int)blockIdx.x);
            pg8::Gemm g{F.O, F.WOUT + (size_t)l * 1024 * 1024, M, D, D}; pg8::StaticOrder S; S.init(M, D, F.G, (int)blockIdx.x);
            pg8::EpiXUpd E{l == 0 ? F.x : F.out, F.out, F.XN, F.SMALL + SM_GT1 + l * 16 * D, F.SMALL + SM_GS2 + l * 16 * D, F.STAT};
            pg8::gemm_phase<pg8::EpiXUpd, pg8::StaticOrder, true, true>(F.lds, g, S, E, F.tid);
        }
        SEAM(pb + 2);
        if (PHM(5) && IN(pb + 3)) {
            LAUNDER_TID(); stagger((int)blockIdx.x);
            pg8::Gemm g{F.XN, F.WUP + (size_t)l * NUP * 1024, M, NUP, D}; pg8::StaticOrder S; S.init(M, NUP, F.G, (int)blockIdx.x);
            pg8::EpiUp E{F.Gb, F.SMALL + SM_B2 + l * 16 * NUP, F.STAT, F.SMALL + SM_CW + l * 3 * NUP, F.SMALL + SM_CB + l * NUP, F.RAWH, F.RAWT, (LAS float*)(F.lds + HALO_OFF)};
            pg8::gemm_phase<pg8::EpiUp, pg8::StaticOrder, true, true>(F.lds, g, S, E, F.tid);
#ifdef PROBE_UP2
            __syncthreads(); LAUNDER_TID(); pg8::gemm_phase<pg8::EpiUp, pg8::StaticOrder, true, true>(F.lds, g, S, E, F.tid);
#endif
        }
        SEAM(pb + 3);
        if (PHM(6) && IN(pb + 4)) { LAUNDER_TID(); fix_phase(F, l); }
        SEAM(pb + 4);
        if (PHM(7) && IN(pb + 5)) {
            LAUNDER_TID(); stagger((int)blockIdx.x);
            pg8::Gemm g{F.Gb, F.WDN + (size_t)l * 1024 * FF, M, D, FF}; pg8::StaticOrder S; S.init(M, D, F.G, (int)blockIdx.x);
            pg8::EpiXUpd E{F.out, F.out, l + 1 < DEPTH ? F.XN : (bf16*)nullptr, F.SMALL + SM_GT2 + l * 16 * D, F.SMALL + SM_GS1 + (l + 1 < DEPTH ? l + 1 : l) * 16 * D, F.STAT};
            pg8::gemm_phase<pg8::EpiXUpd, pg8::StaticOrder, true, true>(F.lds, g, S, E, F.tid);
        }
        SEAM(pb + 5);
    }
    if (PHM(8) && IN(N_PHASES - 1)) { LAUNDER_TID(); final_phase(F); }
#undef IN
#undef SEAM
}

extern "C" void kernel_launch(void* const* d_in, const int* in_sizes, int n_in, void* d_out, int out_size, void* d_ws, size_t ws_size, hipStream_t stream) {
    static int grid = 0;
    if (grid == 0) {
        if (n_in != 18 || in_sizes[0] != M * D || out_size != M * D || ws_size < WS_END) { fprintf(stderr, "kernel_launch: unexpected shapes / workspace (n_in %d, in0 %d, out %d, ws %zu < %zu); nothing launched\n", n_in, n_in > 0 ? in_sizes[0] : -1, out_size, ws_size, (size_t)WS_END); grid = -1; return; }
        int dev = 0, cus = 0, per_cu = 0;
        if (hipGetDevice(&dev) != hipSuccess || hipDeviceGetAttribute(&cus, hipDeviceAttributeMultiprocessorCount, dev) != hipSuccess) { grid = -1; return; }
        if (hipFuncSetAttribute((const void*)fwd, hipFuncAttributeMaxDynamicSharedMemorySize, LDS_BYTES) != hipSuccess) { fprintf(stderr, "kernel_launch: hipFuncSetAttribute failed\n"); grid = -1; return; }
        if (hipOccupancyMaxActiveBlocksPerMultiprocessor(&per_cu, (const void*)fwd, NWAVES * 64, LDS_BYTES) != hipSuccess || per_cu < 1) { fprintf(stderr, "kernel_launch: occupancy query says %d\n", per_cu); }
        (void)hipGetLastError();
        grid = cus;
    }
    if (grid < 0) return;
#ifdef PROBE_ZERO_ALL
    if (hipMemsetAsync((char*)d_ws, 0, WS_END, stream) != hipSuccess) return;
#endif
    if (hipMemsetAsync((char*)d_ws + WS_CTL, 0, CTL_ZERO_BYTES, stream) != hipSuccess) return;
    Args a{};
    for (int i = 0; i < 18; ++i) a.in[i] = (const float*)d_in[i];
    a.out = (float*)d_out; a.ws = (unsigned char*)d_ws;
#if MK_PER_PHASE
    for (int p = 0; p < N_PHASES; ++p) { a.ph_lo = p; a.ph_hi = p + 1; hipLaunchKernelGGL(fwd, dim3(grid), dim3(NWAVES * 64), LDS_BYTES, stream, a); }
#else
    a.ph_lo = 0; a.ph_hi = N_PHASES; hipLaunchKernelGGL(fwd, dim3(grid), dim3(NWAVES * 64), LDS_BYTES, stream, a);
#endif
}
```

```cpp
#include <hip/hip_runtime.h>
#include <cstdio>
#include <cstdint>
namespace pg8 {
#define PG8_LAS __attribute__((address_space(3)))
typedef unsigned short bf16_t;
typedef short bf16x8 __attribute__((ext_vector_type(8)));
typedef float f32x4 __attribute__((ext_vector_type(4)));
typedef unsigned u32x4 __attribute__((ext_vector_type(4)));
constexpr int BM = 256, BK = 64, HALF = 128, HTB = HALF * BK * 2  , STAGE_BYTES = 8 * HTB, NXCD = 8, WGM = 8;

__host__ __device__ __forceinline__ int lds_byte(int r, int c) { const int st = (r >> 4) * 2 + (c >> 5), rr = r & 15, cc = c & 31, ob = rr * 64 + cc * 2; return st * 1024 + (ob ^ (((ob >> 9) & 1) << 5)); }
__host__ __device__ __forceinline__ void stage_rc(int b, int& R, int& C) { const int st = b / 1024, sb = b % 1024, swz = sb ^ (((sb >> 9) & 1) << 5); R = (st >> 1) * 16 + swz / 64; C = (st & 1) * 32 + (swz % 64) / 2; }
__host__ __device__ __forceinline__ int perm32(int rho) { const int n = rho >> 4, i = rho & 15; return 8 * (i >> 2) + 4 * n + (i & 3); }

struct Unit { int pm, pn; };
struct Gemm { const bf16_t* A; const bf16_t* Bt; int M, N, K; };

struct StaticOrder {
    static constexpr bool DUP = false;
    int nM, nN, nwg, G, c;
    __host__ __device__ void init(int M, int N, int G_, int c_) { nM = M / BM; nN = N / BM; nwg = nM * nN; G = G_; c = c_; }
    __host__ __device__ bool next(int i, Unit& u) const {
        const long L = (long)i * G + c; if (L >= nwg) return false;
        int wgid = (int)L; { const int q = nwg / NXCD, r = nwg % NXCD, xcd = wgid % NXCD, off = wgid / NXCD; wgid = (xcd < r ? xcd * (q + 1) : r * (q + 1) + (xcd - r) * q) + off; }
        const int nig = WGM * nN, gid = wgid / nig, fm = gid * WGM, gsz = (nM - fm) < WGM ? (nM - fm) : WGM;
        u.pm = fm + ((wgid % nig) % gsz); u.pn = (wgid % nig) / gsz; return true;
    }
    __device__ __forceinline__ void a_ready(const Unit&) const {}
    __device__ __forceinline__ void done(const Unit&) const {}
};

struct DupOrder : StaticOrder {
    static constexpr bool DUP = true;
    __host__ __device__ bool next(int i, Unit& u) const { return StaticOrder::next(i >> 1, u); }
};

__device__ __forceinline__ unsigned cvt_pk_bf16(float lo, float hi) { unsigned r; asm volatile("v_cvt_pk_bf16_f32 %0, %1, %2" : "=v"(r) : "v"(lo), "v"(hi)); return r; }
typedef unsigned u32x2 __attribute__((ext_vector_type(2)));
constexpr int ROWS_PER_SEQ_TILES = 16;
constexpr float RMS_EPS = 1e-6f;
constexpr int D_MODEL = 1024, N_IN = 3840, N_UP = 5632, N_FF = 2816;

__device__ __forceinline__ float row_rscale(const float* stat, int row, int fq) {
    const f32x4 sp = *(const f32x4*)(stat + (size_t)row * 16 + 4 * fq);
    float s = (sp[0] + sp[1]) + (sp[2] + sp[3]);
    s += __shfl_xor(s, 16); s += __shfl_xor(s, 32);
    return 1.0f / sqrtf(s * (1.0f / (float)D_MODEL) + RMS_EPS);
}

struct EpiNull {
    static constexpr bool PERM = true, AFTER_DRAIN = false, IDEMPOTENT = false;
    __device__ __forceinline__ void operator()(f32x4 (&acc)[2][2][4][2], const Unit&, int, int, int, int) const {
#pragma unroll
        for (int a = 0; a < 2; ++a)
#pragma unroll
            for (int b = 0; b < 2; ++b)
#pragma unroll
                for (int m = 0; m < 4; ++m) asm volatile("" :: "v"(acc[a][b][m][0]), "v"(acc[a][b][m][1]));
    }
};

struct EpiIn {
    static constexpr bool PERM = true, AFTER_DRAIN = false, IDEMPOTENT = true;
    bf16_t* P; const float* bias; const float* stat;
    __device__ __forceinline__ void operator()(f32x4 (&acc)[2][2][4][2], const Unit& u, int wr, int wc, int fr, int fq) const {
        const int row0 = u.pm * BM + wr * 64 + fr, b = u.pm / ROWS_PER_SEQ_TILES, col0 = u.pn * BM + wc * 32 + 8 * fq;
        const float* bp = bias + (size_t)b * N_IN + col0;
        f32x4 bv[2][2];
#pragma unroll
        for (int bj = 0; bj < 2; ++bj)
#pragma unroll
            for (int n = 0; n < 2; ++n) bv[bj][n] = *(const f32x4*)(bp + bj * HALF + 4 * n);
#pragma unroll
        for (int ai = 0; ai < 2; ++ai)
#pragma unroll
            for (int m = 0; m < 4; ++m) { const int row = row0 + ai * HALF + m * 16; const float r = row_rscale(stat, row, fq);
                bf16_t* rowp = P + (size_t)row * N_IN + col0;
#pragma unroll
                for (int bj = 0; bj < 2; ++bj) { const f32x4 v0 = acc[ai][bj][m][0] * r + bv[bj][0], v1 = acc[ai][bj][m][1] * r + bv[bj][1];
                    u32x4 w; w.x = cvt_pk_bf16(v0[0], v0[1]); w.y = cvt_pk_bf16(v0[2], v0[3]); w.z = cvt_pk_bf16(v1[0], v1[1]); w.w = cvt_pk_bf16(v1[2], v1[3]);
                    *(u32x4*)(rowp + bj * HALF) = w; } }
    }
};

struct EpiXUpd {
    static constexpr bool PERM = true, AFTER_DRAIN = false, IDEMPOTENT = false;
    const float* xold; float* xnew; bf16_t* XN; const float* gt; const float* gsn; float* stat;
    __device__ __forceinline__ void operator()(f32x4 (&acc)[2][2][4][2], const Unit& u, int wr, int wc, int fr, int fq) const {
        const int row0 = u.pm * BM + wr * 64 + fr, b = u.pm / ROWS_PER_SEQ_TILES, col0 = u.pn * BM + wc * 32 + 8 * fq;
        f32x4 g[2][2], s[2][2];
#pragma unroll
        for (int bj = 0; bj < 2; ++bj)
#pragma unroll
            for (int n = 0; n < 2; ++n) { g[bj][n] = *(const f32x4*)(gt + (size_t)b * D_MODEL + col0 + bj * HALF + 4 * n);
                s[bj][n] = XN ? *(const f32x4*)(gsn + (size_t)b * D_MODEL + col0 + bj * HALF + 4 * n) : (f32x4){0.f, 0.f, 0.f, 0.f}; }
#pragma unroll
        for (int ai = 0; ai < 2; ++ai)
#pragma unroll
            for (int m = 0; m < 4; ++m) { const int row = row0 + ai * HALF + m * 16; const size_t off = (size_t)row * D_MODEL + col0; float ss = 0.f;
#pragma unroll
                for (int bj = 0; bj < 2; ++bj) {
                    const f32x4 x0 = *(const f32x4*)(xold + off + bj * HALF) + g[bj][0] * acc[ai][bj][m][0], x1 = *(const f32x4*)(xold + off + bj * HALF + 4) + g[bj][1] * acc[ai][bj][m][1];
                    *(f32x4*)(xnew + off + bj * HALF) = x0; *(f32x4*)(xnew + off + bj * HALF + 4) = x1;
                    ss += (x0[0] * x0[0] + x0[1] * x0[1]) + (x0[2] * x0[2] + x0[3] * x0[3]) + (x1[0] * x1[0] + x1[1] * x1[1]) + (x1[2] * x1[2] + x1[3] * x1[3]);
                    if (XN) { const f32x4 y0 = x0 * s[bj][0], y1 = x1 * s[bj][1];
                        u32x4 w; w.x = cvt_pk_bf16(y0[0], y0[1]); w.y = cvt_pk_bf16(y0[2], y0[3]); w.z = cvt_pk_bf16(y1[0], y1[1]); w.w = cvt_pk_bf16(y1[2], y1[3]);
                        *(u32x4*)(XN + off + bj * HALF) = w; } }
                ss += __shfl_xor(ss, 16); ss += __shfl_xor(ss, 32);
                if (fq == 0) stat[(size_t)row * 16 + u.pn * 4 + wc] = ss; }
    }
};

__device__ __forceinline__ float dpp_ror1(float v) { return __builtin_bit_cast(float, __builtin_amdgcn_update_dpp(0, __builtin_bit_cast(int, v), 0x121, 0xf, 0xf, false)); }
__device__ __forceinline__ float dpp_ror2(float v) { return __builtin_bit_cast(float, __builtin_amdgcn_update_dpp(0, __builtin_bit_cast(int, v), 0x122, 0xf, 0xf, false)); }
__device__ __forceinline__ float dpp_shr1z(float v) { return __builtin_bit_cast(float, __builtin_amdgcn_update_dpp(0, __builtin_bit_cast(int, v), 0x111, 0xf, 0xf, true)); }
__device__ __forceinline__ float dpp_shr2z(float v) { return __builtin_bit_cast(float, __builtin_amdgcn_update_dpp(0, __builtin_bit_cast(int, v), 0x112, 0xf, 0xf, true)); }
__device__ __forceinline__ float silu_f(float x) { return x * __builtin_amdgcn_rcpf(1.0f + __builtin_amdgcn_exp2f(-1.4426950408889634f * x)); }
struct EpiUp {
    static constexpr bool PERM = true, AFTER_DRAIN = false, IDEMPOTENT = false;
    bf16_t* G; const float* bias; const float* stat; const float* cw; const float* cb; float* rawh; float* rawt; PG8_LAS float* halo;
    __device__ __forceinline__ void operator()(f32x4 (&acc)[2][2][4][2], const Unit& u, int wr, int wc, int fr, int fq) const {
        const int row0 = u.pm * BM + wr * 64 + fr, b = u.pm / ROWS_PER_SEQ_TILES, tc0 = wc * 32 + 8 * fq, col0 = u.pn * BM + tc0;
        PG8_LAS float* vecs = halo + 2048;
        const int tid = (wr * 4 + wc) * 64 + fq * 16 + fr;
        f32x4 vecv = {0.f, 0.f, 0.f, 0.f};
        if (tid < 256) { const int which = tid >> 6, ch = tid & 63; vecv = *(const f32x4*)((which < 3 ? cw + which * N_UP : cb) + u.pn * BM + 4 * ch); }
        f32x4 sp[2][4], bv[2][2];
#pragma unroll
        for (int ai = 0; ai < 2; ++ai)
#pragma unroll
            for (int m = 0; m < 4; ++m) sp[ai][m] = *(const f32x4*)(stat + (size_t)(row0 + ai * HALF + m * 16) * 16 + 4 * fq);
#pragma unroll
        for (int bj = 0; bj < 2; ++bj)
#pragma unroll
            for (int n = 0; n < 2; ++n) bv[bj][n] = *(const f32x4*)(bias + (size_t)b * N_UP + col0 + bj * HALF + 4 * n);
#pragma unroll
        for (int ai = 0; ai < 2; ++ai)
#pragma unroll
            for (int m = 0; m < 4; ++m) { float s = (sp[ai][m][0] + sp[ai][m][1]) + (sp[ai][m][2] + sp[ai][m][3]); s += __shfl_xor(s, 16); s += __shfl_xor(s, 32);
                const float r = 1.0f / sqrtf(s * (1.0f / (float)D_MODEL) + RMS_EPS);
#pragma unroll
                for (int bj = 0; bj < 2; ++bj)
#pragma unroll
                    for (int n = 0; n < 2; ++n) acc[ai][bj][m][n] = acc[ai][bj][m][n] * r + bv[bj][n];
                asm volatile("" : "+v"(acc[ai][0][m][0]), "+v"(acc[ai][0][m][1]), "+v"(acc[ai][1][m][0]), "+v"(acc[ai][1][m][1])); }
        if (tid < 256) *(PG8_LAS f32x4*)(vecs + 4 * tid) = vecv;
#pragma unroll
        for (int ai = 0; ai < 2; ++ai) {
            if (fr >= 14) {
                PG8_LAS float* hp = halo + ((ai * 2 + wr) * 2 + (fr - 14)) * 256 + tc0;
#pragma unroll
                for (int bj = 0; bj < 2; ++bj)
#pragma unroll
                    for (int n = 0; n < 2; ++n) *(PG8_LAS f32x4*)(hp + bj * HALF + 4 * n) = acc[ai][bj][3][n];
            }
        }
        if (wr == 0 && fr < 2) { float* hp = rawh + ((size_t)u.pm * 2 + fr) * N_UP + col0;
#pragma unroll
            for (int bj = 0; bj < 2; ++bj)
#pragma unroll
                for (int n = 0; n < 2; ++n) *(f32x4*)(hp + bj * HALF + 4 * n) = acc[0][bj][0][n]; }
        if (wr == 1 && fr >= 14) { float* tp = rawt + ((size_t)u.pm * 2 + (fr - 14)) * N_UP + col0;
#pragma unroll
            for (int bj = 0; bj < 2; ++bj)
#pragma unroll
                for (int n = 0; n < 2; ++n) *(f32x4*)(tp + bj * HALF + 4 * n) = acc[1][bj][3][n]; }
        asm volatile("s_waitcnt lgkmcnt(0)" ::: "memory"); __builtin_amdgcn_s_barrier(); asm volatile("" ::: "memory");
        const bool f0 = (fr == 0), f01 = (fr < 2);
        unsigned gp[2][4][2];
#pragma unroll
        for (int n = 0; n < 2; ++n) {
            f32x4 w0[2], w1[2], w2[2], cbv[2];
#pragma unroll
            for (int bj = 0; bj < 2; ++bj) { const int c = tc0 + bj * HALF + 4 * n;
                w0[bj] = *(const PG8_LAS f32x4*)(vecs + c); w1[bj] = *(const PG8_LAS f32x4*)(vecs + 256 + c); w2[bj] = *(const PG8_LAS f32x4*)(vecs + 512 + c); cbv[bj] = *(const PG8_LAS f32x4*)(vecs + 768 + c); }
#pragma unroll
            for (int ai = 0; ai < 2; ++ai) {
                f32x4 prev[2];
                {   const int pai = (wr == 1) ? ai : ai - 1, pwr = (wr == 1) ? 0 : 1;
                    const bool has = (pai >= 0);
                    const PG8_LAS float* hp = halo + ((pai * 2 + pwr) * 2 + (fr & 1)) * 256 + tc0 + 4 * n;
#pragma unroll
                    for (int bj = 0; bj < 2; ++bj) prev[bj] = (has && fr >= 14) ? *(const PG8_LAS f32x4*)(hp + bj * HALF) : (f32x4){0.f, 0.f, 0.f, 0.f}; }
#pragma unroll
                for (int m = 0; m < 4; ++m) {
                    f32x4 cu[2];
#pragma unroll
                    for (int bj = 0; bj < 2; ++bj) { const f32x4 cur = acc[ai][bj][m][n], pv = prev[bj]; f32x4 o;
#pragma unroll
                        for (int j = 0; j < 4; ++j) { const float c1 = dpp_ror1(cur[j]), p1 = dpp_ror1(pv[j]), c2 = dpp_ror2(cur[j]), p2 = dpp_ror2(pv[j]);
                            const float s1 = f0 ? p1 : c1, s2 = f01 ? p2 : c2;
                            o[j] = cbv[bj][j] + w0[bj][j] * s2 + w1[bj][j] * s1 + w2[bj][j] * cur[j]; }
                        cu[bj] = o; prev[bj] = cur; }
                    f32x4 g;
#pragma unroll
                    for (int j = 0; j < 4; ++j) g[j] = silu_f(cu[0][j]) * cu[1][j];
                    const unsigned p0 = cvt_pk_bf16(g[0], g[1]), p1 = cvt_pk_bf16(g[2], g[3]);
                    if (n == 0) { gp[ai][m][0] = p0; gp[ai][m][1] = p1; }
                    else { u32x4 w; w.x = gp[ai][m][0]; w.y = gp[ai][m][1]; w.z = p0; w.w = p1;
                        *(u32x4*)(G + (size_t)(row0 + ai * HALF + m * 16) * N_FF + u.pn * HALF + tc0) = w; }
                }
            }
        }
    }
};
template <class Epi, class Sched, bool ALIGN_EPI = false, bool SP2 = false>
__device__ __forceinline__ void gemm_phase(PG8_LAS unsigned char* lds, const Gemm g, const Sched& S, const Epi& E, const int tid) {
    const int wid = __builtin_amdgcn_readfirstlane(tid >> 6), lane = tid & 63, wr = wid >> 2, wc = wid & 3, fr = lane & 15, fq = lane >> 4;
    const int K = g.K, nt = K / BK;
    unsigned voffA[2], voffB[2];
#pragma unroll
    for (int i = 0; i < 2; ++i) { int R, C; stage_rc(tid * 16 + i * 8192, R, C); const int Rb = Epi::PERM ? ((R & ~31) + perm32(R & 31)) : R;
        voffA[i] = (unsigned)(R * K + C) * 2u; voffB[i] = (unsigned)(Rb * K + C) * 2u; }
    const size_t kstep = (size_t)(BK * 2);
    const size_t hstep = (size_t)HALF * K * 2;
    const size_t tstep = 2 * hstep;
    const unsigned ldsw = (unsigned)wid * 1024u;
    const int aoff = lds_byte(wr * 64 + fr, fq * 8), boff = lds_byte(wc * 32 + fr, fq * 8);
#define PG8_SA(b, h) (((b) * 2 + (h)) * HTB)
#define PG8_SB(b, h) ((4 + (b) * 2 + (h)) * HTB)
#define PG8_STAGE(bufoff, gbase, voff) do { _Pragma("unroll") for (int _i = 0; _i < 2; ++_i) \
        __builtin_amdgcn_global_load_lds((const unsigned*)((const char*)(gbase) + (voff)[_i]), (PG8_LAS unsigned*)(lds + (bufoff) + ldsw + _i * 8192), 16, 0, 0); } while (0)
#define PG8_LDA(dst, b, h) do { _Pragma("unroll") for (int m = 0; m < 4; ++m) _Pragma("unroll") for (int k = 0; k < 2; ++k) dst[m][k] = *(const PG8_LAS bf16x8*)(lds + PG8_SA(b, h) + aoff + m * 2048 + k * 1024); } while (0)
#define PG8_LDB(dst, b, h) do { _Pragma("unroll") for (int n = 0; n < 2; ++n) _Pragma("unroll") for (int k = 0; k < 2; ++k) dst[n][k] = *(const PG8_LAS bf16x8*)(lds + PG8_SB(b, h) + boff + n * 2048 + k * 1024); } while (0)
#define PG8_MMA(ai, bj, At, Bt) do { __builtin_amdgcn_s_setprio(1); _Pragma("unroll") for (int m = 0; m < 4; ++m) _Pragma("unroll") for (int n = 0; n < 2; ++n) _Pragma("unroll") for (int k = 0; k < 2; ++k) \
        acc[ai][bj][m][n] = __builtin_amdgcn_mfma_f32_16x16x32_bf16(Bt[n][k], At[m][k], acc[ai][bj][m][n], 0, 0, 0); __builtin_amdgcn_s_setprio(0); } while (0)
#define PG8_WAIT_V(n) asm volatile("s_waitcnt vmcnt(" #n ")" ::: "memory")
#define PG8_WAIT_L(n) asm volatile("s_waitcnt lgkmcnt(" #n ")" ::: "memory")
#define PG8_BAR __builtin_amdgcn_s_barrier()
#define PG8_SCHED __builtin_amdgcn_sched_barrier(0)
    Unit cur, nxt; int ui = 0;
    if (!S.next(0, cur)) return;
    f32x4 acc[2][2][4][2];
#pragma unroll
    for (int a = 0; a < 2; ++a)
#pragma unroll
        for (int b = 0; b < 2; ++b)
#pragma unroll
            for (int m = 0; m < 4; ++m)
#pragma unroll
                for (int n = 0; n < 2; ++n) acc[a][b][m][n] = (f32x4){0.f, 0.f, 0.f, 0.f};
    bf16x8 At[4][2], B0[2][2], B1[2][2];
    const char* cA = (const char*)g.A + (size_t)cur.pm * tstep; const char* cB = (const char*)g.Bt + (size_t)cur.pn * tstep;
    S.a_ready(cur);
    if constexpr (SP2) {
        PG8_STAGE(PG8_SB(0, 0), cB, voffB); PG8_STAGE(PG8_SB(0, 1), cB + hstep, voffB); PG8_STAGE(PG8_SA(0, 0), cA, voffA); PG8_STAGE(PG8_SA(0, 1), cA + hstep, voffA);
        if (wr == 1) PG8_BAR;
        PG8_WAIT_V(2); PG8_BAR;
        PG8_STAGE(PG8_SB(1, 0), cB + kstep, voffB); PG8_STAGE(PG8_SA(1, 0), cA + kstep, voffA); PG8_STAGE(PG8_SB(1, 1), cB + hstep + kstep, voffB);
        PG8_WAIT_V(6); PG8_BAR;
    } else {
        PG8_STAGE(PG8_SB(0, 0), cB, voffB); PG8_STAGE(PG8_SA(0, 0), cA, voffA); PG8_STAGE(PG8_SB(0, 1), cB + hstep, voffB); PG8_STAGE(PG8_SA(0, 1), cA + hstep, voffA);
        if (wr == 1) PG8_BAR;
        PG8_WAIT_V(4); PG8_BAR;
        PG8_STAGE(PG8_SB(1, 0), cB + kstep, voffB); PG8_STAGE(PG8_SA(1, 0), cA + kstep, voffA); PG8_STAGE(PG8_SB(1, 1), cB + hstep + kstep, voffB);
        PG8_WAIT_V(6); PG8_BAR;
    }
    for (;;) {
        const bool has_next = S.next(ui + 1, nxt);
        const char* nA = has_next ? (const char*)g.A + (size_t)nxt.pm * tstep : cA; const char* nB = has_next ? (const char*)g.Bt + (size_t)nxt.pn * tstep : cB;
        for (int t = 0; t < nt; t += 2) {
            const bool last = (t == nt - 2);
            const char* a1 = cA + (size_t)(t + 1) * kstep;
            const char* a2 = last ? nA : cA + (size_t)(t + 2) * kstep; const char* b2 = last ? nB : cB + (size_t)(t + 2) * kstep;
            const char* a3 = a2 + kstep; const char* b3 = b2 + kstep;
            if (last && has_next) S.a_ready(nxt);
            if constexpr (SP2) {
            PG8_LDB(B0, 0, 0); PG8_LDB(B1, 0, 1); PG8_SCHED; PG8_LDA(At, 0, 0); PG8_STAGE(PG8_SA(1, 1), a1 + hstep, voffA);
            PG8_WAIT_V(8); PG8_WAIT_L(0); PG8_BAR; PG8_MMA(0, 0, At, B0); PG8_MMA(0, 1, At, B1); PG8_BAR; PG8_SCHED;
            PG8_LDA(At, 0, 1); PG8_STAGE(PG8_SB(0, 0), b2, voffB); PG8_STAGE(PG8_SB(0, 1), b2 + hstep, voffB); PG8_STAGE(PG8_SA(0, 0), a2, voffA);
            PG8_WAIT_V(8); PG8_WAIT_L(0); PG8_BAR; PG8_MMA(1, 0, At, B0); PG8_MMA(1, 1, At, B1); PG8_BAR; PG8_SCHED;
            PG8_LDB(B0, 1, 0); PG8_LDB(B1, 1, 1); PG8_SCHED; PG8_LDA(At, 1, 0); PG8_STAGE(PG8_SA(0, 1), a2 + hstep, voffA);
            PG8_WAIT_V(8); PG8_WAIT_L(0); PG8_BAR; PG8_MMA(0, 0, At, B0); PG8_MMA(0, 1, At, B1); PG8_BAR; PG8_SCHED;
            PG8_LDA(At, 1, 1); PG8_STAGE(PG8_SB(1, 0), b3, voffB); PG8_STAGE(PG8_SB(1, 1), b3 + hstep, voffB); PG8_STAGE(PG8_SA(1, 0), a3, voffA);
            PG8_WAIT_V(8); PG8_WAIT_L(0); PG8_BAR; PG8_MMA(1, 0, At, B0); PG8_MMA(1, 1, At, B1); PG8_BAR; PG8_SCHED;
            } else {
            PG8_LDB(B0, 0, 0); PG8_SCHED; PG8_LDA(At, 0, 0); PG8_STAGE(PG8_SA(1, 1), a1 + hstep, voffA);
            PG8_WAIT_L(8); PG8_BAR; PG8_WAIT_L(0); PG8_MMA(0, 0, At, B0); PG8_BAR; PG8_SCHED;
            PG8_LDB(B1, 0, 1); PG8_STAGE(PG8_SB(0, 0), b2, voffB);
            PG8_BAR; PG8_WAIT_L(0); PG8_MMA(0, 1, At, B1); PG8_BAR;
            PG8_LDA(At, 0, 1); PG8_STAGE(PG8_SA(0, 0), a2, voffA);
            PG8_BAR; PG8_WAIT_L(0); PG8_MMA(1, 0, At, B0); PG8_BAR; PG8_SCHED;
            PG8_STAGE(PG8_SB(0, 1), b2 + hstep, voffB);
            PG8_WAIT_V(6); PG8_BAR; PG8_MMA(1, 1, At, B1); PG8_BAR;
            PG8_LDB(B0, 1, 0); PG8_SCHED; PG8_LDA(At, 1, 0); PG8_STAGE(PG8_SA(0, 1), a2 + hstep, voffA);
            PG8_WAIT_L(8); PG8_BAR; PG8_WAIT_L(0); PG8_MMA(0, 0, At, B0); PG8_BAR; PG8_SCHED;
            PG8_LDB(B1, 1, 1); PG8_STAGE(PG8_SB(1, 0), b3, voffB);
            PG8_BAR; PG8_WAIT_L(0); PG8_MMA(0, 1, At, B1); PG8_BAR;
            PG8_LDA(At, 1, 1); PG8_STAGE(PG8_SA(1, 0), a3, voffA);
            PG8_BAR; PG8_WAIT_L(0); PG8_MMA(1, 0, At, B0); PG8_BAR; PG8_SCHED;
            PG8_STAGE(PG8_SB(1, 1), b3 + hstep, voffB);
            PG8_WAIT_V(6); PG8_BAR; PG8_MMA(1, 1, At, B1); PG8_BAR;
            }
        }
        if constexpr (ALIGN_EPI) { if (wr == 0) PG8_BAR; }
        if constexpr (!Epi::AFTER_DRAIN) { int lane_e; asm volatile("v_mbcnt_lo_u32_b32 %0, -1, 0\n\tv_mbcnt_hi_u32_b32 %0, -1, %0" : "=v"(lane_e));
            const int fr_e = lane_e & 15, fq_e = lane_e >> 4; int wr_e = wr, wc_e = wc; asm volatile("" : "+s"(wr_e), "+s"(wc_e));
#ifdef PROBE_KDUP
            if (!Sched::DUP || (ui & 1))
#endif
            E(acc, cur, wr_e, wc_e, fr_e, fq_e);
#ifdef PROBE_EPI2
            if constexpr (Epi::IDEMPOTENT) { asm volatile("" ::: "memory"); E(acc, cur, wr_e, wc_e, fr_e, fq_e); }
#endif
            S.done(cur); }
        if (!has_next) break;
#pragma unroll
        for (int a = 0; a < 2; ++a)
#pragma unroll
            for (int b = 0; b < 2; ++b)
#pragma unroll
                for (int m = 0; m < 4; ++m)
#pragma unroll
                    for (int n = 0; n < 2; ++n) acc[a][b][m][n] = (f32x4){0.f, 0.f, 0.f, 0.f};
        cur = nxt; cA = nA; cB = nB; ++ui;
        if constexpr (ALIGN_EPI) { if (wr == 1) PG8_BAR; }
    }
    PG8_WAIT_V(0);
    if constexpr (!ALIGN_EPI) { if (wr == 0) PG8_BAR; }
    PG8_BAR;
    if constexpr (Epi::AFTER_DRAIN) { E.fused(acc, cur, wr, wc, fr, fq, lds, wid, lane); S.done(cur); }
#undef PG8_SA
#undef PG8_SB
#undef PG8_STAGE
#undef PG8_LDA
#undef PG8_LDB
#undef PG8_MMA
#undef PG8_WAIT_V
#undef PG8_WAIT_L
#undef PG8_BAR
#undef PG8_SCHED
}
}

constexpr int NWAVES = 8;
#ifndef MK_PER_PHASE
#define MK_PER_PHASE 0
#endif
constexpr int NB = 16, SEQ = 4096, D = 1024, DEPTH = 4, M = NB * SEQ;
constexpr int NIN = 3840, NINW = 3584, FF = 2816, NUP = 5632, NMOD = 6144;
constexpr float EPS = 1e-6f;
constexpr int N_PHASES = 2 + 6 * DEPTH + 1;

constexpr size_t MiB = 1u << 20;
constexpr size_t WS_CTL = 0, CTL_ZERO_BYTES = 4 * MiB;
constexpr size_t WS_MOD = 2 * MiB;
constexpr size_t WS_SMALL = 4 * MiB;
constexpr size_t WS_STAT = 12 * MiB;
constexpr size_t WS_RAWH = 16 * MiB, WS_RAWT = 28 * MiB;
constexpr size_t WS_WIN = 40 * MiB;
constexpr size_t WS_WOUT = 70 * MiB;
constexpr size_t WS_WUP = 78 * MiB;
constexpr size_t WS_WDN = 122 * MiB;
constexpr size_t WS_XN = 144 * MiB;
constexpr size_t WS_O = 272 * MiB;
constexpr size_t WS_P = 400 * MiB;
constexpr size_t WS_END = 880 * MiB;
constexpr int SM_LB = 0;
constexpr int SM_CW = SM_LB + 4 * 512;
constexpr int SM_CB = SM_CW + 4 * 3 * NUP;
constexpr int SM_GS1 = SM_CB + 4 * NUP;
constexpr int SM_GS2 = SM_GS1 + 4 * 16 * D;
constexpr int SM_GT1 = SM_GS2 + 4 * 16 * D;
constexpr int SM_GT2 = SM_GT1 + 4 * 16 * D;
constexpr int SM_B1 = SM_GT2 + 4 * 16 * D;
constexpr int SM_B2 = SM_B1 + 4 * 16 * NIN;
constexpr int SM_END = SM_B2 + 4 * 16 * NUP;
static_assert((size_t)SM_END * 4 <= 8 * MiB, "small vectors fit");
constexpr int CW_BAR = 4096;

constexpr int LDS_BYTES = 163840;
constexpr int RING_BYTES = 131072, HALO_OFF = RING_BYTES, HALO_BYTES = 12288, LDSCTL_OFF = LDS_BYTES - 512, MISC_OFF = LDSCTL_OFF + 320;
static_assert(MISC_OFF + 128 <= LDS_BYTES && HALO_OFF + HALO_BYTES <= LDSCTL_OFF, "LDS map");

#define GAS __attribute__((address_space(1)))
#define LAS __attribute__((address_space(3)))
typedef unsigned short bf16;
typedef unsigned v4u __attribute__((ext_vector_type(4)));
typedef unsigned v2u __attribute__((ext_vector_type(2)));
typedef float f32x4 __attribute__((ext_vector_type(4)));
#define LDS_WAIT() asm volatile("s_waitcnt lgkmcnt(0)" ::: "memory")
__device__ __forceinline__ unsigned f2bf(float f) { unsigned u = __builtin_bit_cast(unsigned, f); return (u + 0x7fffu + ((u >> 16) & 1u)) >> 16; }
__device__ __forceinline__ unsigned pk2(float lo, float hi) { return f2bf(lo) | (f2bf(hi) << 16); }
__device__ __forceinline__ float bf2f(unsigned h) { return __builtin_bit_cast(float, h << 16); }
__device__ __forceinline__ float wave_sum(float v) {
#pragma unroll
    for (int o = 1; o < 64; o <<= 1) v += __shfl_xor(v, o);
    return v;
}
__device__ __forceinline__ float sigmoid_f(float x) { return 1.0f / (1.0f + __expf(-x)); }
#define XB_TMO      128
#define XB_XCNT(j)  (256  + 64 * (j))
#define XB_XSUB(j)  (1280 + 64 * (j))
#define XB_XGEN(j)  (2304 + 64 * (j))
#define XB_TOP      3328
#define XB_TOPGEN   3392
#define XCD_BAR_WORDS 3456
#define XB_SPIN_CAP (1u << 18)

__device__ __forceinline__ unsigned xb_ld(unsigned* p)              { return __hip_atomic_load(p, __ATOMIC_RELAXED, __HIP_MEMORY_SCOPE_AGENT); }
__device__ __forceinline__ unsigned xb_add(unsigned* p, unsigned v) { return __hip_atomic_fetch_add(p, v, __ATOMIC_RELAXED, __HIP_MEMORY_SCOPE_AGENT); }
__device__ __forceinline__ unsigned xb_xcc_id() { return (unsigned)__builtin_amdgcn_s_getreg((3 << 11) | 20) & 0xFu; }
#define XB_SPIN(cond, bar) do { unsigned _sp = 0; while (cond) { __builtin_amdgcn_s_sleep(1); \
    if ((++_sp & 255u) == 0u) { if (xb_ld(&(bar)[XB_TMO])) break; if (_sp > XB_SPIN_CAP) { atomicAdd(&(bar)[XB_TMO], 1u); break; } } } } while (0)

struct XcdBarrier {
    unsigned* bar; unsigned x;
    volatile LAS unsigned* st;
};

__device__ __forceinline__ XcdBarrier xcd_barrier_post(unsigned* bar, volatile LAS unsigned* st) {
    XcdBarrier b; b.bar = bar; b.x = xb_xcc_id(); b.st = st;
    if (threadIdx.x == 0) (void)xb_add(&bar[XB_XCNT(b.x)], 1u);
    return b;
}
__device__ __forceinline__ void xcd_barrier_complete(unsigned* bar, unsigned x, unsigned& nloc, unsigned& nx) {
    const unsigned G = gridDim.x * gridDim.y * gridDim.z;
    unsigned sum, cnt, mine, sp = 0u;
    for (;;) {
        sum = 0u; cnt = 0u; mine = 0u;
#pragma unroll
        for (unsigned j = 0; j < 16; ++j) { const unsigned c = xb_ld(&bar[XB_XCNT(j)]); sum += c; cnt += (c > 0u) ? 1u : 0u; mine = (j == x) ? c : mine; }
        if (sum == G) break;
        __builtin_amdgcn_s_sleep(1);
        if ((++sp & 255u) == 0u) { if (xb_ld(&bar[XB_TMO])) break; if (sp > XB_SPIN_CAP) { atomicAdd(&bar[XB_TMO], 1u); break; } }
    }
    nloc = mine > 0u ? mine : 1u; nx = cnt > 0u ? cnt : 1u;
}

__device__ __forceinline__ void xcd_barrier(const XcdBarrier& b, const bool is_t0  ) {
    asm volatile("s_waitcnt vmcnt(0)" ::: "memory");
    __syncthreads();
    if (is_t0) {
        unsigned* bar = b.bar;
        __builtin_amdgcn_s_waitcnt(0);
        unsigned nloc = b.st[0], nx = b.st[1];
        if (nloc == 0u) { xcd_barrier_complete(bar, b.x, nloc, nx); b.st[0] = nloc; b.st[1] = nx; }
        const unsigned old = xb_add(&bar[XB_XSUB(b.x)], 1u);
        const unsigned gen = old / nloc;
        if (old + 1u == (gen + 1u) * nloc) {
            __builtin_amdgcn_fence(__ATOMIC_RELEASE, "agent");
            asm volatile("s_waitcnt vmcnt(0)" ::: "memory");
            const unsigned og = xb_add(&bar[XB_TOP], 1u);
            const unsigned tg = og / nx;
            if (og + 1u == (tg + 1u) * nx) xb_add(&bar[XB_TOPGEN], 1u);
            else XB_SPIN(xb_ld(&bar[XB_TOPGEN]) == tg, bar);
            __builtin_amdgcn_fence(__ATOMIC_ACQUIRE, "agent");
            xb_add(&bar[XB_XGEN(b.x)], 1u);
            asm volatile("s_waitcnt vmcnt(0)" ::: "memory");
        } else {
            XB_SPIN(xb_ld(&bar[XB_XGEN(b.x)]) == gen, bar);
            __builtin_amdgcn_fence(__ATOMIC_ACQUIRE, "agent");
            asm volatile("s_waitcnt vmcnt(0)" ::: "memory");
        }
    }
    __syncthreads();
}

struct Frame {
    LAS unsigned char* lds;
    volatile LAS unsigned* MISC;
    unsigned* ctl;
    int tid, lane, wave, vcu, G;
    const float *x, *c, *ln1_g, *ln2_g, *w_ada, *b_ada, *w_in, *lb_params, *w_gk, *b_gk, *gn_a, *gn_b, *w_out, *w_up, *conv_w, *conv_b, *w_down, *lnf_g;
    float* out;
    float *MOD, *SMALL, *STAT, *RAWH, *RAWT;
    bf16 *WIN, *WOUT, *WUP, *WDN, *XN, *O, *P, *Gb;
};

__device__ __forceinline__ void tr_item(const float* W, int Nsrc, int K, bf16* WT, int kb, int sn0, int dn0, float scale, LAS float* scr, int lane) {
    const int k0 = 64 * kb;
#pragma unroll 8
    for (int i = 0; i < 32; ++i) { const int kk = 2 * i + (lane >> 5); scr[kk * 33 + (lane & 31)] = W[(size_t)(k0 + kk) * Nsrc + sn0 + (lane & 31)]; }
    LDS_WAIT(); asm volatile("" ::: "memory");
    const int c = lane & 7;
#pragma unroll
    for (int j = 0; j < 4; ++j) { const int n = (lane >> 3) + 8 * j; const LAS float* s = scr + (8 * c) * 33 + n;
        v4u o; o.x = pk2(s[0 * 33] * scale, s[1 * 33] * scale); o.y = pk2(s[2 * 33] * scale, s[3 * 33] * scale); o.z = pk2(s[4 * 33] * scale, s[5 * 33] * scale); o.w = pk2(s[6 * 33] * scale, s[7 * 33] * scale);
        *(GAS v4u*)(WT + (size_t)(dn0 + n) * K + k0 + 8 * c) = o; }
    LDS_WAIT(); asm volatile("" ::: "memory");
}
__host__ __device__ __forceinline__ int up_orig(int np) { return ((np & 255) >> 7) * FF + 128 * (np >> 8) + (np & 127); }

__device__ __forceinline__ void p0a(Frame& F) {
    const int gw = F.vcu * NWAVES + F.wave, NGW = F.G * NWAVES, gt = F.vcu * (NWAVES * 64) + F.tid, NGT = F.G * NWAVES * 64;
    {
        LAS float* cond = (LAS float*)F.lds;
        for (int e = F.tid; e < 16 * 1024; e += NWAVES * 64) { const int b = e >> 10, d = e & 1023; const float cv = F.c[b * 1024 + d]; cond[d * 16 + b] = cv * sigmoid_f(cv); }
        __syncthreads();
        for (int it = gw; it < DEPTH * 384; it += NGW) {
            const int cb = it % 384, l = it / 384, e = cb * 16 + (F.lane & 15), dq = F.lane >> 4;
            const float* w = F.w_ada + ((size_t)l * 1024 + dq) * NMOD + e;
            float acc[16];
#pragma unroll
            for (int b = 0; b < 16; ++b) acc[b] = 0.f;
#pragma unroll 4
            for (int dd = 0; dd < 256; ++dd) {
                const float wv = w[(size_t)(4 * dd) * NMOD];
                const LAS f32x4* cp = (const LAS f32x4*)(cond + (4 * dd + dq) * 16);
#pragma unroll
                for (int q = 0; q < 4; ++q) { const f32x4 cq = cp[q]; acc[4 * q] += cq[0] * wv; acc[4 * q + 1] += cq[1] * wv; acc[4 * q + 2] += cq[2] * wv; acc[4 * q + 3] += cq[3] * wv; }
            }
            const float bb = F.b_ada[l * NMOD + e];
#pragma unroll
            for (int b = 0; b < 16; ++b) { float v = acc[b]; v += __shfl_xor(v, 16); v += __shfl_xor(v, 32); if (dq == 0) F.MOD[(size_t)(l * 16 + b) * NMOD + e] = v + bb; }
        }
        __syncthreads();
    }
    for (int i = gt; i < 512; i += NGT) {
        const float p0 = F.lb_params[i], p1 = F.lb_params[512 + i], p2 = F.lb_params[1024 + i], p3 = F.lb_params[1536 + i];
        const float mx = fmaxf(fmaxf(p0, p1), fmaxf(p2, p3)); const float e0 = __expf(p0 - mx), e1 = __expf(p1 - mx), e2 = __expf(p2 - mx), e3 = __expf(p3 - mx);
        const float inv = 1.0f / (e0 + e1 + e2 + e3);
        F.SMALL[SM_LB + i] = 0.f; F.SMALL[SM_LB + 512 + i] = e1 * inv; F.SMALL[SM_LB + 1024 + i] = (e1 + e2) * inv; F.SMALL[SM_LB + 1536 + i] = (e1 + e2 + e3) * inv;
    }
    for (int i = gt; i < DEPTH * 3 * NUP; i += NGT) { const int np = i % NUP, lj = i / NUP; F.SMALL[SM_CW + i] = F.conv_w[(size_t)lj * NUP + up_orig(np)]; }
    for (int i = gt; i < DEPTH * NUP; i += NGT) { const int np = i % NUP, l = i / NUP; F.SMALL[SM_CB + i] = F.conv_b[(size_t)l * NUP + up_orig(np)]; }
    for (int i = gt; i < DEPTH * 256 * 1024; i += NGT) {
        const int k = i & 1023, n = (i >> 10) & 255, l = i >> 18;
        const float* wi = F.w_in + ((size_t)l * 1024 + k) * 3600 + NINW; const float* wg = F.w_gk + (size_t)l * 16 * 256 + n;
        float s = 0.f;
#pragma unroll
        for (int r = 0; r < 16; ++r) s += wi[r] * wg[r * 256];
        F.WIN[((size_t)l * NIN + NINW + n) * 1024 + k] = (bf16)f2bf(s);
    }
    {   LAS float* scr = (LAS float*)(F.lds + F.wave * 16384);
        constexpr int I_IN = 16 * 112, I_OUT = 16 * 32, I_UP = 16 * 176, I_DN = 44 * 32, I_L = I_IN + I_OUT + I_UP + I_DN;
        for (int it = gw; it < DEPTH * I_L; it += NGW) {
            const int l = it / I_L; int r = it % I_L;
            if (r < I_IN) { const int kb = r / 112, nb = r % 112; tr_item(F.w_in + (size_t)l * 1024 * 3600, 3600, 1024, F.WIN + (size_t)l * NIN * 1024, kb, 32 * nb, 32 * nb, (nb >= 64 && nb < 72) ? 0.125f : 1.0f, scr, F.lane); continue; } r -= I_IN;
            if (r < I_OUT) { const int kb = r / 32, nb = r % 32; tr_item(F.w_out + (size_t)l * 1024 * 1024, 1024, 1024, F.WOUT + (size_t)l * 1024 * 1024, kb, 32 * nb, 32 * nb, 1.0f, scr, F.lane); continue; } r -= I_OUT;
            if (r < I_UP) { const int kb = r / 176, nb = r % 176; tr_item(F.w_up + (size_t)l * 1024 * NUP, NUP, 1024, F.WUP + (size_t)l * NUP * 1024, kb, up_orig(32 * nb), 32 * nb, 1.0f, scr, F.lane); continue; } r -= I_UP;
            { const int kb = r / 32, nb = r % 32; tr_item(F.w_down + (size_t)l * FF * 1024, 1024, FF, F.WDN + (size_t)l * 1024 * FF, kb, 32 * nb, 32 * nb, 1.0f, scr, F.lane); }
        }
    }
}

__device__ __forceinline__ void p0b(Frame& F) {
    const int gw = F.vcu * NWAVES + F.wave, NGW = F.G * NWAVES, gt = F.vcu * (NWAVES * 64) + F.tid, NGT = F.G * NWAVES * 64;
    LAS float* shL = (LAS float*)F.lds;
    for (int combo = 0; combo < 2 * DEPTH; ++combo) {
        const int l = combo >> 1, which = combo & 1;
        __syncthreads();
        for (int e = F.tid; e < 16 * 1024; e += NWAVES * 64) { const int b = e >> 10, d = e & 1023; shL[e] = F.MOD[(size_t)(l * 16 + b) * NMOD + (which ? 3072 : 0) + d]; }
        __syncthreads();
        const bf16* Wt = which ? F.WUP + (size_t)l * NUP * 1024 : F.WIN + (size_t)l * NIN * 1024; const int ncols = which ? NUP : NIN;
        float* outp = F.SMALL + (which ? SM_B2 + l * 16 * NUP : SM_B1 + l * 16 * NIN);
        for (int n = gw; n < ncols; n += NGW) {
            const GAS v2u* wr = (const GAS v2u*)(Wt + (size_t)n * 1024) + F.lane;
            float w[16];
#pragma unroll
            for (int i = 0; i < 4; ++i) { const v2u p = wr[64 * i]; w[4 * i] = bf2f(p.x & 0xffffu); w[4 * i + 1] = bf2f(p.x >> 16); w[4 * i + 2] = bf2f(p.y & 0xffffu); w[4 * i + 3] = bf2f(p.y >> 16); }
            float res = 0.f;
#pragma unroll 1
            for (int b = 0; b < 16; ++b) { float s = 0.f;
#pragma unroll
                for (int i = 0; i < 4; ++i) { const f32x4 sh = *(const LAS f32x4*)(shL + b * 1024 + 256 * i + 4 * F.lane); s += sh[0] * w[4 * i] + sh[1] * w[4 * i + 1] + sh[2] * w[4 * i + 2] + sh[3] * w[4 * i + 3]; }
                s = wave_sum(s); res = (F.lane == b) ? s : res; }
            if (F.lane < 16) outp[F.lane * ncols + n] = res + ((which == 0 && n >= NINW) ? F.b_gk[l * 256 + n - NINW] : 0.f);
        }
    }
    for (int i = gt; i < DEPTH * 16 * D; i += NGT) { const int d = i & 1023, lb = i >> 10, l = lb >> 4; const float* mod = F.MOD + (size_t)lb * NMOD;
        F.SMALL[SM_GS1 + i] = F.ln1_g[l * D + d] * (1.0f + mod[1024 + d]); F.SMALL[SM_GT1 + i] = mod[2048 + d];
        F.SMALL[SM_GS2 + i] = F.ln2_g[l * D + d] * (1.0f + mod[4096 + d]); F.SMALL[SM_GT2 + i] = mod[5120 + d]; }
    for (int row = gw; row < M; row += NGW) {
        const int b = row / SEQ; const GAS f32x4* xr = (const GAS f32x4*)(F.x + (size_t)row * D) + F.lane; const float* mod = F.MOD + (size_t)b * NMOD + 1024;
        GAS v2u* o8 = (GAS v2u*)(F.XN + (size_t)row * D) + F.lane; float ss = 0.f;
#pragma unroll
        for (int j = 0; j < 4; ++j) { const f32x4 v = xr[64 * j]; const int d = 256 * j + 4 * F.lane; const f32x4 g = *(const f32x4*)(F.ln1_g + d), sc = *(const f32x4*)(mod + d);
            ss += (v[0] * v[0] + v[1] * v[1]) + (v[2] * v[2] + v[3] * v[3]);
            v2u w; w.x = pk2(v[0] * g[0] * (1.0f + sc[0]), v[1] * g[1] * (1.0f + sc[1])); w.y = pk2(v[2] * g[2] * (1.0f + sc[2]), v[3] * g[3] * (1.0f + sc[3])); o8[64 * j] = w; }
        ss = wave_sum(ss);
        if (F.lane < 16) F.STAT[(size_t)row * 16 + F.lane] = (F.lane == 0) ? ss : 0.f;
    }
}

template <int DK, bool IS_A>
__device__ __forceinline__ void mixer_stream(Frame& F, int l, int b, int h) {
    constexpr int DKS = DK / 4, TB = 16;
    LAS float* aL = (LAS float*)F.lds; LAS float* kL = aL + TB * 128; LAS float* qL = kL + TB * 128; LAS float* vL = qL + TB * 128; LAS float* gL = vL + TB * 128;
    LAS float* part = gL + TB * 128;
    LAS float* red = part + TB * 4 * 128;
    const int tid = F.tid, j = tid & 127, sl = tid >> 7;
    const int qc = IS_A ? 128 * h : 2048 + 64 * h, fc = IS_A ? 512 + 128 * h : 2304 + 64 * h, gkc = 3584 + 64 * h;
    const int vc = IS_A ? 1024 + 128 * h : 2560 + 128 * h, gc = IS_A ? 1536 + 128 * h : 3072 + 128 * h, oc = IS_A ? 128 * h : 512 + 128 * h;
    const float* lbp = F.SMALL + SM_LB + l * 512 + 128 * h;
    const float gn = (IS_A ? F.gn_a : F.gn_b)[l * 128 + j];
    float S[DKS];
#pragma unroll
    for (int i = 0; i < DKS; ++i) S[i] = 0.f;
    for (int t0 = 0; t0 < SEQ; t0 += TB) {
        const size_t rowb = (size_t)b * SEQ + t0;
        for (int e = tid; e < TB * DK; e += NWAVES * 64) { const int tt = e / DK, i = e % DK; const bf16* pr = F.P + (rowb + tt) * NIN;
            const float q = bf2f(pr[qc + i]); float a, k;
            if (IS_A) { const float fa = bf2f(pr[fc + i]), lb = lbp[i], sg = sigmoid_f(fa); a = lb + (1.0f - lb) * sg; k = (1.0f - lb) * (1.0f - sg); }
            else { k = bf2f(pr[fc + i]); const float gk = bf2f(pr[gkc + i]); const float ls = fminf(gk, 0.f) - __logf(1.0f + __expf(-fabsf(gk))); a = __expf(ls * (1.0f / 16.0f)); }
            aL[tt * 128 + i] = a; kL[tt * 128 + i] = k; qL[tt * 128 + i] = q; }
        for (int e = tid; e < TB * 128; e += NWAVES * 64) { const int tt = e >> 7, jj = e & 127; const bf16* pr = F.P + (rowb + tt) * NIN; vL[e] = bf2f(pr[vc + jj]); gL[e] = bf2f(pr[gc + jj]); }
        __syncthreads();
#pragma unroll 1
        for (int tt = 0; tt < TB; ++tt) { const float v = vL[tt * 128 + j]; float acc = 0.f;
#pragma unroll
            for (int i4 = 0; i4 < DKS / 4; ++i4) { const f32x4 a4 = *(const LAS f32x4*)(aL + tt * 128 + sl * DKS + 4 * i4), k4 = *(const LAS f32x4*)(kL + tt * 128 + sl * DKS + 4 * i4), q4 = *(const LAS f32x4*)(qL + tt * 128 + sl * DKS + 4 * i4);
#pragma unroll
                for (int r = 0; r < 4; ++r) { S[4 * i4 + r] = a4[r] * S[4 * i4 + r] + k4[r] * v; acc += q4[r] * S[4 * i4 + r]; } }
            part[(tt * 4 + sl) * 128 + j] = acc; }
        __syncthreads();
        float o[4];
#pragma unroll
        for (int r = 0; r < 4; ++r) { const int tt = sl * 4 + r; o[r] = (part[(tt * 4 + 0) * 128 + j] + part[(tt * 4 + 1) * 128 + j]) + (part[(tt * 4 + 2) * 128 + j] + part[(tt * 4 + 3) * 128 + j]);
            const float ss = wave_sum(o[r] * o[r]); if (F.lane == 0) red[tt * 2 + ((tid >> 6) & 1)] = ss; }
        __syncthreads();
#pragma unroll
        for (int r = 0; r < 4; ++r) { const int tt = sl * 4 + r; const float tot = red[tt * 2] + red[tt * 2 + 1]; const float rn = 1.0f / sqrtf(tot * (1.0f / 128.0f) + EPS);
            const float g = gL[tt * 128 + j]; F.O[(rowb + tt) * D + oc + j] = (bf16)f2bf(o[r] * rn * gn * (g * sigmoid_f(g))); }
        __syncthreads();
    }
}
__device__ __forceinline__ void mixer_phase(Frame& F, int l) {
    for (int s = blockIdx.x; s < NB * 8; s += F.G) { const int b = s >> 3, hh = s & 7;
        if (hh < 4) mixer_stream<128, true>(F, l, b, hh); else mixer_stream<64, false>(F, l, b, hh - 4); }
}

#ifndef MIXER_NAIVE
#define MIXER_NAIVE 0
#endif
#ifndef MIXER_V3
#define MIXER_V3 1
#endif
#ifndef MX_SPLIT
#define MX_SPLIT 1
#endif
#if MIXER_NAIVE
#define MIXER_PHASE mixer_phase
#elif MIXER_V3
#define MIXER_PHASE mixer_phase_pipe
#else
#define MIXER_PHASE mixer_phase_chunked
#endif


typedef short bf16x8_t __attribute__((ext_vector_type(8)));
typedef short s16x4_t __attribute__((ext_vector_type(4)));
typedef float f32x2_t __attribute__((ext_vector_type(2)));
typedef __bf16 bf16x2_t __attribute__((ext_vector_type(2)));
#define MFMA16(a, b, c) __builtin_amdgcn_mfma_f32_16x16x32_bf16((a), (b), (c), 0, 0, 0)
#ifdef MX_FULLSYNC
#define LBAR() __syncthreads()
#else
#define LBAR() do { asm volatile("s_waitcnt lgkmcnt(0)" ::: "memory"); __builtin_amdgcn_s_barrier(); asm volatile("" ::: "memory"); } while (0)
#endif
__device__ __forceinline__ unsigned cvtpk(float lo, float hi) { f32x2_t v = {lo, hi}; bf16x2_t r = __builtin_convertvector(v, bf16x2_t); return __builtin_bit_cast(unsigned, r); }
__device__ __forceinline__ float bflo(unsigned u) { return __builtin_bit_cast(float, u << 16); }
__device__ __forceinline__ float bfhi(unsigned u) { return __builtin_bit_cast(float, u & 0xffff0000u); }
__device__ __forceinline__ s16x4_t tr16(const LAS unsigned char* p) { return __builtin_bit_cast(s16x4_t, __builtin_amdgcn_ds_read_tr16_b64_v4i16((LAS s16x4_t*)p)); }
constexpr float L2E = 1.4426950408889634f;

template <int DK, bool IS_A>
__device__ __forceinline__ void mixer_chunked_stream(Frame& F, int l, int b, int h, const int n_lo, const int n_full, const int n_hi) {
    constexpr int CP = DK / 2, TS = 512 / CP, R = 64 / TS, TSREF = 32 / R, NKS = DK / 32, NMT = DK / 16, NCH = SEQ / 64;
    constexpr int PQ = DK * 2 + 16, PT = 144, PV = 272, PO = 528;
    constexpr int L_QH = 0, L_KH = L_QH + 64 * PQ, L_VV = L_KH + 64 * PQ, L_SC = L_VV + 64 * PV, L_SEG = L_SC + 64 * PT, L_ERF = L_SEG + TS * DK * 4, L_ELR = L_ERF + DK * 4, L_DEC = L_ELR + DK * 4,
                  L_OB = L_DEC + DK * 4, L_END = L_OB + 64 * PO;
    static_assert(L_END <= RING_BYTES, "mixer LDS map");
    LAS unsigned char* const lds = F.lds;
    const int w = F.wave;
#define MX_IDS() int lane; asm volatile("v_mbcnt_lo_u32_b32 %0, -1, 0\n\tv_mbcnt_hi_u32_b32 %0, -1, %0" : "=v"(lane)); const int tid = w * 64 + lane, m = lane & 15, g = lane >> 4, q4 = (lane & 15) >> 2, p4 = lane & 3, \
        cp = tid % CP, ts = tid / CP, nt = tid >> 3, ndq = tid & 7, vr0 = tid >> 4, vq = tid & 15; (void)m; (void)g; (void)q4; (void)p4; (void)cp; (void)ts; (void)nt; (void)ndq; (void)vr0; (void)vq
    const int qc = IS_A ? 128 * h : 2048 + 64 * h, fc = IS_A ? 512 + 128 * h : 2304 + 64 * h, gkc = 3584 + 64 * h;
    const int vc = IS_A ? 1024 + 128 * h : 2560 + 128 * h, gc = IS_A ? 1536 + 128 * h : 3072 + 128 * h, oc = IS_A ? 128 * h : 512 + 128 * h;
    float lb0 = 0.f, lb1 = 0.f;
    if (IS_A) { MX_IDS(); lb0 = F.SMALL[SM_LB + l * 512 + 128 * h + 2 * cp]; lb1 = F.SMALL[SM_LB + l * 512 + 128 * h + 2 * cp + 1]; }
    const float* gnp = (IS_A ? F.gn_a : F.gn_b) + l * 128;

    f32x4 S[NMT];
#pragma unroll
    for (int i = 0; i < NMT; ++i) S[i] = (f32x4){0.f, 0.f, 0.f, 0.f};
    unsigned q2[R], f2[R], k2[R];
    v4u vreg[2], ogreg[2];
    float cum[2][R], kk[2][R];

#define MX_LOAD_RAW(n) do { const size_t row0_ = (size_t)b * SEQ + (size_t)(n) * 64; \
        _Pragma("unroll") for (int j = 0; j < R; ++j) { const unsigned* pr = (const unsigned*)(F.P + (row0_ + ts * R + j) * NIN); \
            q2[j] = pr[(qc >> 1) + cp]; if (IS_A) { f2[j] = pr[(fc >> 1) + cp]; } else { k2[j] = pr[(fc >> 1) + cp]; f2[j] = pr[(gkc >> 1) + cp]; } } \
        _Pragma("unroll") for (int i = 0; i < 2; ++i) vreg[i] = *(const v4u*)(F.P + (row0_ + vr0 + 32 * i) * NIN + vc + 8 * vq); } while (0)
#define MX_E1() do { \
        _Pragma("unroll") for (int c = 0; c < 2; ++c) { float run = IS_A ? 1.f : 0.f; const float lb = c ? lb1 : lb0; \
            _Pragma("unroll") for (int j = 0; j < R; ++j) { const float x = c ? bfhi(f2[j]) : bflo(f2[j]); \
                if (IS_A) { const float sg = __builtin_amdgcn_rcpf(1.0f + __builtin_amdgcn_exp2f(-x * L2E)); run *= lb + (1.0f - lb) * sg; kk[c][j] = (1.0f - lb) * (1.0f - sg); } \
                else { run += (fminf(x, 0.f) * L2E - __builtin_amdgcn_logf(1.0f + __builtin_amdgcn_exp2f(-fabsf(x) * L2E))) * (1.0f / 16.0f); kk[c][j] = c ? bfhi(k2[j]) : bflo(k2[j]); } \
                cum[c][j] = run; } } \
        *(LAS f32x2_t*)(lds + L_SEG + (ts * DK + 2 * cp) * 4) = IS_A ? (f32x2_t){__builtin_amdgcn_logf(cum[0][R - 1]), __builtin_amdgcn_logf(cum[1][R - 1])} : (f32x2_t){cum[0][R - 1], cum[1][R - 1]}; } while (0)

    { MX_IDS(); MX_LOAD_RAW(n_lo); MX_E1(); }
#pragma unroll 1
    for (int n = n_lo; n < n_hi; ++n) {
        const size_t row0 = (size_t)b * SEQ + (size_t)n * 64; const bool full = (n >= n_full);
        LBAR();
        {   MX_IDS();
            float base[2] = {0.f, 0.f}, tot[2] = {0.f, 0.f}, refv[2] = {0.f, 0.f};
#pragma unroll
            for (int t2 = 0; t2 < TS; ++t2) { const f32x2_t sv = *(const LAS f32x2_t*)(lds + L_SEG + (t2 * DK + 2 * cp) * 4);
                tot[0] += sv[0]; tot[1] += sv[1]; if (t2 < ts) { base[0] += sv[0]; base[1] += sv[1]; } if (t2 < TSREF) { refv[0] += sv[0]; refv[1] += sv[1]; } }
            if (ts == 0) { *(LAS f32x2_t*)(lds + L_DEC + 2 * cp * 4) = (f32x2_t){__builtin_amdgcn_exp2f(tot[0]), __builtin_amdgcn_exp2f(tot[1])};
                *(LAS f32x2_t*)(lds + L_ERF + 2 * cp * 4) = (f32x2_t){__builtin_amdgcn_exp2f(refv[0]), __builtin_amdgcn_exp2f(refv[1])};
                *(LAS f32x2_t*)(lds + L_ELR + 2 * cp * 4) = (f32x2_t){__builtin_amdgcn_exp2f(tot[0] - refv[0]), __builtin_amdgcn_exp2f(tot[1] - refv[1])}; }
            const float eb0 = IS_A ? __builtin_amdgcn_exp2f(base[0] - refv[0]) : base[0] - refv[0], eb1 = IS_A ? __builtin_amdgcn_exp2f(base[1] - refv[1]) : base[1] - refv[1];
#pragma unroll
            for (int j = 0; j < R; ++j) { const int t = ts * R + j;
                const float e10 = IS_A ? eb0 * cum[0][j] : __builtin_amdgcn_exp2f(eb0 + cum[0][j]), e11 = IS_A ? eb1 * cum[1][j] : __builtin_amdgcn_exp2f(eb1 + cum[1][j]);
                const float e20 = __builtin_amdgcn_rcpf(e10), e21 = __builtin_amdgcn_rcpf(e11);
                *(LAS unsigned*)(lds + L_QH + t * PQ + 4 * cp) = cvtpk(bflo(q2[j]) * e10, bfhi(q2[j]) * e11);
                *(LAS unsigned*)(lds + L_KH + t * PQ + 4 * cp) = cvtpk(kk[0][j] * e20, kk[1][j] * e21);
            }
#pragma unroll
            for (int i = 0; i < 2; ++i) *(LAS v4u*)(lds + L_VV + (vr0 + 32 * i) * PV + 16 * vq) = vreg[i];
            if (full) {
#pragma unroll
                for (int i = 0; i < 2; ++i) ogreg[i] = *(const v4u*)(F.P + (row0 + nt) * NIN + gc + 16 * ndq + 8 * i); }
            if (n + 1 < n_hi) MX_LOAD_RAW(n + 1);
        }
        LBAR();
        if (full) {   MX_IDS(); const int tb = w >> 1;
#pragma unroll
            for (int si = 0; si < 2; ++si) { const int sb = 2 * (w & 1) + si;
                if (sb <= tb) { f32x4 acc = {0.f, 0.f, 0.f, 0.f};
#pragma unroll
                    for (int ks = 0; ks < NKS; ++ks) { const bf16x8_t a = *(const LAS bf16x8_t*)(lds + L_QH + (16 * tb + m) * PQ + 64 * ks + 16 * g), bb = *(const LAS bf16x8_t*)(lds + L_KH + (16 * sb + m) * PQ + 64 * ks + 16 * g);
                        acc = MFMA16(a, bb, acc); }
#pragma unroll
                    for (int j = 0; j < 4; ++j) { const int t = 16 * tb + 4 * g + j, s = 16 * sb + m; const float val = (s <= t) ? acc[j] : 0.f;
                        *(LAS unsigned short*)(lds + L_SC + t * PT + 2 * s) = (unsigned short)f2bf(val); } }
                else {
#pragma unroll
                    for (int j = 0; j < 4; ++j) *(LAS unsigned short*)(lds + L_SC + (16 * tb + 4 * g + j) * PT + 2 * (16 * sb + m)) = (unsigned short)0; } }
            LBAR();
        }
        {   MX_IDS(); const int dv0 = 16 * w;
            bf16x8_t vB[2];
#pragma unroll
            for (int ks2 = 0; ks2 < 2; ++ks2) { const LAS unsigned char* vp = lds + L_VV + (32 * ks2 + 8 * g + q4) * PV + 2 * (dv0 + 4 * p4);
                const s16x4_t lo = tr16(vp), hi = tr16(vp + 4 * PV); vB[ks2] = __builtin_shufflevector(lo, hi, 0, 1, 2, 3, 4, 5, 6, 7); }
            f32x4 o[4];
#pragma unroll
            for (int mt = 0; mt < 4; ++mt) o[mt] = (f32x4){0.f, 0.f, 0.f, 0.f};
            if (full) {
#pragma unroll
            for (int mt = 0; mt < 4; ++mt) {
#pragma unroll
                for (int ks2 = 0; ks2 < 2; ++ks2) if (2 * ks2 <= mt) { const bf16x8_t a = *(const LAS bf16x8_t*)(lds + L_SC + (16 * mt + m) * PT + 64 * ks2 + 16 * g); o[mt] = MFMA16(a, vB[ks2], o[mt]); } }
#pragma unroll
            for (int sg = 0; sg < NKS; ++sg) {
                const f32x4 ea = *(const LAS f32x4*)(lds + L_ERF + 4 * (32 * sg + 4 * g)), eb = *(const LAS f32x4*)(lds + L_ERF + 4 * (32 * sg + 16 + 4 * g));
                const f32x4 sa = S[2 * sg] * ea, sb4 = S[2 * sg + 1] * eb;
                const bf16x8_t sB = __builtin_bit_cast(bf16x8_t, (v4u){cvtpk(sa[0], sa[1]), cvtpk(sa[2], sa[3]), cvtpk(sb4[0], sb4[1]), cvtpk(sb4[2], sb4[3])});
#pragma unroll
                for (int mt = 0; mt < 4; ++mt) { const LAS unsigned char* qp = lds + L_QH + (16 * mt + m) * PQ + 2 * (32 * sg + 4 * g);
                    const s16x4_t lo = *(const LAS s16x4_t*)qp, hi = *(const LAS s16x4_t*)(qp + 32);
                    o[mt] = MFMA16(__builtin_shufflevector(lo, hi, 0, 1, 2, 3, 4, 5, 6, 7), sB, o[mt]); } asm volatile("" ::: "memory"); }
            }
#pragma unroll
            for (int mtile = 0; mtile < NMT; ++mtile) { f32x4 u4 = {0.f, 0.f, 0.f, 0.f};
#pragma unroll
                for (int ks2 = 0; ks2 < 2; ++ks2) { const LAS unsigned char* kp = lds + L_KH + (32 * ks2 + 8 * g + q4) * PQ + 2 * (16 * mtile + 4 * p4);
                    const s16x4_t lo = tr16(kp), hi = tr16(kp + 4 * PQ); u4 = MFMA16(__builtin_shufflevector(lo, hi, 0, 1, 2, 3, 4, 5, 6, 7), vB[ks2], u4); }
                const f32x4 d4 = *(const LAS f32x4*)(lds + L_DEC + 4 * (16 * mtile + 4 * g)), l4 = *(const LAS f32x4*)(lds + L_ELR + 4 * (16 * mtile + 4 * g));
                S[mtile] = S[mtile] * d4 + u4 * l4; if (mtile & 1) asm volatile("" ::: "memory"); }
            if (full) {
#pragma unroll
            for (int mt = 0; mt < 4; ++mt)
#pragma unroll
                for (int j = 0; j < 4; ++j) *(LAS float*)(lds + L_OB + (16 * mt + 4 * g + j) * PO + 4 * (dv0 + m)) = o[mt][j];
            }
        }
        if (full) {   LBAR(); MX_IDS(); f32x4 ov[4]; float ss = 0.f;
#pragma unroll
            for (int i = 0; i < 4; ++i) { ov[i] = *(const LAS f32x4*)(lds + L_OB + nt * PO + 64 * ndq + 16 * i); ss += (ov[i][0] * ov[i][0] + ov[i][1] * ov[i][1]) + (ov[i][2] * ov[i][2] + ov[i][3] * ov[i][3]); }
            ss += __shfl_xor(ss, 1); ss += __shfl_xor(ss, 2); ss += __shfl_xor(ss, 4);
            const float rn = 1.0f / sqrtf(ss * (1.0f / 128.0f) + EPS);
            unsigned ow[8];
#pragma unroll
            for (int i = 0; i < 4; ++i) { const f32x4 gn4 = *(const f32x4*)(gnp + 16 * ndq + 4 * i); const unsigned g01 = ogreg[i >> 1][2 * (i & 1)], g23 = ogreg[i >> 1][2 * (i & 1) + 1];
                const float ga = bflo(g01), gb = bfhi(g01), gcc = bflo(g23), gd = bfhi(g23);
                const float r0 = ov[i][0] * rn * gn4[0] * (ga * __builtin_amdgcn_rcpf(1.0f + __builtin_amdgcn_exp2f(-ga * L2E))), r1 = ov[i][1] * rn * gn4[1] * (gb * __builtin_amdgcn_rcpf(1.0f + __builtin_amdgcn_exp2f(-gb * L2E)));
                const float r2 = ov[i][2] * rn * gn4[2] * (gcc * __builtin_amdgcn_rcpf(1.0f + __builtin_amdgcn_exp2f(-gcc * L2E))), r3 = ov[i][3] * rn * gn4[3] * (gd * __builtin_amdgcn_rcpf(1.0f + __builtin_amdgcn_exp2f(-gd * L2E)));
                ow[2 * i] = cvtpk(r0, r1); ow[2 * i + 1] = cvtpk(r2, r3); }
            bf16* op = F.O + (row0 + nt) * D + oc + 16 * ndq;
            *(v4u*)op = (v4u){ow[0], ow[1], ow[2], ow[3]}; *(v4u*)(op + 8) = (v4u){ow[4], ow[5], ow[6], ow[7]};
        }
        if (n + 1 < n_hi) { MX_IDS(); MX_E1(); }
    }
    LBAR();
#undef MX_LOAD_RAW
#undef MX_E1
#undef MX_IDS
}
#ifndef MX_N0
#define MX_N0 42
#endif
__device__ __forceinline__ void mixer_phase_chunked(Frame& F, int l) {
    for (int it = blockIdx.x; it < 256; it += F.G) { const int s = it & 63, seg = (it >> 6) & 1;
        if (it < 128) mixer_chunked_stream<128, true>(F, l, s >> 2, s & 3, 0, seg ? MX_N0 : 0, seg ? SEQ / 64 : MX_N0);
        else mixer_chunked_stream<64, false>(F, l, s >> 2, s & 3, 0, seg ? MX_N0 : 0, seg ? SEQ / 64 : MX_N0); }
}

template <int DK, bool IS_A>
__device__ __forceinline__ void mixer_pipe_stream(Frame& F, int l, int b, int h, const int n_lo, const int n_full, const int n_hi) {
    constexpr int DKW = DK / 4, PW = DKW / 2, RG = 64 / PW, RR = 64 / RG, RGREF = 32 / RR, NKS = DK / 32, NMT = DK / 16;
    constexpr int PQ = DK * 2 + 16, PT = 144, PV = 272, PO = 528;
    constexpr int BUF = 2 * 64 * PQ + 64 * PV, B_QH = 0, B_KH = 64 * PQ, B_VV = 2 * 64 * PQ;
    constexpr int L_SC = 2 * BUF, L_FAC = L_SC + 64 * PT, FACB = 3 * DK * 4, L_OB = L_FAC + 2 * FACB, L_END = L_OB + 64 * PO;
    static_assert(L_END <= LDSCTL_OFF, "mixer LDS map");
    LAS unsigned char* const lds = F.lds;
    const int w = F.wave;
    const bool producer = (w >= 4);
    const int pw = w - 4, cw = w;
    const int qc = IS_A ? 128 * h : 2048 + 64 * h, fc = IS_A ? 512 + 128 * h : 2304 + 64 * h, gkc = 3584 + 64 * h;
    const int vc = IS_A ? 1024 + 128 * h : 2560 + 128 * h, gc = IS_A ? 1536 + 128 * h : 3072 + 128 * h, oc = IS_A ? 128 * h : 512 + 128 * h;
    const float* gnp = (IS_A ? F.gn_a : F.gn_b) + l * 128;
#define MP_LANE() int lane; asm volatile("v_mbcnt_lo_u32_b32 %0, -1, 0\n\tv_mbcnt_hi_u32_b32 %0, -1, %0" : "=v"(lane))
    f32x4 S[NMT][2];
#pragma unroll
    for (int i = 0; i < NMT; ++i) { S[i][0] = (f32x4){0.f, 0.f, 0.f, 0.f}; S[i][1] = (f32x4){0.f, 0.f, 0.f, 0.f}; }
    v4u ogreg[4];
    unsigned q2[RR], f2[RR], k2[RR]; v4u vreg[4];
    float lb0 = 0.f, lb1 = 0.f;
#define MP_LOAD_RAW(n) do { const size_t row0_ = (size_t)b * SEQ + (size_t)(n) * 64; \
        _Pragma("unroll") for (int j = 0; j < RR; ++j) { const unsigned* pr = (const unsigned*)(F.P + (row0_ + rg * RR + j) * NIN); \
            q2[j] = pr[(qc >> 1) + pw * PW + cpl]; if (IS_A) { f2[j] = pr[(fc >> 1) + pw * PW + cpl]; } else { k2[j] = pr[(fc >> 1) + pw * PW + cpl]; f2[j] = pr[(gkc >> 1) + pw * PW + cpl]; } } \
        _Pragma("unroll") for (int i = 0; i < 4; ++i) { const int id = pw * 64 + lane + 256 * i; vreg[i] = *(const v4u*)(F.P + (row0_ + (id >> 4)) * NIN + vc + 8 * (id & 15)); } } while (0)
    if (producer) {
        MP_LANE(); const int cpl = lane % PW, rg = lane / PW, m = lane & 15, g = lane >> 4;
        if (IS_A) { lb0 = F.SMALL[SM_LB + l * 512 + 128 * h + pw * DKW + 2 * cpl]; lb1 = F.SMALL[SM_LB + l * 512 + 128 * h + pw * DKW + 2 * cpl + 1]; }
        MP_LOAD_RAW(n_lo);
        for (int tb = 0; tb < pw; ++tb)
#pragma unroll
            for (int j = 0; j < 4; ++j) *(LAS unsigned short*)(lds + L_SC + (16 * tb + 4 * g + j) * PT + 2 * (16 * pw + m)) = (unsigned short)0;
    }
#pragma unroll 1
    for (int i = n_lo - 1; i < n_hi; ++i) {
        const int bc = i & 1, bp = (i + 1) & 1;
        const bool c_on = (i >= n_lo), c_full = (i >= n_full), p_on = (i + 1 < n_hi), p_full = (i + 1 >= n_full);
        if (producer) {
            if (p_on) {
                MP_LANE(); const int cpl = lane % PW, rg = lane / PW;
                LAS unsigned char* const bufp = lds + bp * BUF;
                float cum[2][RR], kk[2][RR], lg[2];
#pragma unroll
                for (int c = 0; c < 2; ++c) { float run = IS_A ? 1.f : 0.f; const float lb = c ? lb1 : lb0;
#pragma unroll
                    for (int j = 0; j < RR; ++j) { const float x = c ? bfhi(f2[j]) : bflo(f2[j]);
                        if (IS_A) { const float sg = __builtin_amdgcn_rcpf(1.0f + __builtin_amdgcn_exp2f(-x * L2E)); run *= lb + (1.0f - lb) * sg; kk[c][j] = (1.0f - lb) * (1.0f - sg); }
                        else { run += (fminf(x, 0.f) * L2E - __builtin_amdgcn_logf(1.0f + __builtin_amdgcn_exp2f(-fabsf(x) * L2E))) * (1.0f / 16.0f); kk[c][j] = c ? bfhi(k2[j]) : bflo(k2[j]); }
                        cum[c][j] = run; }
                    lg[c] = IS_A ? __builtin_amdgcn_logf(run) : run; }
                float eb[2];
#pragma unroll
                for (int c = 0; c < 2; ++c) { float incl = lg[c];
#pragma unroll
                    for (int d = 1; d < RG; d <<= 1) { const float t = __shfl_up(incl, d * PW); if (rg >= d) incl += t; }
                    const float base = incl - lg[c], tot = __shfl(incl, (RG - 1) * PW + cpl), refv = __shfl(base, RGREF * PW + cpl);
                    if (rg == 0) { LAS float* fp = (LAS float*)(lds + L_FAC + bp * FACB) + pw * DKW + 2 * cpl + c;
                        fp[0] = __builtin_amdgcn_exp2f(tot); fp[DK] = __builtin_amdgcn_exp2f(refv); fp[2 * DK] = __builtin_amdgcn_exp2f(tot - refv); }
                    eb[c] = IS_A ? __builtin_amdgcn_exp2f(base - refv) : base - refv; }
#pragma unroll
                for (int j = 0; j < RR; ++j) { const int t = rg * RR + j;
                    const float e10 = IS_A ? eb[0] * cum[0][j] : __builtin_amdgcn_exp2f(eb[0] + cum[0][j]), e11 = IS_A ? eb[1] * cum[1][j] : __builtin_amdgcn_exp2f(eb[1] + cum[1][j]);
                    if (p_full) *(LAS unsigned*)(bufp + B_QH + t * PQ + 2 * (pw * DKW + 2 * cpl)) = cvtpk(bflo(q2[j]) * e10, bfhi(q2[j]) * e11);
                    *(LAS unsigned*)(bufp + B_KH + t * PQ + 2 * (pw * DKW + 2 * cpl)) = cvtpk(kk[0][j] * __builtin_amdgcn_rcpf(e10), kk[1][j] * __builtin_amdgcn_rcpf(e11)); }
#pragma unroll
                for (int i2 = 0; i2 < 4; ++i2) { const int id = pw * 64 + lane + 256 * i2; *(LAS v4u*)(bufp + B_VV + (id >> 4) * PV + 16 * (id & 15)) = vreg[i2]; }
                if (i + 2 < n_hi) MP_LOAD_RAW(i + 2);
            }
        } else if (c_on) {
            MP_LANE(); const int m = lane & 15, g = lane >> 4, q4 = (lane & 15) >> 2, p4 = lane & 3, dv0 = 32 * cw;
            const LAS unsigned char* const bufc = lds + bc * BUF; const LAS unsigned char* const facp = lds + L_FAC + bc * FACB;
            const size_t row0 = (size_t)b * SEQ + (size_t)i * 64;
            if (c_full) { const int ctid = cw * 64 + lane;
#pragma unroll
                for (int i2 = 0; i2 < 4; ++i2) ogreg[i2] = *(const v4u*)(F.P + (row0 + (ctid >> 2)) * NIN + gc + 32 * (ctid & 3) + 8 * i2); }
            bf16x8_t vB[2][2];
#pragma unroll
            for (int ks2 = 0; ks2 < 2; ++ks2)
#pragma unroll
                for (int n2 = 0; n2 < 2; ++n2) { const LAS unsigned char* vp = bufc + B_VV + (32 * ks2 + 8 * g + q4) * PV + 2 * (dv0 + 16 * n2 + 4 * p4);
                    const s16x4_t lo = tr16(vp), hi = tr16(vp + 4 * PV); vB[ks2][n2] = __builtin_shufflevector(lo, hi, 0, 1, 2, 3, 4, 5, 6, 7); }
            if (c_full) {
                f32x4 o[4][2];
#pragma unroll
                for (int mt = 0; mt < 4; ++mt) { o[mt][0] = (f32x4){0.f, 0.f, 0.f, 0.f}; o[mt][1] = (f32x4){0.f, 0.f, 0.f, 0.f};
#pragma unroll
                    for (int ks2 = 0; ks2 < 2; ++ks2) if (2 * ks2 <= mt) { const bf16x8_t a = *(const LAS bf16x8_t*)(lds + L_SC + (16 * mt + m) * PT + 64 * ks2 + 16 * g);
                        o[mt][0] = MFMA16(a, vB[ks2][0], o[mt][0]); o[mt][1] = MFMA16(a, vB[ks2][1], o[mt][1]); } }
#pragma unroll
                for (int sg = 0; sg < NKS; ++sg) {
                    const f32x4 ea = *(const LAS f32x4*)(facp + 4 * (DK + 32 * sg + 4 * g)), eb4 = *(const LAS f32x4*)(facp + 4 * (DK + 32 * sg + 16 + 4 * g));
                    bf16x8_t sB[2];
#pragma unroll
                    for (int n2 = 0; n2 < 2; ++n2) { const f32x4 sa = S[2 * sg][n2] * ea, sb4 = S[2 * sg + 1][n2] * eb4;
                        sB[n2] = __builtin_bit_cast(bf16x8_t, (v4u){cvtpk(sa[0], sa[1]), cvtpk(sa[2], sa[3]), cvtpk(sb4[0], sb4[1]), cvtpk(sb4[2], sb4[3])}); }
#pragma unroll
                    for (int mt = 0; mt < 4; ++mt) { const LAS unsigned char* qp = bufc + B_QH + (16 * mt + m) * PQ + 2 * (32 * sg + 4 * g);
                        const s16x4_t lo = *(const LAS s16x4_t*)qp, hi = *(const LAS s16x4_t*)(qp + 32); const bf16x8_t a = __builtin_shufflevector(lo, hi, 0, 1, 2, 3, 4, 5, 6, 7);
                        o[mt][0] = MFMA16(a, sB[0], o[mt][0]); o[mt][1] = MFMA16(a, sB[1], o[mt][1]); }
                    asm volatile("" ::: "memory"); }
#pragma unroll
                for (int mt = 0; mt < 4; ++mt)
#pragma unroll
                    for (int n2 = 0; n2 < 2; ++n2)
#pragma unroll
                        for (int j = 0; j < 4; ++j) *(LAS float*)(lds + L_OB + (16 * mt + 4 * g + j) * PO + 4 * (dv0 + 16 * n2 + m)) = o[mt][n2][j];
            }
#pragma unroll
            for (int mtile = 0; mtile < NMT; ++mtile) {
                bf16x8_t ka[2];
#pragma unroll
                for (int ks2 = 0; ks2 < 2; ++ks2) { const LAS unsigned char* kp = bufc + B_KH + (32 * ks2 + 8 * g + q4) * PQ + 2 * (16 * mtile + 4 * p4);
                    const s16x4_t lo = tr16(kp), hi = tr16(kp + 4 * PQ); ka[ks2] = __builtin_shufflevector(lo, hi, 0, 1, 2, 3, 4, 5, 6, 7); }
                const f32x4 d4 = *(const LAS f32x4*)(facp + 4 * (16 * mtile + 4 * g)), l4 = *(const LAS f32x4*)(facp + 4 * (2 * DK + 16 * mtile + 4 * g));
#pragma unroll
                for (int n2 = 0; n2 < 2; ++n2) { f32x4 u4 = {0.f, 0.f, 0.f, 0.f}; u4 = MFMA16(ka[0], vB[0][n2], u4); u4 = MFMA16(ka[1], vB[1][n2], u4); S[mtile][n2] = S[mtile][n2] * d4 + u4 * l4; }
                if (mtile & 1) asm volatile("" ::: "memory"); }
        }
        LBAR();
        if (producer) {
            if (p_on && p_full) {
                MP_LANE(); const int m = lane & 15, g = lane >> 4, sb = pw;
                const LAS unsigned char* const bufp = lds + bp * BUF;
                bf16x8_t kf[NKS];
#pragma unroll
                for (int ks = 0; ks < NKS; ++ks) kf[ks] = *(const LAS bf16x8_t*)(bufp + B_KH + (16 * sb + m) * PQ + 64 * ks + 16 * g);
                for (int tb = sb; tb < 4; ++tb) { f32x4 acc = {0.f, 0.f, 0.f, 0.f};
#pragma unroll
                    for (int ks = 0; ks < NKS; ++ks) { const bf16x8_t a = *(const LAS bf16x8_t*)(bufp + B_QH + (16 * tb + m) * PQ + 64 * ks + 16 * g); acc = MFMA16(a, kf[ks], acc); }
#pragma unroll
                    for (int j = 0; j < 4; ++j) { const int t = 16 * tb + 4 * g + j, s = 16 * sb + m; const float val = (s <= t) ? acc[j] : 0.f;
                        *(LAS unsigned short*)(lds + L_SC + t * PT + 2 * s) = (unsigned short)f2bf(val); } }
            }
        } else if (c_on && c_full) {
            MP_LANE(); const int ctid = cw * 64 + lane, nt = ctid >> 2, ndq = ctid & 3;
            const size_t row0 = (size_t)b * SEQ + (size_t)i * 64;
            f32x4 ov[8]; float ss = 0.f;
#pragma unroll
            for (int i2 = 0; i2 < 8; ++i2) { ov[i2] = *(const LAS f32x4*)(lds + L_OB + nt * PO + 128 * ndq + 16 * i2); ss += (ov[i2][0] * ov[i2][0] + ov[i2][1] * ov[i2][1]) + (ov[i2][2] * ov[i2][2] + ov[i2][3] * ov[i2][3]); }
            ss += __shfl_xor(ss, 1); ss += __shfl_xor(ss, 2);
            const float rn = 1.0f / sqrtf(ss * (1.0f / 128.0f) + EPS);
            bf16* op = F.O + (row0 + nt) * D + oc + 32 * ndq;
#pragma unroll
            for (int i4 = 0; i4 < 4; ++i4) { unsigned ow[4];
#pragma unroll
                for (int hh = 0; hh < 2; ++hh) { const int i2 = 2 * i4 + hh; const f32x4 gn4 = *(const f32x4*)(gnp + 32 * ndq + 4 * i2); const unsigned g01 = ogreg[i4][2 * hh], g23 = ogreg[i4][2 * hh + 1];
                    const float ga = bflo(g01), gb = bfhi(g01), gcc = bflo(g23), gd = bfhi(g23);
                    const float r0 = ov[i2][0] * rn * gn4[0] * (ga * __builtin_amdgcn_rcpf(1.0f + __builtin_amdgcn_exp2f(-ga * L2E))), r1 = ov[i2][1] * rn * gn4[1] * (gb * __builtin_amdgcn_rcpf(1.0f + __builtin_amdgcn_exp2f(-gb * L2E)));
                    const float r2 = ov[i2][2] * rn * gn4[2] * (gcc * __builtin_amdgcn_rcpf(1.0f + __builtin_amdgcn_exp2f(-gcc * L2E))), r3 = ov[i2][3] * rn * gn4[3] * (gd * __builtin_amdgcn_rcpf(1.0f + __builtin_amdgcn_exp2f(-gd * L2E)));
                    ow[2 * hh] = cvtpk(r0, r1); ow[2 * hh + 1] = cvtpk(r2, r3); }
                *(v4u*)(op + 8 * i4) = (v4u){ow[0], ow[1], ow[2], ow[3]}; }
        }
        LBAR();
    }
#undef MP_LOAD_RAW
#undef MP_LANE
}
#ifndef MX_N0
#define MX_N0 42
#endif
__device__ __forceinline__ void mixer_phase_pipe(Frame& F, int l) {
#if MX_SPLIT
    for (int it = blockIdx.x; it < 256; it += F.G) { const int s = it & 63, seg = (it >> 6) & 1;
        if (it < 128) mixer_pipe_stream<128, true>(F, l, s >> 2, s & 3, 0, seg ? MX_N0 : 0, seg ? SEQ / 64 : MX_N0);
        else mixer_pipe_stream<64, false>(F, l, s >> 2, s & 3, 0, seg ? MX_N0 : 0, seg ? SEQ / 64 : MX_N0); }
#else
    for (int it = blockIdx.x; it < 128; it += F.G) { const int s = it & 63;
        if (it < 64) mixer_pipe_stream<128, true>(F, l, s >> 2, s & 3, 0, 0, SEQ / 64);
        else mixer_pipe_stream<64, false>(F, l, s >> 2, s & 3, 0, 0, SEQ / 64); }
#endif
}
__device__ __forceinline__ void fix_phase(Frame& F, int l) {
    const int gt = F.vcu * (NWAVES * 64) + F.tid, NGT = F.G * NWAVES * 64;
    const float* cw = F.SMALL + SM_CW + l * 3 * NUP; const float* cb = F.SMALL + SM_CB + l * NUP;
    for (int i = gt; i < 256 * FF; i += NGT) { const int pm = i / FF, f = i % FF; if ((pm & 15) == 0) continue;
        const int ca = 256 * (f >> 7) + (f & 127), cv = ca + 128;
        const float* T = F.RAWT + (size_t)(pm - 1) * 2 * NUP; const float* H = F.RAWH + (size_t)pm * 2 * NUP;
        const float a_m2 = T[ca], a_m1 = T[NUP + ca], a_0 = H[ca], a_1 = H[NUP + ca], v_m2 = T[cv], v_m1 = T[NUP + cv], v_0 = H[cv], v_1 = H[NUP + cv];
        const float wa0 = cw[ca], wa1 = cw[NUP + ca], wa2 = cw[2 * NUP + ca], wv0 = cw[cv], wv1 = cw[NUP + cv], wv2 = cw[2 * NUP + cv], ba = cb[ca], bv = cb[cv];
        const float ca0 = ba + wa0 * a_m2 + wa1 * a_m1 + wa2 * a_0, cv0 = bv + wv0 * v_m2 + wv1 * v_m1 + wv2 * v_0;
        const float ca1 = ba + wa0 * a_m1 + wa1 * a_0 + wa2 * a_1, cv1 = bv + wv0 * v_m1 + wv1 * v_0 + wv2 * v_1;
        bf16* g = F.Gb + (size_t)pm * 256 * FF + f;
        g[0] = (bf16)f2bf(ca0 * sigmoid_f(ca0) * cv0); g[FF] = (bf16)f2bf(ca1 * sigmoid_f(ca1) * cv1); }
}

__device__ __forceinline__ void final_phase(Frame& F) {
    const int gw = F.vcu * NWAVES + F.wave, NGW = F.G * NWAVES;
    for (int row = gw; row < M; row += NGW) {
        GAS f32x4* xr = (GAS f32x4*)(F.out + (size_t)row * D) + F.lane;
        float ss = (F.lane < 16) ? F.STAT[(size_t)row * 16 + F.lane] : 0.f; ss = wave_sum(ss);
        const float r = 1.0f / sqrtf(ss * (1.0f / (float)D) + EPS);
#pragma unroll
        for (int j = 0; j < 4; ++j) { const f32x4 v = xr[64 * j]; const f32x4 g = *(const f32x4*)(F.lnf_g + 256 * j + 4 * F.lane); xr[64 * j] = v * r * g; }
    }
}

#ifndef STAGGER_US
#define STAGGER_US 0
#endif
__device__ __forceinline__ void stagger(int idx) {
    if (STAGGER_US > 0) { const unsigned long long t0 = __builtin_amdgcn_s_memrealtime(), dt = (unsigned long long)(idx & 15) * (100ull * STAGGER_US);
        while (__builtin_amdgcn_s_memrealtime() - t0 < dt) __builtin_amdgcn_s_sleep(8); }
}
struct Args { const float* in[18]; float* out; unsigned char* ws; int ph_lo, ph_hi; };
__global__ void __launch_bounds__(NWAVES * 64, 2) fwd(Args args) {
    extern __shared__ __attribute__((aligned(16))) unsigned char lds[];
    Frame F;
    F.lds = (LAS unsigned char*)lds; F.MISC = (volatile LAS unsigned*)(F.lds + MISC_OFF);
    F.tid = threadIdx.x; F.lane = F.tid & 63; F.wave = __builtin_amdgcn_readfirstlane(F.tid >> 6);
    F.G = gridDim.x; { const int bx = blockIdx.x; F.vcu = (F.G % 8 == 0) ? (bx % 8) * (F.G / 8) + bx / 8 : bx; }
    unsigned char* ws = args.ws;
    F.ctl = (unsigned*)(ws + WS_CTL);
    F.x = args.in[0]; F.c = args.in[1]; F.ln1_g = args.in[2]; F.ln2_g = args.in[3]; F.w_ada = args.in[4]; F.b_ada = args.in[5]; F.w_in = args.in[6]; F.lb_params = args.in[7];
    F.w_gk = args.in[8]; F.b_gk = args.in[9]; F.gn_a = args.in[10]; F.gn_b = args.in[11]; F.w_out = args.in[12]; F.w_up = args.in[13]; F.conv_w = args.in[14]; F.conv_b = args.in[15];
    F.w_down = args.in[16]; F.lnf_g = args.in[17]; F.out = args.out;
    F.MOD = (float*)(ws + WS_MOD); F.SMALL = (float*)(ws + WS_SMALL); F.STAT = (float*)(ws + WS_STAT); F.RAWH = (float*)(ws + WS_RAWH); F.RAWT = (float*)(ws + WS_RAWT);
    F.WIN = (bf16*)(ws + WS_WIN); F.WOUT = (bf16*)(ws + WS_WOUT); F.WUP = (bf16*)(ws + WS_WUP); F.WDN = (bf16*)(ws + WS_WDN);
    F.XN = (bf16*)(ws + WS_XN); F.O = (bf16*)(ws + WS_O); F.P = (bf16*)(ws + WS_P); F.Gb = (bf16*)(ws + WS_P);
#ifdef PROBE_ZERO_ALL
    for (int u = F.tid; u < LDSCTL_OFF / 4; u += NWAVES * 64) ((LAS unsigned*)(F.lds))[u] = 0u;
#endif
    for (int u = F.tid; u < (LDS_BYTES - LDSCTL_OFF) / 4; u += NWAVES * 64) ((LAS unsigned*)(F.lds + LDSCTL_OFF))[u] = 0u;
    __syncthreads();
    const int lo = args.ph_lo, hi = args.ph_hi;
    XcdBarrier bar; bar.bar = F.ctl + CW_BAR; bar.x = 0; bar.st = nullptr;
    if (hi - lo > 1) bar = xcd_barrier_post(F.ctl + CW_BAR, F.MISC + 8);
#define IN(k) (lo <= (k) && (k) < hi)
#ifndef PH_MASK
#define PH_MASK 0x1ff
#endif
#define PHM(b) ((PH_MASK >> (b)) & 1)
#define SEAM(k) do { if (IN(k) && IN((k) + 1)) { int l0_; asm volatile("v_mbcnt_lo_u32_b32 %0, -1, 0\n\tv_mbcnt_hi_u32_b32 %0, -1, %0" : "=v"(l0_)); xcd_barrier(bar, F.wave == 0 && l0_ == 0); } } while (0)
    if (PHM(0) && IN(0)) p0a(F);
    SEAM(0);
    if (PHM(1) && IN(1)) p0b(F);
    SEAM(1);
#ifdef PROBE_PRO2
    p0a(F); SEAM(0); p0b(F); SEAM(1);
#endif
    for (int l = 0; l < DEPTH; ++l) {
        const int pb = 2 + 6 * l;
#define LAUNDER_TID() do { int l_; asm volatile("v_mbcnt_lo_u32_b32 %0, -1, 0\n\tv_mbcnt_hi_u32_b32 %0, -1, %0" : "=v"(l_)); F.lane = l_; F.tid = F.wave * 64 + l_; } while (0)
        if (PHM(2) && IN(pb)) {
            LAUNDER_TID(); stagger((int)blockIdx.x);
#ifdef PROBE_KDUP
            typedef pg8::DupOrder InOrder;
#else
            typedef pg8::StaticOrder InOrder;
#endif
            pg8::Gemm g{F.XN, F.WIN + (size_t)l * NIN * 1024, M, NIN, D}; InOrder S; S.init(M, NIN, F.G, (int)blockIdx.x);
            pg8::EpiIn E{F.P, F.SMALL + SM_B1 + l * 16 * NIN, F.STAT};
            pg8::gemm_phase<pg8::EpiIn, InOrder, true, true>(F.lds, g, S, E, F.tid);
#ifdef PROBE_KLOOP
            { __syncthreads(); LAUNDER_TID(); pg8::EpiNull EN; pg8::gemm_phase<pg8::EpiNull, pg8::StaticOrder, true, true>(F.lds, g, S, EN, F.tid); }
#endif
#ifdef PROBE_IN2
            __syncthreads(); LAUNDER_TID(); pg8::gemm_phase<pg8::EpiIn, InOrder, true, true>(F.lds, g, S, E, F.tid);
#endif
        }
        SEAM(pb);
        if (PHM(3) && IN(pb + 1)) { LAUNDER_TID(); MIXER_PHASE(F, l);
#ifdef PROBE_MIX2
            __syncthreads(); LAUNDER_TID(); MIXER_PHASE(F, l);
#endif
        }
        SEAM(pb + 1);
        if (PHM(4) && IN(pb + 2)) {
            LAUNDER_TID(); stagger((int)blockIdx.x);
            pg8::Gemm g{F.O, F.WOUT + (size_t)l * 1024 * 1024, M, D, D}; pg8::StaticOrder S; S.init(M, D, F.G, (int)blockIdx.x);
            pg8::EpiXUpd E{l == 0 ? F.x : F.out, F.out, F.XN, F.SMALL + SM_GT1 + l * 16 * D, F.SMALL + SM_GS2 + l * 16 * D, F.STAT};
            pg8::gemm_phase<pg8::EpiXUpd, pg8::StaticOrder, true, true>(F.lds, g, S, E, F.tid);
        }
        SEAM(pb + 2);
        if (PHM(5) && IN(pb + 3)) {
            LAUNDER_TID(); stagger((int)blockIdx.x);
            pg8::Gemm g{F.XN, F.WUP + (size_t)l * NUP * 1024, M, NUP, D}; pg8::StaticOrder S; S.init(M, NUP, F.G, (int)blockIdx.x);
            pg8::EpiUp E{F.Gb, F.SMALL + SM_B2 + l * 16 * NUP, F.STAT, F.SMALL + SM_CW + l * 3 * NUP, F.SMALL + SM_CB + l * NUP, F.RAWH, F.RAWT, (LAS float*)(F.lds + HALO_OFF)};
            pg8::gemm_phase<pg8::EpiUp, pg8::StaticOrder, true, true>(F.lds, g, S, E, F.tid);
#ifdef PROBE_UP2
            __syncthreads(); LAUNDER_TID(); pg8::gemm_phase<pg8::EpiUp, pg8::StaticOrder, true, true>(F.lds, g, S, E, F.tid);
#endif
        }
        SEAM(pb + 3);
        if (PHM(6) && IN(pb + 4)) { LAUNDER_TID(); fix_phase(F, l); }
        SEAM(pb + 4);
        if (PHM(7) && IN(pb + 5)) {
            LAUNDER_TID(); stagger((int)blockIdx.x);
            pg8::Gemm g{F.Gb, F.WDN + (size_t)l * 1024 * FF, M, D, FF}; pg8::StaticOrder S; S.init(M, D, F.G, (int)blockIdx.x);
            pg8::EpiXUpd E{F.out, F.out, l + 1 < DEPTH ? F.XN : (bf16*)nullptr, F.SMALL + SM_GT2 + l * 16 * D, F.SMALL + SM_GS1 + (l + 1 < DEPTH ? l + 1 : l) * 16 * D, F.STAT};
            pg8::gemm_phase<pg8::EpiXUpd, pg8::StaticOrder, true, true>(F.lds, g, S, E, F.tid);
        }
        SEAM(pb + 5);
    }
    if (PHM(8) && IN(N_PHASES - 1)) { LAUNDER_TID(); final_phase(F); }
#undef IN
#undef SEAM
}

extern "C" void kernel_launch(void* const* d_in, const int* in_sizes, int n_in, void* d_out, int out_size, void* d_ws, size_t ws_size, hipStream_t stream) {
    static int grid = 0;
    if (grid == 0) {
        if (n_in != 18 || in_sizes[0] != M * D || out_size != M * D || ws_size < WS_END) { fprintf(stderr, "kernel_launch: unexpected shapes / workspace (n_in %d, in0 %d, out %d, ws %zu < %zu); nothing launched\n", n_in, n_in > 0 ? in_sizes[0] : -1, out_size, ws_size, (size_t)WS_END); grid = -1; return; }
        int dev = 0, cus = 0, per_cu = 0;
        if (hipGetDevice(&dev) != hipSuccess || hipDeviceGetAttribute(&cus, hipDeviceAttributeMultiprocessorCount, dev) != hipSuccess) { grid = -1; return; }
        if (hipFuncSetAttribute((const void*)fwd, hipFuncAttributeMaxDynamicSharedMemorySize, LDS_BYTES) != hipSuccess) { fprintf(stderr, "kernel_launch: hipFuncSetAttribute failed\n"); grid = -1; return; }
        if (hipOccupancyMaxActiveBlocksPerMultiprocessor(&per_cu, (const void*)fwd, NWAVES * 64, LDS_BYTES) != hipSuccess || per_cu < 1) { fprintf(stderr, "kernel_launch: occupancy query says %d\n", per_cu); }
        (void)hipGetLastError();
        grid = cus;
    }
    if (grid < 0) return;
#ifdef PROBE_ZERO_ALL
    if (hipMemsetAsync((char*)d_ws, 0, WS_END, stream) != hipSuccess) return;
#endif
    if (hipMemsetAsync((char*)d_ws + WS_CTL, 0, CTL_ZERO_BYTES, stream) != hipSuccess) return;
    Args a{};
    for (int i = 0; i < 18; ++i) a.in[i] = (const float*)d_in[i];
    a.out = (float*)d_out; a.ws = (unsigned char*)d_ws;
#if MK_PER_PHASE
    for (int p = 0; p < N_PHASES; ++p) { a.ph_lo = p; a.ph_hi = p + 1; hipLaunchKernelGGL(fwd, dim3(grid), dim3(NWAVES * 64), LDS_BYTES, stream, a); }
#else
    a.ph_lo = 0; a.ph_hi = N_PHASES; hipLaunchKernelGGL(fwd, dim3(grid), dim3(NWAVES * 64), LDS_BYTES, stream, a);
#endif
}
```

```cpp
#include <hip/hip_runtime.h>
#include <cstdio>
#include <cstdint>
namespace pg8 {
#define PG8_LAS __attribute__((address_space(3)))
typedef unsigned short bf16_t;
typedef short bf16x8 __attribute__((ext_vector_type(8)));
typedef float f32x4 __attribute__((ext_vector_type(4)));
typedef unsigned u32x4 __attribute__((ext_vector_type(4)));
constexpr int BM = 256, BK = 64, HALF = 128, HTB = HALF * BK * 2  , STAGE_BYTES = 8 * HTB, NXCD = 8, WGM = 8;

__host__ __device__ __forceinline__ int lds_byte(int r, int c) { const int st = (r >> 4) * 2 + (c >> 5), rr = r & 15, cc = c & 31, ob = rr * 64 + cc * 2; return st * 1024 + (ob ^ (((ob >> 9) & 1) << 5)); }
__host__ __device__ __forceinline__ void stage_rc(int b, int& R, int& C) { const int st = b / 1024, sb = b % 1024, swz = sb ^ (((sb >> 9) & 1) << 5); R = (st >> 1) * 16 + swz / 64; C = (st & 1) * 32 + (swz % 64) / 2; }
__host__ __device__ __forceinline__ int perm32(int rho) { const int n = rho >> 4, i = rho & 15; return 8 * (i >> 2) + 4 * n + (i & 3); }

struct Unit { int pm, pn; };
struct Gemm { const bf16_t* A; const bf16_t* Bt; int M, N, K; };

struct StaticOrder {
    static constexpr bool DUP = false;
    int nM, nN, nwg, G, c;
    __host__ __device__ void init(int M, int N, int G_, int c_) { nM = M / BM; nN = N / BM; nwg = nM * nN; G = G_; c = c_; }
    __host__ __device__ bool next(int i, Unit& u) const {
        const long L = (long)i * G + c; if (L >= nwg) return false;
        int wgid = (int)L; { const int q = nwg / NXCD, r = nwg % NXCD, xcd = wgid % NXCD, off = wgid / NXCD; wgid = (xcd < r ? xcd * (q + 1) : r * (q + 1) + (xcd - r) * q) + off; }
        const int nig = WGM * nN, gid = wgid / nig, fm = gid * WGM, gsz = (nM - fm) < WGM ? (nM - fm) : WGM;
        u.pm = fm + ((wgid % nig) % gsz); u.pn = (wgid % nig) / gsz; return true;
    }
    __device__ __forceinline__ void a_ready(const Unit&) const {}
    __device__ __forceinline__ void done(const Unit&) const {}
};

struct DupOrder : StaticOrder {
    static constexpr bool DUP = true;
    __host__ __device__ bool next(int i, Unit& u) const { return StaticOrder::next(i >> 1, u); }
};

__device__ __forceinline__ unsigned cvt_pk_bf16(float lo, float hi) { unsigned r; asm volatile("v_cvt_pk_bf16_f32 %0, %1, %2" : "=v"(r) : "v"(lo), "v"(hi)); return r; }
typedef unsigned u32x2 __attribute__((ext_vector_type(2)));
constexpr int EPI_LDS_OFF = 143360;
__device__ __forceinline__ void dma16(const void* gsrc_lane, PG8_LAS unsigned char* dst_wave) { __builtin_amdgcn_global_load_lds((const unsigned*)gsrc_lane, (PG8_LAS unsigned*)dst_wave, 16, 0, 0); }
constexpr int ROWS_PER_SEQ_TILES = 16;
constexpr float RMS_EPS = 1e-6f;
constexpr int D_MODEL = 1024, N_IN = 3840, N_UP = 5632, N_FF = 2816;

__device__ __forceinline__ float row_rscale(const float* stat, int row, int fq) {
    const f32x4 sp = *(const f32x4*)(stat + (size_t)row * 16 + 4 * fq);
    float s = (sp[0] + sp[1]) + (sp[2] + sp[3]);
    s += __shfl_xor(s, 16); s += __shfl_xor(s, 32);
    return __builtin_amdgcn_rsqf(s * (1.0f / (float)D_MODEL) + RMS_EPS);
}

struct EpiNull {
    static constexpr bool PERM = true, AFTER_DRAIN = false, IDEMPOTENT = false; static constexpr int NPF = 0;
    __device__ __forceinline__ void prefetch(PG8_LAS unsigned char*, const Unit&, int, int) const {}
    __device__ __forceinline__ void operator()(f32x4 (&acc)[2][2][4][2], PG8_LAS unsigned char*, const Unit&, int, int, int, int) const {
#pragma unroll
        for (int a = 0; a < 2; ++a)
#pragma unroll
            for (int b = 0; b < 2; ++b)
#pragma unroll
                for (int m = 0; m < 4; ++m) asm volatile("" :: "v"(acc[a][b][m][0]), "v"(acc[a][b][m][1]));
    }
};

struct EpiIn {
    static constexpr bool PERM = true, AFTER_DRAIN = false, IDEMPOTENT = true; static constexpr int NPF = 3;
    bf16_t* P; const float* bias; const float* stat;
    __device__ __forceinline__ void prefetch(PG8_LAS unsigned char* epi, const Unit& u, int wid, int lane) const {
        const char* sp = (const char*)(stat + (size_t)(u.pm * BM + 32 * wid) * 16) + 16 * lane;
        dma16(sp, epi + 2048 * wid); dma16(sp + 1024, epi + 2048 * wid + 1024);
        dma16((const char*)(bias + (size_t)(u.pm / ROWS_PER_SEQ_TILES) * N_IN + u.pn * BM) + 16 * lane, epi + 16384);
    }
    __device__ __forceinline__ void operator()(f32x4 (&acc)[2][2][4][2], PG8_LAS unsigned char* epi, const Unit& u, int wr, int wc, int fr, int fq) const {
        const int row0 = u.pm * BM + wr * 64 + fr, col0 = u.pn * BM + wc * 32 + 8 * fq;
        struct { f32x4 sp[2][4], bv[2][2]; } pf;
#pragma unroll
        for (int ai = 0; ai < 2; ++ai)
#pragma unroll
            for (int m = 0; m < 4; ++m) pf.sp[ai][m] = *(const PG8_LAS f32x4*)(epi + ((ai * HALF + wr * 64 + m * 16 + fr) * 16 + 4 * fq) * 4);
#pragma unroll
        for (int bj = 0; bj < 2; ++bj)
#pragma unroll
            for (int n = 0; n < 2; ++n) pf.bv[bj][n] = *(const PG8_LAS f32x4*)(epi + 16384 + (wc * 32 + 8 * fq + bj * HALF + 4 * n) * 4);
#pragma unroll
        for (int ai = 0; ai < 2; ++ai)
#pragma unroll
            for (int m = 0; m < 4; ++m) { const int row = row0 + ai * HALF + m * 16;
                float s = (pf.sp[ai][m][0] + pf.sp[ai][m][1]) + (pf.sp[ai][m][2] + pf.sp[ai][m][3]); s += __shfl_xor(s, 16); s += __shfl_xor(s, 32);
                const float r = __builtin_amdgcn_rsqf(s * (1.0f / (float)D_MODEL) + RMS_EPS);
                bf16_t* rowp = P + (size_t)row * N_IN + col0;
#pragma unroll
                for (int bj = 0; bj < 2; ++bj) { const f32x4 v0 = acc[ai][bj][m][0] * r + pf.bv[bj][0], v1 = acc[ai][bj][m][1] * r + pf.bv[bj][1];
                    u32x4 w; w.x = cvt_pk_bf16(v0[0], v0[1]); w.y = cvt_pk_bf16(v0[2], v0[3]); w.z = cvt_pk_bf16(v1[0], v1[1]); w.w = cvt_pk_bf16(v1[2], v1[3]);
                    *(u32x4*)(rowp + bj * HALF) = w; } }
    }
};

struct EpiXUpd {
    static constexpr bool PERM = true, AFTER_DRAIN = false, IDEMPOTENT = false; static constexpr int NPF = 2;
    const float* xold; float* xnew; bf16_t* XN; const float* gt; const float* gsn; float* stat;
    __device__ __forceinline__ void prefetch(PG8_LAS unsigned char* epi, const Unit& u, int wid, int lane) const {
        const size_t o = (size_t)(u.pm / ROWS_PER_SEQ_TILES) * D_MODEL + u.pn * BM;
        dma16((const char*)(gt + o) + 16 * lane, epi); dma16((const char*)(gsn + o) + 16 * lane, epi + 1024);
    }
    __device__ __forceinline__ void operator()(f32x4 (&acc)[2][2][4][2], PG8_LAS unsigned char* epi, const Unit& u, int wr, int wc, int fr, int fq) const {
        const int row0 = u.pm * BM + wr * 64 + fr, col0 = u.pn * BM + wc * 32 + 8 * fq;
        f32x4 g[2][2], s[2][2];
#pragma unroll
        for (int bj = 0; bj < 2; ++bj)
#pragma unroll
            for (int n = 0; n < 2; ++n) { g[bj][n] = *(const PG8_LAS f32x4*)(epi + (wc * 32 + 8 * fq + bj * HALF + 4 * n) * 4); s[bj][n] = *(const PG8_LAS f32x4*)(epi + 1024 + (wc * 32 + 8 * fq + bj * HALF + 4 * n) * 4); }
#pragma unroll
        for (int ai = 0; ai < 2; ++ai)
#pragma unroll
            for (int m = 0; m < 4; ++m) { const int row = row0 + ai * HALF + m * 16; const size_t off = (size_t)row * D_MODEL + col0; float ss = 0.f;
#pragma unroll
                for (int bj = 0; bj < 2; ++bj) {
                    const f32x4 x0 = *(const f32x4*)(xold + off + bj * HALF) + g[bj][0] * acc[ai][bj][m][0], x1 = *(const f32x4*)(xold + off + bj * HALF + 4) + g[bj][1] * acc[ai][bj][m][1];
                    *(f32x4*)(xnew + off + bj * HALF) = x0; *(f32x4*)(xnew + off + bj * HALF + 4) = x1;
                    ss += (x0[0] * x0[0] + x0[1] * x0[1]) + (x0[2] * x0[2] + x0[3] * x0[3]) + (x1[0] * x1[0] + x1[1] * x1[1]) + (x1[2] * x1[2] + x1[3] * x1[3]);
                    if (XN) { const f32x4 y0 = x0 * s[bj][0], y1 = x1 * s[bj][1];
                        u32x4 w; w.x = cvt_pk_bf16(y0[0], y0[1]); w.y = cvt_pk_bf16(y0[2], y0[3]); w.z = cvt_pk_bf16(y1[0], y1[1]); w.w = cvt_pk_bf16(y1[2], y1[3]);
                        *(u32x4*)(XN + off + bj * HALF) = w; } }
                ss += __shfl_xor(ss, 16); ss += __shfl_xor(ss, 32);
                if (fq == 0) stat[(size_t)row * 16 + u.pn * 4 + wc] = ss; }
    }
};

__device__ __forceinline__ float dpp_ror1(float v) { return __builtin_bit_cast(float, __builtin_amdgcn_mov_dpp(__builtin_bit_cast(int, v), 0x121, 0xf, 0xf, true)); }
__device__ __forceinline__ float dpp_ror2(float v) { return __builtin_bit_cast(float, __builtin_amdgcn_mov_dpp(__builtin_bit_cast(int, v), 0x122, 0xf, 0xf, true)); }
__device__ __forceinline__ float dpp_shr1z(float v) { return __builtin_bit_cast(float, __builtin_amdgcn_update_dpp(0, __builtin_bit_cast(int, v), 0x111, 0xf, 0xf, true)); }
__device__ __forceinline__ float dpp_shr2z(float v) { return __builtin_bit_cast(float, __builtin_amdgcn_update_dpp(0, __builtin_bit_cast(int, v), 0x112, 0xf, 0xf, true)); }
__device__ __forceinline__ float silu_f(float x) { return x * __builtin_amdgcn_rcpf(1.0f + __builtin_amdgcn_exp2f(-1.4426950408889634f * x)); }
struct EpiUp {
    static constexpr bool PERM = true, AFTER_DRAIN = false, IDEMPOTENT = false; static constexpr int NPF = 0;
    bf16_t* G; const float* bias; const float* stat; const float* cw; const float* cb; float* rawh; float* rawt; PG8_LAS float* halo;
    __device__ __forceinline__ void prefetch(PG8_LAS unsigned char*, const Unit&, int, int) const {}
    __device__ __forceinline__ void operator()(f32x4 (&acc)[2][2][4][2], PG8_LAS unsigned char*, const Unit& u, int wr, int wc, int fr, int fq) const {
        const int row0 = u.pm * BM + wr * 64 + fr, b = u.pm / ROWS_PER_SEQ_TILES, tc0 = wc * 32 + 8 * fq, col0 = u.pn * BM + tc0;
        PG8_LAS float* vecs = halo + 2048;
        const int tid = (wr * 4 + wc) * 64 + fq * 16 + fr;
        f32x4 vecv = {0.f, 0.f, 0.f, 0.f};
        if (tid < 256) { const int which = tid >> 6, ch = tid & 63; vecv = *(const f32x4*)((which < 3 ? cw + which * N_UP : cb) + u.pn * BM + 4 * ch); }
        f32x4 sp[2][4], bv[2][2];
#pragma unroll
        for (int ai = 0; ai < 2; ++ai)
#pragma unroll
            for (int m = 0; m < 4; ++m) sp[ai][m] = *(const f32x4*)(stat + (size_t)(row0 + ai * HALF + m * 16) * 16 + 4 * fq);
#pragma unroll
        for (int bj = 0; bj < 2; ++bj)
#pragma unroll
            for (int n = 0; n < 2; ++n) bv[bj][n] = *(const f32x4*)(bias + (size_t)b * N_UP + col0 + bj * HALF + 4 * n);
#pragma unroll
        for (int ai = 0; ai < 2; ++ai)
#pragma unroll
            for (int m = 0; m < 4; ++m) { float s = (sp[ai][m][0] + sp[ai][m][1]) + (sp[ai][m][2] + sp[ai][m][3]); s += __shfl_xor(s, 16); s += __shfl_xor(s, 32);
                const float r = __builtin_amdgcn_rsqf(s * (1.0f / (float)D_MODEL) + RMS_EPS);
#pragma unroll
                for (int bj = 0; bj < 2; ++bj)
#pragma unroll
                    for (int n = 0; n < 2; ++n) acc[ai][bj][m][n] = acc[ai][bj][m][n] * r + bv[bj][n];
                asm volatile("" : "+v"(acc[ai][0][m][0]), "+v"(acc[ai][0][m][1]), "+v"(acc[ai][1][m][0]), "+v"(acc[ai][1][m][1])); }
        if (tid < 256) *(PG8_LAS f32x4*)(vecs + 4 * tid) = vecv;
#pragma unroll
        for (int ai = 0; ai < 2; ++ai) {
            if (fr >= 14) {
                PG8_LAS float* hp = halo + ((ai * 2 + wr) * 2 + (fr - 14)) * 256 + tc0;
#pragma unroll
                for (int bj = 0; bj < 2; ++bj)
#pragma unroll
                    for (int n = 0; n < 2; ++n) *(PG8_LAS f32x4*)(hp + bj * HALF + 4 * n) = acc[ai][bj][3][n];
            }
        }
        if (wr == 0 && fr < 2) { float* hp = rawh + ((size_t)u.pm * 2 + fr) * N_UP + col0;
#pragma unroll
            for (int bj = 0; bj < 2; ++bj)
#pragma unroll
                for (int n = 0; n < 2; ++n) *(f32x4*)(hp + bj * HALF + 4 * n) = acc[0][bj][0][n]; }
        if (wr == 1 && fr >= 14) { float* tp = rawt + ((size_t)u.pm * 2 + (fr - 14)) * N_UP + col0;
#pragma unroll
            for (int bj = 0; bj < 2; ++bj)
#pragma unroll
                for (int n = 0; n < 2; ++n) *(f32x4*)(tp + bj * HALF + 4 * n) = acc[1][bj][3][n]; }
        asm volatile("s_waitcnt lgkmcnt(0)" ::: "memory"); __builtin_amdgcn_s_barrier(); asm volatile("" ::: "memory");
        const bool f15 = (fr == 15), f14 = (fr >= 14);
        unsigned gp[2][4][2];
#pragma unroll
        for (int n = 0; n < 2; ++n) {
            f32x4 w0[2], w1[2], w2[2], cbv[2];
#pragma unroll
            for (int bj = 0; bj < 2; ++bj) { const int c = tc0 + bj * HALF + 4 * n;
                w0[bj] = *(const PG8_LAS f32x4*)(vecs + c); w1[bj] = *(const PG8_LAS f32x4*)(vecs + 256 + c); w2[bj] = *(const PG8_LAS f32x4*)(vecs + 512 + c); cbv[bj] = *(const PG8_LAS f32x4*)(vecs + 768 + c); }
#pragma unroll
            for (int ai = 0; ai < 2; ++ai) {
                f32x4 prev[2];
                {   const int pai = (wr == 1) ? ai : ai - 1, pwr = (wr == 1) ? 0 : 1;
                    const bool has = (pai >= 0);
                    const PG8_LAS float* hp = halo + ((pai * 2 + pwr) * 2 + (fr & 1)) * 256 + tc0 + 4 * n;
#pragma unroll
                    for (int bj = 0; bj < 2; ++bj) prev[bj] = (has && fr >= 14) ? *(const PG8_LAS f32x4*)(hp + bj * HALF) : (f32x4){0.f, 0.f, 0.f, 0.f}; }
#pragma unroll
                for (int m = 0; m < 4; ++m) {
                    f32x4 cu[2];
#pragma unroll
                    for (int bj = 0; bj < 2; ++bj) { const f32x4 cur = acc[ai][bj][m][n], pv = prev[bj]; f32x4 o;
#pragma unroll
                        for (int j = 0; j < 4; ++j) { const float s1 = dpp_ror1(f15 ? pv[j] : cur[j]), s2 = dpp_ror2(f14 ? pv[j] : cur[j]);
                            o[j] = cbv[bj][j] + w0[bj][j] * s2 + w1[bj][j] * s1 + w2[bj][j] * cur[j]; }
                        cu[bj] = o; prev[bj] = cur; }
                    f32x4 g;
#pragma unroll
                    for (int j = 0; j < 4; ++j) g[j] = silu_f(cu[0][j]) * cu[1][j];
                    const unsigned p0 = cvt_pk_bf16(g[0], g[1]), p1 = cvt_pk_bf16(g[2], g[3]);
                    if (n == 0) { gp[ai][m][0] = p0; gp[ai][m][1] = p1; }
                    else { u32x4 w; w.x = gp[ai][m][0]; w.y = gp[ai][m][1]; w.z = p0; w.w = p1;
                        *(u32x4*)(G + (size_t)(row0 + ai * HALF + m * 16) * N_FF + u.pn * HALF + tc0) = w; }
                }
            }
        }
    }
};
template <class Epi, class Sched, bool ALIGN_EPI = false, bool SP2 = false>
__device__ __forceinline__ void gemm_phase(PG8_LAS unsigned char* lds, const Gemm g, const Sched& S, const Epi& E, const int tid) {
    const int wid = __builtin_amdgcn_readfirstlane(tid >> 6), lane = tid & 63, wr = wid >> 2, wc = wid & 3, fr = lane & 15, fq = lane >> 4;
    const int K = g.K, nt = K / BK;
    unsigned voffA[2], voffB[2];
#pragma unroll
    for (int i = 0; i < 2; ++i) { int R, C; stage_rc(tid * 16 + i * 8192, R, C); const int Rb = Epi::PERM ? ((R & ~31) + perm32(R & 31)) : R;
        voffA[i] = (unsigned)(R * K + C) * 2u; voffB[i] = (unsigned)(Rb * K + C) * 2u; }
    const size_t kstep = (size_t)(BK * 2);
    const size_t hstep = (size_t)HALF * K * 2;
    const size_t tstep = 2 * hstep;
    const unsigned ldsw = (unsigned)wid * 1024u;
    const int aoff = lds_byte(wr * 64 + fr, fq * 8), boff = lds_byte(wc * 32 + fr, fq * 8);
#define PG8_SA(b, h) (((b) * 2 + (h)) * HTB)
#define PG8_SB(b, h) ((4 + (b) * 2 + (h)) * HTB)
#define PG8_STAGE(bufoff, gbase, voff) do { _Pragma("unroll") for (int _i = 0; _i < 2; ++_i) \
        __builtin_amdgcn_global_load_lds((const unsigned*)((const char*)(gbase) + (voff)[_i]), (PG8_LAS unsigned*)(lds + (bufoff) + ldsw + _i * 8192), 16, 0, 0); } while (0)
#define PG8_LDA(dst, b, h) do { _Pragma("unroll") for (int m = 0; m < 4; ++m) _Pragma("unroll") for (int k = 0; k < 2; ++k) dst[m][k] = *(const PG8_LAS bf16x8*)(lds + PG8_SA(b, h) + aoff + m * 2048 + k * 1024); } while (0)
#define PG8_LDB(dst, b, h) do { _Pragma("unroll") for (int n = 0; n < 2; ++n) _Pragma("unroll") for (int k = 0; k < 2; ++k) dst[n][k] = *(const PG8_LAS bf16x8*)(lds + PG8_SB(b, h) + boff + n * 2048 + k * 1024); } while (0)
#define PG8_MMA(ai, bj, At, Bt) do { __builtin_amdgcn_s_setprio(1); _Pragma("unroll") for (int m = 0; m < 4; ++m) _Pragma("unroll") for (int n = 0; n < 2; ++n) _Pragma("unroll") for (int k = 0; k < 2; ++k) \
        acc[ai][bj][m][n] = __builtin_amdgcn_mfma_f32_16x16x32_bf16(Bt[n][k], At[m][k], acc[ai][bj][m][n], 0, 0, 0); __builtin_amdgcn_s_setprio(0); } while (0)
#define PG8_WAIT_V(n) asm volatile("s_waitcnt vmcnt(" #n ")" ::: "memory")
#define PG8_WAIT_L(n) asm volatile("s_waitcnt lgkmcnt(" #n ")" ::: "memory")
#define PG8_BAR __builtin_amdgcn_s_barrier()
#define PG8_SCHED __builtin_amdgcn_sched_barrier(0)
    Unit cur, nxt; int ui = 0;
    if (!S.next(0, cur)) return;
    f32x4 acc[2][2][4][2];
#pragma unroll
    for (int a = 0; a < 2; ++a)
#pragma unroll
        for (int b = 0; b < 2; ++b)
#pragma unroll
            for (int m = 0; m < 4; ++m)
#pragma unroll
                for (int n = 0; n < 2; ++n) acc[a][b][m][n] = (f32x4){0.f, 0.f, 0.f, 0.f};
    bf16x8 At[4][2], B0[2][2], B1[2][2];
    const char* cA = (const char*)g.A + (size_t)cur.pm * tstep; const char* cB = (const char*)g.Bt + (size_t)cur.pn * tstep;
    S.a_ready(cur);
    if constexpr (SP2) {
        PG8_STAGE(PG8_SB(0, 0), cB, voffB); PG8_STAGE(PG8_SB(0, 1), cB + hstep, voffB); PG8_STAGE(PG8_SA(0, 0), cA, voffA); PG8_STAGE(PG8_SA(0, 1), cA + hstep, voffA);
        if (wr == 1) PG8_BAR;
        PG8_WAIT_V(2); PG8_BAR;
        PG8_STAGE(PG8_SB(1, 0), cB + kstep, voffB); PG8_STAGE(PG8_SA(1, 0), cA + kstep, voffA); PG8_STAGE(PG8_SB(1, 1), cB + hstep + kstep, voffB);
        PG8_WAIT_V(6); PG8_BAR;
    } else {
        PG8_STAGE(PG8_SB(0, 0), cB, voffB); PG8_STAGE(PG8_SA(0, 0), cA, voffA); PG8_STAGE(PG8_SB(0, 1), cB + hstep, voffB); PG8_STAGE(PG8_SA(0, 1), cA + hstep, voffA);
        if (wr == 1) PG8_BAR;
        PG8_WAIT_V(4); PG8_BAR;
        PG8_STAGE(PG8_SB(1, 0), cB + kstep, voffB); PG8_STAGE(PG8_SA(1, 0), cA + kstep, voffA); PG8_STAGE(PG8_SB(1, 1), cB + hstep + kstep, voffB);
        PG8_WAIT_V(6); PG8_BAR;
    }
    for (;;) {
        const bool has_next = S.next(ui + 1, nxt);
        const char* nA = has_next ? (const char*)g.A + (size_t)nxt.pm * tstep : cA; const char* nB = has_next ? (const char*)g.Bt + (size_t)nxt.pn * tstep : cB;
#define PG8_WAIT_VN(n) asm volatile("s_waitcnt vmcnt(%0)" :: "n"(n) : "memory")
#define PG8_TRIP(a1, a2, b2, a3, b3, PF) do { \
              \
            PG8_LDB(B0, 0, 0); PG8_LDB(B1, 0, 1); PG8_SCHED; PG8_LDA(At, 0, 0); PG8_STAGE(PG8_SA(1, 1), (a1) + hstep, voffA); \
            PG8_WAIT_V(8); PG8_WAIT_L(0); PG8_BAR; PG8_MMA(0, 0, At, B0); PG8_MMA(0, 1, At, B1); PG8_BAR; PG8_SCHED; \
              \
            PG8_LDA(At, 0, 1); PG8_STAGE(PG8_SB(0, 0), (b2), voffB); PG8_STAGE(PG8_SB(0, 1), (b2) + hstep, voffB); PG8_STAGE(PG8_SA(0, 0), (a2), voffA); \
            PG8_WAIT_V(8); PG8_WAIT_L(0); PG8_BAR; PG8_MMA(1, 0, At, B0); PG8_MMA(1, 1, At, B1); PG8_BAR; PG8_SCHED; \
            if (PF) { int lane_p; asm volatile("v_mbcnt_lo_u32_b32 %0, -1, 0\n\tv_mbcnt_hi_u32_b32 %0, -1, %0" : "=v"(lane_p)); E.prefetch(lds + EPI_LDS_OFF, cur, wid, lane_p); } \
              \
            PG8_LDB(B0, 1, 0); PG8_LDB(B1, 1, 1); PG8_SCHED; PG8_LDA(At, 1, 0); PG8_STAGE(PG8_SA(0, 1), (a2) + hstep, voffA); \
            PG8_WAIT_VN((PF) ? 8 + Epi::NPF : 8); PG8_WAIT_L(0); PG8_BAR; PG8_MMA(0, 0, At, B0); PG8_MMA(0, 1, At, B1); PG8_BAR; PG8_SCHED; \
              \
            PG8_LDA(At, 1, 1); PG8_STAGE(PG8_SB(1, 0), (b3), voffB); PG8_STAGE(PG8_SB(1, 1), (b3) + hstep, voffB); PG8_STAGE(PG8_SA(1, 0), (a3), voffA); \
            PG8_WAIT_VN((PF) ? 8 + Epi::NPF : 8); PG8_WAIT_L(0); PG8_BAR; PG8_MMA(1, 0, At, B0); PG8_MMA(1, 1, At, B1); PG8_BAR; PG8_SCHED; } while (0)
        static_assert(SP2, "this build keeps only the two-blocks-per-barrier K-loop");
        if constexpr (Epi::NPF > 0) {
            for (int t = 0; t < nt - 2; t += 2) {
                const char* a1 = cA + (size_t)(t + 1) * kstep; const char* a2 = cA + (size_t)(t + 2) * kstep; const char* b2 = cB + (size_t)(t + 2) * kstep;
                PG8_TRIP(a1, a2, b2, a2 + kstep, b2 + kstep, false);
            }
            {   const char* a1 = cA + (size_t)(nt - 1) * kstep;
                if (has_next) S.a_ready(nxt);
                PG8_TRIP(a1, nA, nB, nA + kstep, nB + kstep, true);
            }
        } else {
            for (int t = 0; t < nt; t += 2) {
                const bool last = (t == nt - 2);
                const char* a1 = cA + (size_t)(t + 1) * kstep;
                const char* a2 = last ? nA : cA + (size_t)(t + 2) * kstep; const char* b2 = last ? nB : cB + (size_t)(t + 2) * kstep;
                if (last && has_next) S.a_ready(nxt);
                PG8_TRIP(a1, a2, b2, a2 + kstep, b2 + kstep, false);
            }
        }
#undef PG8_TRIP
#undef PG8_WAIT_VN
        if constexpr (ALIGN_EPI) { if (wr == 0) PG8_BAR; }
        if constexpr (Epi::NPF > 0) { asm volatile("s_waitcnt vmcnt(8)" ::: "memory"); PG8_BAR; asm volatile("" ::: "memory"); }
        if constexpr (!Epi::AFTER_DRAIN) { int lane_e; asm volatile("v_mbcnt_lo_u32_b32 %0, -1, 0\n\tv_mbcnt_hi_u32_b32 %0, -1, %0" : "=v"(lane_e));
            const int fr_e = lane_e & 15, fq_e = lane_e >> 4; int wr_e = wr, wc_e = wc; asm volatile("" : "+s"(wr_e), "+s"(wc_e));
#ifdef PROBE_KDUP
            if (!Sched::DUP || (ui & 1))
#endif
            E(acc, lds + EPI_LDS_OFF, cur, wr_e, wc_e, fr_e, fq_e);
            S.done(cur); }
        if (!has_next) break;
#pragma unroll
        for (int a = 0; a < 2; ++a)
#pragma unroll
            for (int b = 0; b < 2; ++b)
#pragma unroll
                for (int m = 0; m < 4; ++m)
#pragma unroll
                    for (int n = 0; n < 2; ++n) acc[a][b][m][n] = (f32x4){0.f, 0.f, 0.f, 0.f};
        cur = nxt; cA = nA; cB = nB; ++ui;
        if constexpr (ALIGN_EPI) { if (wr == 1) PG8_BAR; }
    }
    PG8_WAIT_V(0);
    if constexpr (!ALIGN_EPI) { if (wr == 0) PG8_BAR; }
    PG8_BAR;
    if constexpr (Epi::AFTER_DRAIN) { E.fused(acc, cur, wr, wc, fr, fq, lds, wid, lane); S.done(cur); }
#undef PG8_SA
#undef PG8_SB
#undef PG8_STAGE
#undef PG8_LDA
#undef PG8_LDB
#undef PG8_MMA
#undef PG8_WAIT_V
#undef PG8_WAIT_L
#undef PG8_BAR
#undef PG8_SCHED
}
}

constexpr int NWAVES = 8;
#ifndef MK_PER_PHASE
#define MK_PER_PHASE 0
#endif
constexpr int NB = 16, SEQ = 4096, D = 1024, DEPTH = 4, M = NB * SEQ;
constexpr int NIN = 3840, NINW = 3584, FF = 2816, NUP = 5632, NMOD = 6144;
constexpr float EPS = 1e-6f;
constexpr int N_PHASES = 2 + 6 * DEPTH + 1;

constexpr size_t MiB = 1u << 20;
constexpr size_t WS_CTL = 0, CTL_ZERO_BYTES = 4 * MiB;
constexpr size_t WS_MOD = 2 * MiB;
constexpr size_t WS_SMALL = 4 * MiB;
constexpr size_t WS_STAT = 12 * MiB;
constexpr size_t WS_RAWH = 16 * MiB, WS_RAWT = 28 * MiB;
constexpr size_t WS_WIN = 40 * MiB;
constexpr size_t WS_WOUT = 70 * MiB;
constexpr size_t WS_WUP = 78 * MiB;
constexpr size_t WS_WDN = 122 * MiB;
constexpr size_t WS_XN = 144 * MiB;
constexpr size_t WS_O = 272 * MiB;
constexpr size_t WS_P = 400 * MiB;
constexpr size_t WS_END = 880 * MiB;
constexpr int SM_LB = 0;
constexpr int SM_CW = SM_LB + 4 * 512;
constexpr int SM_CB = SM_CW + 4 * 3 * NUP;
constexpr int SM_GS1 = SM_CB + 4 * NUP;
constexpr int SM_GS2 = SM_GS1 + 4 * 16 * D;
constexpr int SM_GT1 = SM_GS2 + 4 * 16 * D;
constexpr int SM_GT2 = SM_GT1 + 4 * 16 * D;
constexpr int SM_B1 = SM_GT2 + 4 * 16 * D;
constexpr int SM_B2 = SM_B1 + 4 * 16 * NIN;
constexpr int SM_END = SM_B2 + 4 * 16 * NUP;
static_assert((size_t)SM_END * 4 <= 8 * MiB, "small vectors fit");
constexpr int CW_BAR = 4096;

constexpr int LDS_BYTES = 163840;
constexpr int RING_BYTES = 131072, HALO_OFF = RING_BYTES, HALO_BYTES = 12288, LDSCTL_OFF = LDS_BYTES - 512, MISC_OFF = LDSCTL_OFF + 320;
static_assert(MISC_OFF + 128 <= LDS_BYTES && HALO_OFF + HALO_BYTES <= LDSCTL_OFF, "LDS map");

#define GAS __attribute__((address_space(1)))
#define LAS __attribute__((address_space(3)))
typedef unsigned short bf16;
typedef unsigned v4u __attribute__((ext_vector_type(4)));
typedef unsigned v2u __attribute__((ext_vector_type(2)));
typedef float f32x4 __attribute__((ext_vector_type(4)));
#define LDS_WAIT() asm volatile("s_waitcnt lgkmcnt(0)" ::: "memory")
__device__ __forceinline__ unsigned f2bf(float f) { unsigned u = __builtin_bit_cast(unsigned, f); return (u + 0x7fffu + ((u >> 16) & 1u)) >> 16; }
__device__ __forceinline__ unsigned pk2(float lo, float hi) { return f2bf(lo) | (f2bf(hi) << 16); }
__device__ __forceinline__ float bf2f(unsigned h) { return __builtin_bit_cast(float, h << 16); }
__device__ __forceinline__ float wave_sum(float v) {
#pragma unroll
    for (int o = 1; o < 64; o <<= 1) v += __shfl_xor(v, o);
    return v;
}
__device__ __forceinline__ float sigmoid_f(float x) { return 1.0f / (1.0f + __expf(-x)); }
#define XB_TMO      128
#define XB_XCNT(j)  (256  + 64 * (j))
#define XB_XSUB(j)  (1280 + 64 * (j))
#define XB_XGEN(j)  (2304 + 64 * (j))
#define XB_TOP      3328
#define XB_TOPGEN   3392
#define XCD_BAR_WORDS 3456
#define XB_SPIN_CAP (1u << 18)

__device__ __forceinline__ unsigned xb_ld(unsigned* p)              { return __hip_atomic_load(p, __ATOMIC_RELAXED, __HIP_MEMORY_SCOPE_AGENT); }
__device__ __forceinline__ unsigned xb_add(unsigned* p, unsigned v) { return __hip_atomic_fetch_add(p, v, __ATOMIC_RELAXED, __HIP_MEMORY_SCOPE_AGENT); }
__device__ __forceinline__ unsigned xb_xcc_id() { return (unsigned)__builtin_amdgcn_s_getreg((3 << 11) | 20) & 0xFu; }
#define XB_SPIN(cond, bar) do { unsigned _sp = 0; while (cond) { __builtin_amdgcn_s_sleep(1); \
    if ((++_sp & 255u) == 0u) { if (xb_ld(&(bar)[XB_TMO])) break; if (_sp > XB_SPIN_CAP) { atomicAdd(&(bar)[XB_TMO], 1u); break; } } } } while (0)

struct XcdBarrier {
    unsigned* bar; unsigned x;
    volatile LAS unsigned* st;
};

__device__ __forceinline__ XcdBarrier xcd_barrier_post(unsigned* bar, volatile LAS unsigned* st) {
    XcdBarrier b; b.bar = bar; b.x = xb_xcc_id(); b.st = st;
    if (threadIdx.x == 0) (void)xb_add(&bar[XB_XCNT(b.x)], 1u);
    return b;
}
__device__ __forceinline__ void xcd_barrier_complete(unsigned* bar, unsigned x, unsigned& nloc, unsigned& nx) {
    const unsigned G = gridDim.x * gridDim.y * gridDim.z;
    unsigned sum, cnt, mine, sp = 0u;
    for (;;) {
        sum = 0u; cnt = 0u; mine = 0u;
#pragma unroll
        for (unsigned j = 0; j < 16; ++j) { const unsigned c = xb_ld(&bar[XB_XCNT(j)]); sum += c; cnt += (c > 0u) ? 1u : 0u; mine = (j == x) ? c : mine; }
        if (sum == G) break;
        __builtin_amdgcn_s_sleep(1);
        if ((++sp & 255u) == 0u) { if (xb_ld(&bar[XB_TMO])) break; if (sp > XB_SPIN_CAP) { atomicAdd(&bar[XB_TMO], 1u); break; } }
    }
    nloc = mine > 0u ? mine : 1u; nx = cnt > 0u ? cnt : 1u;
}

__device__ __forceinline__ void xcd_barrier(const XcdBarrier& b, const bool is_t0  ) {
    asm volatile("s_waitcnt vmcnt(0)" ::: "memory");
    __syncthreads();
    if (is_t0) {
        unsigned* bar = b.bar;
        __builtin_amdgcn_s_waitcnt(0);
        unsigned nloc = b.st[0], nx = b.st[1];
        if (nloc == 0u) { xcd_barrier_complete(bar, b.x, nloc, nx); b.st[0] = nloc; b.st[1] = nx; }
        const unsigned old = xb_add(&bar[XB_XSUB(b.x)], 1u);
        const unsigned gen = old / nloc;
        if (old + 1u == (gen + 1u) * nloc) {
            __builtin_amdgcn_fence(__ATOMIC_RELEASE, "agent");
            asm volatile("s_waitcnt vmcnt(0)" ::: "memory");
            const unsigned og = xb_add(&bar[XB_TOP], 1u);
            const unsigned tg = og / nx;
            if (og + 1u == (tg + 1u) * nx) xb_add(&bar[XB_TOPGEN], 1u);
            else XB_SPIN(xb_ld(&bar[XB_TOPGEN]) == tg, bar);
            __builtin_amdgcn_fence(__ATOMIC_ACQUIRE, "agent");
            xb_add(&bar[XB_XGEN(b.x)], 1u);
            asm volatile("s_waitcnt vmcnt(0)" ::: "memory");
        } else {
            XB_SPIN(xb_ld(&bar[XB_XGEN(b.x)]) == gen, bar);
            __builtin_amdgcn_fence(__ATOMIC_ACQUIRE, "agent");
            asm volatile("s_waitcnt vmcnt(0)" ::: "memory");
        }
    }
    __syncthreads();
}

struct Frame {
    LAS unsigned char* lds;
    volatile LAS unsigned* MISC;
    unsigned* ctl;
    int tid, lane, wave, vcu, G;
    const float *x, *c, *ln1_g, *ln2_g, *w_ada, *b_ada, *w_in, *lb_params, *w_gk, *b_gk, *gn_a, *gn_b, *w_out, *w_up, *conv_w, *conv_b, *w_down, *lnf_g;
    float* out;
    float *MOD, *SMALL, *STAT, *RAWH, *RAWT;
    bf16 *WIN, *WOUT, *WUP, *WDN, *XN, *O, *P, *Gb;
};

__device__ __forceinline__ void tr_item(const float* W, int Nsrc, int K, bf16* WT, int kb, int sn0, int dn0, float scale, LAS float* scr, int lane) {
    const int k0 = 64 * kb;
#pragma unroll 8
    for (int i = 0; i < 32; ++i) { const int kk = 2 * i + (lane >> 5); scr[kk * 33 + (lane & 31)] = W[(size_t)(k0 + kk) * Nsrc + sn0 + (lane & 31)]; }
    LDS_WAIT(); asm volatile("" ::: "memory");
    const int c = lane & 7;
#pragma unroll
    for (int j = 0; j < 4; ++j) { const int n = (lane >> 3) + 8 * j; const LAS float* s = scr + (8 * c) * 33 + n;
        v4u o; o.x = pk2(s[0 * 33] * scale, s[1 * 33] * scale); o.y = pk2(s[2 * 33] * scale, s[3 * 33] * scale); o.z = pk2(s[4 * 33] * scale, s[5 * 33] * scale); o.w = pk2(s[6 * 33] * scale, s[7 * 33] * scale);
        *(GAS v4u*)(WT + (size_t)(dn0 + n) * K + k0 + 8 * c) = o; }
    LDS_WAIT(); asm volatile("" ::: "memory");
}
__host__ __device__ __forceinline__ int up_orig(int np) { return ((np & 255) >> 7) * FF + 128 * (np >> 8) + (np & 127); }

__device__ __forceinline__ void p0a(Frame& F) {
    const int gw = F.vcu * NWAVES + F.wave, NGW = F.G * NWAVES, gt = F.vcu * (NWAVES * 64) + F.tid, NGT = F.G * NWAVES * 64;
    {
        LAS float* cond = (LAS float*)F.lds;
        for (int e = F.tid; e < 16 * 1024; e += NWAVES * 64) { const int b = e >> 10, d = e & 1023; const float cv = F.c[b * 1024 + d]; cond[d * 16 + b] = cv * sigmoid_f(cv); }
        __syncthreads();
        for (int it = gw; it < DEPTH * 384; it += NGW) {
            const int cb = it % 384, l = it / 384, e = cb * 16 + (F.lane & 15), dq = F.lane >> 4;
            const float* w = F.w_ada + ((size_t)l * 1024 + dq) * NMOD + e;
            float acc[16];
#pragma unroll
            for (int b = 0; b < 16; ++b) acc[b] = 0.f;
#pragma unroll 4
            for (int dd = 0; dd < 256; ++dd) {
                const float wv = w[(size_t)(4 * dd) * NMOD];
                const LAS f32x4* cp = (const LAS f32x4*)(cond + (4 * dd + dq) * 16);
#pragma unroll
                for (int q = 0; q < 4; ++q) { const f32x4 cq = cp[q]; acc[4 * q] += cq[0] * wv; acc[4 * q + 1] += cq[1] * wv; acc[4 * q + 2] += cq[2] * wv; acc[4 * q + 3] += cq[3] * wv; }
            }
            const float bb = F.b_ada[l * NMOD + e];
#pragma unroll
            for (int b = 0; b < 16; ++b) { float v = acc[b]; v += __shfl_xor(v, 16); v += __shfl_xor(v, 32); if (dq == 0) F.MOD[(size_t)(l * 16 + b) * NMOD + e] = v + bb; }
        }
        __syncthreads();
    }
    for (int i = gt; i < 512; i += NGT) {
        const float p0 = F.lb_params[i], p1 = F.lb_params[512 + i], p2 = F.lb_params[1024 + i], p3 = F.lb_params[1536 + i];
        const float mx = fmaxf(fmaxf(p0, p1), fmaxf(p2, p3)); const float e0 = __expf(p0 - mx), e1 = __expf(p1 - mx), e2 = __expf(p2 - mx), e3 = __expf(p3 - mx);
        const float inv = 1.0f / (e0 + e1 + e2 + e3);
        F.SMALL[SM_LB + i] = 0.f; F.SMALL[SM_LB + 512 + i] = e1 * inv; F.SMALL[SM_LB + 1024 + i] = (e1 + e2) * inv; F.SMALL[SM_LB + 1536 + i] = (e1 + e2 + e3) * inv;
    }
    for (int i = gt; i < DEPTH * 3 * NUP; i += NGT) { const int np = i % NUP, lj = i / NUP; F.SMALL[SM_CW + i] = F.conv_w[(size_t)lj * NUP + up_orig(np)]; }
    for (int i = gt; i < DEPTH * NUP; i += NGT) { const int np = i % NUP, l = i / NUP; F.SMALL[SM_CB + i] = F.conv_b[(size_t)l * NUP + up_orig(np)]; }
    for (int i = gt; i < DEPTH * 256 * 1024; i += NGT) {
        const int k = i & 1023, n = (i >> 10) & 255, l = i >> 18;
        const float* wi = F.w_in + ((size_t)l * 1024 + k) * 3600 + NINW; const float* wg = F.w_gk + (size_t)l * 16 * 256 + n;
        float s = 0.f;
#pragma unroll
        for (int r = 0; r < 16; ++r) s += wi[r] * wg[r * 256];
        F.WIN[((size_t)l * NIN + NINW + n) * 1024 + k] = (bf16)f2bf(s);
    }
    {   LAS float* scr = (LAS float*)(F.lds + F.wave * 16384);
        constexpr int I_IN = 16 * 112, I_OUT = 16 * 32, I_UP = 16 * 176, I_DN = 44 * 32, I_L = I_IN + I_OUT + I_UP + I_DN;
        for (int it = gw; it < DEPTH * I_L; it += NGW) {
            const int l = it / I_L; int r = it % I_L;
            if (r < I_IN) { const int kb = r / 112, nb = r % 112; tr_item(F.w_in + (size_t)l * 1024 * 3600, 3600, 1024, F.WIN + (size_t)l * NIN * 1024, kb, 32 * nb, 32 * nb, (nb >= 64 && nb < 72) ? 0.125f : 1.0f, scr, F.lane); continue; } r -= I_IN;
            if (r < I_OUT) { const int kb = r / 32, nb = r % 32; tr_item(F.w_out + (size_t)l * 1024 * 1024, 1024, 1024, F.WOUT + (size_t)l * 1024 * 1024, kb, 32 * nb, 32 * nb, 1.0f, scr, F.lane); continue; } r -= I_OUT;
            if (r < I_UP) { const int kb = r / 176, nb = r % 176; tr_item(F.w_up + (size_t)l * 1024 * NUP, NUP, 1024, F.WUP + (size_t)l * NUP * 1024, kb, up_orig(32 * nb), 32 * nb, 1.0f, scr, F.lane); continue; } r -= I_UP;
            { const int kb = r / 32, nb = r % 32; tr_item(F.w_down + (size_t)l * FF * 1024, 1024, FF, F.WDN + (size_t)l * 1024 * FF, kb, 32 * nb, 32 * nb, 1.0f, scr, F.lane); }
        }
    }
}

__device__ __forceinline__ void p0b(Frame& F) {
    const int gw = F.vcu * NWAVES + F.wave, NGW = F.G * NWAVES, gt = F.vcu * (NWAVES * 64) + F.tid, NGT = F.G * NWAVES * 64;
    LAS float* shL = (LAS float*)F.lds;
    for (int combo = 0; combo < 2 * DEPTH; ++combo) {
        const int l = combo >> 1, which = combo & 1;
        __syncthreads();
        for (int e = F.tid; e < 16 * 1024; e += NWAVES * 64) { const int b = e >> 10, d = e & 1023; shL[e] = F.MOD[(size_t)(l * 16 + b) * NMOD + (which ? 3072 : 0) + d]; }
        __syncthreads();
        const bf16* Wt = which ? F.WUP + (size_t)l * NUP * 1024 : F.WIN + (size_t)l * NIN * 1024; const int ncols = which ? NUP : NIN;
        float* outp = F.SMALL + (which ? SM_B2 + l * 16 * NUP : SM_B1 + l * 16 * NIN);
        for (int n = gw; n < ncols; n += NGW) {
            const GAS v2u* wr = (const GAS v2u*)(Wt + (size_t)n * 1024) + F.lane;
            float w[16];
#pragma unroll
            for (int i = 0; i < 4; ++i) { const v2u p = wr[64 * i]; w[4 * i] = bf2f(p.x & 0xffffu); w[4 * i + 1] = bf2f(p.x >> 16); w[4 * i + 2] = bf2f(p.y & 0xffffu); w[4 * i + 3] = bf2f(p.y >> 16); }
            float res = 0.f;
#pragma unroll 1
            for (int b = 0; b < 16; ++b) { float s = 0.f;
#pragma unroll
                for (int i = 0; i < 4; ++i) { const f32x4 sh = *(const LAS f32x4*)(shL + b * 1024 + 256 * i + 4 * F.lane); s += sh[0] * w[4 * i] + sh[1] * w[4 * i + 1] + sh[2] * w[4 * i + 2] + sh[3] * w[4 * i + 3]; }
                s = wave_sum(s); res = (F.lane == b) ? s : res; }
            if (F.lane < 16) outp[F.lane * ncols + n] = res + ((which == 0 && n >= NINW) ? F.b_gk[l * 256 + n - NINW] : 0.f);
        }
    }
    for (int i = gt; i < DEPTH * 16 * D; i += NGT) { const int d = i & 1023, lb = i >> 10, l = lb >> 4; const float* mod = F.MOD + (size_t)lb * NMOD;
        F.SMALL[SM_GS1 + i] = F.ln1_g[l * D + d] * (1.0f + mod[1024 + d]); F.SMALL[SM_GT1 + i] = mod[2048 + d];
        F.SMALL[SM_GS2 + i] = F.ln2_g[l * D + d] * (1.0f + mod[4096 + d]); F.SMALL[SM_GT2 + i] = mod[5120 + d]; }
    for (int row = gw; row < M; row += NGW) {
        const int b = row / SEQ; const GAS f32x4* xr = (const GAS f32x4*)(F.x + (size_t)row * D) + F.lane; const float* mod = F.MOD + (size_t)b * NMOD + 1024;
        GAS v2u* o8 = (GAS v2u*)(F.XN + (size_t)row * D) + F.lane; float ss = 0.f;
#pragma unroll
        for (int j = 0; j < 4; ++j) { const f32x4 v = xr[64 * j]; const int d = 256 * j + 4 * F.lane; const f32x4 g = *(const f32x4*)(F.ln1_g + d), sc = *(const f32x4*)(mod + d);
            ss += (v[0] * v[0] + v[1] * v[1]) + (v[2] * v[2] + v[3] * v[3]);
            v2u w; w.x = pk2(v[0] * g[0] * (1.0f + sc[0]), v[1] * g[1] * (1.0f + sc[1])); w.y = pk2(v[2] * g[2] * (1.0f + sc[2]), v[3] * g[3] * (1.0f + sc[3])); o8[64 * j] = w; }
        ss = wave_sum(ss);
        if (F.lane < 16) F.STAT[(size_t)row * 16 + F.lane] = (F.lane == 0) ? ss : 0.f;
    }
}

template <int DK, bool IS_A>
__device__ __forceinline__ void mixer_stream(Frame& F, int l, int b, int h) {
    constexpr int DKS = DK / 4, TB = 16;
    LAS float* aL = (LAS float*)F.lds; LAS float* kL = aL + TB * 128; LAS float* qL = kL + TB * 128; LAS float* vL = qL + TB * 128; LAS float* gL = vL + TB * 128;
    LAS float* part = gL + TB * 128;
    LAS float* red = part + TB * 4 * 128;
    const int tid = F.tid, j = tid & 127, sl = tid >> 7;
    const int qc = IS_A ? 128 * h : 2048 + 64 * h, fc = IS_A ? 512 + 128 * h : 2304 + 64 * h, gkc = 3584 + 64 * h;
    const int vc = IS_A ? 1024 + 128 * h : 2560 + 128 * h, gc = IS_A ? 1536 + 128 * h : 3072 + 128 * h, oc = IS_A ? 128 * h : 512 + 128 * h;
    const float* lbp = F.SMALL + SM_LB + l * 512 + 128 * h;
    const float gn = (IS_A ? F.gn_a : F.gn_b)[l * 128 + j];
    float S[DKS];
#pragma unroll
    for (int i = 0; i < DKS; ++i) S[i] = 0.f;
    for (int t0 = 0; t0 < SEQ; t0 += TB) {
        const size_t rowb = (size_t)b * SEQ + t0;
        for (int e = tid; e < TB * DK; e += NWAVES * 64) { const int tt = e / DK, i = e % DK; const bf16* pr = F.P + (rowb + tt) * NIN;
            const float q = bf2f(pr[qc + i]); float a, k;
            if (IS_A) { const float fa = bf2f(pr[fc + i]), lb = lbp[i], sg = sigmoid_f(fa); a = lb + (1.0f - lb) * sg; k = (1.0f - lb) * (1.0f - sg); }
            else { k = bf2f(pr[fc + i]); const float gk = bf2f(pr[gkc + i]); const float ls = fminf(gk, 0.f) - __logf(1.0f + __expf(-fabsf(gk))); a = __expf(ls * (1.0f / 16.0f)); }
            aL[tt * 128 + i] = a; kL[tt * 128 + i] = k; qL[tt * 128 + i] = q; }
        for (int e = tid; e < TB * 128; e += NWAVES * 64) { const int tt = e >> 7, jj = e & 127; const bf16* pr = F.P + (rowb + tt) * NIN; vL[e] = bf2f(pr[vc + jj]); gL[e] = bf2f(pr[gc + jj]); }
        __syncthreads();
#pragma unroll 1
        for (int tt = 0; tt < TB; ++tt) { const float v = vL[tt * 128 + j]; float acc = 0.f;
#pragma unroll
            for (int i4 = 0; i4 < DKS / 4; ++i4) { const f32x4 a4 = *(const LAS f32x4*)(aL + tt * 128 + sl * DKS + 4 * i4), k4 = *(const LAS f32x4*)(kL + tt * 128 + sl * DKS + 4 * i4), q4 = *(const LAS f32x4*)(qL + tt * 128 + sl * DKS + 4 * i4);
#pragma unroll
                for (int r = 0; r < 4; ++r) { S[4 * i4 + r] = a4[r] * S[4 * i4 + r] + k4[r] * v; acc += q4[r] * S[4 * i4 + r]; } }
            part[(tt * 4 + sl) * 128 + j] = acc; }
        __syncthreads();
        float o[4];
#pragma unroll
        for (int r = 0; r < 4; ++r) { const int tt = sl * 4 + r; o[r] = (part[(tt * 4 + 0) * 128 + j] + part[(tt * 4 + 1) * 128 + j]) + (part[(tt * 4 + 2) * 128 + j] + part[(tt * 4 + 3) * 128 + j]);
            const float ss = wave_sum(o[r] * o[r]); if (F.lane == 0) red[tt * 2 + ((tid >> 6) & 1)] = ss; }
        __syncthreads();
#pragma unroll
        for (int r = 0; r < 4; ++r) { const int tt = sl * 4 + r; const float tot = red[tt * 2] + red[tt * 2 + 1]; const float rn = 1.0f / sqrtf(tot * (1.0f / 128.0f) + EPS);
            const float g = gL[tt * 128 + j]; F.O[(rowb + tt) * D + oc + j] = (bf16)f2bf(o[r] * rn * gn * (g * sigmoid_f(g))); }
        __syncthreads();
    }
}
__device__ __forceinline__ void mixer_phase(Frame& F, int l) {
    for (int s = blockIdx.x; s < NB * 8; s += F.G) { const int b = s >> 3, hh = s & 7;
        if (hh < 4) mixer_stream<128, true>(F, l, b, hh); else mixer_stream<64, false>(F, l, b, hh - 4); }
}

#ifndef MIXER_NAIVE
#define MIXER_NAIVE 0
#endif
#ifndef MIXER_V3
#define MIXER_V3 1
#endif
#ifndef MX_SPLIT
#define MX_SPLIT 1
#endif
#if MIXER_NAIVE
#define MIXER_PHASE mixer_phase
#elif MIXER_V3
#define MIXER_PHASE mixer_phase_pipe
#else
#define MIXER_PHASE mixer_phase_chunked
#endif


typedef short bf16x8_t __attribute__((ext_vector_type(8)));
typedef short s16x4_t __attribute__((ext_vector_type(4)));
typedef float f32x2_t __attribute__((ext_vector_type(2)));
typedef __bf16 bf16x2_t __attribute__((ext_vector_type(2)));
#define MFMA16(a, b, c) __builtin_amdgcn_mfma_f32_16x16x32_bf16((a), (b), (c), 0, 0, 0)
#ifdef MX_FULLSYNC
#define LBAR() __syncthreads()
#else
#define LBAR() do { asm volatile("s_waitcnt lgkmcnt(0)" ::: "memory"); __builtin_amdgcn_s_barrier(); asm volatile("" ::: "memory"); } while (0)
#endif
__device__ __forceinline__ unsigned cvtpk(float lo, float hi) { f32x2_t v = {lo, hi}; bf16x2_t r = __builtin_convertvector(v, bf16x2_t); return __builtin_bit_cast(unsigned, r); }
__device__ __forceinline__ float bflo(unsigned u) { return __builtin_bit_cast(float, u << 16); }
__device__ __forceinline__ float bfhi(unsigned u) { return __builtin_bit_cast(float, u & 0xffff0000u); }
__device__ __forceinline__ s16x4_t tr16(const LAS unsigned char* p) { return __builtin_bit_cast(s16x4_t, __builtin_amdgcn_ds_read_tr16_b64_v4i16((LAS s16x4_t*)p)); }
constexpr float L2E = 1.4426950408889634f;

template <int DK, bool IS_A>
__device__ __forceinline__ void mixer_chunked_stream(Frame& F, int l, int b, int h, const int n_lo, const int n_full, const int n_hi) {
    constexpr int CP = DK / 2, TS = 512 / CP, R = 64 / TS, TSREF = 32 / R, NKS = DK / 32, NMT = DK / 16, NCH = SEQ / 64;
    constexpr int PQ = DK * 2 + 16, PT = 144, PV = 272, PO = 528;
    constexpr int L_QH = 0, L_KH = L_QH + 64 * PQ, L_VV = L_KH + 64 * PQ, L_SC = L_VV + 64 * PV, L_SEG = L_SC + 64 * PT, L_ERF = L_SEG + TS * DK * 4, L_ELR = L_ERF + DK * 4, L_DEC = L_ELR + DK * 4,
                  L_OB = L_DEC + DK * 4, L_END = L_OB + 64 * PO;
    static_assert(L_END <= RING_BYTES, "mixer LDS map");
    LAS unsigned char* const lds = F.lds;
    const int w = F.wave;
#define MX_IDS() int lane; asm volatile("v_mbcnt_lo_u32_b32 %0, -1, 0\n\tv_mbcnt_hi_u32_b32 %0, -1, %0" : "=v"(lane)); const int tid = w * 64 + lane, m = lane & 15, g = lane >> 4, q4 = (lane & 15) >> 2, p4 = lane & 3, \
        cp = tid % CP, ts = tid / CP, nt = tid >> 3, ndq = tid & 7, vr0 = tid >> 4, vq = tid & 15; (void)m; (void)g; (void)q4; (void)p4; (void)cp; (void)ts; (void)nt; (void)ndq; (void)vr0; (void)vq
    const int qc = IS_A ? 128 * h : 2048 + 64 * h, fc = IS_A ? 512 + 128 * h : 2304 + 64 * h, gkc = 3584 + 64 * h;
    const int vc = IS_A ? 1024 + 128 * h : 2560 + 128 * h, gc = IS_A ? 1536 + 128 * h : 3072 + 128 * h, oc = IS_A ? 128 * h : 512 + 128 * h;
    float lb0 = 0.f, lb1 = 0.f;
    if (IS_A) { MX_IDS(); lb0 = F.SMALL[SM_LB + l * 512 + 128 * h + 2 * cp]; lb1 = F.SMALL[SM_LB + l * 512 + 128 * h + 2 * cp + 1]; }
    const float* gnp = (IS_A ? F.gn_a : F.gn_b) + l * 128;

    f32x4 S[NMT];
#pragma unroll
    for (int i = 0; i < NMT; ++i) S[i] = (f32x4){0.f, 0.f, 0.f, 0.f};
    unsigned q2[R], f2[R], k2[R];
    v4u vreg[2], ogreg[2];
    float cum[2][R], kk[2][R];

#define MX_LOAD_RAW(n) do { const size_t row0_ = (size_t)b * SEQ + (size_t)(n) * 64; \
        _Pragma("unroll") for (int j = 0; j < R; ++j) { const unsigned* pr = (const unsigned*)(F.P + (row0_ + ts * R + j) * NIN); \
            q2[j] = pr[(qc >> 1) + cp]; if (IS_A) { f2[j] = pr[(fc >> 1) + cp]; } else { k2[j] = pr[(fc >> 1) + cp]; f2[j] = pr[(gkc >> 1) + cp]; } } \
        _Pragma("unroll") for (int i = 0; i < 2; ++i) vreg[i] = *(const v4u*)(F.P + (row0_ + vr0 + 32 * i) * NIN + vc + 8 * vq); } while (0)
#define MX_E1() do { \
        _Pragma("unroll") for (int c = 0; c < 2; ++c) { float run = IS_A ? 1.f : 0.f; const float lb = c ? lb1 : lb0; \
            _Pragma("unroll") for (int j = 0; j < R; ++j) { const float x = c ? bfhi(f2[j]) : bflo(f2[j]); \
                if (IS_A) { const float sg = __builtin_amdgcn_rcpf(1.0f + __builtin_amdgcn_exp2f(-x * L2E)); run *= lb + (1.0f - lb) * sg; kk[c][j] = (1.0f - lb) * (1.0f - sg); } \
                else { run += (fminf(x, 0.f) * L2E - __builtin_amdgcn_logf(1.0f + __builtin_amdgcn_exp2f(-fabsf(x) * L2E))) * (1.0f / 16.0f); kk[c][j] = c ? bfhi(k2[j]) : bflo(k2[j]); } \
                cum[c][j] = run; } } \
        *(LAS f32x2_t*)(lds + L_SEG + (ts * DK + 2 * cp) * 4) = IS_A ? (f32x2_t){__builtin_amdgcn_logf(cum[0][R - 1]), __builtin_amdgcn_logf(cum[1][R - 1])} : (f32x2_t){cum[0][R - 1], cum[1][R - 1]}; } while (0)

    { MX_IDS(); MX_LOAD_RAW(n_lo); MX_E1(); }
#pragma unroll 1
    for (int n = n_lo; n < n_hi; ++n) {
        const size_t row0 = (size_t)b * SEQ + (size_t)n * 64; const bool full = (n >= n_full);
        LBAR();
        {   MX_IDS();
            float base[2] = {0.f, 0.f}, tot[2] = {0.f, 0.f}, refv[2] = {0.f, 0.f};
#pragma unroll
            for (int t2 = 0; t2 < TS; ++t2) { const f32x2_t sv = *(const LAS f32x2_t*)(lds + L_SEG + (t2 * DK + 2 * cp) * 4);
                tot[0] += sv[0]; tot[1] += sv[1]; if (t2 < ts) { base[0] += sv[0]; base[1] += sv[1]; } if (t2 < TSREF) { refv[0] += sv[0]; refv[1] += sv[1]; } }
            if (ts == 0) { *(LAS f32x2_t*)(lds + L_DEC + 2 * cp * 4) = (f32x2_t){__builtin_amdgcn_exp2f(tot[0]), __builtin_amdgcn_exp2f(tot[1])};
                *(LAS f32x2_t*)(lds + L_ERF + 2 * cp * 4) = (f32x2_t){__builtin_amdgcn_exp2f(refv[0]), __builtin_amdgcn_exp2f(refv[1])};
                *(LAS f32x2_t*)(lds + L_ELR + 2 * cp * 4) = (f32x2_t){__builtin_amdgcn_exp2f(tot[0] - refv[0]), __builtin_amdgcn_exp2f(tot[1] - refv[1])}; }
            const float eb0 = IS_A ? __builtin_amdgcn_exp2f(base[0] - refv[0]) : base[0] - refv[0], eb1 = IS_A ? __builtin_amdgcn_exp2f(base[1] - refv[1]) : base[1] - refv[1];
#pragma unroll
            for (int j = 0; j < R; ++j) { const int t = ts * R + j;
                const float e10 = IS_A ? eb0 * cum[0][j] : __builtin_amdgcn_exp2f(eb0 + cum[0][j]), e11 = IS_A ? eb1 * cum[1][j] : __builtin_amdgcn_exp2f(eb1 + cum[1][j]);
                const float e20 = __builtin_amdgcn_rcpf(e10), e21 = __builtin_amdgcn_rcpf(e11);
                *(LAS unsigned*)(lds + L_QH + t * PQ + 4 * cp) = cvtpk(bflo(q2[j]) * e10, bfhi(q2[j]) * e11);
                *(LAS unsigned*)(lds + L_KH + t * PQ + 4 * cp) = cvtpk(kk[0][j] * e20, kk[1][j] * e21);
            }
#pragma unroll
            for (int i = 0; i < 2; ++i) *(LAS v4u*)(lds + L_VV + (vr0 + 32 * i) * PV + 16 * vq) = vreg[i];
            if (full) {
#pragma unroll
                for (int i = 0; i < 2; ++i) ogreg[i] = *(const v4u*)(F.P + (row0 + nt) * NIN + gc + 16 * ndq + 8 * i); }
            if (n + 1 < n_hi) MX_LOAD_RAW(n + 1);
        }
        LBAR();
        if (full) {   MX_IDS(); const int tb = w >> 1;
#pragma unroll
            for (int si = 0; si < 2; ++si) { const int sb = 2 * (w & 1) + si;
                if (sb <= tb) { f32x4 acc = {0.f, 0.f, 0.f, 0.f};
#pragma unroll
                    for (int ks = 0; ks < NKS; ++ks) { const bf16x8_t a = *(const LAS bf16x8_t*)(lds + L_QH + (16 * tb + m) * PQ + 64 * ks + 16 * g), bb = *(const LAS bf16x8_t*)(lds + L_KH + (16 * sb + m) * PQ + 64 * ks + 16 * g);
                        acc = MFMA16(a, bb, acc); }
#pragma unroll
                    for (int j = 0; j < 4; ++j) { const int t = 16 * tb + 4 * g + j, s = 16 * sb + m; const float val = (s <= t) ? acc[j] : 0.f;
                        *(LAS unsigned short*)(lds + L_SC + t * PT + 2 * s) = (unsigned short)f2bf(val); } }
                else {
#pragma unroll
                    for (int j = 0; j < 4; ++j) *(LAS unsigned short*)(lds + L_SC + (16 * tb + 4 * g + j) * PT + 2 * (16 * sb + m)) = (unsigned short)0; } }
            LBAR();
        }
        {   MX_IDS(); const int dv0 = 16 * w;
            bf16x8_t vB[2];
#pragma unroll
            for (int ks2 = 0; ks2 < 2; ++ks2) { const LAS unsigned char* vp = lds + L_VV + (32 * ks2 + 8 * g + q4) * PV + 2 * (dv0 + 4 * p4);
                const s16x4_t lo = tr16(vp), hi = tr16(vp + 4 * PV); vB[ks2] = __builtin_shufflevector(lo, hi, 0, 1, 2, 3, 4, 5, 6, 7); }
            f32x4 o[4];
#pragma unroll
            for (int mt = 0; mt < 4; ++mt) o[mt] = (f32x4){0.f, 0.f, 0.f, 0.f};
            if (full) {
#pragma unroll
            for (int mt = 0; mt < 4; ++mt) {
#pragma unroll
                for (int ks2 = 0; ks2 < 2; ++ks2) if (2 * ks2 <= mt) { const bf16x8_t a = *(const LAS bf16x8_t*)(lds + L_SC + (16 * mt + m) * PT + 64 * ks2 + 16 * g); o[mt] = MFMA16(a, vB[ks2], o[mt]); } }
#pragma unroll
            for (int sg = 0; sg < NKS; ++sg) {
                const f32x4 ea = *(const LAS f32x4*)(lds + L_ERF + 4 * (32 * sg + 4 * g)), eb = *(const LAS f32x4*)(lds + L_ERF + 4 * (32 * sg + 16 + 4 * g));
                const f32x4 sa = S[2 * sg] * ea, sb4 = S[2 * sg + 1] * eb;
                const bf16x8_t sB = __builtin_bit_cast(bf16x8_t, (v4u){cvtpk(sa[0], sa[1]), cvtpk(sa[2], sa[3]), cvtpk(sb4[0], sb4[1]), cvtpk(sb4[2], sb4[3])});
#pragma unroll
                for (int mt = 0; mt < 4; ++mt) { const LAS unsigned char* qp = lds + L_QH + (16 * mt + m) * PQ + 2 * (32 * sg + 4 * g);
                    const s16x4_t lo = *(const LAS s16x4_t*)qp, hi = *(const LAS s16x4_t*)(qp + 32);
                    o[mt] = MFMA16(__builtin_shufflevector(lo, hi, 0, 1, 2, 3, 4, 5, 6, 7), sB, o[mt]); } asm volatile("" ::: "memory"); }
            }
#pragma unroll
            for (int mtile = 0; mtile < NMT; ++mtile) { f32x4 u4 = {0.f, 0.f, 0.f, 0.f};
#pragma unroll
                for (int ks2 = 0; ks2 < 2; ++ks2) { const LAS unsigned char* kp = lds + L_KH + (32 * ks2 + 8 * g + q4) * PQ + 2 * (16 * mtile + 4 * p4);
                    const s16x4_t lo = tr16(kp), hi = tr16(kp + 4 * PQ); u4 = MFMA16(__builtin_shufflevector(lo, hi, 0, 1, 2, 3, 4, 5, 6, 7), vB[ks2], u4); }
                const f32x4 d4 = *(const LAS f32x4*)(lds + L_DEC + 4 * (16 * mtile + 4 * g)), l4 = *(const LAS f32x4*)(lds + L_ELR + 4 * (16 * mtile + 4 * g));
                S[mtile] = S[mtile] * d4 + u4 * l4; if (mtile & 1) asm volatile("" ::: "memory"); }
            if (full) {
#pragma unroll
            for (int mt = 0; mt < 4; ++mt)
#pragma unroll
                for (int j = 0; j < 4; ++j) *(LAS float*)(lds + L_OB + (16 * mt + 4 * g + j) * PO + 4 * (dv0 + m)) = o[mt][j];
            }
        }
        if (full) {   LBAR(); MX_IDS(); f32x4 ov[4]; float ss = 0.f;
#pragma unroll
            for (int i = 0; i < 4; ++i) { ov[i] = *(const LAS f32x4*)(lds + L_OB + nt * PO + 64 * ndq + 16 * i); ss += (ov[i][0] * ov[i][0] + ov[i][1] * ov[i][1]) + (ov[i][2] * ov[i][2] + ov[i][3] * ov[i][3]); }
            ss += __shfl_xor(ss, 1); ss += __shfl_xor(ss, 2); ss += __shfl_xor(ss, 4);
            const float rn = __builtin_amdgcn_rsqf(ss * (1.0f / 128.0f) + EPS);
            unsigned ow[8];
#pragma unroll
            for (int i = 0; i < 4; ++i) { const f32x4 gn4 = *(const f32x4*)(gnp + 16 * ndq + 4 * i); const unsigned g01 = ogreg[i >> 1][2 * (i & 1)], g23 = ogreg[i >> 1][2 * (i & 1) + 1];
                const float ga = bflo(g01), gb = bfhi(g01), gcc = bflo(g23), gd = bfhi(g23);
                const float r0 = ov[i][0] * rn * gn4[0] * (ga * __builtin_amdgcn_rcpf(1.0f + __builtin_amdgcn_exp2f(-ga * L2E))), r1 = ov[i][1] * rn * gn4[1] * (gb * __builtin_amdgcn_rcpf(1.0f + __builtin_amdgcn_exp2f(-gb * L2E)));
                const float r2 = ov[i][2] * rn * gn4[2] * (gcc * __builtin_amdgcn_rcpf(1.0f + __builtin_amdgcn_exp2f(-gcc * L2E))), r3 = ov[i][3] * rn * gn4[3] * (gd * __builtin_amdgcn_rcpf(1.0f + __builtin_amdgcn_exp2f(-gd * L2E)));
                ow[2 * i] = cvtpk(r0, r1); ow[2 * i + 1] = cvtpk(r2, r3); }
            bf16* op = F.O + (row0 + nt) * D + oc + 16 * ndq;
            *(v4u*)op = (v4u){ow[0], ow[1], ow[2], ow[3]}; *(v4u*)(op + 8) = (v4u){ow[4], ow[5], ow[6], ow[7]};
        }
        if (n + 1 < n_hi) { MX_IDS(); MX_E1(); }
    }
    LBAR();
#undef MX_LOAD_RAW
#undef MX_E1
#undef MX_IDS
}
#ifndef MX_N0
#define MX_N0 42
#endif
__device__ __forceinline__ void mixer_phase_chunked(Frame& F, int l) {
    for (int it = blockIdx.x; it < 256; it += F.G) { const int s = it & 63, seg = (it >> 6) & 1;
        if (it < 128) mixer_chunked_stream<128, true>(F, l, s >> 2, s & 3, 0, seg ? MX_N0 : 0, seg ? SEQ / 64 : MX_N0);
        else mixer_chunked_stream<64, false>(F, l, s >> 2, s & 3, 0, seg ? MX_N0 : 0, seg ? SEQ / 64 : MX_N0); }
}

template <int DK, bool IS_A>
__device__ __forceinline__ void mixer_pipe_stream(Frame& F, int l, int b, int h, const int n_lo, const int n_full, const int n_hi) {
    constexpr int DKW = DK / 4, PW = DKW / 2, RG = 64 / PW, RR = 64 / RG, RGREF = 32 / RR, NKS = DK / 32, NMT = DK / 16;
    constexpr int PQ = DK * 2 + 16, PT = 144, PV = 272, PO = 528;
    constexpr int BUF = 2 * 64 * PQ + 64 * PV, B_QH = 0, B_KH = 64 * PQ, B_VV = 2 * 64 * PQ;
    constexpr int L_SC = 2 * BUF, L_FAC = L_SC + 64 * PT, FACB = 3 * DK * 4, L_OB = L_FAC + 2 * FACB, L_END = L_OB + 64 * PO;
    static_assert(L_END <= LDSCTL_OFF, "mixer LDS map");
    LAS unsigned char* const lds = F.lds;
    const int w = F.wave;
    const bool producer = (w >= 4);
    const int pw = w - 4, cw = w;
    const int qc = IS_A ? 128 * h : 2048 + 64 * h, fc = IS_A ? 512 + 128 * h : 2304 + 64 * h, gkc = 3584 + 64 * h;
    const int vc = IS_A ? 1024 + 128 * h : 2560 + 128 * h, gc = IS_A ? 1536 + 128 * h : 3072 + 128 * h, oc = IS_A ? 128 * h : 512 + 128 * h;
    const float* gnp = (IS_A ? F.gn_a : F.gn_b) + l * 128;
#define MP_LANE() int lane; asm volatile("v_mbcnt_lo_u32_b32 %0, -1, 0\n\tv_mbcnt_hi_u32_b32 %0, -1, %0" : "=v"(lane))
    f32x4 S[NMT][2];
#pragma unroll
    for (int i = 0; i < NMT; ++i) { S[i][0] = (f32x4){0.f, 0.f, 0.f, 0.f}; S[i][1] = (f32x4){0.f, 0.f, 0.f, 0.f}; }
    v4u ogreg[4];
    unsigned q2[RR], f2[RR], k2[RR]; v4u vreg[4];
    float lb0 = 0.f, lb1 = 0.f;
#define MP_LOAD_RAW(n) do { const size_t row0_ = (size_t)b * SEQ + (size_t)(n) * 64; \
        _Pragma("unroll") for (int j = 0; j < RR; ++j) { const unsigned* pr = (const unsigned*)(F.P + (row0_ + rg * RR + j) * NIN); \
            q2[j] = pr[(qc >> 1) + pw * PW + cpl]; if (IS_A) { f2[j] = pr[(fc >> 1) + pw * PW + cpl]; } else { k2[j] = pr[(fc >> 1) + pw * PW + cpl]; f2[j] = pr[(gkc >> 1) + pw * PW + cpl]; } } \
        _Pragma("unroll") for (int i = 0; i < 4; ++i) { const int id = pw * 64 + lane + 256 * i; vreg[i] = *(const v4u*)(F.P + (row0_ + (id >> 4)) * NIN + vc + 8 * (id & 15)); } } while (0)
    if (producer) {
        MP_LANE(); const int cpl = lane % PW, rg = lane / PW, m = lane & 15, g = lane >> 4;
        if (IS_A) { lb0 = F.SMALL[SM_LB + l * 512 + 128 * h + pw * DKW + 2 * cpl]; lb1 = F.SMALL[SM_LB + l * 512 + 128 * h + pw * DKW + 2 * cpl + 1]; }
        MP_LOAD_RAW(n_lo);
        for (int tb = 0; tb < pw; ++tb)
#pragma unroll
            for (int j = 0; j < 4; ++j) *(LAS unsigned short*)(lds + L_SC + (16 * tb + 4 * g + j) * PT + 2 * (16 * pw + m)) = (unsigned short)0;
    }
#pragma unroll 1
    for (int i = n_lo - 1; i < n_hi; ++i) {
        const int bc = i & 1, bp = (i + 1) & 1;
        const bool c_on = (i >= n_lo), c_full = (i >= n_full), p_on = (i + 1 < n_hi), p_full = (i + 1 >= n_full);
        if (producer) {
            if (p_on) {
                MP_LANE(); const int cpl = lane % PW, rg = lane / PW;
                LAS unsigned char* const bufp = lds + bp * BUF;
                float cum[2][RR], kk[2][RR], lg[2];
#pragma unroll
                for (int c = 0; c < 2; ++c) { float run = IS_A ? 1.f : 0.f; const float lb = c ? lb1 : lb0;
#pragma unroll
                    for (int j = 0; j < RR; ++j) { const float x = c ? bfhi(f2[j]) : bflo(f2[j]);
                        if (IS_A) { const float sg = __builtin_amdgcn_rcpf(1.0f + __builtin_amdgcn_exp2f(-x * L2E)); run *= lb + (1.0f - lb) * sg; kk[c][j] = (1.0f - lb) * (1.0f - sg); }
                        else { run += (fminf(x, 0.f) * L2E - __builtin_amdgcn_logf(1.0f + __builtin_amdgcn_exp2f(-fabsf(x) * L2E))) * (1.0f / 16.0f); kk[c][j] = c ? bfhi(k2[j]) : bflo(k2[j]); }
                        cum[c][j] = run; }
                    lg[c] = IS_A ? __builtin_amdgcn_logf(run) : run; }
                float eb[2];
#pragma unroll
                for (int c = 0; c < 2; ++c) { float incl = lg[c];
#pragma unroll
                    for (int d = 1; d < RG; d <<= 1) { const float t = __shfl_up(incl, d * PW); if (rg >= d) incl += t; }
                    const float base = incl - lg[c], tot = __shfl(incl, (RG - 1) * PW + cpl), refv = __shfl(base, RGREF * PW + cpl);
                    if (rg == 0) { LAS float* fp = (LAS float*)(lds + L_FAC + bp * FACB) + pw * DKW + 2 * cpl + c;
                        fp[0] = __builtin_amdgcn_exp2f(tot); fp[DK] = __builtin_amdgcn_exp2f(refv); fp[2 * DK] = __builtin_amdgcn_exp2f(tot - refv); }
                    eb[c] = IS_A ? __builtin_amdgcn_exp2f(base - refv) : base - refv; }
#pragma unroll
                for (int j = 0; j < RR; ++j) { const int t = rg * RR + j;
                    const float e10 = IS_A ? eb[0] * cum[0][j] : __builtin_amdgcn_exp2f(eb[0] + cum[0][j]), e11 = IS_A ? eb[1] * cum[1][j] : __builtin_amdgcn_exp2f(eb[1] + cum[1][j]);
                    if (p_full) *(LAS unsigned*)(bufp + B_QH + t * PQ + 2 * (pw * DKW + 2 * cpl)) = cvtpk(bflo(q2[j]) * e10, bfhi(q2[j]) * e11);
                    *(LAS unsigned*)(bufp + B_KH + t * PQ + 2 * (pw * DKW + 2 * cpl)) = cvtpk(kk[0][j] * __builtin_amdgcn_rcpf(e10), kk[1][j] * __builtin_amdgcn_rcpf(e11)); }
#pragma unroll
                for (int i2 = 0; i2 < 4; ++i2) { const int id = pw * 64 + lane + 256 * i2; *(LAS v4u*)(bufp + B_VV + (id >> 4) * PV + 16 * (id & 15)) = vreg[i2]; }
                if (i + 2 < n_hi) MP_LOAD_RAW(i + 2);
            }
        } else if (c_on) {
            MP_LANE(); const int m = lane & 15, g = lane >> 4, q4 = (lane & 15) >> 2, p4 = lane & 3, dv0 = 32 * cw;
            const LAS unsigned char* const bufc = lds + bc * BUF; const LAS unsigned char* const facp = lds + L_FAC + bc * FACB;
            const size_t row0 = (size_t)b * SEQ + (size_t)i * 64;
            if (c_full) { const int ctid = cw * 64 + lane;
#pragma unroll
                for (int i2 = 0; i2 < 4; ++i2) ogreg[i2] = *(const v4u*)(F.P + (row0 + (ctid >> 2)) * NIN + gc + 32 * (ctid & 3) + 8 * i2); }
            bf16x8_t vB[2][2];
#pragma unroll
            for (int ks2 = 0; ks2 < 2; ++ks2)
#pragma unroll
                for (int n2 = 0; n2 < 2; ++n2) { const LAS unsigned char* vp = bufc + B_VV + (32 * ks2 + 8 * g + q4) * PV + 2 * (dv0 + 16 * n2 + 4 * p4);
                    const s16x4_t lo = tr16(vp), hi = tr16(vp + 4 * PV); vB[ks2][n2] = __builtin_shufflevector(lo, hi, 0, 1, 2, 3, 4, 5, 6, 7); }
            if (c_full) {
                f32x4 o[4][2];
#pragma unroll
                for (int mt = 0; mt < 4; ++mt) { o[mt][0] = (f32x4){0.f, 0.f, 0.f, 0.f}; o[mt][1] = (f32x4){0.f, 0.f, 0.f, 0.f};
#pragma unroll
                    for (int ks2 = 0; ks2 < 2; ++ks2) if (2 * ks2 <= mt) { const bf16x8_t a = *(const LAS bf16x8_t*)(lds + L_SC + (16 * mt + m) * PT + 64 * ks2 + 16 * g);
                        o[mt][0] = MFMA16(a, vB[ks2][0], o[mt][0]); o[mt][1] = MFMA16(a, vB[ks2][1], o[mt][1]); } }
#pragma unroll
                for (int sg = 0; sg < NKS; ++sg) {
                    const f32x4 ea = *(const LAS f32x4*)(facp + 4 * (DK + 32 * sg + 4 * g)), eb4 = *(const LAS f32x4*)(facp + 4 * (DK + 32 * sg + 16 + 4 * g));
                    bf16x8_t sB[2];
#pragma unroll
                    for (int n2 = 0; n2 < 2; ++n2) { const f32x4 sa = S[2 * sg][n2] * ea, sb4 = S[2 * sg + 1][n2] * eb4;
                        sB[n2] = __builtin_bit_cast(bf16x8_t, (v4u){cvtpk(sa[0], sa[1]), cvtpk(sa[2], sa[3]), cvtpk(sb4[0], sb4[1]), cvtpk(sb4[2], sb4[3])}); }
#pragma unroll
                    for (int mt = 0; mt < 4; ++mt) { const LAS unsigned char* qp = bufc + B_QH + (16 * mt + m) * PQ + 2 * (32 * sg + 4 * g);
                        const s16x4_t lo = *(const LAS s16x4_t*)qp, hi = *(const LAS s16x4_t*)(qp + 32); const bf16x8_t a = __builtin_shufflevector(lo, hi, 0, 1, 2, 3, 4, 5, 6, 7);
                        o[mt][0] = MFMA16(a, sB[0], o[mt][0]); o[mt][1] = MFMA16(a, sB[1], o[mt][1]); }
                    asm volatile("" ::: "memory"); }
#pragma unroll
                for (int mt = 0; mt < 4; ++mt)
#pragma unroll
                    for (int n2 = 0; n2 < 2; ++n2)
#pragma unroll
                        for (int j = 0; j < 4; ++j) *(LAS float*)(lds + L_OB + (16 * mt + 4 * g + j) * PO + 4 * (dv0 + 16 * n2 + m)) = o[mt][n2][j];
            }
#pragma unroll
            for (int mtile = 0; mtile < NMT; ++mtile) {
                bf16x8_t ka[2];
#pragma unroll
                for (int ks2 = 0; ks2 < 2; ++ks2) { const LAS unsigned char* kp = bufc + B_KH + (32 * ks2 + 8 * g + q4) * PQ + 2 * (16 * mtile + 4 * p4);
                    const s16x4_t lo = tr16(kp), hi = tr16(kp + 4 * PQ); ka[ks2] = __builtin_shufflevector(lo, hi, 0, 1, 2, 3, 4, 5, 6, 7); }
                const f32x4 d4 = *(const LAS f32x4*)(facp + 4 * (16 * mtile + 4 * g)), l4 = *(const LAS f32x4*)(facp + 4 * (2 * DK + 16 * mtile + 4 * g));
#pragma unroll
                for (int n2 = 0; n2 < 2; ++n2) { f32x4 u4 = {0.f, 0.f, 0.f, 0.f}; u4 = MFMA16(ka[0], vB[0][n2], u4); u4 = MFMA16(ka[1], vB[1][n2], u4); S[mtile][n2] = S[mtile][n2] * d4 + u4 * l4; }
                if (mtile & 1) asm volatile("" ::: "memory"); }
        }
        LBAR();
        if (producer) {
            if (p_on && p_full) {
                MP_LANE(); const int m = lane & 15, g = lane >> 4, sb = pw;
                const LAS unsigned char* const bufp = lds + bp * BUF;
                bf16x8_t kf[NKS];
#pragma unroll
                for (int ks = 0; ks < NKS; ++ks) kf[ks] = *(const LAS bf16x8_t*)(bufp + B_KH + (16 * sb + m) * PQ + 64 * ks + 16 * g);
                for (int tb = sb; tb < 4; ++tb) { f32x4 acc = {0.f, 0.f, 0.f, 0.f};
#pragma unroll
                    for (int ks = 0; ks < NKS; ++ks) { const bf16x8_t a = *(const LAS bf16x8_t*)(bufp + B_QH + (16 * tb + m) * PQ + 64 * ks + 16 * g); acc = MFMA16(a, kf[ks], acc); }
#pragma unroll
                    for (int j = 0; j < 4; ++j) { const int t = 16 * tb + 4 * g + j, s = 16 * sb + m; const float val = (s <= t) ? acc[j] : 0.f;
                        *(LAS unsigned short*)(lds + L_SC + t * PT + 2 * s) = (unsigned short)f2bf(val); } }
            }
        } else if (c_on && c_full) {
            MP_LANE(); const int ctid = cw * 64 + lane, nt = ctid >> 2, ndq = ctid & 3;
            const size_t row0 = (size_t)b * SEQ + (size_t)i * 64;
            f32x4 ov[8]; float ss = 0.f;
#pragma unroll
            for (int i2 = 0; i2 < 8; ++i2) { ov[i2] = *(const LAS f32x4*)(lds + L_OB + nt * PO + 128 * ndq + 16 * i2); ss += (ov[i2][0] * ov[i2][0] + ov[i2][1] * ov[i2][1]) + (ov[i2][2] * ov[i2][2] + ov[i2][3] * ov[i2][3]); }
            ss += __shfl_xor(ss, 1); ss += __shfl_xor(ss, 2);
            const float rn = __builtin_amdgcn_rsqf(ss * (1.0f / 128.0f) + EPS);
            bf16* op = F.O + (row0 + nt) * D + oc + 32 * ndq;
#pragma unroll
            for (int i4 = 0; i4 < 4; ++i4) { unsigned ow[4];
#pragma unroll
                for (int hh = 0; hh < 2; ++hh) { const int i2 = 2 * i4 + hh; const f32x4 gn4 = *(const f32x4*)(gnp + 32 * ndq + 4 * i2); const unsigned g01 = ogreg[i4][2 * hh], g23 = ogreg[i4][2 * hh + 1];
                    const float ga = bflo(g01), gb = bfhi(g01), gcc = bflo(g23), gd = bfhi(g23);
                    const float r0 = ov[i2][0] * rn * gn4[0] * (ga * __builtin_amdgcn_rcpf(1.0f + __builtin_amdgcn_exp2f(-ga * L2E))), r1 = ov[i2][1] * rn * gn4[1] * (gb * __builtin_amdgcn_rcpf(1.0f + __builtin_amdgcn_exp2f(-gb * L2E)));
                    const float r2 = ov[i2][2] * rn * gn4[2] * (gcc * __builtin_amdgcn_rcpf(1.0f + __builtin_amdgcn_exp2f(-gcc * L2E))), r3 = ov[i2][3] * rn * gn4[3] * (gd * __builtin_amdgcn_rcpf(1.0f + __builtin_amdgcn_exp2f(-gd * L2E)));
                    ow[2 * hh] = cvtpk(r0, r1); ow[2 * hh + 1] = cvtpk(r2, r3); }
                *(v4u*)(op + 8 * i4) = (v4u){ow[0], ow[1], ow[2], ow[3]}; }
        }
        LBAR();
    }
#undef MP_LOAD_RAW
#undef MP_LANE
}
#ifndef MX_N0
#define MX_N0 42
#endif
__device__ __forceinline__ void mixer_phase_pipe(Frame& F, int l) {
#if MX_SPLIT
    for (int it = blockIdx.x; it < 256; it += F.G) { const int s = it & 63, seg = (it >> 6) & 1;
        if (it < 128) mixer_pipe_stream<128, true>(F, l, s >> 2, s & 3, 0, seg ? MX_N0 : 0, seg ? SEQ / 64 : MX_N0);
        else mixer_pipe_stream<64, false>(F, l, s >> 2, s & 3, 0, seg ? MX_N0 : 0, seg ? SEQ / 64 : MX_N0); }
#else
    for (int it = blockIdx.x; it < 128; it += F.G) { const int s = it & 63;
        if (it < 64) mixer_pipe_stream<128, true>(F, l, s >> 2, s & 3, 0, 0, SEQ / 64);
        else mixer_pipe_stream<64, false>(F, l, s >> 2, s & 3, 0, 0, SEQ / 64); }
#endif
}
__device__ __forceinline__ void fix_phase(Frame& F, int l) {
    const int gt = F.vcu * (NWAVES * 64) + F.tid, NGT = F.G * NWAVES * 64;
    const float* cw = F.SMALL + SM_CW + l * 3 * NUP; const float* cb = F.SMALL + SM_CB + l * NUP;
    for (int i = gt; i < 256 * FF; i += NGT) { const int pm = i / FF, f = i % FF; if ((pm & 15) == 0) continue;
        const int ca = 256 * (f >> 7) + (f & 127), cv = ca + 128;
        const float* T = F.RAWT + (size_t)(pm - 1) * 2 * NUP; const float* H = F.RAWH + (size_t)pm * 2 * NUP;
        const float a_m2 = T[ca], a_m1 = T[NUP + ca], a_0 = H[ca], a_1 = H[NUP + ca], v_m2 = T[cv], v_m1 = T[NUP + cv], v_0 = H[cv], v_1 = H[NUP + cv];
        const float wa0 = cw[ca], wa1 = cw[NUP + ca], wa2 = cw[2 * NUP + ca], wv0 = cw[cv], wv1 = cw[NUP + cv], wv2 = cw[2 * NUP + cv], ba = cb[ca], bv = cb[cv];
        const float ca0 = ba + wa0 * a_m2 + wa1 * a_m1 + wa2 * a_0, cv0 = bv + wv0 * v_m2 + wv1 * v_m1 + wv2 * v_0;
        const float ca1 = ba + wa0 * a_m1 + wa1 * a_0 + wa2 * a_1, cv1 = bv + wv0 * v_m1 + wv1 * v_0 + wv2 * v_1;
        bf16* g = F.Gb + (size_t)pm * 256 * FF + f;
        g[0] = (bf16)f2bf(ca0 * sigmoid_f(ca0) * cv0); g[FF] = (bf16)f2bf(ca1 * sigmoid_f(ca1) * cv1); }
}

__device__ __forceinline__ void final_phase(Frame& F) {
    const int gw = F.vcu * NWAVES + F.wave, NGW = F.G * NWAVES;
    for (int row = gw; row < M; row += NGW) {
        GAS f32x4* xr = (GAS f32x4*)(F.out + (size_t)row * D) + F.lane;
        float ss = (F.lane < 16) ? F.STAT[(size_t)row * 16 + F.lane] : 0.f; ss = wave_sum(ss);
        const float r = 1.0f / sqrtf(ss * (1.0f / (float)D) + EPS);
#pragma unroll
        for (int j = 0; j < 4; ++j) { const f32x4 v = xr[64 * j]; const f32x4 g = *(const f32x4*)(F.lnf_g + 256 * j + 4 * F.lane); xr[64 * j] = v * r * g; }
    }
}

#ifndef STAGGER_US
#define STAGGER_US 0
#endif
__device__ __forceinline__ void stagger(int idx) {
    if (STAGGER_US > 0) { const unsigned long long t0 = __builtin_amdgcn_s_memrealtime(), dt = (unsigned long long)(idx & 15) * (100ull * STAGGER_US);
        while (__builtin_amdgcn_s_memrealtime() - t0 < dt) __builtin_amdgcn_s_sleep(8); }
}
struct Args { const float* in[18]; float* out; unsigned char* ws; int ph_lo, ph_hi; };
__global__ void __launch_bounds__(NWAVES * 64, 2) fwd(Args args) {
    extern __shared__ __attribute__((aligned(16))) unsigned char lds[];
    Frame F;
    F.lds = (LAS unsigned char*)lds; F.MISC = (volatile LAS unsigned*)(F.lds + MISC_OFF);
    F.tid = threadIdx.x; F.lane = F.tid & 63; F.wave = __builtin_amdgcn_readfirstlane(F.tid >> 6);
    F.G = gridDim.x; { const int bx = blockIdx.x; F.vcu = (F.G % 8 == 0) ? (bx % 8) * (F.G / 8) + bx / 8 : bx; }
    unsigned char* ws = args.ws;
    F.ctl = (unsigned*)(ws + WS_CTL);
    F.x = args.in[0]; F.c = args.in[1]; F.ln1_g = args.in[2]; F.ln2_g = args.in[3]; F.w_ada = args.in[4]; F.b_ada = args.in[5]; F.w_in = args.in[6]; F.lb_params = args.in[7];
    F.w_gk = args.in[8]; F.b_gk = args.in[9]; F.gn_a = args.in[10]; F.gn_b = args.in[11]; F.w_out = args.in[12]; F.w_up = args.in[13]; F.conv_w = args.in[14]; F.conv_b = args.in[15];
    F.w_down = args.in[16]; F.lnf_g = args.in[17]; F.out = args.out;
    F.MOD = (float*)(ws + WS_MOD); F.SMALL = (float*)(ws + WS_SMALL); F.STAT = (float*)(ws + WS_STAT); F.RAWH = (float*)(ws + WS_RAWH); F.RAWT = (float*)(ws + WS_RAWT);
    F.WIN = (bf16*)(ws + WS_WIN); F.WOUT = (bf16*)(ws + WS_WOUT); F.WUP = (bf16*)(ws + WS_WUP); F.WDN = (bf16*)(ws + WS_WDN);
    F.XN = (bf16*)(ws + WS_XN); F.O = (bf16*)(ws + WS_O); F.P = (bf16*)(ws + WS_P); F.Gb = (bf16*)(ws + WS_P);
#ifdef PROBE_ZERO_ALL
    for (int u = F.tid; u < LDSCTL_OFF / 4; u += NWAVES * 64) ((LAS unsigned*)(F.lds))[u] = 0u;
#endif
    for (int u = F.tid; u < (LDS_BYTES - LDSCTL_OFF) / 4; u += NWAVES * 64) ((LAS unsigned*)(F.lds + LDSCTL_OFF))[u] = 0u;
    __syncthreads();
    const int lo = args.ph_lo, hi = args.ph_hi;
    XcdBarrier bar; bar.bar = F.ctl + CW_BAR; bar.x = 0; bar.st = nullptr;
    if (hi - lo > 1) bar = xcd_barrier_post(F.ctl + CW_BAR, F.MISC + 8);
#define IN(k) (lo <= (k) && (k) < hi)
#ifndef PH_MASK
#define PH_MASK 0x1ff
#endif
#define PHM(b) ((PH_MASK >> (b)) & 1)
#define SEAM(k) do { if (IN(k) && IN((k) + 1)) { int l0_; asm volatile("v_mbcnt_lo_u32_b32 %0, -1, 0\n\tv_mbcnt_hi_u32_b32 %0, -1, %0" : "=v"(l0_)); xcd_barrier(bar, F.wave == 0 && l0_ == 0); } } while (0)
    if (PHM(0) && IN(0)) p0a(F);
    SEAM(0);
    if (PHM(1) && IN(1)) p0b(F);
    SEAM(1);
#ifdef PROBE_PRO2
    p0a(F); SEAM(0); p0b(F); SEAM(1);
#endif
    for (int l = 0; l < DEPTH; ++l) {
        const int pb = 2 + 6 * l;
#define LAUNDER_TID() do { int l_; asm volatile("v_mbcnt_lo_u32_b32 %0, -1, 0\n\tv_mbcnt_hi_u32_b32 %0, -1, %0" : "=v"(l_)); F.lane = l_; F.tid = F.wave * 64 + l_; } while (0)
        if (PHM(2) && IN(pb)) {
            LAUNDER_TID(); stagger((int)blockIdx.x);
#ifdef PROBE_KDUP
            typedef pg8::DupOrder InOrder;
#else
            typedef pg8::StaticOrder InOrder;
#endif
            pg8::Gemm g{F.XN, F.WIN + (size_t)l * NIN * 1024, M, NIN, D}; InOrder S; S.init(M, NIN, F.G, (int)blockIdx.x);
            pg8::EpiIn E{F.P, F.SMALL + SM_B1 + l * 16 * NIN, F.STAT};
            pg8::gemm_phase<pg8::EpiIn, InOrder, true, true>(F.lds, g, S, E, F.tid);
#ifdef PROBE_KLOOP
            { __syncthreads(); LAUNDER_TID(); pg8::EpiNull EN; pg8::gemm_phase<pg8::EpiNull, pg8::StaticOrder, true, true>(F.lds, g, S, EN, F.tid); }
#endif
#ifdef PROBE_IN2
            __syncthreads(); LAUNDER_TID(); pg8::gemm_phase<pg8::EpiIn, InOrder, true, true>(F.lds, g, S, E, F.tid);
#endif
        }
        SEAM(pb);
        if (PHM(3) && IN(pb + 1)) { LAUNDER_TID(); MIXER_PHASE(F, l);
#ifdef PROBE_MIX2
            __syncthreads(); LAUNDER_TID(); MIXER_PHASE(F, l);
#endif
        }
        SEAM(pb + 1);
        if (PHM(4) && IN(pb + 2)) {
            LAUNDER_TID(); stagger((int)blockIdx.x);
            pg8::Gemm g{F.O, F.WOUT + (size_t)l * 1024 * 1024, M, D, D}; pg8::StaticOrder S; S.init(M, D, F.G, (int)blockIdx.x);
            pg8::EpiXUpd E{l == 0 ? F.x : F.out, F.out, F.XN, F.SMALL + SM_GT1 + l * 16 * D, F.SMALL + SM_GS2 + l * 16 * D, F.STAT};
            pg8::gemm_phase<pg8::EpiXUpd, pg8::StaticOrder, true, true>(F.lds, g, S, E, F.tid);
        }
        SEAM(pb + 2);
        if (PHM(5) && IN(pb + 3)) {
            LAUNDER_TID(); stagger((int)blockIdx.x);
            pg8::Gemm g{F.XN, F.WUP + (size_t)l * NUP * 1024, M, NUP, D}; pg8::StaticOrder S; S.init(M, NUP, F.G, (int)blockIdx.x);
            pg8::EpiUp E{F.Gb, F.SMALL + SM_B2 + l * 16 * NUP, F.STAT, F.SMALL + SM_CW + l * 3 * NUP, F.SMALL + SM_CB + l * NUP, F.RAWH, F.RAWT, (LAS float*)(F.lds + HALO_OFF)};
            pg8::gemm_phase<pg8::EpiUp, pg8::StaticOrder, true, true>(F.lds, g, S, E, F.tid);
#ifdef PROBE_UP2
            __syncthreads(); LAUNDER_TID(); pg8::gemm_phase<pg8::EpiUp, pg8::StaticOrder, true, true>(F.lds, g, S, E, F.tid);
#endif
        }
        SEAM(pb + 3);
        if (PHM(6) && IN(pb + 4)) { LAUNDER_TID(); fix_phase(F, l); }
        SEAM(pb + 4);
        if (PHM(7) && IN(pb + 5)) {
            LAUNDER_TID(); stagger((int)blockIdx.x);
            pg8::Gemm g{F.Gb, F.WDN + (size_t)l * 1024 * FF, M, D, FF}; pg8::StaticOrder S; S.init(M, D, F.G, (int)blockIdx.x);
            pg8::EpiXUpd E{F.out, F.out, l + 1 < DEPTH ? F.XN : (bf16*)nullptr, F.SMALL + SM_GT2 + l * 16 * D, F.SMALL + SM_GS1 + (l + 1 < DEPTH ? l + 1 : l) * 16 * D, F.STAT};
            pg8::gemm_phase<pg8::EpiXUpd, pg8::StaticOrder, true, true>(F.lds, g, S, E, F.tid);
        }
        SEAM(pb + 5);
    }
    if (PHM(8) && IN(N_PHASES - 1)) { LAUNDER_TID(); final_phase(F); }
#undef IN
#undef SEAM
}

extern "C" void kernel_launch(void* const* d_in, const int* in_sizes, int n_in, void* d_out, int out_size, void* d_ws, size_t ws_size, hipStream_t stream) {
    static int grid = 0;
    if (grid == 0) {
        if (n_in != 18 || in_sizes[0] != M * D || out_size != M * D || ws_size < WS_END) { fprintf(stderr, "kernel_launch: unexpected shapes / workspace (n_in %d, in0 %d, out %d, ws %zu < %zu); nothing launched\n", n_in, n_in > 0 ? in_sizes[0] : -1, out_size, ws_size, (size_t)WS_END); grid = -1; return; }
        int dev = 0, cus = 0, per_cu = 0;
        if (hipGetDevice(&dev) != hipSuccess || hipDeviceGetAttribute(&cus, hipDeviceAttributeMultiprocessorCount, dev) != hipSuccess) { grid = -1; return; }
        if (hipFuncSetAttribute((const void*)fwd, hipFuncAttributeMaxDynamicSharedMemorySize, LDS_BYTES) != hipSuccess) { fprintf(stderr, "kernel_launch: hipFuncSetAttribute failed\n"); grid = -1; return; }
        if (hipOccupancyMaxActiveBlocksPerMultiprocessor(&per_cu, (const void*)fwd, NWAVES * 64, LDS_BYTES) != hipSuccess || per_cu < 1) { fprintf(stderr, "kernel_launch: occupancy query says %d\n", per_cu); }
        (void)hipGetLastError();
        grid = cus;
    }
    if (grid < 0) return;
#ifdef PROBE_ZERO_ALL
    if (hipMemsetAsync((char*)d_ws, 0, WS_END, stream) != hipSuccess) return;
#endif
    if (hipMemsetAsync((char*)d_ws + WS_CTL, 0, CTL_ZERO_BYTES, stream) != hipSuccess) return;
    Args a{};
    for (int i = 0; i < 18; ++i) a.in[i] = (const float*)d_in[i];
    a.out = (float*)d_out; a.ws = (unsigned char*)d_ws;
#if MK_PER_PHASE
    for (int p = 0; p < N_PHASES; ++p) { a.ph_lo = p; a.ph_hi = p + 1; hipLaunchKernelGGL(fwd, dim3(grid), dim3(NWAVES * 64), LDS_BYTES, stream, a); }
#else
    a.ph_lo = 0; a.ph_hi = N_PHASES; hipLaunchKernelGGL(fwd, dim3(grid), dim3(NWAVES * 64), LDS_BYTES, stream, a);
#endif
}
```

```cpp
#include <hip/hip_runtime.h>
#include <cstdio>
#include <cstdint>
namespace pg8 {
#define PG8_LAS __attribute__((address_space(3)))
typedef unsigned short bf16_t;
typedef short bf16x8 __attribute__((ext_vector_type(8)));
typedef float f32x4 __attribute__((ext_vector_type(4)));
typedef unsigned u32x4 __attribute__((ext_vector_type(4)));
constexpr int BM = 256, BK = 64, HALF = 128, HTB = HALF * BK * 2  , STAGE_BYTES = 8 * HTB, NXCD = 8, WGM = 4;

__host__ __device__ __forceinline__ int lds_byte(int r, int c) { const int st = (r >> 4) * 2 + (c >> 5), rr = r & 15, cc = c & 31, ob = rr * 64 + cc * 2; return st * 1024 + (ob ^ (((ob >> 9) & 1) << 5)); }
__host__ __device__ __forceinline__ void stage_rc(int b, int& R, int& C) { const int st = b / 1024, sb = b % 1024, swz = sb ^ (((sb >> 9) & 1) << 5); R = (st >> 1) * 16 + swz / 64; C = (st & 1) * 32 + (swz % 64) / 2; }
__host__ __device__ __forceinline__ int perm32(int rho) { const int n = rho >> 4, i = rho & 15; return 8 * (i >> 2) + 4 * n + (i & 3); }

struct Unit { int pm, pn; };
struct Gemm { const bf16_t* A; const bf16_t* Bt; int M, N, K; };

struct StaticOrder {
    int nM, nN, nwg, G, c;
    __host__ __device__ void init(int M, int N, int G_, int c_) { nM = M / BM; nN = N / BM; nwg = nM * nN; G = G_; c = c_; }
    __host__ __device__ bool next(int i, Unit& u) const {
        const long L = (long)i * G + c; if (L >= nwg) return false;
        int wgid = (int)L; { const int q = nwg / NXCD, r = nwg % NXCD, xcd = wgid % NXCD, off = wgid / NXCD; wgid = (xcd < r ? xcd * (q + 1) : r * (q + 1) + (xcd - r) * q) + off; }
        const int nig = WGM * nN, gid = wgid / nig, fm = gid * WGM, gsz = (nM - fm) < WGM ? (nM - fm) : WGM;
        u.pm = fm + ((wgid % nig) % gsz); u.pn = (wgid % nig) / gsz; return true;
    }
    __device__ __forceinline__ void a_ready(const Unit&) const {}
    __device__ __forceinline__ void done(const Unit&) const {}
};


__device__ __forceinline__ unsigned cvt_pk_bf16(float lo, float hi) { unsigned r; asm volatile("v_cvt_pk_bf16_f32 %0, %1, %2" : "=v"(r) : "v"(lo), "v"(hi)); return r; }
typedef unsigned u32x2 __attribute__((ext_vector_type(2)));
constexpr int EPI_LDS_OFF = 143360;
__device__ __forceinline__ void dma16(const void* gsrc_lane, PG8_LAS unsigned char* dst_wave) { __builtin_amdgcn_global_load_lds((const unsigned*)gsrc_lane, (PG8_LAS unsigned*)dst_wave, 16, 0, 0); }
constexpr int ROWS_PER_SEQ_TILES = 16;
constexpr float RMS_EPS = 1e-6f;
constexpr int D_MODEL = 1024, N_IN = 3840, N_UP = 5632, N_FF = 2816;

struct EpiIn {
    static constexpr bool PERM = true, AFTER_DRAIN = false; static constexpr int NPF = 3;
    bf16_t* P; const float* bias; const float* stat;
    __device__ __forceinline__ void prefetch(PG8_LAS unsigned char* epi, const Unit& u, int wid, int lane) const {
        const char* sp = (const char*)(stat + (size_t)(u.pm * BM + 32 * wid) * 16) + 16 * lane;
        dma16(sp, epi + 2048 * wid); dma16(sp + 1024, epi + 2048 * wid + 1024);
        dma16((const char*)(bias + (size_t)(u.pm / ROWS_PER_SEQ_TILES) * N_IN + u.pn * BM) + 16 * lane, epi + 16384);
    }
    __device__ __forceinline__ void operator()(f32x4 (&acc)[2][2][4][2], PG8_LAS unsigned char* epi, const Unit& u, int wr, int wc, int fr, int fq) const {
        const int row0 = u.pm * BM + wr * 64 + fr, col0 = u.pn * BM + wc * 32 + 8 * fq;
        struct { f32x4 sp[2][4], bv[2][2]; } pf;
#pragma unroll
        for (int ai = 0; ai < 2; ++ai)
#pragma unroll
            for (int m = 0; m < 4; ++m) pf.sp[ai][m] = *(const PG8_LAS f32x4*)(epi + ((ai * HALF + wr * 64 + m * 16 + fr) * 16 + 4 * fq) * 4);
#pragma unroll
        for (int bj = 0; bj < 2; ++bj)
#pragma unroll
            for (int n = 0; n < 2; ++n) pf.bv[bj][n] = *(const PG8_LAS f32x4*)(epi + 16384 + (wc * 32 + 8 * fq + bj * HALF + 4 * n) * 4);
#pragma unroll
        for (int ai = 0; ai < 2; ++ai)
#pragma unroll
            for (int m = 0; m < 4; ++m) { const int row = row0 + ai * HALF + m * 16;
                float s = (pf.sp[ai][m][0] + pf.sp[ai][m][1]) + (pf.sp[ai][m][2] + pf.sp[ai][m][3]); s += __shfl_xor(s, 16); s += __shfl_xor(s, 32);
                const float r = __builtin_amdgcn_rsqf(s * (1.0f / (float)D_MODEL) + RMS_EPS);
                bf16_t* rowp = P + (size_t)row * N_IN + col0;
#pragma unroll
                for (int bj = 0; bj < 2; ++bj) { const f32x4 v0 = acc[ai][bj][m][0] * r + pf.bv[bj][0], v1 = acc[ai][bj][m][1] * r + pf.bv[bj][1];
                    u32x4 w; w.x = cvt_pk_bf16(v0[0], v0[1]); w.y = cvt_pk_bf16(v0[2], v0[3]); w.z = cvt_pk_bf16(v1[0], v1[1]); w.w = cvt_pk_bf16(v1[2], v1[3]);
                    *(u32x4*)(rowp + bj * HALF) = w; } }
    }
};

struct EpiXUpd {
    static constexpr bool PERM = true, AFTER_DRAIN = false; static constexpr int NPF = 2;
    const float* xold; float* xnew; bf16_t* XN; const float* gt; const float* gsn; float* stat;
    __device__ __forceinline__ void prefetch(PG8_LAS unsigned char* epi, const Unit& u, int wid, int lane) const {
        const size_t o = (size_t)(u.pm / ROWS_PER_SEQ_TILES) * D_MODEL + u.pn * BM;
        dma16((const char*)(gt + o) + 16 * lane, epi); dma16((const char*)(gsn + o) + 16 * lane, epi + 1024);
    }
    __device__ __forceinline__ void operator()(f32x4 (&acc)[2][2][4][2], PG8_LAS unsigned char* epi, const Unit& u, int wr, int wc, int fr, int fq) const {
        const int row0 = u.pm * BM + wr * 64 + fr, col0 = u.pn * BM + wc * 32 + 8 * fq;
        f32x4 g[2][2], s[2][2];
#pragma unroll
        for (int bj = 0; bj < 2; ++bj)
#pragma unroll
            for (int n = 0; n < 2; ++n) { g[bj][n] = *(const PG8_LAS f32x4*)(epi + (wc * 32 + 8 * fq + bj * HALF + 4 * n) * 4); s[bj][n] = *(const PG8_LAS f32x4*)(epi + 1024 + (wc * 32 + 8 * fq + bj * HALF + 4 * n) * 4); }
#pragma unroll
        for (int ai = 0; ai < 2; ++ai)
#pragma unroll
            for (int m = 0; m < 4; ++m) { const int row = row0 + ai * HALF + m * 16; const size_t off = (size_t)row * D_MODEL + col0; float ss = 0.f;
#pragma unroll
                for (int bj = 0; bj < 2; ++bj) {
                    const f32x4 x0 = *(const f32x4*)(xold + off + bj * HALF) + g[bj][0] * acc[ai][bj][m][0], x1 = *(const f32x4*)(xold + off + bj * HALF + 4) + g[bj][1] * acc[ai][bj][m][1];
                    *(f32x4*)(xnew + off + bj * HALF) = x0; *(f32x4*)(xnew + off + bj * HALF + 4) = x1;
                    ss += (x0[0] * x0[0] + x0[1] * x0[1]) + (x0[2] * x0[2] + x0[3] * x0[3]) + (x1[0] * x1[0] + x1[1] * x1[1]) + (x1[2] * x1[2] + x1[3] * x1[3]);
                    if (XN) { const f32x4 y0 = x0 * s[bj][0], y1 = x1 * s[bj][1];
                        u32x4 w; w.x = cvt_pk_bf16(y0[0], y0[1]); w.y = cvt_pk_bf16(y0[2], y0[3]); w.z = cvt_pk_bf16(y1[0], y1[1]); w.w = cvt_pk_bf16(y1[2], y1[3]);
                        *(u32x4*)(XN + off + bj * HALF) = w; } }
                ss += __shfl_xor(ss, 16); ss += __shfl_xor(ss, 32);
                if (fq == 0) stat[(size_t)row * 16 + u.pn * 4 + wc] = ss; }
    }
};

__device__ __forceinline__ float dpp_ror1(float v) { return __builtin_bit_cast(float, __builtin_amdgcn_mov_dpp(__builtin_bit_cast(int, v), 0x121, 0xf, 0xf, true)); }
__device__ __forceinline__ float dpp_ror2(float v) { return __builtin_bit_cast(float, __builtin_amdgcn_mov_dpp(__builtin_bit_cast(int, v), 0x122, 0xf, 0xf, true)); }
__device__ __forceinline__ float dpp_shr1z(float v) { return __builtin_bit_cast(float, __builtin_amdgcn_update_dpp(0, __builtin_bit_cast(int, v), 0x111, 0xf, 0xf, true)); }
__device__ __forceinline__ float dpp_shr2z(float v) { return __builtin_bit_cast(float, __builtin_amdgcn_update_dpp(0, __builtin_bit_cast(int, v), 0x112, 0xf, 0xf, true)); }
__device__ __forceinline__ float silu_f(float x) { return x * __builtin_amdgcn_rcpf(1.0f + __builtin_amdgcn_exp2f(-1.4426950408889634f * x)); }
struct EpiUp {
    static constexpr bool PERM = true, AFTER_DRAIN = false; static constexpr int NPF = 4;
    bf16_t* G; const float* bias; const float* stat; const float* cw; const float* cb; float* rawh; float* rawt; PG8_LAS float* halo;
    __device__ __forceinline__ void prefetch(PG8_LAS unsigned char* epi, const Unit& u, int wid, int lane) const {
        const char* sp = (const char*)(stat + (size_t)(u.pm * BM + 32 * wid) * 16) + 16 * lane;
        dma16(sp, epi + 2048 * wid); dma16(sp + 1024, epi + 2048 * wid + 1024);
        dma16((const char*)(bias + (size_t)(u.pm / ROWS_PER_SEQ_TILES) * N_UP + u.pn * BM) + 16 * lane, epi + 16384);
        const int which = wid & 3;
        dma16((const char*)((which < 3 ? cw + which * N_UP : cb) + u.pn * BM) + 16 * lane, (PG8_LAS unsigned char*)(halo + 2048) + 1024 * which);
    }
    __device__ __forceinline__ void operator()(f32x4 (&acc)[2][2][4][2], PG8_LAS unsigned char* epi, const Unit& u, int wr, int wc, int fr, int fq) const {
        const int row0 = u.pm * BM + wr * 64 + fr, tc0 = wc * 32 + 8 * fq, col0 = u.pn * BM + tc0;
        PG8_LAS float* vecs = halo + 2048;
        f32x4 bv[2][2];
#pragma unroll
        for (int bj = 0; bj < 2; ++bj)
#pragma unroll
            for (int n = 0; n < 2; ++n) bv[bj][n] = *(const PG8_LAS f32x4*)(epi + 16384 + (tc0 + bj * HALF + 4 * n) * 4);
#pragma unroll
        for (int ai = 0; ai < 2; ++ai)
#pragma unroll
            for (int m = 0; m < 4; ++m) { const f32x4 sp = *(const PG8_LAS f32x4*)(epi + ((ai * HALF + wr * 64 + m * 16 + fr) * 16 + 4 * fq) * 4);
                float s = (sp[0] + sp[1]) + (sp[2] + sp[3]); s += __shfl_xor(s, 16); s += __shfl_xor(s, 32);
                const float r = __builtin_amdgcn_rsqf(s * (1.0f / (float)D_MODEL) + RMS_EPS);
#pragma unroll
                for (int bj = 0; bj < 2; ++bj)
#pragma unroll
                    for (int n = 0; n < 2; ++n) acc[ai][bj][m][n] = acc[ai][bj][m][n] * r + bv[bj][n];
                asm volatile("" : "+v"(acc[ai][0][m][0]), "+v"(acc[ai][0][m][1]), "+v"(acc[ai][1][m][0]), "+v"(acc[ai][1][m][1])); }
#pragma unroll
        for (int ai = 0; ai < 2; ++ai) {
            if (fr >= 14) {
                PG8_LAS float* hp = halo + ((ai * 2 + wr) * 2 + (fr - 14)) * 256 + tc0;
#pragma unroll
                for (int bj = 0; bj < 2; ++bj)
#pragma unroll
                    for (int n = 0; n < 2; ++n) *(PG8_LAS f32x4*)(hp + bj * HALF + 4 * n) = acc[ai][bj][3][n];
            }
        }
        if (wr == 0 && fr < 2) { float* hp = rawh + ((size_t)u.pm * 2 + fr) * N_UP + col0;
#pragma unroll
            for (int bj = 0; bj < 2; ++bj)
#pragma unroll
                for (int n = 0; n < 2; ++n) *(f32x4*)(hp + bj * HALF + 4 * n) = acc[0][bj][0][n]; }
        if (wr == 1 && fr >= 14) { float* tp = rawt + ((size_t)u.pm * 2 + (fr - 14)) * N_UP + col0;
#pragma unroll
            for (int bj = 0; bj < 2; ++bj)
#pragma unroll
                for (int n = 0; n < 2; ++n) *(f32x4*)(tp + bj * HALF + 4 * n) = acc[1][bj][3][n]; }
        asm volatile("s_waitcnt lgkmcnt(0)" ::: "memory"); __builtin_amdgcn_s_barrier(); asm volatile("" ::: "memory");
        const bool f15 = (fr == 15), f14 = (fr >= 14);
        unsigned gp[2][4][2];
#pragma unroll
        for (int n = 0; n < 2; ++n) {
            f32x4 w0[2], w1[2], w2[2], cbv[2];
#pragma unroll
            for (int bj = 0; bj < 2; ++bj) { const int c = tc0 + bj * HALF + 4 * n;
                w0[bj] = *(const PG8_LAS f32x4*)(vecs + c); w1[bj] = *(const PG8_LAS f32x4*)(vecs + 256 + c); w2[bj] = *(const PG8_LAS f32x4*)(vecs + 512 + c); cbv[bj] = *(const PG8_LAS f32x4*)(vecs + 768 + c); }
#pragma unroll
            for (int ai = 0; ai < 2; ++ai) {
                f32x4 prev[2];
                {   const int pai = (wr == 1) ? ai : ai - 1, pwr = (wr == 1) ? 0 : 1;
                    const bool has = (pai >= 0);
                    const PG8_LAS float* hp = halo + ((pai * 2 + pwr) * 2 + (fr & 1)) * 256 + tc0 + 4 * n;
#pragma unroll
                    for (int bj = 0; bj < 2; ++bj) prev[bj] = (has && fr >= 14) ? *(const PG8_LAS f32x4*)(hp + bj * HALF) : (f32x4){0.f, 0.f, 0.f, 0.f}; }
#pragma unroll
                for (int m = 0; m < 4; ++m) {
                    f32x4 cu[2];
#pragma unroll
                    for (int bj = 0; bj < 2; ++bj) { const f32x4 cur = acc[ai][bj][m][n], pv = prev[bj]; f32x4 o;
#pragma unroll
                        for (int j = 0; j < 4; ++j) { const float s1 = dpp_ror1(f15 ? pv[j] : cur[j]), s2 = dpp_ror2(f14 ? pv[j] : cur[j]);
                            o[j] = cbv[bj][j] + w0[bj][j] * s2 + w1[bj][j] * s1 + w2[bj][j] * cur[j]; }
                        cu[bj] = o; prev[bj] = cur; }
                    f32x4 g;
#pragma unroll
                    for (int j = 0; j < 4; ++j) g[j] = silu_f(cu[0][j]) * cu[1][j];
                    const unsigned p0 = cvt_pk_bf16(g[0], g[1]), p1 = cvt_pk_bf16(g[2], g[3]);
                    if (n == 0) { gp[ai][m][0] = p0; gp[ai][m][1] = p1; }
                    else { u32x4 w; w.x = gp[ai][m][0]; w.y = gp[ai][m][1]; w.z = p0; w.w = p1;
                        *(u32x4*)(G + (size_t)(row0 + ai * HALF + m * 16) * N_FF + u.pn * HALF + tc0) = w; }
                }
            }
        }
    }
};
template <class Epi, class Sched, bool ALIGN_EPI = false, bool SP2 = false>
__device__ __forceinline__ void gemm_phase(PG8_LAS unsigned char* lds, const Gemm g, const Sched& S, const Epi& E, const int tid) {
    const int wid = __builtin_amdgcn_readfirstlane(tid >> 6), lane = tid & 63, wr = wid >> 2, wc = wid & 3, fr = lane & 15, fq = lane >> 4;
    const int K = g.K, nt = K / BK;
    unsigned voffA[2], voffB[2];
#pragma unroll
    for (int i = 0; i < 2; ++i) { int R, C; stage_rc(tid * 16 + i * 8192, R, C); const int Rb = Epi::PERM ? ((R & ~31) + perm32(R & 31)) : R;
        voffA[i] = (unsigned)(R * K + C) * 2u; voffB[i] = (unsigned)(Rb * K + C) * 2u; }
    const size_t kstep = (size_t)(BK * 2);
    const size_t hstep = (size_t)HALF * K * 2;
    const size_t tstep = 2 * hstep;
    const unsigned ldsw = (unsigned)wid * 1024u;
    const int aoff = lds_byte(wr * 64 + fr, fq * 8), boff = lds_byte(wc * 32 + fr, fq * 8);
#define PG8_SA(b, h) (((b) * 2 + (h)) * HTB)
#define PG8_SB(b, h) ((4 + (b) * 2 + (h)) * HTB)
#define PG8_STAGE(bufoff, gbase, voff) do { _Pragma("unroll") for (int _i = 0; _i < 2; ++_i) \
        __builtin_amdgcn_global_load_lds((const unsigned*)((const char*)(gbase) + (voff)[_i]), (PG8_LAS unsigned*)(lds + (bufoff) + ldsw + _i * 8192), 16, 0, 0); } while (0)
#define PG8_LDA(dst, b, h) do { _Pragma("unroll") for (int m = 0; m < 4; ++m) _Pragma("unroll") for (int k = 0; k < 2; ++k) dst[m][k] = *(const PG8_LAS bf16x8*)(lds + PG8_SA(b, h) + aoff + m * 2048 + k * 1024); } while (0)
#define PG8_LDB(dst, b, h) do { _Pragma("unroll") for (int n = 0; n < 2; ++n) _Pragma("unroll") for (int k = 0; k < 2; ++k) dst[n][k] = *(const PG8_LAS bf16x8*)(lds + PG8_SB(b, h) + boff + n * 2048 + k * 1024); } while (0)
#define PG8_MMA(ai, bj, At, Bt) do { __builtin_amdgcn_s_setprio(1); _Pragma("unroll") for (int m = 0; m < 4; ++m) _Pragma("unroll") for (int n = 0; n < 2; ++n) _Pragma("unroll") for (int k = 0; k < 2; ++k) \
        acc[ai][bj][m][n] = __builtin_amdgcn_mfma_f32_16x16x32_bf16(Bt[n][k], At[m][k], acc[ai][bj][m][n], 0, 0, 0); __builtin_amdgcn_s_setprio(0); } while (0)
#define PG8_WAIT_V(n) asm volatile("s_waitcnt vmcnt(" #n ")" ::: "memory")
#define PG8_WAIT_L(n) asm volatile("s_waitcnt lgkmcnt(" #n ")" ::: "memory")
#define PG8_BAR __builtin_amdgcn_s_barrier()
#define PG8_SCHED __builtin_amdgcn_sched_barrier(0)
    Unit cur, nxt; int ui = 0;
    if (!S.next(0, cur)) return;
    f32x4 acc[2][2][4][2];
#pragma unroll
    for (int a = 0; a < 2; ++a)
#pragma unroll
        for (int b = 0; b < 2; ++b)
#pragma unroll
            for (int m = 0; m < 4; ++m)
#pragma unroll
                for (int n = 0; n < 2; ++n) acc[a][b][m][n] = (f32x4){0.f, 0.f, 0.f, 0.f};
    bf16x8 At[4][2], B0[2][2], B1[2][2];
    const char* cA = (const char*)g.A + (size_t)cur.pm * tstep; const char* cB = (const char*)g.Bt + (size_t)cur.pn * tstep;
    S.a_ready(cur);
    if constexpr (SP2) {
        PG8_STAGE(PG8_SB(0, 0), cB, voffB); PG8_STAGE(PG8_SB(0, 1), cB + hstep, voffB); PG8_STAGE(PG8_SA(0, 0), cA, voffA); PG8_STAGE(PG8_SA(0, 1), cA + hstep, voffA);
        if (wr == 1) PG8_BAR;
        PG8_WAIT_V(2); PG8_BAR;
        PG8_STAGE(PG8_SB(1, 0), cB + kstep, voffB); PG8_STAGE(PG8_SA(1, 0), cA + kstep, voffA); PG8_STAGE(PG8_SB(1, 1), cB + hstep + kstep, voffB);
        PG8_WAIT_V(6); PG8_BAR;
    } else {
        PG8_STAGE(PG8_SB(0, 0), cB, voffB); PG8_STAGE(PG8_SA(0, 0), cA, voffA); PG8_STAGE(PG8_SB(0, 1), cB + hstep, voffB); PG8_STAGE(PG8_SA(0, 1), cA + hstep, voffA);
        if (wr == 1) PG8_BAR;
        PG8_WAIT_V(4); PG8_BAR;
        PG8_STAGE(PG8_SB(1, 0), cB + kstep, voffB); PG8_STAGE(PG8_SA(1, 0), cA + kstep, voffA); PG8_STAGE(PG8_SB(1, 1), cB + hstep + kstep, voffB);
        PG8_WAIT_V(6); PG8_BAR;
    }
    for (;;) {
        const bool has_next = S.next(ui + 1, nxt);
        const char* nA = has_next ? (const char*)g.A + (size_t)nxt.pm * tstep : cA; const char* nB = has_next ? (const char*)g.Bt + (size_t)nxt.pn * tstep : cB;
#define PG8_WAIT_VN(n) asm volatile("s_waitcnt vmcnt(%0)" :: "n"(n) : "memory")
#define PG8_TRIP(a1, a2, b2, a3, b3, PF) do { \
              \
            PG8_LDB(B0, 0, 0); PG8_LDB(B1, 0, 1); PG8_SCHED; PG8_LDA(At, 0, 0); PG8_STAGE(PG8_SA(1, 1), (a1) + hstep, voffA); \
            PG8_WAIT_V(8); PG8_WAIT_L(0); PG8_BAR; PG8_MMA(0, 0, At, B0); PG8_MMA(0, 1, At, B1); PG8_BAR; PG8_SCHED; \
              \
            PG8_LDA(At, 0, 1); PG8_STAGE(PG8_SB(0, 0), (b2), voffB); PG8_STAGE(PG8_SB(0, 1), (b2) + hstep, voffB); PG8_STAGE(PG8_SA(0, 0), (a2), voffA); \
            PG8_WAIT_V(8); PG8_WAIT_L(0); PG8_BAR; PG8_MMA(1, 0, At, B0); PG8_MMA(1, 1, At, B1); PG8_BAR; PG8_SCHED; \
            if (PF) { int lane_p; asm volatile("v_mbcnt_lo_u32_b32 %0, -1, 0\n\tv_mbcnt_hi_u32_b32 %0, -1, %0" : "=v"(lane_p)); E.prefetch(lds + EPI_LDS_OFF, cur, wid, lane_p); } \
              \
            PG8_LDB(B0, 1, 0); PG8_LDB(B1, 1, 1); PG8_SCHED; PG8_LDA(At, 1, 0); PG8_STAGE(PG8_SA(0, 1), (a2) + hstep, voffA); \
            if (PF) PG8_WAIT_VN(8 + Epi::NPF); else PG8_WAIT_V(8); PG8_WAIT_L(0); PG8_BAR; PG8_MMA(0, 0, At, B0); PG8_MMA(0, 1, At, B1); PG8_BAR; PG8_SCHED; \
              \
            PG8_LDA(At, 1, 1); PG8_STAGE(PG8_SB(1, 0), (b3), voffB); PG8_STAGE(PG8_SB(1, 1), (b3) + hstep, voffB); PG8_STAGE(PG8_SA(1, 0), (a3), voffA); \
            if (PF) PG8_WAIT_VN(8 + Epi::NPF); else PG8_WAIT_V(8); PG8_WAIT_L(0); PG8_BAR; PG8_MMA(1, 0, At, B0); PG8_MMA(1, 1, At, B1); PG8_BAR; PG8_SCHED; } while (0)
        static_assert(SP2, "this build keeps only the two-blocks-per-barrier K-loop");
        for (int t = 0; t < nt; t += 2) {
            const bool last = (t == nt - 2);
            const char* a1 = cA + (size_t)(t + 1) * kstep;
            const char* a2 = last ? nA : cA + (size_t)(t + 2) * kstep; const char* b2 = last ? nB : cB + (size_t)(t + 2) * kstep;
            if (last && has_next) S.a_ready(nxt);
            const bool pfl = last && (Epi::NPF > 0);
            PG8_TRIP(a1, a2, b2, a2 + kstep, b2 + kstep, pfl);
        }
#undef PG8_TRIP
#undef PG8_WAIT_VN
        if constexpr (ALIGN_EPI) { if (wr == 0) PG8_BAR; }
        if constexpr (Epi::NPF > 0) { asm volatile("s_waitcnt vmcnt(8)" ::: "memory"); PG8_BAR; asm volatile("" ::: "memory"); }
        if constexpr (!Epi::AFTER_DRAIN) { int lane_e; asm volatile("v_mbcnt_lo_u32_b32 %0, -1, 0\n\tv_mbcnt_hi_u32_b32 %0, -1, %0" : "=v"(lane_e));
            const int fr_e = lane_e & 15, fq_e = lane_e >> 4; int wr_e = wr, wc_e = wc; asm volatile("" : "+s"(wr_e), "+s"(wc_e));
            E(acc, lds + EPI_LDS_OFF, cur, wr_e, wc_e, fr_e, fq_e);
            S.done(cur); }
        if (!has_next) break;
#pragma unroll
        for (int a = 0; a < 2; ++a)
#pragma unroll
            for (int b = 0; b < 2; ++b)
#pragma unroll
                for (int m = 0; m < 4; ++m)
#pragma unroll
                    for (int n = 0; n < 2; ++n) acc[a][b][m][n] = (f32x4){0.f, 0.f, 0.f, 0.f};
        cur = nxt; cA = nA; cB = nB; ++ui;
        if constexpr (ALIGN_EPI) { if (wr == 1) PG8_BAR; }
    }
    PG8_WAIT_V(0);
    if constexpr (!ALIGN_EPI) { if (wr == 0) PG8_BAR; }
    PG8_BAR;
    if constexpr (Epi::AFTER_DRAIN) { E.fused(acc, cur, wr, wc, fr, fq, lds, wid, lane); S.done(cur); }
#undef PG8_SA
#undef PG8_SB
#undef PG8_STAGE
#undef PG8_LDA
#undef PG8_LDB
#undef PG8_MMA
#undef PG8_WAIT_V
#undef PG8_WAIT_L
#undef PG8_BAR
#undef PG8_SCHED
}
}

constexpr int NWAVES = 8;
#ifndef MK_PER_PHASE
#define MK_PER_PHASE 0
#endif
constexpr int NB = 16, SEQ = 4096, D = 1024, DEPTH = 4, M = NB * SEQ;
constexpr int NIN = 3840, NINW = 3584, FF = 2816, NUP = 5632, NMOD = 6144;
constexpr float EPS = 1e-6f;
constexpr int N_PHASES = 2 + 6 * DEPTH + 1;

constexpr size_t MiB = 1u << 20;
constexpr size_t WS_CTL = 0, CTL_ZERO_BYTES = 4 * MiB;
constexpr size_t WS_MOD = 2 * MiB;
constexpr size_t WS_SMALL = 4 * MiB;
constexpr size_t WS_STAT = 12 * MiB;
constexpr size_t WS_RAWH = 16 * MiB, WS_RAWT = 28 * MiB;
constexpr size_t WS_WIN = 40 * MiB;
constexpr size_t WS_WOUT = 70 * MiB;
constexpr size_t WS_WUP = 78 * MiB;
constexpr size_t WS_WDN = 122 * MiB;
constexpr size_t WS_XN = 144 * MiB;
constexpr size_t WS_O = 272 * MiB;
constexpr size_t WS_P = 400 * MiB;
constexpr size_t WS_END = 880 * MiB;
constexpr int SM_LB = 0;
constexpr int SM_CW = SM_LB + 4 * 512;
constexpr int SM_CB = SM_CW + 4 * 3 * NUP;
constexpr int SM_GS1 = SM_CB + 4 * NUP;
constexpr int SM_GS2 = SM_GS1 + 4 * 16 * D;
constexpr int SM_GT1 = SM_GS2 + 4 * 16 * D;
constexpr int SM_GT2 = SM_GT1 + 4 * 16 * D;
constexpr int SM_B1 = SM_GT2 + 4 * 16 * D;
constexpr int SM_B2 = SM_B1 + 4 * 16 * NIN;
constexpr int SM_END = SM_B2 + 4 * 16 * NUP;
static_assert((size_t)SM_END * 4 <= 8 * MiB, "small vectors fit");
constexpr int CW_BAR = 4096;

constexpr int LDS_BYTES = 163840;
constexpr int RING_BYTES = 131072, HALO_OFF = RING_BYTES, HALO_BYTES = 12288, LDSCTL_OFF = LDS_BYTES - 512, MISC_OFF = LDSCTL_OFF + 320;
static_assert(MISC_OFF + 128 <= LDS_BYTES && HALO_OFF + HALO_BYTES <= LDSCTL_OFF, "LDS map");

#define GAS __attribute__((address_space(1)))
#define LAS __attribute__((address_space(3)))
typedef unsigned short bf16;
typedef unsigned v4u __attribute__((ext_vector_type(4)));
typedef unsigned v2u __attribute__((ext_vector_type(2)));
typedef float f32x4 __attribute__((ext_vector_type(4)));
#define LDS_WAIT() asm volatile("s_waitcnt lgkmcnt(0)" ::: "memory")
__device__ __forceinline__ unsigned f2bf(float f) { unsigned u = __builtin_bit_cast(unsigned, f); return (u + 0x7fffu + ((u >> 16) & 1u)) >> 16; }
__device__ __forceinline__ unsigned pk2(float lo, float hi) { return f2bf(lo) | (f2bf(hi) << 16); }
__device__ __forceinline__ float bf2f(unsigned h) { return __builtin_bit_cast(float, h << 16); }
__device__ __forceinline__ float wave_sum(float v) {
#pragma unroll
    for (int o = 1; o < 64; o <<= 1) v += __shfl_xor(v, o);
    return v;
}
__device__ __forceinline__ float sigmoid_f(float x) { return 1.0f / (1.0f + __expf(-x)); }
#define XB_TMO      128
#define XB_XCNT(j)  (256  + 64 * (j))
#define XB_XSUB(j)  (1280 + 64 * (j))
#define XB_XGEN(j)  (2304 + 64 * (j))
#define XB_TOP      3328
#define XB_TOPGEN   3392
#define XCD_BAR_WORDS 3456
#define XB_SPIN_CAP (1u << 18)

__device__ __forceinline__ unsigned xb_ld(unsigned* p)              { return __hip_atomic_load(p, __ATOMIC_RELAXED, __HIP_MEMORY_SCOPE_AGENT); }
__device__ __forceinline__ unsigned xb_add(unsigned* p, unsigned v) { return __hip_atomic_fetch_add(p, v, __ATOMIC_RELAXED, __HIP_MEMORY_SCOPE_AGENT); }
__device__ __forceinline__ unsigned xb_xcc_id() { return (unsigned)__builtin_amdgcn_s_getreg((3 << 11) | 20) & 0xFu; }
#define XB_SPIN(cond, bar) do { unsigned _sp = 0; while (cond) { __builtin_amdgcn_s_sleep(1); \
    if ((++_sp & 255u) == 0u) { if (xb_ld(&(bar)[XB_TMO])) break; if (_sp > XB_SPIN_CAP) { atomicAdd(&(bar)[XB_TMO], 1u); break; } } } } while (0)

struct XcdBarrier {
    unsigned* bar; unsigned x;
    volatile LAS unsigned* st;
};

__device__ __forceinline__ XcdBarrier xcd_barrier_post(unsigned* bar, volatile LAS unsigned* st) {
    XcdBarrier b; b.bar = bar; b.x = xb_xcc_id(); b.st = st;
    if (threadIdx.x == 0) (void)xb_add(&bar[XB_XCNT(b.x)], 1u);
    return b;
}
__device__ __forceinline__ void xcd_barrier_complete(unsigned* bar, unsigned x, unsigned& nloc, unsigned& nx) {
    const unsigned G = gridDim.x * gridDim.y * gridDim.z;
    unsigned sum, cnt, mine, sp = 0u;
    for (;;) {
        sum = 0u; cnt = 0u; mine = 0u;
#pragma unroll
        for (unsigned j = 0; j < 16; ++j) { const unsigned c = xb_ld(&bar[XB_XCNT(j)]); sum += c; cnt += (c > 0u) ? 1u : 0u; mine = (j == x) ? c : mine; }
        if (sum == G) break;
        __builtin_amdgcn_s_sleep(1);
        if ((++sp & 255u) == 0u) { if (xb_ld(&bar[XB_TMO])) break; if (sp > XB_SPIN_CAP) { atomicAdd(&bar[XB_TMO], 1u); break; } }
    }
    nloc = mine > 0u ? mine : 1u; nx = cnt > 0u ? cnt : 1u;
}

__device__ __forceinline__ void xcd_barrier(const XcdBarrier& b, const bool is_t0  ) {
    asm volatile("s_waitcnt vmcnt(0)" ::: "memory");
    __syncthreads();
    if (is_t0) {
        unsigned* bar = b.bar;
        __builtin_amdgcn_s_waitcnt(0);
        unsigned nloc = b.st[0], nx = b.st[1];
        if (nloc == 0u) { xcd_barrier_complete(bar, b.x, nloc, nx); b.st[0] = nloc; b.st[1] = nx; }
        const unsigned old = xb_add(&bar[XB_XSUB(b.x)], 1u);
        const unsigned gen = old / nloc;
        if (old + 1u == (gen + 1u) * nloc) {
            __builtin_amdgcn_fence(__ATOMIC_RELEASE, "agent");
            asm volatile("s_waitcnt vmcnt(0)" ::: "memory");
            const unsigned og = xb_add(&bar[XB_TOP], 1u);
            const unsigned tg = og / nx;
            if (og + 1u == (tg + 1u) * nx) xb_add(&bar[XB_TOPGEN], 1u);
            else XB_SPIN(xb_ld(&bar[XB_TOPGEN]) == tg, bar);
            __builtin_amdgcn_fence(__ATOMIC_ACQUIRE, "agent");
            xb_add(&bar[XB_XGEN(b.x)], 1u);
            asm volatile("s_waitcnt vmcnt(0)" ::: "memory");
        } else {
            XB_SPIN(xb_ld(&bar[XB_XGEN(b.x)]) == gen, bar);
            __builtin_amdgcn_fence(__ATOMIC_ACQUIRE, "agent");
            asm volatile("s_waitcnt vmcnt(0)" ::: "memory");
        }
    }
    __syncthreads();
}

struct Frame {
    LAS unsigned char* lds;
    volatile LAS unsigned* MISC;
    unsigned* ctl;
    int tid, lane, wave, vcu, G;
    const float *x, *c, *ln1_g, *ln2_g, *w_ada, *b_ada, *w_in, *lb_params, *w_gk, *b_gk, *gn_a, *gn_b, *w_out, *w_up, *conv_w, *conv_b, *w_down, *lnf_g;
    float* out;
    float *MOD, *SMALL, *STAT, *RAWH, *RAWT;
    bf16 *WIN, *WOUT, *WUP, *WDN, *XN, *O, *P, *Gb;
};

__device__ __forceinline__ void tr_item(const float* W, int Nsrc, int K, bf16* WT, int kb, int sn0, int dn0, float scale, LAS float* scr, int lane) {
    const int k0 = 64 * kb;
#pragma unroll 8
    for (int i = 0; i < 32; ++i) { const int kk = 2 * i + (lane >> 5); scr[kk * 33 + (lane & 31)] = W[(size_t)(k0 + kk) * Nsrc + sn0 + (lane & 31)]; }
    LDS_WAIT(); asm volatile("" ::: "memory");
    const int c = lane & 7;
#pragma unroll
    for (int j = 0; j < 4; ++j) { const int n = (lane >> 3) + 8 * j; const LAS float* s = scr + (8 * c) * 33 + n;
        v4u o; o.x = pk2(s[0 * 33] * scale, s[1 * 33] * scale); o.y = pk2(s[2 * 33] * scale, s[3 * 33] * scale); o.z = pk2(s[4 * 33] * scale, s[5 * 33] * scale); o.w = pk2(s[6 * 33] * scale, s[7 * 33] * scale);
        *(GAS v4u*)(WT + (size_t)(dn0 + n) * K + k0 + 8 * c) = o; }
    LDS_WAIT(); asm volatile("" ::: "memory");
}
__host__ __device__ __forceinline__ int up_orig(int np) { return ((np & 255) >> 7) * FF + 128 * (np >> 8) + (np & 127); }

__device__ __forceinline__ void p0a(Frame& F) {
    const int gw = F.vcu * NWAVES + F.wave, NGW = F.G * NWAVES, gt = F.vcu * (NWAVES * 64) + F.tid, NGT = F.G * NWAVES * 64;
    {
        LAS float* cond = (LAS float*)F.lds;
        for (int e = F.tid; e < 16 * 1024; e += NWAVES * 64) { const int b = e >> 10, d = e & 1023; const float cv = F.c[b * 1024 + d]; cond[d * 16 + b] = cv * sigmoid_f(cv); }
        __syncthreads();
        for (int it = gw; it < DEPTH * 384; it += NGW) {
            const int cb = it % 384, l = it / 384, e = cb * 16 + (F.lane & 15), dq = F.lane >> 4;
            const float* w = F.w_ada + ((size_t)l * 1024 + dq) * NMOD + e;
            float acc[16];
#pragma unroll
            for (int b = 0; b < 16; ++b) acc[b] = 0.f;
#pragma unroll 4
            for (int dd = 0; dd < 256; ++dd) {
                const float wv = w[(size_t)(4 * dd) * NMOD];
                const LAS f32x4* cp = (const LAS f32x4*)(cond + (4 * dd + dq) * 16);
#pragma unroll
                for (int q = 0; q < 4; ++q) { const f32x4 cq = cp[q]; acc[4 * q] += cq[0] * wv; acc[4 * q + 1] += cq[1] * wv; acc[4 * q + 2] += cq[2] * wv; acc[4 * q + 3] += cq[3] * wv; }
            }
            const float bb = F.b_ada[l * NMOD + e];
#pragma unroll
            for (int b = 0; b < 16; ++b) { float v = acc[b]; v += __shfl_xor(v, 16); v += __shfl_xor(v, 32); if (dq == 0) F.MOD[(size_t)(l * 16 + b) * NMOD + e] = v + bb; }
        }
        __syncthreads();
    }
    for (int i = gt; i < 512; i += NGT) {
        const float p0 = F.lb_params[i], p1 = F.lb_params[512 + i], p2 = F.lb_params[1024 + i], p3 = F.lb_params[1536 + i];
        const float mx = fmaxf(fmaxf(p0, p1), fmaxf(p2, p3)); const float e0 = __expf(p0 - mx), e1 = __expf(p1 - mx), e2 = __expf(p2 - mx), e3 = __expf(p3 - mx);
        const float inv = 1.0f / (e0 + e1 + e2 + e3);
        F.SMALL[SM_LB + i] = 0.f; F.SMALL[SM_LB + 512 + i] = e1 * inv; F.SMALL[SM_LB + 1024 + i] = (e1 + e2) * inv; F.SMALL[SM_LB + 1536 + i] = (e1 + e2 + e3) * inv;
    }
    for (int i = gt; i < DEPTH * 3 * NUP; i += NGT) { const int np = i % NUP, lj = i / NUP; F.SMALL[SM_CW + i] = F.conv_w[(size_t)lj * NUP + up_orig(np)]; }
    for (int i = gt; i < DEPTH * NUP; i += NGT) { const int np = i % NUP, l = i / NUP; F.SMALL[SM_CB + i] = F.conv_b[(size_t)l * NUP + up_orig(np)]; }
    for (int i = gt; i < DEPTH * 256 * 1024; i += NGT) {
        const int k = i & 1023, n = (i >> 10) & 255, l = i >> 18;
        const float* wi = F.w_in + ((size_t)l * 1024 + k) * 3600 + NINW; const float* wg = F.w_gk + (size_t)l * 16 * 256 + n;
        float s = 0.f;
#pragma unroll
        for (int r = 0; r < 16; ++r) s += wi[r] * wg[r * 256];
        F.WIN[((size_t)l * NIN + NINW + n) * 1024 + k] = (bf16)f2bf(s);
    }
    {   LAS float* scr = (LAS float*)(F.lds + F.wave * 16384);
        constexpr int I_IN = 16 * 112, I_OUT = 16 * 32, I_UP = 16 * 176, I_DN = 44 * 32, I_L = I_IN + I_OUT + I_UP + I_DN;
        for (int it = gw; it < DEPTH * I_L; it += NGW) {
            const int l = it / I_L; int r = it % I_L;
            if (r < I_IN) { const int kb = r / 112, nb = r % 112; tr_item(F.w_in + (size_t)l * 1024 * 3600, 3600, 1024, F.WIN + (size_t)l * NIN * 1024, kb, 32 * nb, 32 * nb, (nb >= 64 && nb < 72) ? 0.125f : 1.0f, scr, F.lane); continue; } r -= I_IN;
            if (r < I_OUT) { const int kb = r / 32, nb = r % 32; tr_item(F.w_out + (size_t)l * 1024 * 1024, 1024, 1024, F.WOUT + (size_t)l * 1024 * 1024, kb, 32 * nb, 32 * nb, 1.0f, scr, F.lane); continue; } r -= I_OUT;
            if (r < I_UP) { const int kb = r / 176, nb = r % 176; tr_item(F.w_up + (size_t)l * 1024 * NUP, NUP, 1024, F.WUP + (size_t)l * NUP * 1024, kb, up_orig(32 * nb), 32 * nb, 1.0f, scr, F.lane); continue; } r -= I_UP;
            { const int kb = r / 32, nb = r % 32; tr_item(F.w_down + (size_t)l * FF * 1024, 1024, FF, F.WDN + (size_t)l * 1024 * FF, kb, 32 * nb, 32 * nb, 1.0f, scr, F.lane); }
        }
    }
}

__device__ __forceinline__ void p0b(Frame& F) {
    const int gw = F.vcu * NWAVES + F.wave, NGW = F.G * NWAVES, gt = F.vcu * (NWAVES * 64) + F.tid, NGT = F.G * NWAVES * 64;
    LAS float* shL = (LAS float*)F.lds;
    for (int combo = 0; combo < 2 * DEPTH; ++combo) {
        const int l = combo >> 1, which = combo & 1;
        __syncthreads();
        for (int e = F.tid; e < 16 * 1024; e += NWAVES * 64) { const int b = e >> 10, d = e & 1023; shL[e] = F.MOD[(size_t)(l * 16 + b) * NMOD + (which ? 3072 : 0) + d]; }
        __syncthreads();
        const bf16* Wt = which ? F.WUP + (size_t)l * NUP * 1024 : F.WIN + (size_t)l * NIN * 1024; const int ncols = which ? NUP : NIN;
        float* outp = F.SMALL + (which ? SM_B2 + l * 16 * NUP : SM_B1 + l * 16 * NIN);
        for (int n = gw; n < ncols; n += NGW) {
            const GAS v2u* wr = (const GAS v2u*)(Wt + (size_t)n * 1024) + F.lane;
            float w[16];
#pragma unroll
            for (int i = 0; i < 4; ++i) { const v2u p = wr[64 * i]; w[4 * i] = bf2f(p.x & 0xffffu); w[4 * i + 1] = bf2f(p.x >> 16); w[4 * i + 2] = bf2f(p.y & 0xffffu); w[4 * i + 3] = bf2f(p.y >> 16); }
            float res = 0.f;
#pragma unroll 1
            for (int b = 0; b < 16; ++b) { float s = 0.f;
#pragma unroll
                for (int i = 0; i < 4; ++i) { const f32x4 sh = *(const LAS f32x4*)(shL + b * 1024 + 256 * i + 4 * F.lane); s += sh[0] * w[4 * i] + sh[1] * w[4 * i + 1] + sh[2] * w[4 * i + 2] + sh[3] * w[4 * i + 3]; }
                s = wave_sum(s); res = (F.lane == b) ? s : res; }
            if (F.lane < 16) outp[F.lane * ncols + n] = res + ((which == 0 && n >= NINW) ? F.b_gk[l * 256 + n - NINW] : 0.f);
        }
    }
    for (int i = gt; i < DEPTH * 16 * D; i += NGT) { const int d = i & 1023, lb = i >> 10, l = lb >> 4; const float* mod = F.MOD + (size_t)lb * NMOD;
        F.SMALL[SM_GS1 + i] = F.ln1_g[l * D + d] * (1.0f + mod[1024 + d]); F.SMALL[SM_GT1 + i] = mod[2048 + d];
        F.SMALL[SM_GS2 + i] = F.ln2_g[l * D + d] * (1.0f + mod[4096 + d]); F.SMALL[SM_GT2 + i] = mod[5120 + d]; }
    for (int row = gw; row < M; row += NGW) {
        const int b = row / SEQ; const GAS f32x4* xr = (const GAS f32x4*)(F.x + (size_t)row * D) + F.lane; const float* mod = F.MOD + (size_t)b * NMOD + 1024;
        GAS v2u* o8 = (GAS v2u*)(F.XN + (size_t)row * D) + F.lane; float ss = 0.f;
#pragma unroll
        for (int j = 0; j < 4; ++j) { const f32x4 v = xr[64 * j]; const int d = 256 * j + 4 * F.lane; const f32x4 g = *(const f32x4*)(F.ln1_g + d), sc = *(const f32x4*)(mod + d);
            ss += (v[0] * v[0] + v[1] * v[1]) + (v[2] * v[2] + v[3] * v[3]);
            v2u w; w.x = pk2(v[0] * g[0] * (1.0f + sc[0]), v[1] * g[1] * (1.0f + sc[1])); w.y = pk2(v[2] * g[2] * (1.0f + sc[2]), v[3] * g[3] * (1.0f + sc[3])); o8[64 * j] = w; }
        ss = wave_sum(ss);
        if (F.lane < 16) F.STAT[(size_t)row * 16 + F.lane] = (F.lane == 0) ? ss : 0.f;
    }
}

#ifndef MX_SPLIT
#define MX_SPLIT 1
#endif


typedef short bf16x8_t __attribute__((ext_vector_type(8)));
typedef short s16x4_t __attribute__((ext_vector_type(4)));
typedef float f32x2_t __attribute__((ext_vector_type(2)));
typedef __bf16 bf16x2_t __attribute__((ext_vector_type(2)));
#define MFMA16(a, b, c) __builtin_amdgcn_mfma_f32_16x16x32_bf16((a), (b), (c), 0, 0, 0)
#define LBAR() do { asm volatile("s_waitcnt lgkmcnt(0)" ::: "memory"); __builtin_amdgcn_s_barrier(); asm volatile("" ::: "memory"); } while (0)
__device__ __forceinline__ unsigned cvtpk(float lo, float hi) { f32x2_t v = {lo, hi}; bf16x2_t r = __builtin_convertvector(v, bf16x2_t); return __builtin_bit_cast(unsigned, r); }
__device__ __forceinline__ float bflo(unsigned u) { return __builtin_bit_cast(float, u << 16); }
__device__ __forceinline__ float bfhi(unsigned u) { return __builtin_bit_cast(float, u & 0xffff0000u); }
__device__ __forceinline__ s16x4_t tr16(const LAS unsigned char* p) { return __builtin_bit_cast(s16x4_t, __builtin_amdgcn_ds_read_tr16_b64_v4i16((LAS s16x4_t*)p)); }
constexpr float L2E = 1.4426950408889634f;


template <int DK, bool IS_A>
__device__ __forceinline__ void mixer_pipe_stream(Frame& F, int l, int b, int h, const int n_lo, const int n_full, const int n_hi) {
    constexpr int DKW = DK / 4, PW = DKW / 2, RG = 64 / PW, RR = 64 / RG, RGREF = 32 / RR, NKS = DK / 32, NMT = DK / 16;
    constexpr int PQ = DK * 2 + 16, PT = 144, PV = 272, PO = 528;
    constexpr int BUF = 2 * 64 * PQ + 64 * PV, B_QH = 0, B_KH = 64 * PQ, B_VV = 2 * 64 * PQ;
    constexpr int L_SC = 2 * BUF, L_FAC = L_SC + 64 * PT, FACB = 3 * DK * 4, L_OB = L_FAC + 2 * FACB, L_END = L_OB + 64 * PO;
    static_assert(L_END <= LDSCTL_OFF, "mixer LDS map");
    LAS unsigned char* const lds = F.lds;
    const int w = F.wave;
    const bool producer = (w >= 4);
    const int pw = w - 4, cw = w;
    const int qc = IS_A ? 128 * h : 2048 + 64 * h, fc = IS_A ? 512 + 128 * h : 2304 + 64 * h, gkc = 3584 + 64 * h;
    const int vc = IS_A ? 1024 + 128 * h : 2560 + 128 * h, gc = IS_A ? 1536 + 128 * h : 3072 + 128 * h, oc = IS_A ? 128 * h : 512 + 128 * h;
    const float* gnp = (IS_A ? F.gn_a : F.gn_b) + l * 128;
#define MP_LANE() int lane; asm volatile("v_mbcnt_lo_u32_b32 %0, -1, 0\n\tv_mbcnt_hi_u32_b32 %0, -1, %0" : "=v"(lane))
    f32x4 S[NMT][2];
#pragma unroll
    for (int i = 0; i < NMT; ++i) { S[i][0] = (f32x4){0.f, 0.f, 0.f, 0.f}; S[i][1] = (f32x4){0.f, 0.f, 0.f, 0.f}; }
    v4u ogreg[4];
    unsigned q2[RR], f2[RR], k2[RR]; v4u vreg[4];
    float lb0 = 0.f, lb1 = 0.f;
#define MP_LOAD_RAW(n) do { const size_t row0_ = (size_t)b * SEQ + (size_t)(n) * 64; \
        _Pragma("unroll") for (int j = 0; j < RR; ++j) { const unsigned* pr = (const unsigned*)(F.P + (row0_ + rg * RR + j) * NIN); \
            q2[j] = pr[(qc >> 1) + pw * PW + cpl]; if (IS_A) { f2[j] = pr[(fc >> 1) + pw * PW + cpl]; } else { k2[j] = pr[(fc >> 1) + pw * PW + cpl]; f2[j] = pr[(gkc >> 1) + pw * PW + cpl]; } } \
        _Pragma("unroll") for (int i = 0; i < 4; ++i) { const int id = pw * 64 + lane + 256 * i; vreg[i] = *(const v4u*)(F.P + (row0_ + (id >> 4)) * NIN + vc + 8 * (id & 15)); } } while (0)
    if (producer) {
        MP_LANE(); const int cpl = lane % PW, rg = lane / PW, m = lane & 15, g = lane >> 4;
        if (IS_A) { lb0 = F.SMALL[SM_LB + l * 512 + 128 * h + pw * DKW + 2 * cpl]; lb1 = F.SMALL[SM_LB + l * 512 + 128 * h + pw * DKW + 2 * cpl + 1]; }
        MP_LOAD_RAW(n_lo);
        for (int tb = 0; tb < pw; ++tb)
#pragma unroll
            for (int j = 0; j < 4; ++j) *(LAS unsigned short*)(lds + L_SC + (16 * tb + 4 * g + j) * PT + 2 * (16 * pw + m)) = (unsigned short)0;
    }
#pragma unroll 1
    for (int i = n_lo - 1; i < n_hi; ++i) {
        const int bc = i & 1, bp = (i + 1) & 1;
        const bool c_on = (i >= n_lo), c_full = (i >= n_full), p_on = (i + 1 < n_hi), p_full = (i + 1 >= n_full);
        if (producer) {
            if (p_on) {
                MP_LANE(); const int cpl = lane % PW, rg = lane / PW;
                LAS unsigned char* const bufp = lds + bp * BUF;
                float cum[2][RR], kk[2][RR], lg[2];
#pragma unroll
                for (int c = 0; c < 2; ++c) { float run = IS_A ? 1.f : 0.f; const float lb = c ? lb1 : lb0;
#pragma unroll
                    for (int j = 0; j < RR; ++j) { const float x = c ? bfhi(f2[j]) : bflo(f2[j]);
                        if (IS_A) { const float sg = __builtin_amdgcn_rcpf(1.0f + __builtin_amdgcn_exp2f(-x * L2E)); run *= lb + (1.0f - lb) * sg; kk[c][j] = (1.0f - lb) * (1.0f - sg); }
                        else { run += (fminf(x, 0.f) * L2E - __builtin_amdgcn_logf(1.0f + __builtin_amdgcn_exp2f(-fabsf(x) * L2E))) * (1.0f / 16.0f); kk[c][j] = c ? bfhi(k2[j]) : bflo(k2[j]); }
                        cum[c][j] = run; }
                    lg[c] = IS_A ? __builtin_amdgcn_logf(run) : run; }
                float eb[2];
#pragma unroll
                for (int c = 0; c < 2; ++c) { float incl = lg[c];
#pragma unroll
                    for (int d = 1; d < RG; d <<= 1) { const float t = __shfl_up(incl, d * PW); if (rg >= d) incl += t; }
                    const float base = incl - lg[c], tot = __shfl(incl, (RG - 1) * PW + cpl), refv = __shfl(base, RGREF * PW + cpl);
                    if (rg == 0) { LAS float* fp = (LAS float*)(lds + L_FAC + bp * FACB) + pw * DKW + 2 * cpl + c;
                        fp[0] = __builtin_amdgcn_exp2f(tot); fp[DK] = __builtin_amdgcn_exp2f(refv); fp[2 * DK] = __builtin_amdgcn_exp2f(tot - refv); }
                    eb[c] = IS_A ? __builtin_amdgcn_exp2f(base - refv) : base - refv; }
#pragma unroll
                for (int j = 0; j < RR; ++j) { const int t = rg * RR + j;
                    const float e10 = IS_A ? eb[0] * cum[0][j] : __builtin_amdgcn_exp2f(eb[0] + cum[0][j]), e11 = IS_A ? eb[1] * cum[1][j] : __builtin_amdgcn_exp2f(eb[1] + cum[1][j]);
                    if (p_full) *(LAS unsigned*)(bufp + B_QH + t * PQ + 2 * (pw * DKW + 2 * cpl)) = cvtpk(bflo(q2[j]) * e10, bfhi(q2[j]) * e11);
                    *(LAS unsigned*)(bufp + B_KH + t * PQ + 2 * (pw * DKW + 2 * cpl)) = cvtpk(kk[0][j] * __builtin_amdgcn_rcpf(e10), kk[1][j] * __builtin_amdgcn_rcpf(e11)); }
#pragma unroll
                for (int i2 = 0; i2 < 4; ++i2) { const int id = pw * 64 + lane + 256 * i2; *(LAS v4u*)(bufp + B_VV + (id >> 4) * PV + 16 * (id & 15)) = vreg[i2]; }
                if (i + 2 < n_hi) MP_LOAD_RAW(i + 2);
            }
        } else if (c_on) {
            MP_LANE(); const int m = lane & 15, g = lane >> 4, q4 = (lane & 15) >> 2, p4 = lane & 3, dv0 = 32 * cw;
            const LAS unsigned char* const bufc = lds + bc * BUF; const LAS unsigned char* const facp = lds + L_FAC + bc * FACB;
            const size_t row0 = (size_t)b * SEQ + (size_t)i * 64;
            if (c_full) { const int ctid = cw * 64 + lane;
#pragma unroll
                for (int i2 = 0; i2 < 4; ++i2) ogreg[i2] = *(const v4u*)(F.P + (row0 + (ctid >> 2)) * NIN + gc + 32 * (ctid & 3) + 8 * i2); }
            bf16x8_t vB[2][2];
#pragma unroll
            for (int ks2 = 0; ks2 < 2; ++ks2)
#pragma unroll
                for (int n2 = 0; n2 < 2; ++n2) { const LAS unsigned char* vp = bufc + B_VV + (32 * ks2 + 8 * g + q4) * PV + 2 * (dv0 + 16 * n2 + 4 * p4);
                    const s16x4_t lo = tr16(vp), hi = tr16(vp + 4 * PV); vB[ks2][n2] = __builtin_shufflevector(lo, hi, 0, 1, 2, 3, 4, 5, 6, 7); }
            if (c_full) {
                f32x4 o[4][2];
#pragma unroll
                for (int mt = 0; mt < 4; ++mt) { o[mt][0] = (f32x4){0.f, 0.f, 0.f, 0.f}; o[mt][1] = (f32x4){0.f, 0.f, 0.f, 0.f};
#pragma unroll
                    for (int ks2 = 0; ks2 < 2; ++ks2) if (2 * ks2 <= mt) { const bf16x8_t a = *(const LAS bf16x8_t*)(lds + L_SC + (16 * mt + m) * PT + 64 * ks2 + 16 * g);
                        o[mt][0] = MFMA16(a, vB[ks2][0], o[mt][0]); o[mt][1] = MFMA16(a, vB[ks2][1], o[mt][1]); } }
#pragma unroll
                for (int sg = 0; sg < NKS; ++sg) {
                    const f32x4 ea = *(const LAS f32x4*)(facp + 4 * (DK + 32 * sg + 4 * g)), eb4 = *(const LAS f32x4*)(facp + 4 * (DK + 32 * sg + 16 + 4 * g));
                    bf16x8_t sB[2];
#pragma unroll
                    for (int n2 = 0; n2 < 2; ++n2) { const f32x4 sa = S[2 * sg][n2] * ea, sb4 = S[2 * sg + 1][n2] * eb4;
                        sB[n2] = __builtin_bit_cast(bf16x8_t, (v4u){cvtpk(sa[0], sa[1]), cvtpk(sa[2], sa[3]), cvtpk(sb4[0], sb4[1]), cvtpk(sb4[2], sb4[3])}); }
#pragma unroll
                    for (int mt = 0; mt < 4; ++mt) { const LAS unsigned char* qp = bufc + B_QH + (16 * mt + m) * PQ + 2 * (32 * sg + 4 * g);
                        const s16x4_t lo = *(const LAS s16x4_t*)qp, hi = *(const LAS s16x4_t*)(qp + 32); const bf16x8_t a = __builtin_shufflevector(lo, hi, 0, 1, 2, 3, 4, 5, 6, 7);
                        o[mt][0] = MFMA16(a, sB[0], o[mt][0]); o[mt][1] = MFMA16(a, sB[1], o[mt][1]); }
                    asm volatile("" ::: "memory"); }
#pragma unroll
                for (int mt = 0; mt < 4; ++mt)
#pragma unroll
                    for (int n2 = 0; n2 < 2; ++n2)
#pragma unroll
                        for (int j = 0; j < 4; ++j) *(LAS float*)(lds + L_OB + (16 * mt + 4 * g + j) * PO + 4 * (dv0 + 16 * n2 + m)) = o[mt][n2][j];
            }
#pragma unroll
            for (int mtile = 0; mtile < NMT; ++mtile) {
                bf16x8_t ka[2];
#pragma unroll
                for (int ks2 = 0; ks2 < 2; ++ks2) { const LAS unsigned char* kp = bufc + B_KH + (32 * ks2 + 8 * g + q4) * PQ + 2 * (16 * mtile + 4 * p4);
                    const s16x4_t lo = tr16(kp), hi = tr16(kp + 4 * PQ); ka[ks2] = __builtin_shufflevector(lo, hi, 0, 1, 2, 3, 4, 5, 6, 7); }
                const f32x4 d4 = *(const LAS f32x4*)(facp + 4 * (16 * mtile + 4 * g)), l4 = *(const LAS f32x4*)(facp + 4 * (2 * DK + 16 * mtile + 4 * g));
#pragma unroll
                for (int n2 = 0; n2 < 2; ++n2) { f32x4 u4 = {0.f, 0.f, 0.f, 0.f}; u4 = MFMA16(ka[0], vB[0][n2], u4); u4 = MFMA16(ka[1], vB[1][n2], u4); S[mtile][n2] = S[mtile][n2] * d4 + u4 * l4; }
                if (mtile & 1) asm volatile("" ::: "memory"); }
        }
        LBAR();
        if (producer) {
            if (p_on && p_full) {
                MP_LANE(); const int m = lane & 15, g = lane >> 4, sb = pw;
                const LAS unsigned char* const bufp = lds + bp * BUF;
                bf16x8_t kf[NKS];
#pragma unroll
                for (int ks = 0; ks < NKS; ++ks) kf[ks] = *(const LAS bf16x8_t*)(bufp + B_KH + (16 * sb + m) * PQ + 64 * ks + 16 * g);
                for (int tb = sb; tb < 4; ++tb) { f32x4 acc = {0.f, 0.f, 0.f, 0.f};
#pragma unroll
                    for (int ks = 0; ks < NKS; ++ks) { const bf16x8_t a = *(const LAS bf16x8_t*)(bufp + B_QH + (16 * tb + m) * PQ + 64 * ks + 16 * g); acc = MFMA16(a, kf[ks], acc); }
#pragma unroll
                    for (int j = 0; j < 4; ++j) { const int t = 16 * tb + 4 * g + j, s = 16 * sb + m; const float val = (s <= t) ? acc[j] : 0.f;
                        *(LAS unsigned short*)(lds + L_SC + t * PT + 2 * s) = (unsigned short)f2bf(val); } }
            }
        } else if (c_on && c_full) {
            MP_LANE(); const int ctid = cw * 64 + lane, nt = ctid >> 2, ndq = ctid & 3;
            const size_t row0 = (size_t)b * SEQ + (size_t)i * 64;
            f32x4 ov[8]; float ss = 0.f;
#pragma unroll
            for (int i2 = 0; i2 < 8; ++i2) { ov[i2] = *(const LAS f32x4*)(lds + L_OB + nt * PO + 128 * ndq + 16 * i2); ss += (ov[i2][0] * ov[i2][0] + ov[i2][1] * ov[i2][1]) + (ov[i2][2] * ov[i2][2] + ov[i2][3] * ov[i2][3]); }
            ss += __shfl_xor(ss, 1); ss += __shfl_xor(ss, 2);
            const float rn = __builtin_amdgcn_rsqf(ss * (1.0f / 128.0f) + EPS);
            bf16* op = F.O + (row0 + nt) * D + oc + 32 * ndq;
#pragma unroll
            for (int i4 = 0; i4 < 4; ++i4) { unsigned ow[4];
#pragma unroll
                for (int hh = 0; hh < 2; ++hh) { const int i2 = 2 * i4 + hh; const f32x4 gn4 = *(const f32x4*)(gnp + 32 * ndq + 4 * i2); const unsigned g01 = ogreg[i4][2 * hh], g23 = ogreg[i4][2 * hh + 1];
                    const float ga = bflo(g01), gb = bfhi(g01), gcc = bflo(g23), gd = bfhi(g23);
                    const float r0 = ov[i2][0] * rn * gn4[0] * (ga * __builtin_amdgcn_rcpf(1.0f + __builtin_amdgcn_exp2f(-ga * L2E))), r1 = ov[i2][1] * rn * gn4[1] * (gb * __builtin_amdgcn_rcpf(1.0f + __builtin_amdgcn_exp2f(-gb * L2E)));
                    const float r2 = ov[i2][2] * rn * gn4[2] * (gcc * __builtin_amdgcn_rcpf(1.0f + __builtin_amdgcn_exp2f(-gcc * L2E))), r3 = ov[i2][3] * rn * gn4[3] * (gd * __builtin_amdgcn_rcpf(1.0f + __builtin_amdgcn_exp2f(-gd * L2E)));
                    ow[2 * hh] = cvtpk(r0, r1); ow[2 * hh + 1] = cvtpk(r2, r3); }
                *(v4u*)(op + 8 * i4) = (v4u){ow[0], ow[1], ow[2], ow[3]}; }
        }
        LBAR();
    }
#undef MP_LOAD_RAW
#undef MP_LANE
}
#ifndef MX_N0
#define MX_N0 42
#endif
__device__ __forceinline__ void mixer_phase_pipe(Frame& F, int l) {
#if MX_SPLIT
    for (int it = blockIdx.x; it < 256; it += F.G) { const int s = it & 63, seg = (it >> 6) & 1;
        if (it < 128) mixer_pipe_stream<128, true>(F, l, s >> 2, s & 3, 0, seg ? MX_N0 : 0, seg ? SEQ / 64 : MX_N0);
        else mixer_pipe_stream<64, false>(F, l, s >> 2, s & 3, 0, seg ? MX_N0 : 0, seg ? SEQ / 64 : MX_N0); }
#else
    for (int it = blockIdx.x; it < 128; it += F.G) { const int s = it & 63;
        if (it < 64) mixer_pipe_stream<128, true>(F, l, s >> 2, s & 3, 0, 0, SEQ / 64);
        else mixer_pipe_stream<64, false>(F, l, s >> 2, s & 3, 0, 0, SEQ / 64); }
#endif
}
__device__ __forceinline__ void fix_phase(Frame& F, int l) {
    const int gt = F.vcu * (NWAVES * 64) + F.tid, NGT = F.G * NWAVES * 64;
    const float* cw = F.SMALL + SM_CW + l * 3 * NUP; const float* cb = F.SMALL + SM_CB + l * NUP;
    for (int i = gt; i < 256 * FF; i += NGT) { const int pm = i / FF, f = i % FF; if ((pm & 15) == 0) continue;
        const int ca = 256 * (f >> 7) + (f & 127), cv = ca + 128;
        const float* T = F.RAWT + (size_t)(pm - 1) * 2 * NUP; const float* H = F.RAWH + (size_t)pm * 2 * NUP;
        const float a_m2 = T[ca], a_m1 = T[NUP + ca], a_0 = H[ca], a_1 = H[NUP + ca], v_m2 = T[cv], v_m1 = T[NUP + cv], v_0 = H[cv], v_1 = H[NUP + cv];
        const float wa0 = cw[ca], wa1 = cw[NUP + ca], wa2 = cw[2 * NUP + ca], wv0 = cw[cv], wv1 = cw[NUP + cv], wv2 = cw[2 * NUP + cv], ba = cb[ca], bv = cb[cv];
        const float ca0 = ba + wa0 * a_m2 + wa1 * a_m1 + wa2 * a_0, cv0 = bv + wv0 * v_m2 + wv1 * v_m1 + wv2 * v_0;
        const float ca1 = ba + wa0 * a_m1 + wa1 * a_0 + wa2 * a_1, cv1 = bv + wv0 * v_m1 + wv1 * v_0 + wv2 * v_1;
        bf16* g = F.Gb + (size_t)pm * 256 * FF + f;
        g[0] = (bf16)f2bf(ca0 * sigmoid_f(ca0) * cv0); g[FF] = (bf16)f2bf(ca1 * sigmoid_f(ca1) * cv1); }
}

__device__ __forceinline__ void final_phase(Frame& F) {
    const int gw = F.vcu * NWAVES + F.wave, NGW = F.G * NWAVES;
    for (int row = gw; row < M; row += NGW) {
        GAS f32x4* xr = (GAS f32x4*)(F.out + (size_t)row * D) + F.lane;
        float ss = (F.lane < 16) ? F.STAT[(size_t)row * 16 + F.lane] : 0.f; ss = wave_sum(ss);
        const float r = 1.0f / sqrtf(ss * (1.0f / (float)D) + EPS);
#pragma unroll
        for (int j = 0; j < 4; ++j) { const f32x4 v = xr[64 * j]; const f32x4 g = *(const f32x4*)(F.lnf_g + 256 * j + 4 * F.lane); xr[64 * j] = v * r * g; }
    }
}

struct Args { const float* in[18]; float* out; unsigned char* ws; int ph_lo, ph_hi; };
__global__ void __launch_bounds__(NWAVES * 64, 2) fwd(Args args) {
    extern __shared__ __attribute__((aligned(16))) unsigned char lds[];
    Frame F;
    F.lds = (LAS unsigned char*)lds; F.MISC = (volatile LAS unsigned*)(F.lds + MISC_OFF);
    F.tid = threadIdx.x; F.lane = F.tid & 63; F.wave = __builtin_amdgcn_readfirstlane(F.tid >> 6);
    F.G = gridDim.x; { const int bx = blockIdx.x; F.vcu = (F.G % 8 == 0) ? (bx % 8) * (F.G / 8) + bx / 8 : bx; }
    unsigned char* ws = args.ws;
    F.ctl = (unsigned*)(ws + WS_CTL);
    F.x = args.in[0]; F.c = args.in[1]; F.ln1_g = args.in[2]; F.ln2_g = args.in[3]; F.w_ada = args.in[4]; F.b_ada = args.in[5]; F.w_in = args.in[6]; F.lb_params = args.in[7];
    F.w_gk = args.in[8]; F.b_gk = args.in[9]; F.gn_a = args.in[10]; F.gn_b = args.in[11]; F.w_out = args.in[12]; F.w_up = args.in[13]; F.conv_w = args.in[14]; F.conv_b = args.in[15];
    F.w_down = args.in[16]; F.lnf_g = args.in[17]; F.out = args.out;
    F.MOD = (float*)(ws + WS_MOD); F.SMALL = (float*)(ws + WS_SMALL); F.STAT = (float*)(ws + WS_STAT); F.RAWH = (float*)(ws + WS_RAWH); F.RAWT = (float*)(ws + WS_RAWT);
    F.WIN = (bf16*)(ws + WS_WIN); F.WOUT = (bf16*)(ws + WS_WOUT); F.WUP = (bf16*)(ws + WS_WUP); F.WDN = (bf16*)(ws + WS_WDN);
    F.XN = (bf16*)(ws + WS_XN); F.O = (bf16*)(ws + WS_O); F.P = (bf16*)(ws + WS_P); F.Gb = (bf16*)(ws + WS_P);
    for (int u = F.tid; u < (LDS_BYTES - LDSCTL_OFF) / 4; u += NWAVES * 64) ((LAS unsigned*)(F.lds + LDSCTL_OFF))[u] = 0u;
    __syncthreads();
    const int lo = args.ph_lo, hi = args.ph_hi;
    XcdBarrier bar; bar.bar = F.ctl + CW_BAR; bar.x = 0; bar.st = nullptr;
    if (hi - lo > 1) bar = xcd_barrier_post(F.ctl + CW_BAR, F.MISC + 8);
#define IN(k) (lo <= (k) && (k) < hi)
#define SEAM(k) do { if (IN(k) && IN((k) + 1)) { int l0_; asm volatile("v_mbcnt_lo_u32_b32 %0, -1, 0\n\tv_mbcnt_hi_u32_b32 %0, -1, %0" : "=v"(l0_)); xcd_barrier(bar, F.wave == 0 && l0_ == 0); } } while (0)
    if (IN(0)) p0a(F);
    SEAM(0);
    if (IN(1)) p0b(F);
    SEAM(1);
    for (int l = 0; l < DEPTH; ++l) {
        const int pb = 2 + 6 * l;
#define LAUNDER_TID() do { int l_; asm volatile("v_mbcnt_lo_u32_b32 %0, -1, 0\n\tv_mbcnt_hi_u32_b32 %0, -1, %0" : "=v"(l_)); F.lane = l_; F.tid = F.wave * 64 + l_; } while (0)
        if (IN(pb)) {
            LAUNDER_TID();
            pg8::Gemm g{F.XN, F.WIN + (size_t)l * NIN * 1024, M, NIN, D}; pg8::StaticOrder S; S.init(M, NIN, F.G, (int)blockIdx.x);
            pg8::EpiIn E{F.P, F.SMALL + SM_B1 + l * 16 * NIN, F.STAT};
            pg8::gemm_phase<pg8::EpiIn, pg8::StaticOrder, true, true>(F.lds, g, S, E, F.tid);
        }
        SEAM(pb);
        if (IN(pb + 1)) { LAUNDER_TID(); mixer_phase_pipe(F, l); }
        SEAM(pb + 1);
        if (IN(pb + 2)) {
            LAUNDER_TID();
            pg8::Gemm g{F.O, F.WOUT + (size_t)l * 1024 * 1024, M, D, D}; pg8::StaticOrder S; S.init(M, D, F.G, (int)blockIdx.x);
            pg8::EpiXUpd E{l == 0 ? F.x : F.out, F.out, F.XN, F.SMALL + SM_GT1 + l * 16 * D, F.SMALL + SM_GS2 + l * 16 * D, F.STAT};
            pg8::gemm_phase<pg8::EpiXUpd, pg8::StaticOrder, true, true>(F.lds, g, S, E, F.tid);
        }
        SEAM(pb + 2);
        if (IN(pb + 3)) {
            LAUNDER_TID();
            pg8::Gemm g{F.XN, F.WUP + (size_t)l * NUP * 1024, M, NUP, D}; pg8::StaticOrder S; S.init(M, NUP, F.G, (int)blockIdx.x);
            pg8::EpiUp E{F.Gb, F.SMALL + SM_B2 + l * 16 * NUP, F.STAT, F.SMALL + SM_CW + l * 3 * NUP, F.SMALL + SM_CB + l * NUP, F.RAWH, F.RAWT, (LAS float*)(F.lds + HALO_OFF)};
            pg8::gemm_phase<pg8::EpiUp, pg8::StaticOrder, true, true>(F.lds, g, S, E, F.tid);
        }
        SEAM(pb + 3);
        if (IN(pb + 4)) { LAUNDER_TID(); fix_phase(F, l); }
        SEAM(pb + 4);
        if (IN(pb + 5)) {
            LAUNDER_TID();
            pg8::Gemm g{F.Gb, F.WDN + (size_t)l * 1024 * FF, M, D, FF}; pg8::StaticOrder S; S.init(M, D, F.G, (int)blockIdx.x);
            pg8::EpiXUpd E{F.out, F.out, l + 1 < DEPTH ? F.XN : (bf16*)nullptr, F.SMALL + SM_GT2 + l * 16 * D, F.SMALL + SM_GS1 + (l + 1 < DEPTH ? l + 1 : l) * 16 * D, F.STAT};
            pg8::gemm_phase<pg8::EpiXUpd, pg8::StaticOrder, true, true>(F.lds, g, S, E, F.tid);
        }
        SEAM(pb + 5);
    }
    if (IN(N_PHASES - 1)) { LAUNDER_TID(); final_phase(F); }
#undef IN
#undef SEAM
}

extern "C" void kernel_launch(void* const* d_in, const int* in_sizes, int n_in, void* d_out, int out_size, void* d_ws, size_t ws_size, hipStream_t stream) {
    static int grid = 0;
    if (grid == 0) {
        if (n_in != 18 || in_sizes[0] != M * D || out_size != M * D || ws_size < WS_END) { fprintf(stderr, "kernel_launch: unexpected shapes / workspace (n_in %d, in0 %d, out %d, ws %zu < %zu); nothing launched\n", n_in, n_in > 0 ? in_sizes[0] : -1, out_size, ws_size, (size_t)WS_END); grid = -1; return; }
        int dev = 0, cus = 0, per_cu = 0;
        if (hipGetDevice(&dev) != hipSuccess || hipDeviceGetAttribute(&cus, hipDeviceAttributeMultiprocessorCount, dev) != hipSuccess) { grid = -1; return; }
        if (hipFuncSetAttribute((const void*)fwd, hipFuncAttributeMaxDynamicSharedMemorySize, LDS_BYTES) != hipSuccess) { fprintf(stderr, "kernel_launch: hipFuncSetAttribute failed\n"); grid = -1; return; }
        if (hipOccupancyMaxActiveBlocksPerMultiprocessor(&per_cu, (const void*)fwd, NWAVES * 64, LDS_BYTES) != hipSuccess || per_cu < 1) { fprintf(stderr, "kernel_launch: occupancy query says %d\n", per_cu); }
        (void)hipGetLastError();
        grid = cus;
    }
    if (grid < 0) return;
    if (hipMemsetAsync((char*)d_ws + WS_CTL, 0, CTL_ZERO_BYTES, stream) != hipSuccess) return;
    Args a{};
    for (int i = 0; i < 18; ++i) a.in[i] = (const float*)d_in[i];
    a.out = (float*)d_out; a.ws = (unsigned char*)d_ws;
#if MK_PER_PHASE
    for (int p = 0; p < N_PHASES; ++p) { a.ph_lo = p; a.ph_hi = p + 1; hipLaunchKernelGGL(fwd, dim3(grid), dim3(NWAVES * 64), LDS_BYTES, stream, a); }
#else
    a.ph_lo = 0; a.ph_hi = N_PHASES; hipLaunchKernelGGL(fwd, dim3(grid), dim3(NWAVES * 64), LDS_BYTES, stream, a);
#endif
}
```

```cpp
#include <hip/hip_runtime.h>
#include <cstdio>
#include <cstdint>
namespace pg8 {
#define PG8_LAS __attribute__((address_space(3)))
typedef unsigned short bf16_t;
typedef short bf16x8 __attribute__((ext_vector_type(8)));
typedef float f32x4 __attribute__((ext_vector_type(4)));
typedef unsigned u32x4 __attribute__((ext_vector_type(4)));
constexpr int BM = 256, BK = 64, HALF = 128, HTB = HALF * BK * 2  , STAGE_BYTES = 8 * HTB, NXCD = 8, WGM = 4;

__host__ __device__ __forceinline__ int lds_byte(int r, int c) { const int st = (r >> 4) * 2 + (c >> 5), rr = r & 15, cc = c & 31, ob = rr * 64 + cc * 2; return st * 1024 + (ob ^ (((ob >> 9) & 1) << 5)); }
__host__ __device__ __forceinline__ void stage_rc(int b, int& R, int& C) { const int st = b / 1024, sb = b % 1024, swz = sb ^ (((sb >> 9) & 1) << 5); R = (st >> 1) * 16 + swz / 64; C = (st & 1) * 32 + (swz % 64) / 2; }
__host__ __device__ __forceinline__ int perm32(int rho) { const int n = rho >> 4, i = rho & 15; return 8 * (i >> 2) + 4 * n + (i & 3); }

struct Unit { int pm, pn; };
struct Gemm { const bf16_t* A; const bf16_t* Bt; int M, N, K; };

struct StaticOrder {
    int nM, nN, nwg, G, c;
    __host__ __device__ void init(int M, int N, int G_, int c_) { nM = M / BM; nN = N / BM; nwg = nM * nN; G = G_; c = c_; }
    __host__ __device__ bool next(int i, Unit& u) const {
        const long L = (long)i * G + c; if (L >= nwg) return false;
        int wgid = (int)L; { const int q = nwg / NXCD, r = nwg % NXCD, xcd = wgid % NXCD, off = wgid / NXCD; wgid = (xcd < r ? xcd * (q + 1) : r * (q + 1) + (xcd - r) * q) + off; }
        const int nig = WGM * nN, gid = wgid / nig, fm = gid * WGM, gsz = (nM - fm) < WGM ? (nM - fm) : WGM;
        u.pm = fm + ((wgid % nig) % gsz); u.pn = (wgid % nig) / gsz; return true;
    }
    __device__ __forceinline__ void a_ready(const Unit&) const {}
    __device__ __forceinline__ void done(const Unit&) const {}
};


__device__ __forceinline__ float shfl_x(float v, int mask, int lane) { return __builtin_bit_cast(float, __builtin_amdgcn_ds_bpermute((lane ^ mask) << 2, __builtin_bit_cast(int, v))); }
__device__ __forceinline__ unsigned cvt_pk_bf16(float lo, float hi) { unsigned r; asm volatile("v_cvt_pk_bf16_f32 %0, %1, %2" : "=v"(r) : "v"(lo), "v"(hi)); return r; }
typedef unsigned u32x2 __attribute__((ext_vector_type(2)));
constexpr int EPI_LDS_OFF = 143360;
__device__ __forceinline__ void dma16(const void* gsrc_lane, PG8_LAS unsigned char* dst_wave) { __builtin_amdgcn_global_load_lds((const unsigned*)gsrc_lane, (PG8_LAS unsigned*)dst_wave, 16, 0, 0); }
constexpr int ROWS_PER_SEQ_TILES = 16;
constexpr float RMS_EPS = 1e-6f;
constexpr int D_MODEL = 1024, N_IN = 3840, N_UP = 5632, N_FF = 2816;

struct EpiIn {
    static constexpr bool PERM = true, AFTER_DRAIN = false; static constexpr int NPF = 3, NST = 16;
    bf16_t* P; const float* bias; const float* stat;
    __device__ __forceinline__ void prefetch(PG8_LAS unsigned char* epi, const Unit& u, int wid, int lane) const {
        const char* sp = (const char*)(stat + (size_t)(u.pm * BM + 32 * wid) * 16) + 16 * lane;
        dma16(sp, epi + 2048 * wid); dma16(sp + 1024, epi + 2048 * wid + 1024);
        dma16((const char*)(bias + (size_t)(u.pm / ROWS_PER_SEQ_TILES) * N_IN + u.pn * BM) + 16 * lane, epi + 16384);
    }
    __device__ __forceinline__ void operator()(f32x4 (&acc)[2][2][4][2], PG8_LAS unsigned char* epi, const Unit& u, int wr, int wc, int fr, int fq) const {
        const int row0 = u.pm * BM + wr * 64 + fr, col0 = u.pn * BM + wc * 32 + 8 * fq;
        struct { f32x4 sp[2][4], bv[2][2]; } pf;
#pragma unroll
        for (int ai = 0; ai < 2; ++ai)
#pragma unroll
            for (int m = 0; m < 4; ++m) pf.sp[ai][m] = *(const PG8_LAS f32x4*)(epi + ((ai * HALF + wr * 64 + m * 16 + fr) * 16 + 4 * fq) * 4);
#pragma unroll
        for (int bj = 0; bj < 2; ++bj)
#pragma unroll
            for (int n = 0; n < 2; ++n) pf.bv[bj][n] = *(const PG8_LAS f32x4*)(epi + 16384 + (wc * 32 + 8 * fq + bj * HALF + 4 * n) * 4);
#pragma unroll
        for (int ai = 0; ai < 2; ++ai)
#pragma unroll
            for (int m = 0; m < 4; ++m) { const int row = row0 + ai * HALF + m * 16;
                float s = (pf.sp[ai][m][0] + pf.sp[ai][m][1]) + (pf.sp[ai][m][2] + pf.sp[ai][m][3]); s += shfl_x(s, 16, fq * 16 + fr); s += shfl_x(s, 32, fq * 16 + fr);
                const float r = __builtin_amdgcn_rsqf(s * (1.0f / (float)D_MODEL) + RMS_EPS);
                bf16_t* rowp = P + (size_t)row * N_IN + col0;
#pragma unroll
                for (int bj = 0; bj < 2; ++bj) { const f32x4 v0 = acc[ai][bj][m][0] * r + pf.bv[bj][0], v1 = acc[ai][bj][m][1] * r + pf.bv[bj][1];
                    u32x4 w; w.x = cvt_pk_bf16(v0[0], v0[1]); w.y = cvt_pk_bf16(v0[2], v0[3]); w.z = cvt_pk_bf16(v1[0], v1[1]); w.w = cvt_pk_bf16(v1[2], v1[3]);
                    *(u32x4*)(rowp + bj * HALF) = w; } }
    }
};

struct EpiXUpd {
    static constexpr bool PERM = true, AFTER_DRAIN = false; static constexpr int NPF = 2, NST = 40;
    const float* xold; float* xnew; bf16_t* XN; const float* gt; const float* gsn; float* stat;
    __device__ __forceinline__ void prefetch(PG8_LAS unsigned char* epi, const Unit& u, int wid, int lane) const {
        const size_t o = (size_t)(u.pm / ROWS_PER_SEQ_TILES) * D_MODEL + u.pn * BM;
        dma16((const char*)(gt + o) + 16 * lane, epi); dma16((const char*)(gsn + o) + 16 * lane, epi + 1024);
    }
    __device__ __forceinline__ void operator()(f32x4 (&acc)[2][2][4][2], PG8_LAS unsigned char* epi, const Unit& u, int wr, int wc, int fr, int fq) const {
        const int row0 = u.pm * BM + wr * 64 + fr, col0 = u.pn * BM + wc * 32 + 8 * fq;
        f32x4 g[2][2], s[2][2];
#pragma unroll
        for (int bj = 0; bj < 2; ++bj)
#pragma unroll
            for (int n = 0; n < 2; ++n) { g[bj][n] = *(const PG8_LAS f32x4*)(epi + (wc * 32 + 8 * fq + bj * HALF + 4 * n) * 4); s[bj][n] = *(const PG8_LAS f32x4*)(epi + 1024 + (wc * 32 + 8 * fq + bj * HALF + 4 * n) * 4); }
#pragma unroll
        for (int ai = 0; ai < 2; ++ai)
#pragma unroll
            for (int m = 0; m < 4; ++m) { const int row = row0 + ai * HALF + m * 16; const size_t off = (size_t)row * D_MODEL + col0; float ss = 0.f;
#pragma unroll
                for (int bj = 0; bj < 2; ++bj) {
                    const f32x4 x0 = *(const f32x4*)(xold + off + bj * HALF) + g[bj][0] * acc[ai][bj][m][0], x1 = *(const f32x4*)(xold + off + bj * HALF + 4) + g[bj][1] * acc[ai][bj][m][1];
                    *(f32x4*)(xnew + off + bj * HALF) = x0; *(f32x4*)(xnew + off + bj * HALF + 4) = x1;
                    ss += (x0[0] * x0[0] + x0[1] * x0[1]) + (x0[2] * x0[2] + x0[3] * x0[3]) + (x1[0] * x1[0] + x1[1] * x1[1]) + (x1[2] * x1[2] + x1[3] * x1[3]);
                    if (XN) { const f32x4 y0 = x0 * s[bj][0], y1 = x1 * s[bj][1];
                        u32x4 w; w.x = cvt_pk_bf16(y0[0], y0[1]); w.y = cvt_pk_bf16(y0[2], y0[3]); w.z = cvt_pk_bf16(y1[0], y1[1]); w.w = cvt_pk_bf16(y1[2], y1[3]);
                        *(u32x4*)(XN + off + bj * HALF) = w; } }
                ss += shfl_x(ss, 16, fq * 16 + fr); ss += shfl_x(ss, 32, fq * 16 + fr);
                if (fq == 0) stat[(size_t)row * 16 + u.pn * 4 + wc] = ss; }
    }
};

__device__ __forceinline__ float dpp_ror1(float v) { return __builtin_bit_cast(float, __builtin_amdgcn_mov_dpp(__builtin_bit_cast(int, v), 0x121, 0xf, 0xf, true)); }
__device__ __forceinline__ float dpp_ror2(float v) { return __builtin_bit_cast(float, __builtin_amdgcn_mov_dpp(__builtin_bit_cast(int, v), 0x122, 0xf, 0xf, true)); }
__device__ __forceinline__ float dpp_shr1z(float v) { return __builtin_bit_cast(float, __builtin_amdgcn_update_dpp(0, __builtin_bit_cast(int, v), 0x111, 0xf, 0xf, true)); }
__device__ __forceinline__ float dpp_shr2z(float v) { return __builtin_bit_cast(float, __builtin_amdgcn_update_dpp(0, __builtin_bit_cast(int, v), 0x112, 0xf, 0xf, true)); }
__device__ __forceinline__ float silu_f(float x) { return x * __builtin_amdgcn_rcpf(1.0f + __builtin_amdgcn_exp2f(-1.4426950408889634f * x)); }
struct EpiUp {
    static constexpr bool PERM = true, AFTER_DRAIN = false; static constexpr int NPF = 4, NST = 16;
    bf16_t* G; const float* bias; const float* stat; const float* cw; const float* cb; float* rawh; float* rawt; PG8_LAS float* halo;
    __device__ __forceinline__ void prefetch(PG8_LAS unsigned char* epi, const Unit& u, int wid, int lane) const {
        const char* sp = (const char*)(stat + (size_t)(u.pm * BM + 32 * wid) * 16) + 16 * lane;
        dma16(sp, epi + 2048 * wid); dma16(sp + 1024, epi + 2048 * wid + 1024);
        dma16((const char*)(bias + (size_t)(u.pm / ROWS_PER_SEQ_TILES) * N_UP + u.pn * BM) + 16 * lane, epi + 16384);
        const int which = wid & 3;
        dma16((const char*)((which < 3 ? cw + which * N_UP : cb) + u.pn * BM) + 16 * lane, (PG8_LAS unsigned char*)(halo + 2048) + 1024 * which);
    }
    __device__ __forceinline__ void operator()(f32x4 (&acc)[2][2][4][2], PG8_LAS unsigned char* epi, const Unit& u, int wr, int wc, int fr, int fq) const {
        const int row0 = u.pm * BM + wr * 64 + fr, tc0 = wc * 32 + 8 * fq, col0 = u.pn * BM + tc0;
        PG8_LAS float* vecs = halo + 2048;
        f32x4 bv[2][2];
#pragma unroll
        for (int bj = 0; bj < 2; ++bj)
#pragma unroll
            for (int n = 0; n < 2; ++n) bv[bj][n] = *(const PG8_LAS f32x4*)(epi + 16384 + (tc0 + bj * HALF + 4 * n) * 4);
#pragma unroll
        for (int ai = 0; ai < 2; ++ai)
#pragma unroll
            for (int m = 0; m < 4; ++m) { const f32x4 sp = *(const PG8_LAS f32x4*)(epi + ((ai * HALF + wr * 64 + m * 16 + fr) * 16 + 4 * fq) * 4);
                float s = (sp[0] + sp[1]) + (sp[2] + sp[3]); s += shfl_x(s, 16, fq * 16 + fr); s += shfl_x(s, 32, fq * 16 + fr);
                const float r = __builtin_amdgcn_rsqf(s * (1.0f / (float)D_MODEL) + RMS_EPS);
#pragma unroll
                for (int bj = 0; bj < 2; ++bj)
#pragma unroll
                    for (int n = 0; n < 2; ++n) acc[ai][bj][m][n] = acc[ai][bj][m][n] * r + bv[bj][n];
                asm volatile("" : "+v"(acc[ai][0][m][0]), "+v"(acc[ai][0][m][1]), "+v"(acc[ai][1][m][0]), "+v"(acc[ai][1][m][1])); }
#pragma unroll
        for (int ai = 0; ai < 2; ++ai) {
            if (fr >= 14) {
                PG8_LAS float* hp = halo + ((ai * 2 + wr) * 2 + (fr - 14)) * 256 + tc0;
#pragma unroll
                for (int bj = 0; bj < 2; ++bj)
#pragma unroll
                    for (int n = 0; n < 2; ++n) *(PG8_LAS f32x4*)(hp + bj * HALF + 4 * n) = acc[ai][bj][3][n];
            }
        }
        if (wr == 0 && fr < 2) { float* hp = rawh + ((size_t)u.pm * 2 + fr) * N_UP + col0;
#pragma unroll
            for (int bj = 0; bj < 2; ++bj)
#pragma unroll
                for (int n = 0; n < 2; ++n) *(f32x4*)(hp + bj * HALF + 4 * n) = acc[0][bj][0][n]; }
        if (wr == 1 && fr >= 14) { float* tp = rawt + ((size_t)u.pm * 2 + (fr - 14)) * N_UP + col0;
#pragma unroll
            for (int bj = 0; bj < 2; ++bj)
#pragma unroll
                for (int n = 0; n < 2; ++n) *(f32x4*)(tp + bj * HALF + 4 * n) = acc[1][bj][3][n]; }
        asm volatile("s_waitcnt lgkmcnt(0)" ::: "memory"); __builtin_amdgcn_s_barrier(); asm volatile("" ::: "memory");
        const bool f15 = (fr == 15), f14 = (fr >= 14);
        unsigned gp[2][4][2];
#pragma unroll
        for (int n = 0; n < 2; ++n) {
            f32x4 w0[2], w1[2], w2[2], cbv[2];
#pragma unroll
            for (int bj = 0; bj < 2; ++bj) { const int c = tc0 + bj * HALF + 4 * n;
                w0[bj] = *(const PG8_LAS f32x4*)(vecs + c); w1[bj] = *(const PG8_LAS f32x4*)(vecs + 256 + c); w2[bj] = *(const PG8_LAS f32x4*)(vecs + 512 + c); cbv[bj] = *(const PG8_LAS f32x4*)(vecs + 768 + c); }
#pragma unroll
            for (int ai = 0; ai < 2; ++ai) {
                f32x4 prev[2];
                {   const int pai = (wr == 1) ? ai : ai - 1, pwr = (wr == 1) ? 0 : 1;
                    const bool has = (pai >= 0);
                    const PG8_LAS float* hp = halo + ((pai * 2 + pwr) * 2 + (fr & 1)) * 256 + tc0 + 4 * n;
#pragma unroll
                    for (int bj = 0; bj < 2; ++bj) prev[bj] = (has && fr >= 14) ? *(const PG8_LAS f32x4*)(hp + bj * HALF) : (f32x4){0.f, 0.f, 0.f, 0.f}; }
#pragma unroll
                for (int m = 0; m < 4; ++m) {
                    f32x4 cu[2];
#pragma unroll
                    for (int bj = 0; bj < 2; ++bj) { const f32x4 cur = acc[ai][bj][m][n], pv = prev[bj]; f32x4 o;
#pragma unroll
                        for (int j = 0; j < 4; ++j) { const float s1 = dpp_ror1(f15 ? pv[j] : cur[j]), s2 = dpp_ror2(f14 ? pv[j] : cur[j]);
                            o[j] = cbv[bj][j] + w0[bj][j] * s2 + w1[bj][j] * s1 + w2[bj][j] * cur[j]; }
                        cu[bj] = o; prev[bj] = cur; }
                    f32x4 g;
#pragma unroll
                    for (int j = 0; j < 4; ++j) g[j] = silu_f(cu[0][j]) * cu[1][j];
                    const unsigned p0 = cvt_pk_bf16(g[0], g[1]), p1 = cvt_pk_bf16(g[2], g[3]);
                    if (n == 0) { gp[ai][m][0] = p0; gp[ai][m][1] = p1; }
                    else { u32x4 w; w.x = gp[ai][m][0]; w.y = gp[ai][m][1]; w.z = p0; w.w = p1;
                        *(u32x4*)(G + (size_t)(row0 + ai * HALF + m * 16) * N_FF + u.pn * HALF + tc0) = w; }
                }
            }
        }
    }
};
template <class Epi, class Sched, bool ALIGN_EPI = false, bool SP2 = false>
__device__ __forceinline__ void gemm_phase(PG8_LAS unsigned char* lds, const Gemm g, const Sched& S, const Epi& E, const int tid) {
    const int wid = __builtin_amdgcn_readfirstlane(tid >> 6), lane = tid & 63, wr = wid >> 2, wc = wid & 3, fr = lane & 15, fq = lane >> 4;
    const int K = g.K, nt = K / BK;
    unsigned voffA[2], voffB[2];
#pragma unroll
    for (int i = 0; i < 2; ++i) { int R, C; stage_rc(tid * 16 + i * 8192, R, C); const int Rb = Epi::PERM ? ((R & ~31) + perm32(R & 31)) : R;
        voffA[i] = (unsigned)(R * K + C) * 2u; voffB[i] = (unsigned)(Rb * K + C) * 2u; }
    const size_t kstep = (size_t)(BK * 2);
    const size_t hstep = (size_t)HALF * K * 2;
    const size_t tstep = 2 * hstep;
    const unsigned ldsw = (unsigned)wid * 1024u;
    const int aoff = lds_byte(wr * 64 + fr, fq * 8), boff = lds_byte(wc * 32 + fr, fq * 8);
#define PG8_SA(b, h) (((b) * 2 + (h)) * HTB)
#define PG8_SB(b, h) ((4 + (b) * 2 + (h)) * HTB)
#define PG8_STAGE(bufoff, gbase, voff) do { _Pragma("unroll") for (int _i = 0; _i < 2; ++_i) \
        __builtin_amdgcn_global_load_lds((const unsigned*)((const char*)(gbase) + (voff)[_i]), (PG8_LAS unsigned*)(lds + (bufoff) + ldsw + _i * 8192), 16, 0, 0); } while (0)
#define PG8_LDA(dst, b, h) do { _Pragma("unroll") for (int m = 0; m < 4; ++m) _Pragma("unroll") for (int k = 0; k < 2; ++k) dst[m][k] = *(const PG8_LAS bf16x8*)(lds + PG8_SA(b, h) + aoff + m * 2048 + k * 1024); } while (0)
#define PG8_LDB(dst, b, h) do { _Pragma("unroll") for (int n = 0; n < 2; ++n) _Pragma("unroll") for (int k = 0; k < 2; ++k) dst[n][k] = *(const PG8_LAS bf16x8*)(lds + PG8_SB(b, h) + boff + n * 2048 + k * 1024); } while (0)
#define PG8_MMA(ai, bj, At, Bt) do { __builtin_amdgcn_s_setprio(1); _Pragma("unroll") for (int m = 0; m < 4; ++m) _Pragma("unroll") for (int n = 0; n < 2; ++n) _Pragma("unroll") for (int k = 0; k < 2; ++k) \
        acc[ai][bj][m][n] = __builtin_amdgcn_mfma_f32_16x16x32_bf16(Bt[n][k], At[m][k], acc[ai][bj][m][n], 0, 0, 0); __builtin_amdgcn_s_setprio(0); } while (0)
#define PG8_WAIT_V(n) asm volatile("s_waitcnt vmcnt(" #n ")" ::: "memory")
#define PG8_WAIT_L(n) asm volatile("s_waitcnt lgkmcnt(" #n ")" ::: "memory")
#define PG8_BAR __builtin_amdgcn_s_barrier()
#define PG8_SCHED __builtin_amdgcn_sched_barrier(0)
    Unit cur, nxt; int ui = 0;
    if (!S.next(0, cur)) return;
    f32x4 acc[2][2][4][2];
#pragma unroll
    for (int a = 0; a < 2; ++a)
#pragma unroll
        for (int b = 0; b < 2; ++b)
#pragma unroll
            for (int m = 0; m < 4; ++m)
#pragma unroll
                for (int n = 0; n < 2; ++n) acc[a][b][m][n] = (f32x4){0.f, 0.f, 0.f, 0.f};
    bf16x8 At[4][2], B0[2][2], B1[2][2];
    const char* cA = (const char*)g.A + (size_t)cur.pm * tstep; const char* cB = (const char*)g.Bt + (size_t)cur.pn * tstep;
    S.a_ready(cur);
    if constexpr (SP2) {
        PG8_STAGE(PG8_SB(0, 0), cB, voffB); PG8_STAGE(PG8_SB(0, 1), cB + hstep, voffB); PG8_STAGE(PG8_SA(0, 0), cA, voffA); PG8_STAGE(PG8_SA(0, 1), cA + hstep, voffA);
        if (wr == 1) PG8_BAR;
        PG8_WAIT_V(2); PG8_BAR;
        PG8_STAGE(PG8_SB(1, 0), cB + kstep, voffB); PG8_STAGE(PG8_SA(1, 0), cA + kstep, voffA); PG8_STAGE(PG8_SB(1, 1), cB + hstep + kstep, voffB);
        PG8_WAIT_V(6); PG8_BAR;
    } else {
        PG8_STAGE(PG8_SB(0, 0), cB, voffB); PG8_STAGE(PG8_SA(0, 0), cA, voffA); PG8_STAGE(PG8_SB(0, 1), cB + hstep, voffB); PG8_STAGE(PG8_SA(0, 1), cA + hstep, voffA);
        if (wr == 1) PG8_BAR;
        PG8_WAIT_V(4); PG8_BAR;
        PG8_STAGE(PG8_SB(1, 0), cB + kstep, voffB); PG8_STAGE(PG8_SA(1, 0), cA + kstep, voffA); PG8_STAGE(PG8_SB(1, 1), cB + hstep + kstep, voffB);
        PG8_WAIT_V(6); PG8_BAR;
    }
    for (;;) {
        const bool has_next = S.next(ui + 1, nxt);
        const char* nA = has_next ? (const char*)g.A + (size_t)nxt.pm * tstep : cA; const char* nB = has_next ? (const char*)g.Bt + (size_t)nxt.pn * tstep : cB;
#define PG8_WAIT_VN(n) asm volatile("s_waitcnt vmcnt(%0)" :: "n"(n) : "memory")
#define PG8_TRIP(a1, a2, b2, a3, b3, PF, FA) do { \
              \
            PG8_LDB(B0, 0, 0); PG8_LDB(B1, 0, 1); PG8_SCHED; PG8_LDA(At, 0, 0); PG8_STAGE(PG8_SA(1, 1), (a1) + hstep, voffA); \
            if (FA) PG8_WAIT_VN(8 + Epi::NST); else PG8_WAIT_V(8); PG8_WAIT_L(0); PG8_BAR; PG8_MMA(0, 0, At, B0); PG8_MMA(0, 1, At, B1); PG8_BAR; PG8_SCHED; \
              \
            PG8_LDA(At, 0, 1); PG8_STAGE(PG8_SB(0, 0), (b2), voffB); PG8_STAGE(PG8_SB(0, 1), (b2) + hstep, voffB); PG8_STAGE(PG8_SA(0, 0), (a2), voffA); \
            if (FA) PG8_WAIT_VN(8 + Epi::NST); else PG8_WAIT_V(8); PG8_WAIT_L(0); PG8_BAR; PG8_MMA(1, 0, At, B0); PG8_MMA(1, 1, At, B1); PG8_BAR; PG8_SCHED; \
            if (PF) { int lane_p; asm volatile("v_mbcnt_lo_u32_b32 %0, -1, 0\n\tv_mbcnt_hi_u32_b32 %0, -1, %0" : "=v"(lane_p)); E.prefetch(lds + EPI_LDS_OFF, cur, wid, lane_p); } \
              \
            PG8_LDB(B0, 1, 0); PG8_LDB(B1, 1, 1); PG8_SCHED; PG8_LDA(At, 1, 0); PG8_STAGE(PG8_SA(0, 1), (a2) + hstep, voffA); \
            if (PF) PG8_WAIT_VN(8 + Epi::NPF); else PG8_WAIT_V(8); PG8_WAIT_L(0); PG8_BAR; PG8_MMA(0, 0, At, B0); PG8_MMA(0, 1, At, B1); PG8_BAR; PG8_SCHED; \
              \
            PG8_LDA(At, 1, 1); PG8_STAGE(PG8_SB(1, 0), (b3), voffB); PG8_STAGE(PG8_SB(1, 1), (b3) + hstep, voffB); PG8_STAGE(PG8_SA(1, 0), (a3), voffA); \
            if (PF) PG8_WAIT_VN(8 + Epi::NPF); else PG8_WAIT_V(8); PG8_WAIT_L(0); PG8_BAR; PG8_MMA(1, 0, At, B0); PG8_MMA(1, 1, At, B1); PG8_BAR; PG8_SCHED; } while (0)
        static_assert(SP2, "this build keeps only the two-blocks-per-barrier K-loop");
        for (int t = 0; t < nt; t += 2) {
            const bool last = (t == nt - 2);
            const char* a1 = cA + (size_t)(t + 1) * kstep;
            const char* a2 = last ? nA : cA + (size_t)(t + 2) * kstep; const char* b2 = last ? nB : cB + (size_t)(t + 2) * kstep;
            if (last && has_next) S.a_ready(nxt);
            const bool pfl = last && (Epi::NPF > 0), fa = (t == 0) && (ui > 0) && (Epi::NST > 0);
            PG8_TRIP(a1, a2, b2, a2 + kstep, b2 + kstep, pfl, fa);
        }
#undef PG8_TRIP
#undef PG8_WAIT_VN
        if constexpr (ALIGN_EPI) { if (wr == 0) PG8_BAR; }
        if constexpr (Epi::NPF > 0) { asm volatile("s_waitcnt vmcnt(8)" ::: "memory"); PG8_BAR; asm volatile("" ::: "memory"); }
        if constexpr (!Epi::AFTER_DRAIN) { int lane_e; asm volatile("v_mbcnt_lo_u32_b32 %0, -1, 0\n\tv_mbcnt_hi_u32_b32 %0, -1, %0" : "=v"(lane_e));
            const int fr_e = lane_e & 15, fq_e = lane_e >> 4; int wr_e = wr, wc_e = wc; asm volatile("" : "+s"(wr_e), "+s"(wc_e));
            E(acc, lds + EPI_LDS_OFF, cur, wr_e, wc_e, fr_e, fq_e);
            S.done(cur); }
        if (!has_next) break;
#pragma unroll
        for (int a = 0; a < 2; ++a)
#pragma unroll
            for (int b = 0; b < 2; ++b)
#pragma unroll
                for (int m = 0; m < 4; ++m)
#pragma unroll
                    for (int n = 0; n < 2; ++n) acc[a][b][m][n] = (f32x4){0.f, 0.f, 0.f, 0.f};
        cur = nxt; cA = nA; cB = nB; ++ui;
        if constexpr (ALIGN_EPI) { if (wr == 1) PG8_BAR; }
    }
    PG8_WAIT_V(0);
    if constexpr (!ALIGN_EPI) { if (wr == 0) PG8_BAR; }
    PG8_BAR;
    if constexpr (Epi::AFTER_DRAIN) { E.fused(acc, cur, wr, wc, fr, fq, lds, wid, lane); S.done(cur); }
#undef PG8_SA
#undef PG8_SB
#undef PG8_STAGE
#undef PG8_LDA
#undef PG8_LDB
#undef PG8_MMA
#undef PG8_WAIT_V
#undef PG8_WAIT_L
#undef PG8_BAR
#undef PG8_SCHED
}
}

constexpr int NWAVES = 8;
#ifndef MK_PER_PHASE
#define MK_PER_PHASE 0
#endif
constexpr int NB = 16, SEQ = 4096, D = 1024, DEPTH = 4, M = NB * SEQ;
constexpr int NIN = 3840, NINW = 3584, FF = 2816, NUP = 5632, NMOD = 6144;
constexpr float EPS = 1e-6f;
constexpr int N_PHASES = 2 + 6 * DEPTH + 1;

constexpr size_t MiB = 1u << 20;
constexpr size_t WS_CTL = 0, CTL_ZERO_BYTES = 4 * MiB;
constexpr size_t WS_MOD = 2 * MiB;
constexpr size_t WS_SMALL = 4 * MiB;
constexpr size_t WS_STAT = 12 * MiB;
constexpr size_t WS_RAWH = 16 * MiB, WS_RAWT = 28 * MiB;
constexpr size_t WS_WIN = 40 * MiB;
constexpr size_t WS_WOUT = 70 * MiB;
constexpr size_t WS_WUP = 78 * MiB;
constexpr size_t WS_WDN = 122 * MiB;
constexpr size_t WS_XN = 144 * MiB;
constexpr size_t WS_O = 272 * MiB;
constexpr size_t WS_P = 400 * MiB;
constexpr size_t WS_END = 880 * MiB;
constexpr int SM_LB = 0;
constexpr int SM_CW = SM_LB + 4 * 512;
constexpr int SM_CB = SM_CW + 4 * 3 * NUP;
constexpr int SM_GS1 = SM_CB + 4 * NUP;
constexpr int SM_GS2 = SM_GS1 + 4 * 16 * D;
constexpr int SM_GT1 = SM_GS2 + 4 * 16 * D;
constexpr int SM_GT2 = SM_GT1 + 4 * 16 * D;
constexpr int SM_B1 = SM_GT2 + 4 * 16 * D;
constexpr int SM_B2 = SM_B1 + 4 * 16 * NIN;
constexpr int SM_END = SM_B2 + 4 * 16 * NUP;
static_assert((size_t)SM_END * 4 <= 8 * MiB, "small vectors fit");
constexpr int CW_BAR = 4096;

constexpr int LDS_BYTES = 163840;
constexpr int RING_BYTES = 131072, HALO_OFF = RING_BYTES, HALO_BYTES = 12288, LDSCTL_OFF = LDS_BYTES - 512, MISC_OFF = LDSCTL_OFF + 320;
static_assert(MISC_OFF + 128 <= LDS_BYTES && HALO_OFF + HALO_BYTES <= LDSCTL_OFF, "LDS map");

#define GAS __attribute__((address_space(1)))
#define LAS __attribute__((address_space(3)))
typedef unsigned short bf16;
typedef unsigned v4u __attribute__((ext_vector_type(4)));
typedef unsigned v2u __attribute__((ext_vector_type(2)));
typedef float f32x4 __attribute__((ext_vector_type(4)));
#define LDS_WAIT() asm volatile("s_waitcnt lgkmcnt(0)" ::: "memory")
__device__ __forceinline__ unsigned f2bf(float f) { unsigned u = __builtin_bit_cast(unsigned, f); return (u + 0x7fffu + ((u >> 16) & 1u)) >> 16; }
__device__ __forceinline__ unsigned pk2(float lo, float hi) { return f2bf(lo) | (f2bf(hi) << 16); }
__device__ __forceinline__ float bf2f(unsigned h) { return __builtin_bit_cast(float, h << 16); }
__device__ __forceinline__ float shfl_idx(float v, int src_lane) { return __builtin_bit_cast(float, __builtin_amdgcn_ds_bpermute(src_lane << 2, __builtin_bit_cast(int, v))); }
__device__ __forceinline__ float shfl_xor_l(float v, int mask, int lane) { return shfl_idx(v, lane ^ mask); }
__device__ __forceinline__ float wave_sum(float v, int lane) {
#pragma unroll
    for (int o = 1; o < 64; o <<= 1) v += shfl_xor_l(v, o, lane);
    return v;
}
__device__ __forceinline__ float sigmoid_f(float x) { return 1.0f / (1.0f + __expf(-x)); }
#define XB_TMO      128
#define XB_XCNT(j)  (256  + 64 * (j))
#define XB_XSUB(j)  (1280 + 64 * (j))
#define XB_XGEN(j)  (2304 + 64 * (j))
#define XB_TOP      3328
#define XB_TOPGEN   3392
#define XCD_BAR_WORDS 3456
#define XB_SPIN_CAP (1u << 18)

__device__ __forceinline__ unsigned xb_ld(unsigned* p)              { return __hip_atomic_load(p, __ATOMIC_RELAXED, __HIP_MEMORY_SCOPE_AGENT); }
__device__ __forceinline__ unsigned xb_add(unsigned* p, unsigned v) { return __hip_atomic_fetch_add(p, v, __ATOMIC_RELAXED, __HIP_MEMORY_SCOPE_AGENT); }
__device__ __forceinline__ unsigned xb_xcc_id() { return (unsigned)__builtin_amdgcn_s_getreg((3 << 11) | 20) & 0xFu; }
#define XB_SPIN(cond, bar) do { unsigned _sp = 0; while (cond) { __builtin_amdgcn_s_sleep(1); \
    if ((++_sp & 255u) == 0u) { if (xb_ld(&(bar)[XB_TMO])) break; if (_sp > XB_SPIN_CAP) { atomicAdd(&(bar)[XB_TMO], 1u); break; } } } } while (0)

struct XcdBarrier {
    unsigned* bar; unsigned x;
    volatile LAS unsigned* st;
};

__device__ __forceinline__ XcdBarrier xcd_barrier_post(unsigned* bar, volatile LAS unsigned* st) {
    XcdBarrier b; b.bar = bar; b.x = xb_xcc_id(); b.st = st;
    if (threadIdx.x == 0) (void)xb_add(&bar[XB_XCNT(b.x)], 1u);
    return b;
}
__device__ __forceinline__ void xcd_barrier_complete(unsigned* bar, unsigned x, unsigned& nloc, unsigned& nx) {
    const unsigned G = gridDim.x * gridDim.y * gridDim.z;
    unsigned sum, cnt, mine, sp = 0u;
    for (;;) {
        sum = 0u; cnt = 0u; mine = 0u;
#pragma unroll
        for (unsigned j = 0; j < 16; ++j) { const unsigned c = xb_ld(&bar[XB_XCNT(j)]); sum += c; cnt += (c > 0u) ? 1u : 0u; mine = (j == x) ? c : mine; }
        if (sum == G) break;
        __builtin_amdgcn_s_sleep(1);
        if ((++sp & 255u) == 0u) { if (xb_ld(&bar[XB_TMO])) break; if (sp > XB_SPIN_CAP) { atomicAdd(&bar[XB_TMO], 1u); break; } }
    }
    nloc = mine > 0u ? mine : 1u; nx = cnt > 0u ? cnt : 1u;
}

__device__ __forceinline__ void xcd_barrier(const XcdBarrier& b, const bool is_t0  ) {
    asm volatile("s_waitcnt vmcnt(0)" ::: "memory");
    __syncthreads();
    if (is_t0) {
        unsigned* bar = b.bar;
        __builtin_amdgcn_s_waitcnt(0);
        unsigned nloc = b.st[0], nx = b.st[1];
        if (nloc == 0u) { xcd_barrier_complete(bar, b.x, nloc, nx); b.st[0] = nloc; b.st[1] = nx; }
        const unsigned old = xb_add(&bar[XB_XSUB(b.x)], 1u);
        const unsigned gen = old / nloc;
        if (old + 1u == (gen + 1u) * nloc) {
            __builtin_amdgcn_fence(__ATOMIC_RELEASE, "agent");
            asm volatile("s_waitcnt vmcnt(0)" ::: "memory");
            const unsigned og = xb_add(&bar[XB_TOP], 1u);
            const unsigned tg = og / nx;
            if (og + 1u == (tg + 1u) * nx) xb_add(&bar[XB_TOPGEN], 1u);
            else XB_SPIN(xb_ld(&bar[XB_TOPGEN]) == tg, bar);
            __builtin_amdgcn_fence(__ATOMIC_ACQUIRE, "agent");
            xb_add(&bar[XB_XGEN(b.x)], 1u);
            asm volatile("s_waitcnt vmcnt(0)" ::: "memory");
        } else {
            XB_SPIN(xb_ld(&bar[XB_XGEN(b.x)]) == gen, bar);
            __builtin_amdgcn_fence(__ATOMIC_ACQUIRE, "agent");
            asm volatile("s_waitcnt vmcnt(0)" ::: "memory");
        }
    }
    __syncthreads();
}

struct Frame {
    LAS unsigned char* lds;
    volatile LAS unsigned* MISC;
    unsigned* ctl;
    int tid, lane, wave, vcu, G;
    const float *x, *c, *ln1_g, *ln2_g, *w_ada, *b_ada, *w_in, *lb_params, *w_gk, *b_gk, *gn_a, *gn_b, *w_out, *w_up, *conv_w, *conv_b, *w_down, *lnf_g;
    float* out;
    unsigned char* ws;
    __device__ __forceinline__ float* MOD() const { return (float*)(ws + WS_MOD); }
    __device__ __forceinline__ float* SMALL() const { return (float*)(ws + WS_SMALL); }
    __device__ __forceinline__ float* STAT() const { return (float*)(ws + WS_STAT); }
    __device__ __forceinline__ float* RAWH() const { return (float*)(ws + WS_RAWH); }
    __device__ __forceinline__ float* RAWT() const { return (float*)(ws + WS_RAWT); }
    __device__ __forceinline__ bf16* WIN() const { return (bf16*)(ws + WS_WIN); }
    __device__ __forceinline__ bf16* WOUT() const { return (bf16*)(ws + WS_WOUT); }
    __device__ __forceinline__ bf16* WUP() const { return (bf16*)(ws + WS_WUP); }
    __device__ __forceinline__ bf16* WDN() const { return (bf16*)(ws + WS_WDN); }
    __device__ __forceinline__ bf16* XN() const { return (bf16*)(ws + WS_XN); }
    __device__ __forceinline__ bf16* O() const { return (bf16*)(ws + WS_O); }
    __device__ __forceinline__ bf16* P() const { return (bf16*)(ws + WS_P); }
    __device__ __forceinline__ bf16* Gb() const { return (bf16*)(ws + WS_P); }
};

__device__ __forceinline__ void tr_item(const float* W, int Nsrc, int K, bf16* WT, int kb, int sn0, int dn0, float scale, LAS float* scr, int lane) {
    const int k0 = 64 * kb;
#pragma unroll 8
    for (int i = 0; i < 32; ++i) { const int kk = 2 * i + (lane >> 5); scr[kk * 33 + (lane & 31)] = W[(size_t)(k0 + kk) * Nsrc + sn0 + (lane & 31)]; }
    LDS_WAIT(); asm volatile("" ::: "memory");
    const int c = lane & 7;
#pragma unroll
    for (int j = 0; j < 4; ++j) { const int n = (lane >> 3) + 8 * j; const LAS float* s = scr + (8 * c) * 33 + n;
        v4u o; o.x = pk2(s[0 * 33] * scale, s[1 * 33] * scale); o.y = pk2(s[2 * 33] * scale, s[3 * 33] * scale); o.z = pk2(s[4 * 33] * scale, s[5 * 33] * scale); o.w = pk2(s[6 * 33] * scale, s[7 * 33] * scale);
        *(GAS v4u*)(WT + (size_t)(dn0 + n) * K + k0 + 8 * c) = o; }
    LDS_WAIT(); asm volatile("" ::: "memory");
}
__host__ __device__ __forceinline__ int up_orig(int np) { return ((np & 255) >> 7) * FF + 128 * (np >> 8) + (np & 127); }

__device__ __forceinline__ void p0a(Frame& F) {
    const int gw = F.vcu * NWAVES + F.wave, NGW = F.G * NWAVES, gt = F.vcu * (NWAVES * 64) + F.tid, NGT = F.G * NWAVES * 64;
    {
        LAS float* cond = (LAS float*)F.lds;
        for (int e = F.tid; e < 16 * 1024; e += NWAVES * 64) { const int b = e >> 10, d = e & 1023; const float cv = F.c[b * 1024 + d]; cond[d * 16 + b] = cv * sigmoid_f(cv); }
        __syncthreads();
        for (int it = gw; it < DEPTH * 384; it += NGW) {
            const int cb = it % 384, l = it / 384, e = cb * 16 + (F.lane & 15), dq = F.lane >> 4;
            const float* w = F.w_ada + ((size_t)l * 1024 + dq) * NMOD + e;
            float acc[16];
#pragma unroll
            for (int b = 0; b < 16; ++b) acc[b] = 0.f;
#pragma unroll 4
            for (int dd = 0; dd < 256; ++dd) {
                const float wv = w[(size_t)(4 * dd) * NMOD];
                const LAS f32x4* cp = (const LAS f32x4*)(cond + (4 * dd + dq) * 16);
#pragma unroll
                for (int q = 0; q < 4; ++q) { const f32x4 cq = cp[q]; acc[4 * q] += cq[0] * wv; acc[4 * q + 1] += cq[1] * wv; acc[4 * q + 2] += cq[2] * wv; acc[4 * q + 3] += cq[3] * wv; }
            }
            const float bb = F.b_ada[l * NMOD + e];
#pragma unroll
            for (int b = 0; b < 16; ++b) { float v = acc[b]; v += shfl_xor_l(v, 16, F.lane); v += shfl_xor_l(v, 32, F.lane); if (dq == 0) F.MOD()[(size_t)(l * 16 + b) * NMOD + e] = v + bb; }
        }
        __syncthreads();
    }
    for (int i = gt; i < 512; i += NGT) {
        const float p0 = F.lb_params[i], p1 = F.lb_params[512 + i], p2 = F.lb_params[1024 + i], p3 = F.lb_params[1536 + i];
        const float mx = fmaxf(fmaxf(p0, p1), fmaxf(p2, p3)); const float e0 = __expf(p0 - mx), e1 = __expf(p1 - mx), e2 = __expf(p2 - mx), e3 = __expf(p3 - mx);
        const float inv = 1.0f / (e0 + e1 + e2 + e3);
        F.SMALL()[SM_LB + i] = 0.f; F.SMALL()[SM_LB + 512 + i] = e1 * inv; F.SMALL()[SM_LB + 1024 + i] = (e1 + e2) * inv; F.SMALL()[SM_LB + 1536 + i] = (e1 + e2 + e3) * inv;
    }
    for (int i = gt; i < DEPTH * 3 * NUP; i += NGT) { const int np = i % NUP, lj = i / NUP; F.SMALL()[SM_CW + i] = F.conv_w[(size_t)lj * NUP + up_orig(np)]; }
    for (int i = gt; i < DEPTH * NUP; i += NGT) { const int np = i % NUP, l = i / NUP; F.SMALL()[SM_CB + i] = F.conv_b[(size_t)l * NUP + up_orig(np)]; }
    for (int i = gt; i < DEPTH * 256 * 1024; i += NGT) {
        const int k = i & 1023, n = (i >> 10) & 255, l = i >> 18;
        const float* wi = F.w_in + ((size_t)l * 1024 + k) * 3600 + NINW; const float* wg = F.w_gk + (size_t)l * 16 * 256 + n;
        float s = 0.f;
#pragma unroll
        for (int r = 0; r < 16; ++r) s += wi[r] * wg[r * 256];
        F.WIN()[((size_t)l * NIN + NINW + n) * 1024 + k] = (bf16)f2bf(s);
    }
    {   LAS float* scr = (LAS float*)(F.lds + F.wave * 16384);
        constexpr int I_IN = 16 * 112, I_OUT = 16 * 32, I_UP = 16 * 176, I_DN = 44 * 32, I_L = I_IN + I_OUT + I_UP + I_DN;
        for (int it = gw; it < DEPTH * I_L; it += NGW) {
            const int l = it / I_L; int r = it % I_L;
            if (r < I_IN) { const int kb = r / 112, nb = r % 112; tr_item(F.w_in + (size_t)l * 1024 * 3600, 3600, 1024, F.WIN() + (size_t)l * NIN * 1024, kb, 32 * nb, 32 * nb, (nb >= 64 && nb < 72) ? 0.125f : 1.0f, scr, F.lane); continue; } r -= I_IN;
            if (r < I_OUT) { const int kb = r / 32, nb = r % 32; tr_item(F.w_out + (size_t)l * 1024 * 1024, 1024, 1024, F.WOUT() + (size_t)l * 1024 * 1024, kb, 32 * nb, 32 * nb, 1.0f, scr, F.lane); continue; } r -= I_OUT;
            if (r < I_UP) { const int kb = r / 176, nb = r % 176; tr_item(F.w_up + (size_t)l * 1024 * NUP, NUP, 1024, F.WUP() + (size_t)l * NUP * 1024, kb, up_orig(32 * nb), 32 * nb, 1.0f, scr, F.lane); continue; } r -= I_UP;
            { const int kb = r / 32, nb = r % 32; tr_item(F.w_down + (size_t)l * FF * 1024, 1024, FF, F.WDN() + (size_t)l * 1024 * FF, kb, 32 * nb, 32 * nb, 1.0f, scr, F.lane); }
        }
    }
}

__device__ __forceinline__ void p0b(Frame& F) {
    const int gw = F.vcu * NWAVES + F.wave, NGW = F.G * NWAVES, gt = F.vcu * (NWAVES * 64) + F.tid, NGT = F.G * NWAVES * 64;
    LAS float* shL = (LAS float*)F.lds;
    for (int combo = 0; combo < 2 * DEPTH; ++combo) {
        const int l = combo >> 1, which = combo & 1;
        __syncthreads();
        for (int e = F.tid; e < 16 * 1024; e += NWAVES * 64) { const int b = e >> 10, d = e & 1023; shL[e] = F.MOD()[(size_t)(l * 16 + b) * NMOD + (which ? 3072 : 0) + d]; }
        __syncthreads();
        const bf16* Wt = which ? F.WUP() + (size_t)l * NUP * 1024 : F.WIN() + (size_t)l * NIN * 1024; const int ncols = which ? NUP : NIN;
        float* outp = F.SMALL() + (which ? SM_B2 + l * 16 * NUP : SM_B1 + l * 16 * NIN);
        for (int n = gw; n < ncols; n += NGW) {
            const GAS v2u* wr = (const GAS v2u*)(Wt + (size_t)n * 1024) + F.lane;
            float w[16];
#pragma unroll
            for (int i = 0; i < 4; ++i) { const v2u p = wr[64 * i]; w[4 * i] = bf2f(p.x & 0xffffu); w[4 * i + 1] = bf2f(p.x >> 16); w[4 * i + 2] = bf2f(p.y & 0xffffu); w[4 * i + 3] = bf2f(p.y >> 16); }
            float res = 0.f;
#pragma unroll 1
            for (int b = 0; b < 16; ++b) { float s = 0.f;
#pragma unroll
                for (int i = 0; i < 4; ++i) { const f32x4 sh = *(const LAS f32x4*)(shL + b * 1024 + 256 * i + 4 * F.lane); s += sh[0] * w[4 * i] + sh[1] * w[4 * i + 1] + sh[2] * w[4 * i + 2] + sh[3] * w[4 * i + 3]; }
                s = wave_sum(s, F.lane); res = (F.lane == b) ? s : res; }
            if (F.lane < 16) outp[F.lane * ncols + n] = res + ((which == 0 && n >= NINW) ? F.b_gk[l * 256 + n - NINW] : 0.f);
        }
    }
    for (int i = gt; i < DEPTH * 16 * D; i += NGT) { const int d = i & 1023, lb = i >> 10, l = lb >> 4; const float* mod = F.MOD() + (size_t)lb * NMOD;
        F.SMALL()[SM_GS1 + i] = F.ln1_g[l * D + d] * (1.0f + mod[1024 + d]); F.SMALL()[SM_GT1 + i] = mod[2048 + d];
        F.SMALL()[SM_GS2 + i] = F.ln2_g[l * D + d] * (1.0f + mod[4096 + d]); F.SMALL()[SM_GT2 + i] = mod[5120 + d]; }
    for (int row = gw; row < M; row += NGW) {
        const int b = row / SEQ; const GAS f32x4* xr = (const GAS f32x4*)(F.x + (size_t)row * D) + F.lane; const float* mod = F.MOD() + (size_t)b * NMOD + 1024;
        GAS v2u* o8 = (GAS v2u*)(F.XN() + (size_t)row * D) + F.lane; float ss = 0.f;
#pragma unroll
        for (int j = 0; j < 4; ++j) { const f32x4 v = xr[64 * j]; const int d = 256 * j + 4 * F.lane; const f32x4 g = *(const f32x4*)(F.ln1_g + d), sc = *(const f32x4*)(mod + d);
            ss += (v[0] * v[0] + v[1] * v[1]) + (v[2] * v[2] + v[3] * v[3]);
            v2u w; w.x = pk2(v[0] * g[0] * (1.0f + sc[0]), v[1] * g[1] * (1.0f + sc[1])); w.y = pk2(v[2] * g[2] * (1.0f + sc[2]), v[3] * g[3] * (1.0f + sc[3])); o8[64 * j] = w; }
        ss = wave_sum(ss, F.lane);
        if (F.lane < 16) F.STAT()[(size_t)row * 16 + F.lane] = (F.lane == 0) ? ss : 0.f;
    }
}

#ifndef MX_SPLIT
#define MX_SPLIT 1
#endif


typedef short bf16x8_t __attribute__((ext_vector_type(8)));
typedef short s16x4_t __attribute__((ext_vector_type(4)));
typedef float f32x2_t __attribute__((ext_vector_type(2)));
typedef __bf16 bf16x2_t __attribute__((ext_vector_type(2)));
#define MFMA16(a, b, c) __builtin_amdgcn_mfma_f32_16x16x32_bf16((a), (b), (c), 0, 0, 0)
#define LBAR() do { asm volatile("s_waitcnt lgkmcnt(0)" ::: "memory"); __builtin_amdgcn_s_barrier(); asm volatile("" ::: "memory"); } while (0)
__device__ __forceinline__ unsigned cvtpk(float lo, float hi) { f32x2_t v = {lo, hi}; bf16x2_t r = __builtin_convertvector(v, bf16x2_t); return __builtin_bit_cast(unsigned, r); }
__device__ __forceinline__ float bflo(unsigned u) { return __builtin_bit_cast(float, u << 16); }
__device__ __forceinline__ float bfhi(unsigned u) { return __builtin_bit_cast(float, u & 0xffff0000u); }
__device__ __forceinline__ s16x4_t tr16(const LAS unsigned char* p) { return __builtin_bit_cast(s16x4_t, __builtin_amdgcn_ds_read_tr16_b64_v4i16((LAS s16x4_t*)p)); }
constexpr float L2E = 1.4426950408889634f;


template <int DK, bool IS_A>
__device__ __forceinline__ void mixer_pipe_stream(Frame& F, int l, int b, int h, const int n_lo, const int n_full, const int n_hi) {
    constexpr int DKW = DK / 4, PW = DKW / 2, RG = 64 / PW, RR = 64 / RG, RGREF = 32 / RR, NKS = DK / 32, NMT = DK / 16;
    constexpr int PQ = DK * 2 + 16, PT = 144, PV = 272, PO = 528;
    constexpr int BUF = 2 * 64 * PQ + 64 * PV, B_QH = 0, B_KH = 64 * PQ, B_VV = 2 * 64 * PQ;
    constexpr int L_SC = 2 * BUF, L_FAC = L_SC + 64 * PT, FACB = 3 * DK * 4, L_OB = L_FAC + 2 * FACB, L_END = L_OB + 64 * PO;
    static_assert(L_END <= LDSCTL_OFF, "mixer LDS map");
    LAS unsigned char* const lds = F.lds;
    const int w = F.wave;
    const bool producer = (w >= 4);
    const int pw = w - 4, cw = w;
    const int qc = IS_A ? 128 * h : 2048 + 64 * h, fc = IS_A ? 512 + 128 * h : 2304 + 64 * h, gkc = 3584 + 64 * h;
    const int vc = IS_A ? 1024 + 128 * h : 2560 + 128 * h, gc = IS_A ? 1536 + 128 * h : 3072 + 128 * h, oc = IS_A ? 128 * h : 512 + 128 * h;
    const float* gnp = (IS_A ? F.gn_a : F.gn_b) + l * 128;
#define MP_LANE() int lane; asm volatile("v_mbcnt_lo_u32_b32 %0, -1, 0\n\tv_mbcnt_hi_u32_b32 %0, -1, %0" : "=v"(lane))
    f32x4 S[NMT][2];
#pragma unroll
    for (int i = 0; i < NMT; ++i) { S[i][0] = (f32x4){0.f, 0.f, 0.f, 0.f}; S[i][1] = (f32x4){0.f, 0.f, 0.f, 0.f}; }
    v4u ogreg[4];
    unsigned q2[RR], f2[RR], k2[RR]; v4u vreg[4];
    float lb0 = 0.f, lb1 = 0.f;
#define MP_LOAD_RAW(n) do { const size_t row0_ = (size_t)b * SEQ + (size_t)(n) * 64; \
        _Pragma("unroll") for (int j = 0; j < RR; ++j) { const unsigned* pr = (const unsigned*)(F.P() + (row0_ + rg * RR + j) * NIN); \
            q2[j] = pr[(qc >> 1) + pw * PW + cpl]; if (IS_A) { f2[j] = pr[(fc >> 1) + pw * PW + cpl]; } else { k2[j] = pr[(fc >> 1) + pw * PW + cpl]; f2[j] = pr[(gkc >> 1) + pw * PW + cpl]; } } \
        _Pragma("unroll") for (int i = 0; i < 4; ++i) { const int id = pw * 64 + lane + 256 * i; vreg[i] = *(const v4u*)(F.P() + (row0_ + (id >> 4)) * NIN + vc + 8 * (id & 15)); } } while (0)
    if (producer) {
        MP_LANE(); const int cpl = lane % PW, rg = lane / PW, m = lane & 15, g = lane >> 4;
        if (IS_A) { lb0 = F.SMALL()[SM_LB + l * 512 + 128 * h + pw * DKW + 2 * cpl]; lb1 = F.SMALL()[SM_LB + l * 512 + 128 * h + pw * DKW + 2 * cpl + 1]; }
        MP_LOAD_RAW(n_lo);
        for (int tb = 0; tb < pw; ++tb)
#pragma unroll
            for (int j = 0; j < 4; ++j) *(LAS unsigned short*)(lds + L_SC + (16 * tb + 4 * g + j) * PT + 2 * (16 * pw + m)) = (unsigned short)0;
    }
#pragma unroll 1
    for (int i = n_lo - 1; i < n_hi; ++i) {
        const int bc = i & 1, bp = (i + 1) & 1;
        const bool c_on = (i >= n_lo), c_full = (i >= n_full), p_on = (i + 1 < n_hi), p_full = (i + 1 >= n_full);
        if (producer) {
            if (p_on) {
                MP_LANE(); const int cpl = lane % PW, rg = lane / PW;
                LAS unsigned char* const bufp = lds + bp * BUF;
                float cum[2][RR], kk[2][RR], lg[2];
#pragma unroll
                for (int c = 0; c < 2; ++c) { float run = IS_A ? 1.f : 0.f; const float lb = c ? lb1 : lb0;
#pragma unroll
                    for (int j = 0; j < RR; ++j) { const float x = c ? bfhi(f2[j]) : bflo(f2[j]);
                        if (IS_A) { const float sg = __builtin_amdgcn_rcpf(1.0f + __builtin_amdgcn_exp2f(-x * L2E)); run *= lb + (1.0f - lb) * sg; kk[c][j] = (1.0f - lb) * (1.0f - sg); }
                        else { run += (fminf(x, 0.f) * L2E - __builtin_amdgcn_logf(1.0f + __builtin_amdgcn_exp2f(-fabsf(x) * L2E))) * (1.0f / 16.0f); kk[c][j] = c ? bfhi(k2[j]) : bflo(k2[j]); }
                        cum[c][j] = run; }
                    lg[c] = IS_A ? __builtin_amdgcn_logf(run) : run; }
                float eb[2];
#pragma unroll
                for (int c = 0; c < 2; ++c) { float incl = lg[c];
#pragma unroll
                    for (int d = 1; d < RG; d <<= 1) { const float t = shfl_idx(incl, lane - d * PW); if (rg >= d) incl += t; }
                    const float base = incl - lg[c], tot = shfl_idx(incl, (RG - 1) * PW + cpl), refv = shfl_idx(base, RGREF * PW + cpl);
                    if (rg == 0) { LAS float* fp = (LAS float*)(lds + L_FAC + bp * FACB) + pw * DKW + 2 * cpl + c;
                        fp[0] = __builtin_amdgcn_exp2f(tot); fp[DK] = __builtin_amdgcn_exp2f(refv); fp[2 * DK] = __builtin_amdgcn_exp2f(tot - refv); }
                    eb[c] = IS_A ? __builtin_amdgcn_exp2f(base - refv) : base - refv; }
#pragma unroll
                for (int j = 0; j < RR; ++j) { const int t = rg * RR + j;
                    const float e10 = IS_A ? eb[0] * cum[0][j] : __builtin_amdgcn_exp2f(eb[0] + cum[0][j]), e11 = IS_A ? eb[1] * cum[1][j] : __builtin_amdgcn_exp2f(eb[1] + cum[1][j]);
                    if (p_full) *(LAS unsigned*)(bufp + B_QH + t * PQ + 2 * (pw * DKW + 2 * cpl)) = cvtpk(bflo(q2[j]) * e10, bfhi(q2[j]) * e11);
                    *(LAS unsigned*)(bufp + B_KH + t * PQ + 2 * (pw * DKW + 2 * cpl)) = cvtpk(kk[0][j] * __builtin_amdgcn_rcpf(e10), kk[1][j] * __builtin_amdgcn_rcpf(e11)); }
#pragma unroll
                for (int i2 = 0; i2 < 4; ++i2) { const int id = pw * 64 + lane + 256 * i2; *(LAS v4u*)(bufp + B_VV + (id >> 4) * PV + 16 * (id & 15)) = vreg[i2]; }
                if (i + 2 < n_hi) MP_LOAD_RAW(i + 2);
            }
        } else if (c_on) {
            MP_LANE(); const int m = lane & 15, g = lane >> 4, q4 = (lane & 15) >> 2, p4 = lane & 3, dv0 = 32 * cw;
            const LAS unsigned char* const bufc = lds + bc * BUF; const LAS unsigned char* const facp = lds + L_FAC + bc * FACB;
            const size_t row0 = (size_t)b * SEQ + (size_t)i * 64;
            if (c_full) { const int ctid = cw * 64 + lane;
#pragma unroll
                for (int i2 = 0; i2 < 4; ++i2) ogreg[i2] = *(const v4u*)(F.P() + (row0 + (ctid >> 2)) * NIN + gc + 32 * (ctid & 3) + 8 * i2); }
            bf16x8_t vB[2][2];
#pragma unroll
            for (int ks2 = 0; ks2 < 2; ++ks2)
#pragma unroll
                for (int n2 = 0; n2 < 2; ++n2) { const LAS unsigned char* vp = bufc + B_VV + (32 * ks2 + 8 * g + q4) * PV + 2 * (dv0 + 16 * n2 + 4 * p4);
                    const s16x4_t lo = tr16(vp), hi = tr16(vp + 4 * PV); vB[ks2][n2] = __builtin_shufflevector(lo, hi, 0, 1, 2, 3, 4, 5, 6, 7); }
            if (c_full) {
                f32x4 o[4][2];
#pragma unroll
                for (int mt = 0; mt < 4; ++mt) { o[mt][0] = (f32x4){0.f, 0.f, 0.f, 0.f}; o[mt][1] = (f32x4){0.f, 0.f, 0.f, 0.f};
#pragma unroll
                    for (int ks2 = 0; ks2 < 2; ++ks2) if (2 * ks2 <= mt) { const bf16x8_t a = *(const LAS bf16x8_t*)(lds + L_SC + (16 * mt + m) * PT + 64 * ks2 + 16 * g);
                        o[mt][0] = MFMA16(a, vB[ks2][0], o[mt][0]); o[mt][1] = MFMA16(a, vB[ks2][1], o[mt][1]); } }
#pragma unroll
                for (int sg = 0; sg < NKS; ++sg) {
                    const f32x4 ea = *(const LAS f32x4*)(facp + 4 * (DK + 32 * sg + 4 * g)), eb4 = *(const LAS f32x4*)(facp + 4 * (DK + 32 * sg + 16 + 4 * g));
                    bf16x8_t sB[2];
#pragma unroll
                    for (int n2 = 0; n2 < 2; ++n2) { const f32x4 sa = S[2 * sg][n2] * ea, sb4 = S[2 * sg + 1][n2] * eb4;
                        sB[n2] = __builtin_bit_cast(bf16x8_t, (v4u){cvtpk(sa[0], sa[1]), cvtpk(sa[2], sa[3]), cvtpk(sb4[0], sb4[1]), cvtpk(sb4[2], sb4[3])}); }
#pragma unroll
                    for (int mt = 0; mt < 4; ++mt) { const LAS unsigned char* qp = bufc + B_QH + (16 * mt + m) * PQ + 2 * (32 * sg + 4 * g);
                        const s16x4_t lo = *(const LAS s16x4_t*)qp, hi = *(const LAS s16x4_t*)(qp + 32); const bf16x8_t a = __builtin_shufflevector(lo, hi, 0, 1, 2, 3, 4, 5, 6, 7);
                        o[mt][0] = MFMA16(a, sB[0], o[mt][0]); o[mt][1] = MFMA16(a, sB[1], o[mt][1]); }
                    asm volatile("" ::: "memory"); }
#pragma unroll
                for (int mt = 0; mt < 4; ++mt)
#pragma unroll
                    for (int n2 = 0; n2 < 2; ++n2)
#pragma unroll
                        for (int j = 0; j < 4; ++j) *(LAS float*)(lds + L_OB + (16 * mt + 4 * g + j) * PO + 4 * (dv0 + 16 * n2 + m)) = o[mt][n2][j];
            }
#pragma unroll
            for (int mtile = 0; mtile < NMT; ++mtile) {
                bf16x8_t ka[2];
#pragma unroll
                for (int ks2 = 0; ks2 < 2; ++ks2) { const LAS unsigned char* kp = bufc + B_KH + (32 * ks2 + 8 * g + q4) * PQ + 2 * (16 * mtile + 4 * p4);
                    const s16x4_t lo = tr16(kp), hi = tr16(kp + 4 * PQ); ka[ks2] = __builtin_shufflevector(lo, hi, 0, 1, 2, 3, 4, 5, 6, 7); }
                const f32x4 d4 = *(const LAS f32x4*)(facp + 4 * (16 * mtile + 4 * g)), l4 = *(const LAS f32x4*)(facp + 4 * (2 * DK + 16 * mtile + 4 * g));
#pragma unroll
                for (int n2 = 0; n2 < 2; ++n2) { f32x4 u4 = {0.f, 0.f, 0.f, 0.f}; u4 = MFMA16(ka[0], vB[0][n2], u4); u4 = MFMA16(ka[1], vB[1][n2], u4); S[mtile][n2] = S[mtile][n2] * d4 + u4 * l4; }
                if (mtile & 1) asm volatile("" ::: "memory"); }
        }
        LBAR();
        if (producer) {
            if (p_on && p_full) {
                MP_LANE(); const int m = lane & 15, g = lane >> 4, sb = pw;
                const LAS unsigned char* const bufp = lds + bp * BUF;
                bf16x8_t kf[NKS];
#pragma unroll
                for (int ks = 0; ks < NKS; ++ks) kf[ks] = *(const LAS bf16x8_t*)(bufp + B_KH + (16 * sb + m) * PQ + 64 * ks + 16 * g);
                for (int tb = sb; tb < 4; ++tb) { f32x4 acc = {0.f, 0.f, 0.f, 0.f};
#pragma unroll
                    for (int ks = 0; ks < NKS; ++ks) { const bf16x8_t a = *(const LAS bf16x8_t*)(bufp + B_QH + (16 * tb + m) * PQ + 64 * ks + 16 * g); acc = MFMA16(a, kf[ks], acc); }
#pragma unroll
                    for (int j = 0; j < 4; ++j) { const int t = 16 * tb + 4 * g + j, s = 16 * sb + m; const float val = (s <= t) ? acc[j] : 0.f;
                        *(LAS unsigned short*)(lds + L_SC + t * PT + 2 * s) = (unsigned short)f2bf(val); } }
            }
        } else if (c_on && c_full) {
            MP_LANE(); const int ctid = cw * 64 + lane, nt = ctid >> 2, ndq = ctid & 3;
            const size_t row0 = (size_t)b * SEQ + (size_t)i * 64;
            f32x4 ov[8]; float ss = 0.f;
#pragma unroll
            for (int i2 = 0; i2 < 8; ++i2) { ov[i2] = *(const LAS f32x4*)(lds + L_OB + nt * PO + 128 * ndq + 16 * i2); ss += (ov[i2][0] * ov[i2][0] + ov[i2][1] * ov[i2][1]) + (ov[i2][2] * ov[i2][2] + ov[i2][3] * ov[i2][3]); }
            ss += shfl_xor_l(ss, 1, lane); ss += shfl_xor_l(ss, 2, lane);
            const float rn = __builtin_amdgcn_rsqf(ss * (1.0f / 128.0f) + EPS);
            bf16* op = F.O() + (row0 + nt) * D + oc + 32 * ndq;
#pragma unroll
            for (int i4 = 0; i4 < 4; ++i4) { unsigned ow[4];
#pragma unroll
                for (int hh = 0; hh < 2; ++hh) { const int i2 = 2 * i4 + hh; const f32x4 gn4 = *(const f32x4*)(gnp + 32 * ndq + 4 * i2); const unsigned g01 = ogreg[i4][2 * hh], g23 = ogreg[i4][2 * hh + 1];
                    const float ga = bflo(g01), gb = bfhi(g01), gcc = bflo(g23), gd = bfhi(g23);
                    const float r0 = ov[i2][0] * rn * gn4[0] * (ga * __builtin_amdgcn_rcpf(1.0f + __builtin_amdgcn_exp2f(-ga * L2E))), r1 = ov[i2][1] * rn * gn4[1] * (gb * __builtin_amdgcn_rcpf(1.0f + __builtin_amdgcn_exp2f(-gb * L2E)));
                    const float r2 = ov[i2][2] * rn * gn4[2] * (gcc * __builtin_amdgcn_rcpf(1.0f + __builtin_amdgcn_exp2f(-gcc * L2E))), r3 = ov[i2][3] * rn * gn4[3] * (gd * __builtin_amdgcn_rcpf(1.0f + __builtin_amdgcn_exp2f(-gd * L2E)));
                    ow[2 * hh] = cvtpk(r0, r1); ow[2 * hh + 1] = cvtpk(r2, r3); }
                *(v4u*)(op + 8 * i4) = (v4u){ow[0], ow[1], ow[2], ow[3]}; }
        }
        LBAR();
    }
#undef MP_LOAD_RAW
#undef MP_LANE
}
#ifndef MX_N0
#define MX_N0 42
#endif
__device__ __forceinline__ void mixer_phase_pipe(Frame& F, int l) {
#if MX_SPLIT
    for (int it = blockIdx.x; it < 256; it += F.G) { const int s = it & 63, seg = (it >> 6) & 1;
        if (it < 128) mixer_pipe_stream<128, true>(F, l, s >> 2, s & 3, 0, seg ? MX_N0 : 0, seg ? SEQ / 64 : MX_N0);
        else mixer_pipe_stream<64, false>(F, l, s >> 2, s & 3, 0, seg ? MX_N0 : 0, seg ? SEQ / 64 : MX_N0); }
#else
    for (int it = blockIdx.x; it < 128; it += F.G) { const int s = it & 63;
        if (it < 64) mixer_pipe_stream<128, true>(F, l, s >> 2, s & 3, 0, 0, SEQ / 64);
        else mixer_pipe_stream<64, false>(F, l, s >> 2, s & 3, 0, 0, SEQ / 64); }
#endif
}
__device__ __forceinline__ void fix_phase(Frame& F, int l) {
    const int gt = F.vcu * (NWAVES * 64) + F.tid, NGT = F.G * NWAVES * 64;
    const float* cw = F.SMALL() + SM_CW + l * 3 * NUP; const float* cb = F.SMALL() + SM_CB + l * NUP;
    for (int i = gt; i < 256 * FF; i += NGT) { const int pm = i / FF, f = i % FF; if ((pm & 15) == 0) continue;
        const int ca = 256 * (f >> 7) + (f & 127), cv = ca + 128;
        const float* T = F.RAWT() + (size_t)(pm - 1) * 2 * NUP; const float* H = F.RAWH() + (size_t)pm * 2 * NUP;
        const float a_m2 = T[ca], a_m1 = T[NUP + ca], a_0 = H[ca], a_1 = H[NUP + ca], v_m2 = T[cv], v_m1 = T[NUP + cv], v_0 = H[cv], v_1 = H[NUP + cv];
        const float wa0 = cw[ca], wa1 = cw[NUP + ca], wa2 = cw[2 * NUP + ca], wv0 = cw[cv], wv1 = cw[NUP + cv], wv2 = cw[2 * NUP + cv], ba = cb[ca], bv = cb[cv];
        const float ca0 = ba + wa0 * a_m2 + wa1 * a_m1 + wa2 * a_0, cv0 = bv + wv0 * v_m2 + wv1 * v_m1 + wv2 * v_0;
        const float ca1 = ba + wa0 * a_m1 + wa1 * a_0 + wa2 * a_1, cv1 = bv + wv0 * v_m1 + wv1 * v_0 + wv2 * v_1;
        bf16* g = F.Gb() + (size_t)pm * 256 * FF + f;
        g[0] = (bf16)f2bf(ca0 * sigmoid_f(ca0) * cv0); g[FF] = (bf16)f2bf(ca1 * sigmoid_f(ca1) * cv1); }
}

__device__ __forceinline__ void final_phase(Frame& F) {
    const int gw = F.vcu * NWAVES + F.wave, NGW = F.G * NWAVES;
    for (int row = gw; row < M; row += NGW) {
        GAS f32x4* xr = (GAS f32x4*)(F.out + (size_t)row * D) + F.lane;
        float ss = (F.lane < 16) ? F.STAT()[(size_t)row * 16 + F.lane] : 0.f; ss = wave_sum(ss, F.lane);
        const float r = 1.0f / sqrtf(ss * (1.0f / (float)D) + EPS);
#pragma unroll
        for (int j = 0; j < 4; ++j) { const f32x4 v = xr[64 * j]; const f32x4 g = *(const f32x4*)(F.lnf_g + 256 * j + 4 * F.lane); xr[64 * j] = v * r * g; }
    }
}

struct Args { const float* in[18]; float* out; unsigned char* ws; int ph_lo, ph_hi; };
__global__ void __launch_bounds__(NWAVES * 64, 2) fwd(Args args) {
    extern __shared__ __attribute__((aligned(16))) unsigned char lds[];
    Frame F;
    F.lds = (LAS unsigned char*)lds; F.MISC = (volatile LAS unsigned*)(F.lds + MISC_OFF);
    F.tid = threadIdx.x; F.lane = F.tid & 63; F.wave = __builtin_amdgcn_readfirstlane(F.tid >> 6);
    F.G = gridDim.x; { const int bx = blockIdx.x; F.vcu = (F.G % 8 == 0) ? (bx % 8) * (F.G / 8) + bx / 8 : bx; }
    unsigned char* ws = args.ws;
    F.ctl = (unsigned*)(ws + WS_CTL); F.ws = ws;
    F.x = args.in[0]; F.c = args.in[1]; F.ln1_g = args.in[2]; F.ln2_g = args.in[3]; F.w_ada = args.in[4]; F.b_ada = args.in[5]; F.w_in = args.in[6]; F.lb_params = args.in[7];
    F.w_gk = args.in[8]; F.b_gk = args.in[9]; F.gn_a = args.in[10]; F.gn_b = args.in[11]; F.w_out = args.in[12]; F.w_up = args.in[13]; F.conv_w = args.in[14]; F.conv_b = args.in[15];
    F.w_down = args.in[16]; F.lnf_g = args.in[17]; F.out = args.out;
    for (int u = F.tid; u < (LDS_BYTES - LDSCTL_OFF) / 4; u += NWAVES * 64) ((LAS unsigned*)(F.lds + LDSCTL_OFF))[u] = 0u;
    __syncthreads();
    const int lo = args.ph_lo, hi = args.ph_hi;
    XcdBarrier bar; bar.bar = F.ctl + CW_BAR; bar.x = 0; bar.st = nullptr;
    if (hi - lo > 1) bar = xcd_barrier_post(F.ctl + CW_BAR, F.MISC + 8);
#define IN(k) (lo <= (k) && (k) < hi)
#define SEAM(k) do { if (IN(k) && IN((k) + 1)) { int l0_; asm volatile("v_mbcnt_lo_u32_b32 %0, -1, 0\n\tv_mbcnt_hi_u32_b32 %0, -1, %0" : "=v"(l0_)); xcd_barrier(bar, F.wave == 0 && l0_ == 0); } } while (0)
    if (IN(0)) p0a(F);
    SEAM(0);
    if (IN(1)) p0b(F);
    SEAM(1);
    for (int l = 0; l < DEPTH; ++l) {
        const int pb = 2 + 6 * l;
#define LAUNDER_TID() do { int l_; asm volatile("v_mbcnt_lo_u32_b32 %0, -1, 0\n\tv_mbcnt_hi_u32_b32 %0, -1, %0" : "=v"(l_)); F.lane = l_; F.tid = F.wave * 64 + l_; asm volatile("" : "+s"(F.ws)); } while (0)
        if (IN(pb)) {
            LAUNDER_TID();
            pg8::Gemm g{F.XN(), F.WIN() + (size_t)l * NIN * 1024, M, NIN, D}; pg8::StaticOrder S; S.init(M, NIN, F.G, (int)blockIdx.x);
            pg8::EpiIn E{F.P(), F.SMALL() + SM_B1 + l * 16 * NIN, F.STAT()};
            pg8::gemm_phase<pg8::EpiIn, pg8::StaticOrder, true, true>(F.lds, g, S, E, F.tid);
        }
        SEAM(pb);
        if (IN(pb + 1)) { LAUNDER_TID(); mixer_phase_pipe(F, l); }
        SEAM(pb + 1);
        if (IN(pb + 2)) {
            LAUNDER_TID();
            pg8::Gemm g{F.O(), F.WOUT() + (size_t)l * 1024 * 1024, M, D, D}; pg8::StaticOrder S; S.init(M, D, F.G, (int)blockIdx.x);
            pg8::EpiXUpd E{l == 0 ? F.x : F.out, F.out, F.XN(), F.SMALL() + SM_GT1 + l * 16 * D, F.SMALL() + SM_GS2 + l * 16 * D, F.STAT()};
            pg8::gemm_phase<pg8::EpiXUpd, pg8::StaticOrder, true, true>(F.lds, g, S, E, F.tid);
        }
        SEAM(pb + 2);
        if (IN(pb + 3)) {
            LAUNDER_TID();
            pg8::Gemm g{F.XN(), F.WUP() + (size_t)l * NUP * 1024, M, NUP, D}; pg8::StaticOrder S; S.init(M, NUP, F.G, (int)blockIdx.x);
            pg8::EpiUp E{F.Gb(), F.SMALL() + SM_B2 + l * 16 * NUP, F.STAT(), F.SMALL() + SM_CW + l * 3 * NUP, F.SMALL() + SM_CB + l * NUP, F.RAWH(), F.RAWT(), (LAS float*)(F.lds + HALO_OFF)};
            pg8::gemm_phase<pg8::EpiUp, pg8::StaticOrder, true, true>(F.lds, g, S, E, F.tid);
        }
        SEAM(pb + 3);
        if (IN(pb + 4)) { LAUNDER_TID(); fix_phase(F, l); }
        SEAM(pb + 4);
        if (IN(pb + 5)) {
            LAUNDER_TID();
            pg8::Gemm g{F.Gb(), F.WDN() + (size_t)l * 1024 * FF, M, D, FF}; pg8::StaticOrder S; S.init(M, D, F.G, (int)blockIdx.x);
            pg8::EpiXUpd E{F.out, F.out, l + 1 < DEPTH ? F.XN() : (bf16*)nullptr, F.SMALL() + SM_GT2 + l * 16 * D, F.SMALL() + SM_GS1 + (l + 1 < DEPTH ? l + 1 : l) * 16 * D, F.STAT()};
            pg8::gemm_phase<pg8::EpiXUpd, pg8::StaticOrder, true, true>(F.lds, g, S, E, F.tid);
        }
        SEAM(pb + 5);
    }
    if (IN(N_PHASES - 1)) { LAUNDER_TID(); final_phase(F); }
#undef IN
#undef SEAM
}

extern "C" void kernel_launch(void* const* d_in, const int* in_sizes, int n_in, void* d_out, int out_size, void* d_ws, size_t ws_size, hipStream_t stream) {
    static int grid = 0;
    if (grid == 0) {
        if (n_in != 18 || in_sizes[0] != M * D || out_size != M * D || ws_size < WS_END) { fprintf(stderr, "kernel_launch: unexpected shapes / workspace (n_in %d, in0 %d, out %d, ws %zu < %zu); nothing launched\n", n_in, n_in > 0 ? in_sizes[0] : -1, out_size, ws_size, (size_t)WS_END); grid = -1; return; }
        int dev = 0, cus = 0, per_cu = 0;
        if (hipGetDevice(&dev) != hipSuccess || hipDeviceGetAttribute(&cus, hipDeviceAttributeMultiprocessorCount, dev) != hipSuccess) { grid = -1; return; }
        if (hipFuncSetAttribute((const void*)fwd, hipFuncAttributeMaxDynamicSharedMemorySize, LDS_BYTES) != hipSuccess) { fprintf(stderr, "kernel_launch: hipFuncSetAttribute failed\n"); grid = -1; return; }
        if (hipOccupancyMaxActiveBlocksPerMultiprocessor(&per_cu, (const void*)fwd, NWAVES * 64, LDS_BYTES) != hipSuccess || per_cu < 1) { fprintf(stderr, "kernel_launch: occupancy query says %d\n", per_cu); }
        (void)hipGetLastError();
        grid = cus;
    }
    if (grid < 0) return;
    if (hipMemsetAsync((char*)d_ws + WS_CTL, 0, CTL_ZERO_BYTES, stream) != hipSuccess) return;
    Args a{};
    for (int i = 0; i < 18; ++i) a.in[i] = (const float*)d_in[i];
    a.out = (float*)d_out; a.ws = (unsigned char*)d_ws;
#if MK_PER_PHASE
    for (int p = 0; p < N_PHASES; ++p) { a.ph_lo = p; a.ph_hi = p + 1; hipLaunchKernelGGL(fwd, dim3(grid), dim3(NWAVES * 64), LDS_BYTES, stream, a); }
#else
    a.ph_lo = 0; a.ph_hi = N_PHASES; hipLaunchKernelGGL(fwd, dim3(grid), dim3(NWAVES * 64), LDS_BYTES, stream, a);
#endif
}
```

```cpp
#include <hip/hip_runtime.h>
#include <cstdio>
#include <cstdint>
namespace pg8 {
#define PG8_LAS __attribute__((address_space(3)))
typedef unsigned short bf16_t;
typedef short bf16x8 __attribute__((ext_vector_type(8)));
typedef float f32x4 __attribute__((ext_vector_type(4)));
typedef unsigned u32x4 __attribute__((ext_vector_type(4)));
constexpr int BM = 256, BK = 64, HALF = 128, HTB = HALF * BK * 2  , STAGE_BYTES = 8 * HTB, NXCD = 8, WGM = 4;

__host__ __device__ __forceinline__ int lds_byte(int r, int c) { const int st = (r >> 4) * 2 + (c >> 5), rr = r & 15, cc = c & 31, ob = rr * 64 + cc * 2; return st * 1024 + (ob ^ (((ob >> 9) & 1) << 5)); }
__host__ __device__ __forceinline__ void stage_rc(int b, int& R, int& C) { const int st = b / 1024, sb = b % 1024, swz = sb ^ (((sb >> 9) & 1) << 5); R = (st >> 1) * 16 + swz / 64; C = (st & 1) * 32 + (swz % 64) / 2; }
__host__ __device__ __forceinline__ int perm32(int rho) { const int n = rho >> 4, i = rho & 15; return 8 * (i >> 2) + 4 * n + (i & 3); }

struct Unit { int pm, pn; };
struct Gemm { const bf16_t* A; const bf16_t* Bt; int M, N, K; };

struct StaticOrder {
    int nM, nN, nwg, G, c;
    __host__ __device__ void init(int M, int N, int G_, int c_) { nM = M / BM; nN = N / BM; nwg = nM * nN; G = G_; c = c_; }
    __host__ __device__ bool next(int i, Unit& u) const {
        const long L = (long)i * G + c; if (L >= nwg) return false;
        int wgid = (int)L; { const int q = nwg / NXCD, r = nwg % NXCD, xcd = wgid % NXCD, off = wgid / NXCD; wgid = (xcd < r ? xcd * (q + 1) : r * (q + 1) + (xcd - r) * q) + off; }
        const int nig = WGM * nN, gid = wgid / nig, fm = gid * WGM, gsz = (nM - fm) < WGM ? (nM - fm) : WGM;
        u.pm = fm + ((wgid % nig) % gsz); u.pn = (wgid % nig) / gsz; return true;
    }
    __device__ __forceinline__ void a_ready(const Unit&) const {}
    __device__ __forceinline__ void done(const Unit&) const {}
};


__device__ __forceinline__ float shfl_x(float v, int mask, int lane) { return __builtin_bit_cast(float, __builtin_amdgcn_ds_bpermute((lane ^ mask) << 2, __builtin_bit_cast(int, v))); }
__device__ __forceinline__ unsigned cvt_pk_bf16(float lo, float hi) { unsigned r; asm volatile("v_cvt_pk_bf16_f32 %0, %1, %2" : "=v"(r) : "v"(lo), "v"(hi)); return r; }
typedef unsigned u32x2 __attribute__((ext_vector_type(2)));
constexpr int EPI_LDS_OFF = 143360;
__device__ __forceinline__ void dma16(const void* gsrc_lane, PG8_LAS unsigned char* dst_wave) { __builtin_amdgcn_global_load_lds((const unsigned*)gsrc_lane, (PG8_LAS unsigned*)dst_wave, 16, 0, 0); }
constexpr int ROWS_PER_SEQ_TILES = 16;
constexpr float RMS_EPS = 1e-6f;
constexpr int D_MODEL = 1024, N_IN = 3840, N_UP = 5632, N_FF = 2816;

struct EpiIn {
    static constexpr bool PERM = true, AFTER_DRAIN = false; static constexpr int NPF = 3, NST = 16;
    bf16_t* P; const float* bias; const float* stat;
    __device__ __forceinline__ void prefetch(PG8_LAS unsigned char* epi, const Unit& u, int wid, int lane) const {
        const char* sp = (const char*)(stat + (size_t)(u.pm * BM + 32 * wid) * 16) + 16 * lane;
        dma16(sp, epi + 2048 * wid); dma16(sp + 1024, epi + 2048 * wid + 1024);
        dma16((const char*)(bias + (size_t)(u.pm / ROWS_PER_SEQ_TILES) * N_IN + u.pn * BM) + 16 * lane, epi + 16384);
    }
    __device__ __forceinline__ void operator()(f32x4 (&acc)[2][2][4][2], PG8_LAS unsigned char* epi, const Unit& u, int wr, int wc, int fr, int fq) const {
        const int row0 = u.pm * BM + wr * 64 + fr, col0 = u.pn * BM + wc * 32 + 8 * fq;
        struct { f32x4 sp[2][4], bv[2][2]; } pf;
#pragma unroll
        for (int ai = 0; ai < 2; ++ai)
#pragma unroll
            for (int m = 0; m < 4; ++m) pf.sp[ai][m] = *(const PG8_LAS f32x4*)(epi + ((ai * HALF + wr * 64 + m * 16 + fr) * 16 + 4 * fq) * 4);
#pragma unroll
        for (int bj = 0; bj < 2; ++bj)
#pragma unroll
            for (int n = 0; n < 2; ++n) pf.bv[bj][n] = *(const PG8_LAS f32x4*)(epi + 16384 + (wc * 32 + 8 * fq + bj * HALF + 4 * n) * 4);
#pragma unroll
        for (int ai = 0; ai < 2; ++ai)
#pragma unroll
            for (int m = 0; m < 4; ++m) { const int row = row0 + ai * HALF + m * 16;
                float s = (pf.sp[ai][m][0] + pf.sp[ai][m][1]) + (pf.sp[ai][m][2] + pf.sp[ai][m][3]); s += shfl_x(s, 16, fq * 16 + fr); s += shfl_x(s, 32, fq * 16 + fr);
                const float r = __builtin_amdgcn_rsqf(s * (1.0f / (float)D_MODEL) + RMS_EPS);
                bf16_t* rowp = P + (size_t)row * N_IN + col0;
#pragma unroll
                for (int bj = 0; bj < 2; ++bj) { const f32x4 v0 = acc[ai][bj][m][0] * r + pf.bv[bj][0], v1 = acc[ai][bj][m][1] * r + pf.bv[bj][1];
                    u32x4 w; w.x = cvt_pk_bf16(v0[0], v0[1]); w.y = cvt_pk_bf16(v0[2], v0[3]); w.z = cvt_pk_bf16(v1[0], v1[1]); w.w = cvt_pk_bf16(v1[2], v1[3]);
                    *(u32x4*)(rowp + bj * HALF) = w; } }
    }
};

struct EpiXUpd {
    static constexpr bool PERM = true, AFTER_DRAIN = false; static constexpr int NPF = 2, NST = 40;
    const float* xold; float* xnew; bf16_t* XN; const float* gt; const float* gsn; float* stat;
    __device__ __forceinline__ void prefetch(PG8_LAS unsigned char* epi, const Unit& u, int wid, int lane) const {
        const size_t o = (size_t)(u.pm / ROWS_PER_SEQ_TILES) * D_MODEL + u.pn * BM;
        dma16((const char*)(gt + o) + 16 * lane, epi); dma16((const char*)(gsn + o) + 16 * lane, epi + 1024);
    }
    __device__ __forceinline__ void operator()(f32x4 (&acc)[2][2][4][2], PG8_LAS unsigned char* epi, const Unit& u, int wr, int wc, int fr, int fq) const {
        const int row0 = u.pm * BM + wr * 64 + fr, col0 = u.pn * BM + wc * 32 + 8 * fq;
        f32x4 g[2][2], s[2][2];
#pragma unroll
        for (int bj = 0; bj < 2; ++bj)
#pragma unroll
            for (int n = 0; n < 2; ++n) { g[bj][n] = *(const PG8_LAS f32x4*)(epi + (wc * 32 + 8 * fq + bj * HALF + 4 * n) * 4); s[bj][n] = *(const PG8_LAS f32x4*)(epi + 1024 + (wc * 32 + 8 * fq + bj * HALF + 4 * n) * 4); }
#pragma unroll
        for (int ai = 0; ai < 2; ++ai)
#pragma unroll
            for (int m = 0; m < 4; ++m) { const int row = row0 + ai * HALF + m * 16; const size_t off = (size_t)row * D_MODEL + col0; float ss = 0.f;
#pragma unroll
                for (int bj = 0; bj < 2; ++bj) {
                    const f32x4 x0 = *(const f32x4*)(xold + off + bj * HALF) + g[bj][0] * acc[ai][bj][m][0], x1 = *(const f32x4*)(xold + off + bj * HALF + 4) + g[bj][1] * acc[ai][bj][m][1];
                    *(f32x4*)(xnew + off + bj * HALF) = x0; *(f32x4*)(xnew + off + bj * HALF + 4) = x1;
                    ss += (x0[0] * x0[0] + x0[1] * x0[1]) + (x0[2] * x0[2] + x0[3] * x0[3]) + (x1[0] * x1[0] + x1[1] * x1[1]) + (x1[2] * x1[2] + x1[3] * x1[3]);
                    if (XN) { const f32x4 y0 = x0 * s[bj][0], y1 = x1 * s[bj][1];
                        u32x4 w; w.x = cvt_pk_bf16(y0[0], y0[1]); w.y = cvt_pk_bf16(y0[2], y0[3]); w.z = cvt_pk_bf16(y1[0], y1[1]); w.w = cvt_pk_bf16(y1[2], y1[3]);
                        *(u32x4*)(XN + off + bj * HALF) = w; } }
                ss += shfl_x(ss, 16, fq * 16 + fr); ss += shfl_x(ss, 32, fq * 16 + fr);
                if (fq == 0) stat[(size_t)row * 16 + u.pn * 4 + wc] = ss; }
    }
};

__device__ __forceinline__ float dpp_ror1(float v) { return __builtin_bit_cast(float, __builtin_amdgcn_mov_dpp(__builtin_bit_cast(int, v), 0x121, 0xf, 0xf, true)); }
__device__ __forceinline__ float dpp_ror2(float v) { return __builtin_bit_cast(float, __builtin_amdgcn_mov_dpp(__builtin_bit_cast(int, v), 0x122, 0xf, 0xf, true)); }
__device__ __forceinline__ float dpp_shr1z(float v) { return __builtin_bit_cast(float, __builtin_amdgcn_update_dpp(0, __builtin_bit_cast(int, v), 0x111, 0xf, 0xf, true)); }
__device__ __forceinline__ float dpp_shr2z(float v) { return __builtin_bit_cast(float, __builtin_amdgcn_update_dpp(0, __builtin_bit_cast(int, v), 0x112, 0xf, 0xf, true)); }
__device__ __forceinline__ float silu_f(float x) { return x * __builtin_amdgcn_rcpf(1.0f + __builtin_amdgcn_exp2f(-1.4426950408889634f * x)); }
struct EpiUp {
    static constexpr bool PERM = true, AFTER_DRAIN = false; static constexpr int NPF = 4, NST = 16;
    bf16_t* G; const float* bias; const float* stat; const float* cw; const float* cb; float* rawh; float* rawt; PG8_LAS float* halo;
    __device__ __forceinline__ void prefetch(PG8_LAS unsigned char* epi, const Unit& u, int wid, int lane) const {
        const char* sp = (const char*)(stat + (size_t)(u.pm * BM + 32 * wid) * 16) + 16 * lane;
        dma16(sp, epi + 2048 * wid); dma16(sp + 1024, epi + 2048 * wid + 1024);
        dma16((const char*)(bias + (size_t)(u.pm / ROWS_PER_SEQ_TILES) * N_UP + u.pn * BM) + 16 * lane, epi + 16384);
        const int which = wid & 3;
        dma16((const char*)((which < 3 ? cw + which * N_UP : cb) + u.pn * BM) + 16 * lane, (PG8_LAS unsigned char*)(halo + 2048) + 1024 * which);
    }
    __device__ __forceinline__ void operator()(f32x4 (&acc)[2][2][4][2], PG8_LAS unsigned char* epi, const Unit& u, int wr, int wc, int fr, int fq) const {
        const int row0 = u.pm * BM + wr * 64 + fr, tc0 = wc * 32 + 8 * fq, col0 = u.pn * BM + tc0;
        PG8_LAS float* vecs = halo + 2048;
        f32x4 bv[2][2];
#pragma unroll
        for (int bj = 0; bj < 2; ++bj)
#pragma unroll
            for (int n = 0; n < 2; ++n) bv[bj][n] = *(const PG8_LAS f32x4*)(epi + 16384 + (tc0 + bj * HALF + 4 * n) * 4);
#pragma unroll
        for (int ai = 0; ai < 2; ++ai)
#pragma unroll
            for (int m = 0; m < 4; ++m) { const f32x4 sp = *(const PG8_LAS f32x4*)(epi + ((ai * HALF + wr * 64 + m * 16 + fr) * 16 + 4 * fq) * 4);
                float s = (sp[0] + sp[1]) + (sp[2] + sp[3]); s += shfl_x(s, 16, fq * 16 + fr); s += shfl_x(s, 32, fq * 16 + fr);
                const float r = __builtin_amdgcn_rsqf(s * (1.0f / (float)D_MODEL) + RMS_EPS);
#pragma unroll
                for (int bj = 0; bj < 2; ++bj)
#pragma unroll
                    for (int n = 0; n < 2; ++n) acc[ai][bj][m][n] = acc[ai][bj][m][n] * r + bv[bj][n];
                asm volatile("" : "+v"(acc[ai][0][m][0]), "+v"(acc[ai][0][m][1]), "+v"(acc[ai][1][m][0]), "+v"(acc[ai][1][m][1])); }
#pragma unroll
        for (int ai = 0; ai < 2; ++ai) {
            if (fr >= 14) {
                PG8_LAS float* hp = halo + ((ai * 2 + wr) * 2 + (fr - 14)) * 256 + tc0;
#pragma unroll
                for (int bj = 0; bj < 2; ++bj)
#pragma unroll
                    for (int n = 0; n < 2; ++n) *(PG8_LAS f32x4*)(hp + bj * HALF + 4 * n) = acc[ai][bj][3][n];
            }
        }
        if (wr == 0 && fr < 2) { float* hp = rawh + ((size_t)u.pm * 2 + fr) * N_UP + col0;
#pragma unroll
            for (int bj = 0; bj < 2; ++bj)
#pragma unroll
                for (int n = 0; n < 2; ++n) *(f32x4*)(hp + bj * HALF + 4 * n) = acc[0][bj][0][n]; }
        if (wr == 1 && fr >= 14) { float* tp = rawt + ((size_t)u.pm * 2 + (fr - 14)) * N_UP + col0;
#pragma unroll
            for (int bj = 0; bj < 2; ++bj)
#pragma unroll
                for (int n = 0; n < 2; ++n) *(f32x4*)(tp + bj * HALF + 4 * n) = acc[1][bj][3][n]; }
        asm volatile("s_waitcnt lgkmcnt(0)" ::: "memory"); __builtin_amdgcn_s_barrier(); asm volatile("" ::: "memory");
        const bool f15 = (fr == 15), f14 = (fr >= 14);
        unsigned gp[2][4][2];
#pragma unroll
        for (int n = 0; n < 2; ++n) {
            f32x4 w0[2], w1[2], w2[2], cbv[2];
#pragma unroll
            for (int bj = 0; bj < 2; ++bj) { const int c = tc0 + bj * HALF + 4 * n;
                w0[bj] = *(const PG8_LAS f32x4*)(vecs + c); w1[bj] = *(const PG8_LAS f32x4*)(vecs + 256 + c); w2[bj] = *(const PG8_LAS f32x4*)(vecs + 512 + c); cbv[bj] = *(const PG8_LAS f32x4*)(vecs + 768 + c); }
#pragma unroll
            for (int ai = 0; ai < 2; ++ai) {
                f32x4 prev[2];
                {   const int pai = (wr == 1) ? ai : ai - 1, pwr = (wr == 1) ? 0 : 1;
                    const bool has = (pai >= 0);
                    const PG8_LAS float* hp = halo + ((pai * 2 + pwr) * 2 + (fr & 1)) * 256 + tc0 + 4 * n;
#pragma unroll
                    for (int bj = 0; bj < 2; ++bj) prev[bj] = (has && fr >= 14) ? *(const PG8_LAS f32x4*)(hp + bj * HALF) : (f32x4){0.f, 0.f, 0.f, 0.f}; }
#pragma unroll
                for (int m = 0; m < 4; ++m) {
                    f32x4 cu[2];
#pragma unroll
                    for (int bj = 0; bj < 2; ++bj) { const f32x4 cur = acc[ai][bj][m][n], pv = prev[bj]; f32x4 o;
#pragma unroll
                        for (int j = 0; j < 4; ++j) { const float s1 = dpp_ror1(f15 ? pv[j] : cur[j]), s2 = dpp_ror2(f14 ? pv[j] : cur[j]);
                            o[j] = cbv[bj][j] + w0[bj][j] * s2 + w1[bj][j] * s1 + w2[bj][j] * cur[j]; }
                        cu[bj] = o; prev[bj] = cur; }
                    f32x4 g;
#pragma unroll
                    for (int j = 0; j < 4; ++j) g[j] = silu_f(cu[0][j]) * cu[1][j];
                    const unsigned p0 = cvt_pk_bf16(g[0], g[1]), p1 = cvt_pk_bf16(g[2], g[3]);
                    if (n == 0) { gp[ai][m][0] = p0; gp[ai][m][1] = p1; }
                    else { u32x4 w; w.x = gp[ai][m][0]; w.y = gp[ai][m][1]; w.z = p0; w.w = p1;
                        *(u32x4*)(G + (size_t)(row0 + ai * HALF + m * 16) * N_FF + u.pn * HALF + tc0) = w; }
                }
            }
        }
    }
};
template <class Epi, class Sched, bool ALIGN_EPI = false, bool SP2 = false>
__device__ __forceinline__ void gemm_phase(PG8_LAS unsigned char* lds, const Gemm g, const Sched& S, const Epi& E, const int tid) {
    const int wid = __builtin_amdgcn_readfirstlane(tid >> 6), lane = tid & 63, wr = wid >> 2, wc = wid & 3, fr = lane & 15, fq = lane >> 4;
    const int K = g.K, nt = K / BK;
    unsigned voffA[2], voffB[2];
#pragma unroll
    for (int i = 0; i < 2; ++i) { int R, C; stage_rc(tid * 16 + i * 8192, R, C); const int Rb = Epi::PERM ? ((R & ~31) + perm32(R & 31)) : R;
        voffA[i] = (unsigned)(R * K + C) * 2u; voffB[i] = (unsigned)(Rb * K + C) * 2u; }
    const size_t kstep = (size_t)(BK * 2);
    const size_t hstep = (size_t)HALF * K * 2;
    const size_t tstep = 2 * hstep;
    const unsigned ldsw = (unsigned)wid * 1024u;
    const int aoff = lds_byte(wr * 64 + fr, fq * 8), boff = lds_byte(wc * 32 + fr, fq * 8);
#define PG8_SA(b, h) (((b) * 2 + (h)) * HTB)
#define PG8_SB(b, h) ((4 + (b) * 2 + (h)) * HTB)
#define PG8_STAGE(bufoff, gbase, voff) do { _Pragma("unroll") for (int _i = 0; _i < 2; ++_i) \
        __builtin_amdgcn_global_load_lds((const unsigned*)((const char*)(gbase) + (voff)[_i]), (PG8_LAS unsigned*)(lds + (bufoff) + ldsw + _i * 8192), 16, 0, 0); } while (0)
#define PG8_LDA(dst, b, h) do { _Pragma("unroll") for (int m = 0; m < 4; ++m) _Pragma("unroll") for (int k = 0; k < 2; ++k) dst[m][k] = *(const PG8_LAS bf16x8*)(lds + PG8_SA(b, h) + aoff + m * 2048 + k * 1024); } while (0)
#define PG8_LDB(dst, b, h) do { _Pragma("unroll") for (int n = 0; n < 2; ++n) _Pragma("unroll") for (int k = 0; k < 2; ++k) dst[n][k] = *(const PG8_LAS bf16x8*)(lds + PG8_SB(b, h) + boff + n * 2048 + k * 1024); } while (0)
#define PG8_MMA(ai, bj, At, Bt) do { __builtin_amdgcn_s_setprio(1); _Pragma("unroll") for (int m = 0; m < 4; ++m) _Pragma("unroll") for (int n = 0; n < 2; ++n) _Pragma("unroll") for (int k = 0; k < 2; ++k) \
        acc[ai][bj][m][n] = __builtin_amdgcn_mfma_f32_16x16x32_bf16(Bt[n][k], At[m][k], acc[ai][bj][m][n], 0, 0, 0); __builtin_amdgcn_s_setprio(0); } while (0)
#define PG8_WAIT_V(n) asm volatile("s_waitcnt vmcnt(" #n ")" ::: "memory")
#define PG8_WAIT_L(n) asm volatile("s_waitcnt lgkmcnt(" #n ")" ::: "memory")
#define PG8_BAR __builtin_amdgcn_s_barrier()
#define PG8_SCHED __builtin_amdgcn_sched_barrier(0)
    Unit cur, nxt; int ui = 0;
    if (!S.next(0, cur)) return;
    f32x4 acc[2][2][4][2];
#pragma unroll
    for (int a = 0; a < 2; ++a)
#pragma unroll
        for (int b = 0; b < 2; ++b)
#pragma unroll
            for (int m = 0; m < 4; ++m)
#pragma unroll
                for (int n = 0; n < 2; ++n) acc[a][b][m][n] = (f32x4){0.f, 0.f, 0.f, 0.f};
    bf16x8 At[4][2], B0[2][2], B1[2][2];
    const char* cA = (const char*)g.A + (size_t)cur.pm * tstep; const char* cB = (const char*)g.Bt + (size_t)cur.pn * tstep;
    S.a_ready(cur);
    if constexpr (SP2) {
        PG8_STAGE(PG8_SB(0, 0), cB, voffB); PG8_STAGE(PG8_SB(0, 1), cB + hstep, voffB); PG8_STAGE(PG8_SA(0, 0), cA, voffA); PG8_STAGE(PG8_SA(0, 1), cA + hstep, voffA);
        if (wr == 1) PG8_BAR;
        PG8_WAIT_V(2); PG8_BAR;
        PG8_STAGE(PG8_SB(1, 0), cB + kstep, voffB); PG8_STAGE(PG8_SA(1, 0), cA + kstep, voffA); PG8_STAGE(PG8_SB(1, 1), cB + hstep + kstep, voffB);
        PG8_WAIT_V(6); PG8_BAR;
    } else {
        PG8_STAGE(PG8_SB(0, 0), cB, voffB); PG8_STAGE(PG8_SA(0, 0), cA, voffA); PG8_STAGE(PG8_SB(0, 1), cB + hstep, voffB); PG8_STAGE(PG8_SA(0, 1), cA + hstep, voffA);
        if (wr == 1) PG8_BAR;
        PG8_WAIT_V(4); PG8_BAR;
        PG8_STAGE(PG8_SB(1, 0), cB + kstep, voffB); PG8_STAGE(PG8_SA(1, 0), cA + kstep, voffA); PG8_STAGE(PG8_SB(1, 1), cB + hstep + kstep, voffB);
        PG8_WAIT_V(6); PG8_BAR;
    }
    for (;;) {
        const bool has_next = S.next(ui + 1, nxt);
        const char* nA = has_next ? (const char*)g.A + (size_t)nxt.pm * tstep : cA; const char* nB = has_next ? (const char*)g.Bt + (size_t)nxt.pn * tstep : cB;
#define PG8_WAIT_VN(n) asm volatile("s_waitcnt vmcnt(%0)" :: "n"(n) : "memory")
#define PG8_TRIP(a1, a2, b2, a3, b3, PF, FA) do { \
              \
            PG8_LDB(B0, 0, 0); PG8_LDB(B1, 0, 1); PG8_SCHED; PG8_LDA(At, 0, 0); PG8_STAGE(PG8_SA(1, 1), (a1) + hstep, voffA); \
            if (FA) PG8_WAIT_VN(8 + Epi::NST); else PG8_WAIT_V(8); PG8_WAIT_L(0); PG8_BAR; PG8_MMA(0, 0, At, B0); PG8_MMA(0, 1, At, B1); PG8_BAR; PG8_SCHED; \
              \
            PG8_LDA(At, 0, 1); PG8_STAGE(PG8_SB(0, 0), (b2), voffB); PG8_STAGE(PG8_SB(0, 1), (b2) + hstep, voffB); PG8_STAGE(PG8_SA(0, 0), (a2), voffA); \
            if (FA) PG8_WAIT_VN(8 + Epi::NST); else PG8_WAIT_V(8); PG8_WAIT_L(0); PG8_BAR; PG8_MMA(1, 0, At, B0); PG8_MMA(1, 1, At, B1); PG8_BAR; PG8_SCHED; \
            if (PF) { int lane_p; asm volatile("v_mbcnt_lo_u32_b32 %0, -1, 0\n\tv_mbcnt_hi_u32_b32 %0, -1, %0" : "=v"(lane_p)); E.prefetch(lds + EPI_LDS_OFF, cur, wid, lane_p); } \
              \
            PG8_LDB(B0, 1, 0); PG8_LDB(B1, 1, 1); PG8_SCHED; PG8_LDA(At, 1, 0); PG8_STAGE(PG8_SA(0, 1), (a2) + hstep, voffA); \
            if (PF) PG8_WAIT_VN(8 + Epi::NPF); else PG8_WAIT_V(8); PG8_WAIT_L(0); PG8_BAR; PG8_MMA(0, 0, At, B0); PG8_MMA(0, 1, At, B1); PG8_BAR; PG8_SCHED; \
              \
            PG8_LDA(At, 1, 1); PG8_STAGE(PG8_SB(1, 0), (b3), voffB); PG8_STAGE(PG8_SB(1, 1), (b3) + hstep, voffB); PG8_STAGE(PG8_SA(1, 0), (a3), voffA); \
            if (PF) PG8_WAIT_VN(8 + Epi::NPF); else PG8_WAIT_V(8); PG8_WAIT_L(0); PG8_BAR; PG8_MMA(1, 0, At, B0); PG8_MMA(1, 1, At, B1); PG8_BAR; PG8_SCHED; } while (0)
        static_assert(SP2, "this build keeps only the two-blocks-per-barrier K-loop");
        for (int t = 0; t < nt; t += 2) {
            const bool last = (t == nt - 2);
            const char* a1 = cA + (size_t)(t + 1) * kstep;
            const char* a2 = last ? nA : cA + (size_t)(t + 2) * kstep; const char* b2 = last ? nB : cB + (size_t)(t + 2) * kstep;
            if (last && has_next) S.a_ready(nxt);
            const bool pfl = last && (Epi::NPF > 0), fa = (t == 0) && (ui > 0) && (Epi::NST > 0);
            PG8_TRIP(a1, a2, b2, a2 + kstep, b2 + kstep, pfl, fa);
        }
#undef PG8_TRIP
#undef PG8_WAIT_VN
        if constexpr (ALIGN_EPI) { if (wr == 0) PG8_BAR; }
        if constexpr (Epi::NPF > 0) { asm volatile("s_waitcnt vmcnt(8)" ::: "memory"); PG8_BAR; asm volatile("" ::: "memory"); }
        if constexpr (!Epi::AFTER_DRAIN) { int lane_e; asm volatile("v_mbcnt_lo_u32_b32 %0, -1, 0\n\tv_mbcnt_hi_u32_b32 %0, -1, %0" : "=v"(lane_e));
            const int fr_e = lane_e & 15, fq_e = lane_e >> 4; int wr_e = wr, wc_e = wc; asm volatile("" : "+s"(wr_e), "+s"(wc_e));
            E(acc, lds + EPI_LDS_OFF, cur, wr_e, wc_e, fr_e, fq_e);
            S.done(cur); }
        if (!has_next) break;
#pragma unroll
        for (int a = 0; a < 2; ++a)
#pragma unroll
            for (int b = 0; b < 2; ++b)
#pragma unroll
                for (int m = 0; m < 4; ++m)
#pragma unroll
                    for (int n = 0; n < 2; ++n) acc[a][b][m][n] = (f32x4){0.f, 0.f, 0.f, 0.f};
        cur = nxt; cA = nA; cB = nB; ++ui;
        if constexpr (ALIGN_EPI) { if (wr == 1) PG8_BAR; }
    }
    PG8_WAIT_V(0);
    if constexpr (!ALIGN_EPI) { if (wr == 0) PG8_BAR; }
    PG8_BAR;
    if constexpr (Epi::AFTER_DRAIN) { E.fused(acc, cur, wr, wc, fr, fq, lds, wid, lane); S.done(cur); }
#undef PG8_SA
#undef PG8_SB
#undef PG8_STAGE
#undef PG8_LDA
#undef PG8_LDB
#undef PG8_MMA
#undef PG8_WAIT_V
#undef PG8_WAIT_L
#undef PG8_BAR
#undef PG8_SCHED
}
}

constexpr int NWAVES = 8;
#ifndef MK_PER_PHASE
#define MK_PER_PHASE 0
#endif
constexpr int NB = 16, SEQ = 4096, D = 1024, DEPTH = 4, M = NB * SEQ;
constexpr int NIN = 3840, NINW = 3584, FF = 2816, NUP = 5632, NMOD = 6144;
constexpr float EPS = 1e-6f;
constexpr int N_PHASES = 2 + 6 * DEPTH + 1;

constexpr size_t MiB = 1u << 20;
constexpr size_t WS_CTL = 0, CTL_ZERO_BYTES = 4 * MiB;
constexpr size_t WS_MOD = 2 * MiB;
constexpr size_t WS_SMALL = 4 * MiB;
constexpr size_t WS_STAT = 12 * MiB;
constexpr size_t WS_RAWH = 16 * MiB, WS_RAWT = 28 * MiB;
constexpr size_t WS_WIN = 40 * MiB;
constexpr size_t WS_WOUT = 70 * MiB;
constexpr size_t WS_WUP = 78 * MiB;
constexpr size_t WS_WDN = 122 * MiB;
constexpr size_t WS_XN = 144 * MiB;
constexpr size_t WS_O = 272 * MiB;
constexpr size_t WS_P = 400 * MiB;
constexpr size_t WS_END = 880 * MiB;
constexpr int SM_LB = 0;
constexpr int SM_CW = SM_LB + 4 * 512;
constexpr int SM_CB = SM_CW + 4 * 3 * NUP;
constexpr int SM_GS1 = SM_CB + 4 * NUP;
constexpr int SM_GS2 = SM_GS1 + 4 * 16 * D;
constexpr int SM_GT1 = SM_GS2 + 4 * 16 * D;
constexpr int SM_GT2 = SM_GT1 + 4 * 16 * D;
constexpr int SM_B1 = SM_GT2 + 4 * 16 * D;
constexpr int SM_B2 = SM_B1 + 4 * 16 * NIN;
constexpr int SM_END = SM_B2 + 4 * 16 * NUP;
static_assert((size_t)SM_END * 4 <= 8 * MiB, "small vectors fit");
constexpr int CW_BAR = 4096;

constexpr int LDS_BYTES = 163840;
constexpr int RING_BYTES = 131072, HALO_OFF = RING_BYTES, HALO_BYTES = 12288, LDSCTL_OFF = LDS_BYTES - 512, MISC_OFF = LDSCTL_OFF + 320;
static_assert(MISC_OFF + 128 <= LDS_BYTES && HALO_OFF + HALO_BYTES <= LDSCTL_OFF, "LDS map");

#define GAS __attribute__((address_space(1)))
#define LAS __attribute__((address_space(3)))
typedef unsigned short bf16;
typedef unsigned v4u __attribute__((ext_vector_type(4)));
typedef unsigned v2u __attribute__((ext_vector_type(2)));
typedef float f32x4 __attribute__((ext_vector_type(4)));
#define LDS_WAIT() asm volatile("s_waitcnt lgkmcnt(0)" ::: "memory")
__device__ __forceinline__ unsigned f2bf(float f) { unsigned u = __builtin_bit_cast(unsigned, f); return (u + 0x7fffu + ((u >> 16) & 1u)) >> 16; }
__device__ __forceinline__ unsigned pk2(float lo, float hi) { return f2bf(lo) | (f2bf(hi) << 16); }
__device__ __forceinline__ float bf2f(unsigned h) { return __builtin_bit_cast(float, h << 16); }
__device__ __forceinline__ float shfl_idx(float v, int src_lane) { return __builtin_bit_cast(float, __builtin_amdgcn_ds_bpermute(src_lane << 2, __builtin_bit_cast(int, v))); }
__device__ __forceinline__ float shfl_xor_l(float v, int mask, int lane) { return shfl_idx(v, lane ^ mask); }
__device__ __forceinline__ float wave_sum(float v, int lane) {
#pragma unroll
    for (int o = 1; o < 64; o <<= 1) v += shfl_xor_l(v, o, lane);
    return v;
}
__device__ __forceinline__ float sigmoid_f(float x) { return 1.0f / (1.0f + __expf(-x)); }
#define XB_TMO      128
#define XB_XCNT(j)  (256  + 64 * (j))
#define XB_XSUB(j)  (1280 + 64 * (j))
#define XB_XGEN(j)  (2304 + 64 * (j))
#define XB_TOP      3328
#define XB_TOPGEN   3392
#define XCD_BAR_WORDS 3456
#define XB_SPIN_CAP (1u << 18)

__device__ __forceinline__ unsigned xb_ld(unsigned* p)              { return __hip_atomic_load(p, __ATOMIC_RELAXED, __HIP_MEMORY_SCOPE_AGENT); }
__device__ __forceinline__ unsigned xb_add(unsigned* p, unsigned v) { return __hip_atomic_fetch_add(p, v, __ATOMIC_RELAXED, __HIP_MEMORY_SCOPE_AGENT); }
__device__ __forceinline__ unsigned xb_xcc_id() { return (unsigned)__builtin_amdgcn_s_getreg((3 << 11) | 20) & 0xFu; }
#define XB_SPIN(cond, bar) do { unsigned _sp = 0; while (cond) { __builtin_amdgcn_s_sleep(1); \
    if ((++_sp & 255u) == 0u) { if (xb_ld(&(bar)[XB_TMO])) break; if (_sp > XB_SPIN_CAP) { atomicAdd(&(bar)[XB_TMO], 1u); break; } } } } while (0)

struct XcdBarrier {
    unsigned* bar; unsigned x;
    volatile LAS unsigned* st;
};

__device__ __forceinline__ XcdBarrier xcd_barrier_post(unsigned* bar, volatile LAS unsigned* st) {
    XcdBarrier b; b.bar = bar; b.x = xb_xcc_id(); b.st = st;
    if (threadIdx.x == 0) (void)xb_add(&bar[XB_XCNT(b.x)], 1u);
    return b;
}
__device__ __forceinline__ void xcd_barrier_complete(unsigned* bar, unsigned x, unsigned& nloc, unsigned& nx) {
    const unsigned G = gridDim.x * gridDim.y * gridDim.z;
    unsigned sum, cnt, mine, sp = 0u;
    for (;;) {
        sum = 0u; cnt = 0u; mine = 0u;
#pragma unroll
        for (unsigned j = 0; j < 16; ++j) { const unsigned c = xb_ld(&bar[XB_XCNT(j)]); sum += c; cnt += (c > 0u) ? 1u : 0u; mine = (j == x) ? c : mine; }
        if (sum == G) break;
        __builtin_amdgcn_s_sleep(1);
        if ((++sp & 255u) == 0u) { if (xb_ld(&bar[XB_TMO])) break; if (sp > XB_SPIN_CAP) { atomicAdd(&bar[XB_TMO], 1u); break; } }
    }
    nloc = mine > 0u ? mine : 1u; nx = cnt > 0u ? cnt : 1u;
}

__device__ __forceinline__ void xcd_barrier(const XcdBarrier& b, const bool is_t0  ) {
    asm volatile("s_waitcnt vmcnt(0)" ::: "memory");
    __syncthreads();
    if (is_t0) {
        unsigned* bar = b.bar;
        __builtin_amdgcn_s_waitcnt(0);
        unsigned nloc = b.st[0], nx = b.st[1];
        if (nloc == 0u) { xcd_barrier_complete(bar, b.x, nloc, nx); b.st[0] = nloc; b.st[1] = nx; }
        const unsigned old = xb_add(&bar[XB_XSUB(b.x)], 1u);
        const unsigned gen = old / nloc;
        if (old + 1u == (gen + 1u) * nloc) {
            __builtin_amdgcn_fence(__ATOMIC_RELEASE, "agent");
            asm volatile("s_waitcnt vmcnt(0)" ::: "memory");
            const unsigned og = xb_add(&bar[XB_TOP], 1u);
            const unsigned tg = og / nx;
            if (og + 1u == (tg + 1u) * nx) xb_add(&bar[XB_TOPGEN], 1u);
            else XB_SPIN(xb_ld(&bar[XB_TOPGEN]) == tg, bar);
            __builtin_amdgcn_fence(__ATOMIC_ACQUIRE, "agent");
            xb_add(&bar[XB_XGEN(b.x)], 1u);
            asm volatile("s_waitcnt vmcnt(0)" ::: "memory");
        } else {
            XB_SPIN(xb_ld(&bar[XB_XGEN(b.x)]) == gen, bar);
            __builtin_amdgcn_fence(__ATOMIC_ACQUIRE, "agent");
            asm volatile("s_waitcnt vmcnt(0)" ::: "memory");
        }
    }
    __syncthreads();
}

struct Frame {
    LAS unsigned char* lds;
    volatile LAS unsigned* MISC;
    unsigned* ctl;
    int tid, lane, wave, vcu, G;
    const float *x, *c, *ln1_g, *ln2_g, *w_ada, *b_ada, *w_in, *lb_params, *w_gk, *b_gk, *gn_a, *gn_b, *w_out, *w_up, *conv_w, *conv_b, *w_down, *lnf_g;
    float* out;
    unsigned char* ws;
    __device__ __forceinline__ float* MOD() const { return (float*)(ws + WS_MOD); }
    __device__ __forceinline__ float* SMALL() const { return (float*)(ws + WS_SMALL); }
    __device__ __forceinline__ float* STAT() const { return (float*)(ws + WS_STAT); }
    __device__ __forceinline__ float* RAWH() const { return (float*)(ws + WS_RAWH); }
    __device__ __forceinline__ float* RAWT() const { return (float*)(ws + WS_RAWT); }
    __device__ __forceinline__ bf16* WIN() const { return (bf16*)(ws + WS_WIN); }
    __device__ __forceinline__ bf16* WOUT() const { return (bf16*)(ws + WS_WOUT); }
    __device__ __forceinline__ bf16* WUP() const { return (bf16*)(ws + WS_WUP); }
    __device__ __forceinline__ bf16* WDN() const { return (bf16*)(ws + WS_WDN); }
    __device__ __forceinline__ bf16* XN() const { return (bf16*)(ws + WS_XN); }
    __device__ __forceinline__ bf16* O() const { return (bf16*)(ws + WS_O); }
    __device__ __forceinline__ bf16* P() const { return (bf16*)(ws + WS_P); }
    __device__ __forceinline__ bf16* Gb() const { return (bf16*)(ws + WS_P); }
};

__device__ __forceinline__ void tr_item(const float* W, int Nsrc, int K, bf16* WT, int kb, int sn0, int dn0, float scale, LAS float* scr, int lane) {
    const int k0 = 64 * kb;
#pragma unroll 8
    for (int i = 0; i < 32; ++i) { const int kk = 2 * i + (lane >> 5); scr[kk * 33 + (lane & 31)] = W[(size_t)(k0 + kk) * Nsrc + sn0 + (lane & 31)]; }
    LDS_WAIT(); asm volatile("" ::: "memory");
    const int c = lane & 7;
#pragma unroll
    for (int j = 0; j < 4; ++j) { const int n = (lane >> 3) + 8 * j; const LAS float* s = scr + (8 * c) * 33 + n;
        v4u o; o.x = pk2(s[0 * 33] * scale, s[1 * 33] * scale); o.y = pk2(s[2 * 33] * scale, s[3 * 33] * scale); o.z = pk2(s[4 * 33] * scale, s[5 * 33] * scale); o.w = pk2(s[6 * 33] * scale, s[7 * 33] * scale);
        *(GAS v4u*)(WT + (size_t)(dn0 + n) * K + k0 + 8 * c) = o; }
    LDS_WAIT(); asm volatile("" ::: "memory");
}
__host__ __device__ __forceinline__ int up_orig(int np) { return ((np & 255) >> 7) * FF + 128 * (np >> 8) + (np & 127); }

__device__ __forceinline__ void p0a(Frame& F) {
    const int gw = F.vcu * NWAVES + F.wave, NGW = F.G * NWAVES, gt = F.vcu * (NWAVES * 64) + F.tid, NGT = F.G * NWAVES * 64;
    {
        LAS float* cond = (LAS float*)F.lds;
        for (int e = F.tid; e < 16 * 1024; e += NWAVES * 64) { const int b = e >> 10, d = e & 1023; const float cv = F.c[b * 1024 + d]; cond[d * 16 + b] = cv * sigmoid_f(cv); }
        __syncthreads();
        for (int it = gw; it < DEPTH * 384; it += NGW) {
            const int cb = it % 384, l = it / 384, e = cb * 16 + (F.lane & 15), dq = F.lane >> 4;
            const float* w = F.w_ada + ((size_t)l * 1024 + dq) * NMOD + e;
            float acc[16];
#pragma unroll
            for (int b = 0; b < 16; ++b) acc[b] = 0.f;
#pragma unroll 4
            for (int dd = 0; dd < 256; ++dd) {
                const float wv = w[(size_t)(4 * dd) * NMOD];
                const LAS f32x4* cp = (const LAS f32x4*)(cond + (4 * dd + dq) * 16);
#pragma unroll
                for (int q = 0; q < 4; ++q) { const f32x4 cq = cp[q]; acc[4 * q] += cq[0] * wv; acc[4 * q + 1] += cq[1] * wv; acc[4 * q + 2] += cq[2] * wv; acc[4 * q + 3] += cq[3] * wv; }
            }
            const float bb = F.b_ada[l * NMOD + e];
#pragma unroll
            for (int b = 0; b < 16; ++b) { float v = acc[b]; v += shfl_xor_l(v, 16, F.lane); v += shfl_xor_l(v, 32, F.lane); if (dq == 0) F.MOD()[(size_t)(l * 16 + b) * NMOD + e] = v + bb; }
        }
        __syncthreads();
    }
    for (int i = gt; i < 512; i += NGT) {
        const float p0 = F.lb_params[i], p1 = F.lb_params[512 + i], p2 = F.lb_params[1024 + i], p3 = F.lb_params[1536 + i];
        const float mx = fmaxf(fmaxf(p0, p1), fmaxf(p2, p3)); const float e0 = __expf(p0 - mx), e1 = __expf(p1 - mx), e2 = __expf(p2 - mx), e3 = __expf(p3 - mx);
        const float inv = 1.0f / (e0 + e1 + e2 + e3);
        F.SMALL()[SM_LB + i] = 0.f; F.SMALL()[SM_LB + 512 + i] = e1 * inv; F.SMALL()[SM_LB + 1024 + i] = (e1 + e2) * inv; F.SMALL()[SM_LB + 1536 + i] = (e1 + e2 + e3) * inv;
    }
    for (int i = gt; i < DEPTH * 3 * NUP; i += NGT) { const int np = i % NUP, lj = i / NUP; F.SMALL()[SM_CW + i] = F.conv_w[(size_t)lj * NUP + up_orig(np)]; }
    for (int i = gt; i < DEPTH * NUP; i += NGT) { const int np = i % NUP, l = i / NUP; F.SMALL()[SM_CB + i] = F.conv_b[(size_t)l * NUP + up_orig(np)]; }
    for (int i = gt; i < DEPTH * 256 * 1024; i += NGT) {
        const int k = i & 1023, n = (i >> 10) & 255, l = i >> 18;
        const float* wi = F.w_in + ((size_t)l * 1024 + k) * 3600 + NINW; const float* wg = F.w_gk + (size_t)l * 16 * 256 + n;
        float s = 0.f;
#pragma unroll
        for (int r = 0; r < 16; ++r) s += wi[r] * wg[r * 256];
        F.WIN()[((size_t)l * NIN + NINW + n) * 1024 + k] = (bf16)f2bf(s);
    }
    {   LAS float* scr = (LAS float*)(F.lds + F.wave * 16384);
        constexpr int I_IN = 16 * 112, I_OUT = 16 * 32, I_UP = 16 * 176, I_DN = 44 * 32, I_L = I_IN + I_OUT + I_UP + I_DN;
        for (int it = gw; it < DEPTH * I_L; it += NGW) {
            const int l = it / I_L; int r = it % I_L;
            if (r < I_IN) { const int kb = r / 112, nb = r % 112; tr_item(F.w_in + (size_t)l * 1024 * 3600, 3600, 1024, F.WIN() + (size_t)l * NIN * 1024, kb, 32 * nb, 32 * nb, (nb >= 64 && nb < 72) ? 0.125f : 1.0f, scr, F.lane); continue; } r -= I_IN;
            if (r < I_OUT) { const int kb = r / 32, nb = r % 32; tr_item(F.w_out + (size_t)l * 1024 * 1024, 1024, 1024, F.WOUT() + (size_t)l * 1024 * 1024, kb, 32 * nb, 32 * nb, 1.0f, scr, F.lane); continue; } r -= I_OUT;
            if (r < I_UP) { const int kb = r / 176, nb = r % 176; tr_item(F.w_up + (size_t)l * 1024 * NUP, NUP, 1024, F.WUP() + (size_t)l * NUP * 1024, kb, up_orig(32 * nb), 32 * nb, 1.0f, scr, F.lane); continue; } r -= I_UP;
            { const int kb = r / 32, nb = r % 32; tr_item(F.w_down + (size_t)l * FF * 1024, 1024, FF, F.WDN() + (size_t)l * 1024 * FF, kb, 32 * nb, 32 * nb, 1.0f, scr, F.lane); }
        }
    }
}

__device__ __forceinline__ void p0b(Frame& F) {
    const int gw = F.vcu * NWAVES + F.wave, NGW = F.G * NWAVES, gt = F.vcu * (NWAVES * 64) + F.tid, NGT = F.G * NWAVES * 64;
    {   typedef short b8_t __attribute__((ext_vector_type(8)));
        constexpr int NB1 = NIN / 16, NB2 = NUP / 16, NBL = NB1 + NB2;
        const int m = F.lane & 15, g = F.lane >> 4;
        for (int it = gw; it < DEPTH * NBL; it += NGW) {
            const int l = it / NBL, r = it % NBL, which = r >= NB1, n0 = 16 * (which ? r - NB1 : r), ncols = which ? NUP : NIN;
            const bf16* wrow = (which ? F.WUP() + (size_t)l * NUP * 1024 : F.WIN() + (size_t)l * NIN * 1024) + (size_t)(n0 + m) * 1024 + 8 * g;
            const float* shp = F.MOD() + (size_t)(l * 16 + m) * NMOD + (which ? 3072 : 0) + 8 * g;
            f32x4 acc = {0.f, 0.f, 0.f, 0.f};
#pragma unroll 4
            for (int ks = 0; ks < 32; ++ks) {
                const b8_t bw = *(const GAS b8_t*)(wrow + 32 * ks);
                const f32x4 s0 = *(const GAS f32x4*)(shp + 32 * ks), s1 = *(const GAS f32x4*)(shp + 32 * ks + 4);
                unsigned hi[4], lo[4];
#pragma unroll
                for (int q = 0; q < 2; ++q) { const f32x4 s = q ? s1 : s0;
                    hi[2 * q] = pk2(s[0], s[1]); hi[2 * q + 1] = pk2(s[2], s[3]);
                    lo[2 * q] = pk2(s[0] - bf2f(hi[2 * q] & 0xffffu), s[1] - bf2f(hi[2 * q] >> 16)); lo[2 * q + 1] = pk2(s[2] - bf2f(hi[2 * q + 1] & 0xffffu), s[3] - bf2f(hi[2 * q + 1] >> 16)); }
                acc = __builtin_amdgcn_mfma_f32_16x16x32_bf16(__builtin_bit_cast(b8_t, (v4u){hi[0], hi[1], hi[2], hi[3]}), bw, acc, 0, 0, 0);
                acc = __builtin_amdgcn_mfma_f32_16x16x32_bf16(__builtin_bit_cast(b8_t, (v4u){lo[0], lo[1], lo[2], lo[3]}), bw, acc, 0, 0, 0);
            }
            float* outp = F.SMALL() + (which ? SM_B2 + l * 16 * NUP : SM_B1 + l * 16 * NIN);
            const int n = n0 + m; const float extra = (which == 0 && n >= NINW) ? F.b_gk[l * 256 + n - NINW] : 0.f;
#pragma unroll
            for (int j = 0; j < 4; ++j) outp[(4 * g + j) * ncols + n] = acc[j] + extra;
        }
    }
    for (int i = gt; i < DEPTH * 16 * D; i += NGT) { const int d = i & 1023, lb = i >> 10, l = lb >> 4; const float* mod = F.MOD() + (size_t)lb * NMOD;
        F.SMALL()[SM_GS1 + i] = F.ln1_g[l * D + d] * (1.0f + mod[1024 + d]); F.SMALL()[SM_GT1 + i] = mod[2048 + d];
        F.SMALL()[SM_GS2 + i] = F.ln2_g[l * D + d] * (1.0f + mod[4096 + d]); F.SMALL()[SM_GT2 + i] = mod[5120 + d]; }
    for (int row0 = 4 * gw; row0 < M; row0 += 4 * NGW) {
        const int b = row0 / SEQ; const float* mod = F.MOD() + (size_t)b * NMOD + 1024;
        f32x4 v[4][4];
#pragma unroll
        for (int r = 0; r < 4; ++r)
#pragma unroll
            for (int j = 0; j < 4; ++j) v[r][j] = ((const GAS f32x4*)(F.x + (size_t)(row0 + r) * D) + F.lane)[64 * j];
        f32x4 gsv[4];
#pragma unroll
        for (int j = 0; j < 4; ++j) { const int d = 256 * j + 4 * F.lane; const f32x4 g = *(const f32x4*)(F.ln1_g + d), sc = *(const f32x4*)(mod + d); gsv[j] = g * (sc + 1.0f); }
#pragma unroll
        for (int r = 0; r < 4; ++r) { GAS v2u* o8 = (GAS v2u*)(F.XN() + (size_t)(row0 + r) * D) + F.lane; float ss = 0.f;
#pragma unroll
            for (int j = 0; j < 4; ++j) { const f32x4 x = v[r][j]; ss += (x[0] * x[0] + x[1] * x[1]) + (x[2] * x[2] + x[3] * x[3]); const f32x4 y = x * gsv[j];
                v2u w; w.x = pk2(y[0], y[1]); w.y = pk2(y[2], y[3]); o8[64 * j] = w; }
            ss = wave_sum(ss, F.lane);
            if (F.lane < 16) F.STAT()[(size_t)(row0 + r) * 16 + F.lane] = (F.lane == 0) ? ss : 0.f; }
    }
}

#ifndef MX_SPLIT
#define MX_SPLIT 1
#endif


typedef short bf16x8_t __attribute__((ext_vector_type(8)));
typedef short s16x4_t __attribute__((ext_vector_type(4)));
typedef float f32x2_t __attribute__((ext_vector_type(2)));
typedef __bf16 bf16x2_t __attribute__((ext_vector_type(2)));
#define MFMA16(a, b, c) __builtin_amdgcn_mfma_f32_16x16x32_bf16((a), (b), (c), 0, 0, 0)
#define LBAR() do { asm volatile("s_waitcnt lgkmcnt(0)" ::: "memory"); __builtin_amdgcn_s_barrier(); asm volatile("" ::: "memory"); } while (0)
__device__ __forceinline__ unsigned cvtpk(float lo, float hi) { f32x2_t v = {lo, hi}; bf16x2_t r = __builtin_convertvector(v, bf16x2_t); return __builtin_bit_cast(unsigned, r); }
__device__ __forceinline__ float bflo(unsigned u) { return __builtin_bit_cast(float, u << 16); }
__device__ __forceinline__ float bfhi(unsigned u) { return __builtin_bit_cast(float, u & 0xffff0000u); }
__device__ __forceinline__ s16x4_t tr16(const LAS unsigned char* p) { return __builtin_bit_cast(s16x4_t, __builtin_amdgcn_ds_read_tr16_b64_v4i16((LAS s16x4_t*)p)); }
constexpr float L2E = 1.4426950408889634f;


template <int DK, bool IS_A>
__device__ __forceinline__ void mixer_pipe_stream(Frame& F, int l, int b, int h, const int n_lo, const int n_full, const int n_hi) {
    constexpr int DKW = DK / 4, PW = DKW / 2, RG = 64 / PW, RR = 64 / RG, RGREF = 32 / RR, NKS = DK / 32, NMT = DK / 16;
    constexpr int PQ = DK * 2 + 16, PT = 144, PV = 272, PO = 528;
    constexpr int BUF = 2 * 64 * PQ + 64 * PV, B_QH = 0, B_KH = 64 * PQ, B_VV = 2 * 64 * PQ;
    constexpr int L_SC = 2 * BUF, L_FAC = L_SC + 64 * PT, FACB = 3 * DK * 4, L_OB = L_FAC + 2 * FACB, L_END = L_OB + 64 * PO;
    static_assert(L_END <= LDSCTL_OFF, "mixer LDS map");
    LAS unsigned char* const lds = F.lds;
    const int w = F.wave;
    const bool producer = (w >= 4);
    const int pw = w - 4, cw = w;
    const int qc = IS_A ? 128 * h : 2048 + 64 * h, fc = IS_A ? 512 + 128 * h : 2304 + 64 * h, gkc = 3584 + 64 * h;
    const int vc = IS_A ? 1024 + 128 * h : 2560 + 128 * h, gc = IS_A ? 1536 + 128 * h : 3072 + 128 * h, oc = IS_A ? 128 * h : 512 + 128 * h;
    const float* gnp = (IS_A ? F.gn_a : F.gn_b) + l * 128;
#define MP_LANE() int lane; asm volatile("v_mbcnt_lo_u32_b32 %0, -1, 0\n\tv_mbcnt_hi_u32_b32 %0, -1, %0" : "=v"(lane))
    f32x4 S[NMT][2];
#pragma unroll
    for (int i = 0; i < NMT; ++i) { S[i][0] = (f32x4){0.f, 0.f, 0.f, 0.f}; S[i][1] = (f32x4){0.f, 0.f, 0.f, 0.f}; }
    v4u ogreg[4];
    unsigned q2[RR], f2[RR], k2[RR]; v4u vreg[4];
    float lb0 = 0.f, lb1 = 0.f;
#define MP_LOAD_RAW(n) do { const size_t row0_ = (size_t)b * SEQ + (size_t)(n) * 64; \
        _Pragma("unroll") for (int j = 0; j < RR; ++j) { const unsigned* pr = (const unsigned*)(F.P() + (row0_ + rg * RR + j) * NIN); \
            q2[j] = pr[(qc >> 1) + pw * PW + cpl]; if (IS_A) { f2[j] = pr[(fc >> 1) + pw * PW + cpl]; } else { k2[j] = pr[(fc >> 1) + pw * PW + cpl]; f2[j] = pr[(gkc >> 1) + pw * PW + cpl]; } } \
        _Pragma("unroll") for (int i = 0; i < 4; ++i) { const int id = pw * 64 + lane + 256 * i; vreg[i] = *(const v4u*)(F.P() + (row0_ + (id >> 4)) * NIN + vc + 8 * (id & 15)); } } while (0)
    if (producer) {
        MP_LANE(); const int cpl = lane % PW, rg = lane / PW, m = lane & 15, g = lane >> 4;
        if (IS_A) { lb0 = F.SMALL()[SM_LB + l * 512 + 128 * h + pw * DKW + 2 * cpl]; lb1 = F.SMALL()[SM_LB + l * 512 + 128 * h + pw * DKW + 2 * cpl + 1]; }
        MP_LOAD_RAW(n_lo);
        for (int tb = 0; tb < pw; ++tb)
#pragma unroll
            for (int j = 0; j < 4; ++j) *(LAS unsigned short*)(lds + L_SC + (16 * tb + 4 * g + j) * PT + 2 * (16 * pw + m)) = (unsigned short)0;
    }
#pragma unroll 1
    for (int i = n_lo - 1; i < n_hi; ++i) {
        const int bc = i & 1, bp = (i + 1) & 1;
        const bool c_on = (i >= n_lo), c_full = (i >= n_full), p_on = (i + 1 < n_hi), p_full = (i + 1 >= n_full);
        if (producer) {
            if (p_on) {
                MP_LANE(); const int cpl = lane % PW, rg = lane / PW;
                LAS unsigned char* const bufp = lds + bp * BUF;
                float cum[2][RR], kk[2][RR], lg[2];
#pragma unroll
                for (int c = 0; c < 2; ++c) { float run = IS_A ? 1.f : 0.f; const float lb = c ? lb1 : lb0;
#pragma unroll
                    for (int j = 0; j < RR; ++j) { const float x = c ? bfhi(f2[j]) : bflo(f2[j]);
                        if (IS_A) { const float sg = __builtin_amdgcn_rcpf(1.0f + __builtin_amdgcn_exp2f(-x * L2E)); run *= lb + (1.0f - lb) * sg; kk[c][j] = (1.0f - lb) * (1.0f - sg); }
                        else { run += (fminf(x, 0.f) * L2E - __builtin_amdgcn_logf(1.0f + __builtin_amdgcn_exp2f(-fabsf(x) * L2E))) * (1.0f / 16.0f); kk[c][j] = c ? bfhi(k2[j]) : bflo(k2[j]); }
                        cum[c][j] = run; }
                    lg[c] = IS_A ? __builtin_amdgcn_logf(run) : run; }
                float eb[2];
#pragma unroll
                for (int c = 0; c < 2; ++c) { float incl = lg[c];
#pragma unroll
                    for (int d = 1; d < RG; d <<= 1) { const float t = shfl_idx(incl, lane - d * PW); if (rg >= d) incl += t; }
                    const float base = incl - lg[c], tot = shfl_idx(incl, (RG - 1) * PW + cpl), refv = shfl_idx(base, RGREF * PW + cpl);
                    if (rg == 0) { LAS float* fp = (LAS float*)(lds + L_FAC + bp * FACB) + pw * DKW + 2 * cpl + c;
                        fp[0] = __builtin_amdgcn_exp2f(tot); fp[DK] = __builtin_amdgcn_exp2f(refv); fp[2 * DK] = __builtin_amdgcn_exp2f(tot - refv); }
                    eb[c] = IS_A ? __builtin_amdgcn_exp2f(base - refv) : base - refv; }
#pragma unroll
                for (int j = 0; j < RR; ++j) { const int t = rg * RR + j;
                    const float e10 = IS_A ? eb[0] * cum[0][j] : __builtin_amdgcn_exp2f(eb[0] + cum[0][j]), e11 = IS_A ? eb[1] * cum[1][j] : __builtin_amdgcn_exp2f(eb[1] + cum[1][j]);
                    if (p_full) *(LAS unsigned*)(bufp + B_QH + t * PQ + 2 * (pw * DKW + 2 * cpl)) = cvtpk(bflo(q2[j]) * e10, bfhi(q2[j]) * e11);
                    *(LAS unsigned*)(bufp + B_KH + t * PQ + 2 * (pw * DKW + 2 * cpl)) = cvtpk(kk[0][j] * __builtin_amdgcn_rcpf(e10), kk[1][j] * __builtin_amdgcn_rcpf(e11)); }
#pragma unroll
                for (int i2 = 0; i2 < 4; ++i2) { const int id = pw * 64 + lane + 256 * i2; *(LAS v4u*)(bufp + B_VV + (id >> 4) * PV + 16 * (id & 15)) = vreg[i2]; }
                if (i + 2 < n_hi) MP_LOAD_RAW(i + 2);
            }
        } else if (c_on) {
            MP_LANE(); const int m = lane & 15, g = lane >> 4, q4 = (lane & 15) >> 2, p4 = lane & 3, dv0 = 32 * cw;
            const LAS unsigned char* const bufc = lds + bc * BUF; const LAS unsigned char* const facp = lds + L_FAC + bc * FACB;
            const size_t row0 = (size_t)b * SEQ + (size_t)i * 64;
            if (c_full) { const int ctid = cw * 64 + lane;
#pragma unroll
                for (int i2 = 0; i2 < 4; ++i2) ogreg[i2] = *(const v4u*)(F.P() + (row0 + (ctid >> 2)) * NIN + gc + 32 * (ctid & 3) + 8 * i2); }
            bf16x8_t vB[2][2];
#pragma unroll
            for (int ks2 = 0; ks2 < 2; ++ks2)
#pragma unroll
                for (int n2 = 0; n2 < 2; ++n2) { const LAS unsigned char* vp = bufc + B_VV + (32 * ks2 + 8 * g + q4) * PV + 2 * (dv0 + 16 * n2 + 4 * p4);
                    const s16x4_t lo = tr16(vp), hi = tr16(vp + 4 * PV); vB[ks2][n2] = __builtin_shufflevector(lo, hi, 0, 1, 2, 3, 4, 5, 6, 7); }
            if (c_full) {
                f32x4 o[4][2];
#pragma unroll
                for (int mt = 0; mt < 4; ++mt) { o[mt][0] = (f32x4){0.f, 0.f, 0.f, 0.f}; o[mt][1] = (f32x4){0.f, 0.f, 0.f, 0.f};
#pragma unroll
                    for (int ks2 = 0; ks2 < 2; ++ks2) if (2 * ks2 <= mt) { const bf16x8_t a = *(const LAS bf16x8_t*)(lds + L_SC + (16 * mt + m) * PT + 64 * ks2 + 16 * g);
                        o[mt][0] = MFMA16(a, vB[ks2][0], o[mt][0]); o[mt][1] = MFMA16(a, vB[ks2][1], o[mt][1]); } }
#pragma unroll
                for (int sg = 0; sg < NKS; ++sg) {
                    const f32x4 ea = *(const LAS f32x4*)(facp + 4 * (DK + 32 * sg + 4 * g)), eb4 = *(const LAS f32x4*)(facp + 4 * (DK + 32 * sg + 16 + 4 * g));
                    bf16x8_t sB[2];
#pragma unroll
                    for (int n2 = 0; n2 < 2; ++n2) { const f32x4 sa = S[2 * sg][n2] * ea, sb4 = S[2 * sg + 1][n2] * eb4;
                        sB[n2] = __builtin_bit_cast(bf16x8_t, (v4u){cvtpk(sa[0], sa[1]), cvtpk(sa[2], sa[3]), cvtpk(sb4[0], sb4[1]), cvtpk(sb4[2], sb4[3])}); }
#pragma unroll
                    for (int mt = 0; mt < 4; ++mt) { const LAS unsigned char* qp = bufc + B_QH + (16 * mt + m) * PQ + 2 * (32 * sg + 4 * g);
                        const s16x4_t lo = *(const LAS s16x4_t*)qp, hi = *(const LAS s16x4_t*)(qp + 32); const bf16x8_t a = __builtin_shufflevector(lo, hi, 0, 1, 2, 3, 4, 5, 6, 7);
                        o[mt][0] = MFMA16(a, sB[0], o[mt][0]); o[mt][1] = MFMA16(a, sB[1], o[mt][1]); }
                    asm volatile("" ::: "memory"); }
#pragma unroll
                for (int mt = 0; mt < 4; ++mt)
#pragma unroll
                    for (int n2 = 0; n2 < 2; ++n2)
#pragma unroll
                        for (int j = 0; j < 4; ++j) *(LAS float*)(lds + L_OB + (16 * mt + 4 * g + j) * PO + 4 * (dv0 + 16 * n2 + m)) = o[mt][n2][j];
            }
#pragma unroll
            for (int mtile = 0; mtile < NMT; ++mtile) {
                bf16x8_t ka[2];
#pragma unroll
                for (int ks2 = 0; ks2 < 2; ++ks2) { const LAS unsigned char* kp = bufc + B_KH + (32 * ks2 + 8 * g + q4) * PQ + 2 * (16 * mtile + 4 * p4);
                    const s16x4_t lo = tr16(kp), hi = tr16(kp + 4 * PQ); ka[ks2] = __builtin_shufflevector(lo, hi, 0, 1, 2, 3, 4, 5, 6, 7); }
                const f32x4 d4 = *(const LAS f32x4*)(facp + 4 * (16 * mtile + 4 * g)), l4 = *(const LAS f32x4*)(facp + 4 * (2 * DK + 16 * mtile + 4 * g));
#pragma unroll
                for (int n2 = 0; n2 < 2; ++n2) { f32x4 u4 = {0.f, 0.f, 0.f, 0.f}; u4 = MFMA16(ka[0], vB[0][n2], u4); u4 = MFMA16(ka[1], vB[1][n2], u4); S[mtile][n2] = S[mtile][n2] * d4 + u4 * l4; }
                if (mtile & 1) asm volatile("" ::: "memory"); }
        }
        LBAR();
        if (producer) {
            if (p_on && p_full) {
                MP_LANE(); const int m = lane & 15, g = lane >> 4, sb = pw;
                const LAS unsigned char* const bufp = lds + bp * BUF;
                bf16x8_t kf[NKS];
#pragma unroll
                for (int ks = 0; ks < NKS; ++ks) kf[ks] = *(const LAS bf16x8_t*)(bufp + B_KH + (16 * sb + m) * PQ + 64 * ks + 16 * g);
                for (int tb = sb; tb < 4; ++tb) { f32x4 acc = {0.f, 0.f, 0.f, 0.f};
#pragma unroll
                    for (int ks = 0; ks < NKS; ++ks) { const bf16x8_t a = *(const LAS bf16x8_t*)(bufp + B_QH + (16 * tb + m) * PQ + 64 * ks + 16 * g); acc = MFMA16(a, kf[ks], acc); }
#pragma unroll
                    for (int j = 0; j < 4; ++j) { const int t = 16 * tb + 4 * g + j, s = 16 * sb + m; const float val = (s <= t) ? acc[j] : 0.f;
                        *(LAS unsigned short*)(lds + L_SC + t * PT + 2 * s) = (unsigned short)f2bf(val); } }
            }
        } else if (c_on && c_full) {
            MP_LANE(); const int ctid = cw * 64 + lane, nt = ctid >> 2, ndq = ctid & 3;
            const size_t row0 = (size_t)b * SEQ + (size_t)i * 64;
            f32x4 ov[8]; float ss = 0.f;
#pragma unroll
            for (int i2 = 0; i2 < 8; ++i2) { ov[i2] = *(const LAS f32x4*)(lds + L_OB + nt * PO + 128 * ndq + 16 * i2); ss += (ov[i2][0] * ov[i2][0] + ov[i2][1] * ov[i2][1]) + (ov[i2][2] * ov[i2][2] + ov[i2][3] * ov[i2][3]); }
            ss += shfl_xor_l(ss, 1, lane); ss += shfl_xor_l(ss, 2, lane);
            const float rn = __builtin_amdgcn_rsqf(ss * (1.0f / 128.0f) + EPS);
            bf16* op = F.O() + (row0 + nt) * D + oc + 32 * ndq;
#pragma unroll
            for (int i4 = 0; i4 < 4; ++i4) { unsigned ow[4];
#pragma unroll
                for (int hh = 0; hh < 2; ++hh) { const int i2 = 2 * i4 + hh; const f32x4 gn4 = *(const f32x4*)(gnp + 32 * ndq + 4 * i2); const unsigned g01 = ogreg[i4][2 * hh], g23 = ogreg[i4][2 * hh + 1];
                    const float ga = bflo(g01), gb = bfhi(g01), gcc = bflo(g23), gd = bfhi(g23);
                    const float r0 = ov[i2][0] * rn * gn4[0] * (ga * __builtin_amdgcn_rcpf(1.0f + __builtin_amdgcn_exp2f(-ga * L2E))), r1 = ov[i2][1] * rn * gn4[1] * (gb * __builtin_amdgcn_rcpf(1.0f + __builtin_amdgcn_exp2f(-gb * L2E)));
                    const float r2 = ov[i2][2] * rn * gn4[2] * (gcc * __builtin_amdgcn_rcpf(1.0f + __builtin_amdgcn_exp2f(-gcc * L2E))), r3 = ov[i2][3] * rn * gn4[3] * (gd * __builtin_amdgcn_rcpf(1.0f + __builtin_amdgcn_exp2f(-gd * L2E)));
                    ow[2 * hh] = cvtpk(r0, r1); ow[2 * hh + 1] = cvtpk(r2, r3); }
                *(v4u*)(op + 8 * i4) = (v4u){ow[0], ow[1], ow[2], ow[3]}; }
        }
        LBAR();
    }
#undef MP_LOAD_RAW
#undef MP_LANE
}
#ifndef MX_N0
#define MX_N0 42
#endif
#ifndef MX_N0B
#define MX_N0B MX_N0
#endif
__device__ __forceinline__ void mixer_phase_pipe(Frame& F, int l) {
#if MX_SPLIT
    for (int it = blockIdx.x; it < 256; it += F.G) { const int s = it & 63, seg = (it >> 6) & 1;
        if (it < 128) mixer_pipe_stream<128, true>(F, l, s >> 2, s & 3, 0, seg ? MX_N0 : 0, seg ? SEQ / 64 : MX_N0);
        else mixer_pipe_stream<64, false>(F, l, s >> 2, s & 3, 0, seg ? MX_N0B : 0, seg ? SEQ / 64 : MX_N0B); }
#else
    for (int it = blockIdx.x; it < 128; it += F.G) { const int s = it & 63;
        if (it < 64) mixer_pipe_stream<128, true>(F, l, s >> 2, s & 3, 0, 0, SEQ / 64);
        else mixer_pipe_stream<64, false>(F, l, s >> 2, s & 3, 0, 0, SEQ / 64); }
#endif
}
__device__ __forceinline__ void fix_phase(Frame& F, int l) {
    const int gt = F.vcu * (NWAVES * 64) + F.tid, NGT = F.G * NWAVES * 64;
    const float* cw = F.SMALL() + SM_CW + l * 3 * NUP; const float* cb = F.SMALL() + SM_CB + l * NUP;
    for (int i = gt; i < 256 * FF; i += NGT) { const int pm = i / FF, f = i % FF; if ((pm & 15) == 0) continue;
        const int ca = 256 * (f >> 7) + (f & 127), cv = ca + 128;
        const float* T = F.RAWT() + (size_t)(pm - 1) * 2 * NUP; const float* H = F.RAWH() + (size_t)pm * 2 * NUP;
        const float a_m2 = T[ca], a_m1 = T[NUP + ca], a_0 = H[ca], a_1 = H[NUP + ca], v_m2 = T[cv], v_m1 = T[NUP + cv], v_0 = H[cv], v_1 = H[NUP + cv];
        const float wa0 = cw[ca], wa1 = cw[NUP + ca], wa2 = cw[2 * NUP + ca], wv0 = cw[cv], wv1 = cw[NUP + cv], wv2 = cw[2 * NUP + cv], ba = cb[ca], bv = cb[cv];
        const float ca0 = ba + wa0 * a_m2 + wa1 * a_m1 + wa2 * a_0, cv0 = bv + wv0 * v_m2 + wv1 * v_m1 + wv2 * v_0;
        const float ca1 = ba + wa0 * a_m1 + wa1 * a_0 + wa2 * a_1, cv1 = bv + wv0 * v_m1 + wv1 * v_0 + wv2 * v_1;
        bf16* g = F.Gb() + (size_t)pm * 256 * FF + f;
        g[0] = (bf16)f2bf(ca0 * sigmoid_f(ca0) * cv0); g[FF] = (bf16)f2bf(ca1 * sigmoid_f(ca1) * cv1); }
}

__device__ __forceinline__ void final_phase(Frame& F) {
    const int gw = F.vcu * NWAVES + F.wave, NGW = F.G * NWAVES;
    f32x4 gv[4];
#pragma unroll
    for (int j = 0; j < 4; ++j) gv[j] = *(const f32x4*)(F.lnf_g + 256 * j + 4 * F.lane);
    for (int row0 = 4 * gw; row0 < M; row0 += 4 * NGW) {
        f32x4 v[4][4]; float ssr[4];
#pragma unroll
        for (int r = 0; r < 4; ++r) { ssr[r] = (F.lane < 16) ? F.STAT()[(size_t)(row0 + r) * 16 + F.lane] : 0.f;
#pragma unroll
            for (int j = 0; j < 4; ++j) v[r][j] = ((const GAS f32x4*)(F.out + (size_t)(row0 + r) * D) + F.lane)[64 * j]; }
#pragma unroll
        for (int r = 0; r < 4; ++r) { const float rs = __builtin_amdgcn_rsqf(wave_sum(ssr[r], F.lane) * (1.0f / (float)D) + EPS);
#pragma unroll
            for (int j = 0; j < 4; ++j) ((GAS f32x4*)(F.out + (size_t)(row0 + r) * D) + F.lane)[64 * j] = v[r][j] * rs * gv[j]; }
    }
}

struct Args { const float* in[18]; float* out; unsigned char* ws; int ph_lo, ph_hi; };
__global__ void __launch_bounds__(NWAVES * 64, 2) fwd(Args args) {
    extern __shared__ __attribute__((aligned(16))) unsigned char lds[];
    Frame F;
    F.lds = (LAS unsigned char*)lds; F.MISC = (volatile LAS unsigned*)(F.lds + MISC_OFF);
    F.tid = threadIdx.x; F.lane = F.tid & 63; F.wave = __builtin_amdgcn_readfirstlane(F.tid >> 6);
    F.G = gridDim.x; { const int bx = blockIdx.x; F.vcu = (F.G % 8 == 0) ? (bx % 8) * (F.G / 8) + bx / 8 : bx; }
    unsigned char* ws = args.ws;
    F.ctl = (unsigned*)(ws + WS_CTL); F.ws = ws;
    F.x = args.in[0]; F.c = args.in[1]; F.ln1_g = args.in[2]; F.ln2_g = args.in[3]; F.w_ada = args.in[4]; F.b_ada = args.in[5]; F.w_in = args.in[6]; F.lb_params = args.in[7];
    F.w_gk = args.in[8]; F.b_gk = args.in[9]; F.gn_a = args.in[10]; F.gn_b = args.in[11]; F.w_out = args.in[12]; F.w_up = args.in[13]; F.conv_w = args.in[14]; F.conv_b = args.in[15];
    F.w_down = args.in[16]; F.lnf_g = args.in[17]; F.out = args.out;
    for (int u = F.tid; u < (LDS_BYTES - LDSCTL_OFF) / 4; u += NWAVES * 64) ((LAS unsigned*)(F.lds + LDSCTL_OFF))[u] = 0u;
    __syncthreads();
    const int lo = args.ph_lo, hi = args.ph_hi;
    XcdBarrier bar; bar.bar = F.ctl + CW_BAR; bar.x = 0; bar.st = nullptr;
    if (hi - lo > 1) bar = xcd_barrier_post(F.ctl + CW_BAR, F.MISC + 8);
#define IN(k) (lo <= (k) && (k) < hi)
#define SEAM(k) do { if (IN(k) && IN((k) + 1)) { int l0_; asm volatile("v_mbcnt_lo_u32_b32 %0, -1, 0\n\tv_mbcnt_hi_u32_b32 %0, -1, %0" : "=v"(l0_)); xcd_barrier(bar, F.wave == 0 && l0_ == 0); } } while (0)
    if (IN(0)) p0a(F);
    SEAM(0);
#ifdef PROBE_P0A2
    p0a(F); SEAM(0);
#endif
    if (IN(1)) p0b(F);
    SEAM(1);
#ifdef PROBE_P0B2
    p0b(F); SEAM(1);
#endif
    for (int l = 0; l < DEPTH; ++l) {
        const int pb = 2 + 6 * l;
#define LAUNDER_TID() do { int l_; asm volatile("v_mbcnt_lo_u32_b32 %0, -1, 0\n\tv_mbcnt_hi_u32_b32 %0, -1, %0" : "=v"(l_)); F.lane = l_; F.tid = F.wave * 64 + l_; asm volatile("" : "+s"(F.ws)); } while (0)
        if (IN(pb)) {
            LAUNDER_TID();
            pg8::Gemm g{F.XN(), F.WIN() + (size_t)l * NIN * 1024, M, NIN, D}; pg8::StaticOrder S; S.init(M, NIN, F.G, (int)blockIdx.x);
            pg8::EpiIn E{F.P(), F.SMALL() + SM_B1 + l * 16 * NIN, F.STAT()};
            pg8::gemm_phase<pg8::EpiIn, pg8::StaticOrder, true, true>(F.lds, g, S, E, F.tid);
        }
        SEAM(pb);
        if (IN(pb + 1)) { LAUNDER_TID(); mixer_phase_pipe(F, l); }
        SEAM(pb + 1);
        if (IN(pb + 2)) {
            LAUNDER_TID();
            pg8::Gemm g{F.O(), F.WOUT() + (size_t)l * 1024 * 1024, M, D, D}; pg8::StaticOrder S; S.init(M, D, F.G, (int)blockIdx.x);
            pg8::EpiXUpd E{l == 0 ? F.x : F.out, F.out, F.XN(), F.SMALL() + SM_GT1 + l * 16 * D, F.SMALL() + SM_GS2 + l * 16 * D, F.STAT()};
            pg8::gemm_phase<pg8::EpiXUpd, pg8::StaticOrder, true, true>(F.lds, g, S, E, F.tid);
        }
        SEAM(pb + 2);
        if (IN(pb + 3)) {
            LAUNDER_TID();
            pg8::Gemm g{F.XN(), F.WUP() + (size_t)l * NUP * 1024, M, NUP, D}; pg8::StaticOrder S; S.init(M, NUP, F.G, (int)blockIdx.x);
            pg8::EpiUp E{F.Gb(), F.SMALL() + SM_B2 + l * 16 * NUP, F.STAT(), F.SMALL() + SM_CW + l * 3 * NUP, F.SMALL() + SM_CB + l * NUP, F.RAWH(), F.RAWT(), (LAS float*)(F.lds + HALO_OFF)};
            pg8::gemm_phase<pg8::EpiUp, pg8::StaticOrder, true, true>(F.lds, g, S, E, F.tid);
        }
        SEAM(pb + 3);
        if (IN(pb + 4)) { LAUNDER_TID(); fix_phase(F, l); }
        SEAM(pb + 4);
        if (IN(pb + 5)) {
            LAUNDER_TID();
            pg8::Gemm g{F.Gb(), F.WDN() + (size_t)l * 1024 * FF, M, D, FF}; pg8::StaticOrder S; S.init(M, D, F.G, (int)blockIdx.x);
            pg8::EpiXUpd E{F.out, F.out, l + 1 < DEPTH ? F.XN() : (bf16*)nullptr, F.SMALL() + SM_GT2 + l * 16 * D, F.SMALL() + SM_GS1 + (l + 1 < DEPTH ? l + 1 : l) * 16 * D, F.STAT()};
            pg8::gemm_phase<pg8::EpiXUpd, pg8::StaticOrder, true, true>(F.lds, g, S, E, F.tid);
        }
        SEAM(pb + 5);
    }
    if (IN(N_PHASES - 1)) { LAUNDER_TID(); final_phase(F); }
#undef IN
#undef SEAM
}

extern "C" void kernel_launch(void* const* d_in, const int* in_sizes, int n_in, void* d_out, int out_size, void* d_ws, size_t ws_size, hipStream_t stream) {
    static int grid = 0;
    if (grid == 0) {
        if (n_in != 18 || in_sizes[0] != M * D || out_size != M * D || ws_size < WS_END) { fprintf(stderr, "kernel_launch: unexpected shapes / workspace (n_in %d, in0 %d, out %d, ws %zu < %zu); nothing launched\n", n_in, n_in > 0 ? in_sizes[0] : -1, out_size, ws_size, (size_t)WS_END); grid = -1; return; }
        int dev = 0, cus = 0, per_cu = 0;
        if (hipGetDevice(&dev) != hipSuccess || hipDeviceGetAttribute(&cus, hipDeviceAttributeMultiprocessorCount, dev) != hipSuccess) { grid = -1; return; }
        if (hipFuncSetAttribute((const void*)fwd, hipFuncAttributeMaxDynamicSharedMemorySize, LDS_BYTES) != hipSuccess) { fprintf(stderr, "kernel_launch: hipFuncSetAttribute failed\n"); grid = -1; return; }
        if (hipOccupancyMaxActiveBlocksPerMultiprocessor(&per_cu, (const void*)fwd, NWAVES * 64, LDS_BYTES) != hipSuccess || per_cu < 1) { fprintf(stderr, "kernel_launch: occupancy query says %d\n", per_cu); }
        (void)hipGetLastError();
        grid = cus;
    }
    if (grid < 0) return;
    if (hipMemsetAsync((char*)d_ws + WS_CTL, 0, CTL_ZERO_BYTES, stream) != hipSuccess) return;
    Args a{};
    for (int i = 0; i < 18; ++i) a.in[i] = (const float*)d_in[i];
    a.out = (float*)d_out; a.ws = (unsigned char*)d_ws;
#if MK_PER_PHASE
    for (int p = 0; p < N_PHASES; ++p) { a.ph_lo = p; a.ph_hi = p + 1; hipLaunchKernelGGL(fwd, dim3(grid), dim3(NWAVES * 64), LDS_BYTES, stream, a); }
#else
    a.ph_lo = 0; a.ph_hi = N_PHASES; hipLaunchKernelGGL(fwd, dim3(grid), dim3(NWAVES * 64), LDS_BYTES, stream, a);
#endif
}
```

```cpp
#include <hip/hip_runtime.h>
#include <cstdio>
#include <cstdint>
namespace pg8 {
#define PG8_LAS __attribute__((address_space(3)))
typedef unsigned short bf16_t;
typedef short bf16x8 __attribute__((ext_vector_type(8)));
typedef float f32x4 __attribute__((ext_vector_type(4)));
typedef unsigned u32x4 __attribute__((ext_vector_type(4)));
constexpr int BM = 256, BK = 64, HALF = 128, HTB = HALF * BK * 2  , STAGE_BYTES = 8 * HTB, NXCD = 8, WGM = 4;

__host__ __device__ __forceinline__ int lds_byte(int r, int c) { const int st = (r >> 4) * 2 + (c >> 5), rr = r & 15, cc = c & 31, ob = rr * 64 + cc * 2; return st * 1024 + (ob ^ (((ob >> 9) & 1) << 5)); }
__host__ __device__ __forceinline__ void stage_rc(int b, int& R, int& C) { const int st = b / 1024, sb = b % 1024, swz = sb ^ (((sb >> 9) & 1) << 5); R = (st >> 1) * 16 + swz / 64; C = (st & 1) * 32 + (swz % 64) / 2; }
__host__ __device__ __forceinline__ int perm32(int rho) { const int n = rho >> 4, i = rho & 15; return 8 * (i >> 2) + 4 * n + (i & 3); }

struct Unit { int pm, pn; };
struct Gemm { const bf16_t* A; const bf16_t* Bt; int M, N, K; };

struct StaticOrder {
    int nM, nN, nwg, G, c;
    __host__ __device__ void init(int M, int N, int G_, int c_) { nM = M / BM; nN = N / BM; nwg = nM * nN; G = G_; c = c_; }
    __host__ __device__ bool next(int i, Unit& u) const {
        const long L = (long)i * G + c; if (L >= nwg) return false;
        int wgid = (int)L; { const int q = nwg / NXCD, r = nwg % NXCD, xcd = wgid % NXCD, off = wgid / NXCD; wgid = (xcd < r ? xcd * (q + 1) : r * (q + 1) + (xcd - r) * q) + off; }
        const int nig = WGM * nN, gid = wgid / nig, fm = gid * WGM, gsz = (nM - fm) < WGM ? (nM - fm) : WGM;
        u.pm = fm + ((wgid % nig) % gsz); u.pn = (wgid % nig) / gsz; return true;
    }
    __device__ __forceinline__ void a_ready(const Unit&) const {}
    __device__ __forceinline__ void done(const Unit&) const {}
};


__device__ __forceinline__ float shfl_x(float v, int mask, int lane) { return __builtin_bit_cast(float, __builtin_amdgcn_ds_bpermute((lane ^ mask) << 2, __builtin_bit_cast(int, v))); }
__device__ __forceinline__ unsigned cvt_pk_bf16(float lo, float hi) { unsigned r; asm volatile("v_cvt_pk_bf16_f32 %0, %1, %2" : "=v"(r) : "v"(lo), "v"(hi)); return r; }
typedef unsigned u32x2 __attribute__((ext_vector_type(2)));
#define PG8_GAS __attribute__((address_space(1)))
constexpr int EPI_LDS_OFF = 143360;
__device__ __forceinline__ void dma16(const void* gsrc_lane, PG8_LAS unsigned char* dst_wave) { __builtin_amdgcn_global_load_lds((const unsigned*)gsrc_lane, (PG8_LAS unsigned*)dst_wave, 16, 0, 0); }
constexpr int ROWS_PER_SEQ_TILES = 16;
constexpr float RMS_EPS = 1e-6f;
constexpr int D_MODEL = 1024, N_IN = 3840, N_UP = 5632, N_FF = 2816;

struct EpiIn {
    static constexpr bool PERM = true, AFTER_DRAIN = false; static constexpr int NPF = 4, NST = 16;
    bf16_t* P; const float* bias; const float* stat; const float* lb;
    __device__ __forceinline__ void prefetch(PG8_LAS unsigned char* epi, const Unit& u, int wid, int lane) const {
        const char* sp = (const char*)(stat + (size_t)(u.pm * BM + 32 * wid) * 16) + 16 * lane;
        dma16(sp, epi + 2048 * wid); dma16(sp + 1024, epi + 2048 * wid + 1024);
        dma16((const char*)(bias + (size_t)(u.pm / ROWS_PER_SEQ_TILES) * N_IN + u.pn * BM) + 16 * lane, epi + 16384);
        dma16((const char*)(lb + (u.pn & 1) * BM) + 16 * lane, epi + 17408);
    }
    __device__ __forceinline__ void operator()(f32x4 (&acc)[2][2][4][2], PG8_LAS unsigned char* epi, const Unit& u, int wr, int wc, int fr, int fq) const {
        const int row0 = u.pm * BM + wr * 64 + fr, col0 = u.pn * BM + wc * 32 + 8 * fq;
        const int mode = (u.pn == 2 || u.pn == 3) ? 1 : ((u.pn == 6 || u.pn == 7 || u.pn == 12 || u.pn == 13) ? 2 : 0);
        const float esc = (mode == 1) ? 1.4426950408889634f : -1.4426950408889634f;
        float rr[2][4];
#pragma unroll
        for (int ai = 0; ai < 2; ++ai)
#pragma unroll
            for (int m = 0; m < 4; ++m) { const f32x4 sp = *(const PG8_LAS f32x4*)(epi + ((ai * HALF + wr * 64 + m * 16 + fr) * 16 + 4 * fq) * 4);
                float s = (sp[0] + sp[1]) + (sp[2] + sp[3]); s += shfl_x(s, 16, fq * 16 + fr); s += shfl_x(s, 32, fq * 16 + fr);
                rr[ai][m] = __builtin_amdgcn_rsqf(s * (1.0f / (float)D_MODEL) + RMS_EPS); }
#pragma unroll
        for (int bj = 0; bj < 2; ++bj) {
            f32x4 bv[2], oml[2];
#pragma unroll
            for (int n = 0; n < 2; ++n) { bv[n] = *(const PG8_LAS f32x4*)(epi + 16384 + (wc * 32 + 8 * fq + bj * HALF + 4 * n) * 4); oml[n] = 1.0f - *(const PG8_LAS f32x4*)(epi + 17408 + (wc * 32 + 8 * fq + bj * HALF + 4 * n) * 4); }
#pragma unroll
            for (int ai = 0; ai < 2; ++ai)
#pragma unroll
                for (int m = 0; m < 4; ++m) { const int row = row0 + ai * HALF + m * 16; const float r = rr[ai][m];
                    f32x4 v[2];
#pragma unroll
                    for (int n = 0; n < 2; ++n) v[n] = acc[ai][bj][m][n] * r + bv[n];
                    if (mode != 0) {
#pragma unroll
                        for (int n = 0; n < 2; ++n)
#pragma unroll
                            for (int j = 0; j < 4; ++j) { const float z = v[n][j], sg = __builtin_amdgcn_rcpf(1.0f + __builtin_amdgcn_exp2f(z * esc)); const float tv = ((mode == 1) ? oml[n][j] : z) * sg; v[n][j] = (mode == 1) ? fminf(tv, 0.99609375f) : tv; }
                    }
                    u32x4 w; w.x = cvt_pk_bf16(v[0][0], v[0][1]); w.y = cvt_pk_bf16(v[0][2], v[0][3]); w.z = cvt_pk_bf16(v[1][0], v[1][1]); w.w = cvt_pk_bf16(v[1][2], v[1][3]);
                    *(PG8_GAS u32x4*)(P + (size_t)row * N_IN + col0 + bj * HALF) = w; }
        }
    }
};

struct EpiXUpd {
    static constexpr bool PERM = true, AFTER_DRAIN = false; static constexpr int NPF = 2, NST = 32;
    bf16_t* xb; bf16_t* XN; const float* gt; const float* gsn; float* stat;
    __device__ __forceinline__ void prefetch(PG8_LAS unsigned char* epi, const Unit& u, int wid, int lane) const {
        const size_t o = (size_t)(u.pm / ROWS_PER_SEQ_TILES) * D_MODEL + u.pn * BM;
        dma16((const char*)(gt + o) + 16 * lane, epi); dma16((const char*)(gsn + o) + 16 * lane, epi + 1024);
    }
    __device__ __forceinline__ void operator()(f32x4 (&acc)[2][2][4][2], PG8_LAS unsigned char* epi, const Unit& u, int wr, int wc, int fr, int fq) const {
        const int row0 = u.pm * BM + wr * 64 + fr, col0 = u.pn * BM + wc * 32 + 8 * fq;
        f32x4 g[2][2], s[2][2];
#pragma unroll
        for (int bj = 0; bj < 2; ++bj)
#pragma unroll
            for (int n = 0; n < 2; ++n) { g[bj][n] = *(const PG8_LAS f32x4*)(epi + (wc * 32 + 8 * fq + bj * HALF + 4 * n) * 4); s[bj][n] = *(const PG8_LAS f32x4*)(epi + 1024 + (wc * 32 + 8 * fq + bj * HALF + 4 * n) * 4); }
#pragma unroll
        for (int ai = 0; ai < 2; ++ai)
#pragma unroll
            for (int m = 0; m < 4; ++m) { const int row = row0 + ai * HALF + m * 16; const size_t off = (size_t)row * D_MODEL + col0; float ss = 0.f;
#pragma unroll
                for (int bj = 0; bj < 2; ++bj) {
                    const u32x4 xo = *(const PG8_GAS u32x4*)(xb + off + bj * HALF);
                    f32x4 o0, o1;
                    o0[0] = __builtin_bit_cast(float, xo.x << 16); o0[1] = __builtin_bit_cast(float, xo.x & 0xffff0000u); o0[2] = __builtin_bit_cast(float, xo.y << 16); o0[3] = __builtin_bit_cast(float, xo.y & 0xffff0000u);
                    o1[0] = __builtin_bit_cast(float, xo.z << 16); o1[1] = __builtin_bit_cast(float, xo.z & 0xffff0000u); o1[2] = __builtin_bit_cast(float, xo.w << 16); o1[3] = __builtin_bit_cast(float, xo.w & 0xffff0000u);
                    const f32x4 x0 = o0 + g[bj][0] * acc[ai][bj][m][0], x1 = o1 + g[bj][1] * acc[ai][bj][m][1];
                    u32x4 xw; xw.x = cvt_pk_bf16(x0[0], x0[1]); xw.y = cvt_pk_bf16(x0[2], x0[3]); xw.z = cvt_pk_bf16(x1[0], x1[1]); xw.w = cvt_pk_bf16(x1[2], x1[3]);
                    *(PG8_GAS u32x4*)(xb + off + bj * HALF) = xw;
                    ss += (x0[0] * x0[0] + x0[1] * x0[1]) + (x0[2] * x0[2] + x0[3] * x0[3]) + (x1[0] * x1[0] + x1[1] * x1[1]) + (x1[2] * x1[2] + x1[3] * x1[3]);
                    if (XN) { const f32x4 y0 = x0 * s[bj][0], y1 = x1 * s[bj][1];
                        u32x4 w; w.x = cvt_pk_bf16(y0[0], y0[1]); w.y = cvt_pk_bf16(y0[2], y0[3]); w.z = cvt_pk_bf16(y1[0], y1[1]); w.w = cvt_pk_bf16(y1[2], y1[3]);
                        *(PG8_GAS u32x4*)(XN + off + bj * HALF) = w; } }
                ss += shfl_x(ss, 16, fq * 16 + fr); ss += shfl_x(ss, 32, fq * 16 + fr);
                if (fq == 0) *(PG8_GAS float*)(stat + (size_t)row * 16 + u.pn * 4 + wc) = ss; }
    }
};

__device__ __forceinline__ float dpp_ror1(float v) { return __builtin_bit_cast(float, __builtin_amdgcn_mov_dpp(__builtin_bit_cast(int, v), 0x121, 0xf, 0xf, true)); }
__device__ __forceinline__ float dpp_ror2(float v) { return __builtin_bit_cast(float, __builtin_amdgcn_mov_dpp(__builtin_bit_cast(int, v), 0x122, 0xf, 0xf, true)); }
__device__ __forceinline__ float dpp_shr1z(float v) { return __builtin_bit_cast(float, __builtin_amdgcn_update_dpp(0, __builtin_bit_cast(int, v), 0x111, 0xf, 0xf, true)); }
__device__ __forceinline__ float dpp_shr2z(float v) { return __builtin_bit_cast(float, __builtin_amdgcn_update_dpp(0, __builtin_bit_cast(int, v), 0x112, 0xf, 0xf, true)); }
__device__ __forceinline__ float silu_f(float x) { return x * __builtin_amdgcn_rcpf(1.0f + __builtin_amdgcn_exp2f(-1.4426950408889634f * x)); }
struct EpiUp {
    static constexpr bool PERM = true, AFTER_DRAIN = false; static constexpr int NPF = 4, NST = 12;
    bf16_t* G; const float* bias; const float* stat; const float* cw; const float* cb; float* rawh; float* rawt; PG8_LAS float* halo;
    __device__ __forceinline__ void prefetch(PG8_LAS unsigned char* epi, const Unit& u, int wid, int lane) const {
        const char* sp = (const char*)(stat + (size_t)(u.pm * BM + 32 * wid) * 16) + 16 * lane;
        dma16(sp, epi + 2048 * wid); dma16(sp + 1024, epi + 2048 * wid + 1024);
        dma16((const char*)(bias + (size_t)(u.pm / ROWS_PER_SEQ_TILES) * N_UP + u.pn * BM) + 16 * lane, epi + 16384);
        const int which = wid & 3;
        dma16((const char*)((which < 3 ? cw + which * N_UP : cb) + u.pn * BM) + 16 * lane, (PG8_LAS unsigned char*)(halo + 2048) + 1024 * which);
    }
    __device__ __forceinline__ void operator()(f32x4 (&acc)[2][2][4][2], PG8_LAS unsigned char* epi, const Unit& u, int wr, int wc, int fr, int fq) const {
        const int row0 = u.pm * BM + wr * 64 + fr, tc0 = wc * 32 + 8 * fq, col0 = u.pn * BM + tc0;
        PG8_LAS float* vecs = halo + 2048;
        f32x4 bv[2][2];
#pragma unroll
        for (int bj = 0; bj < 2; ++bj)
#pragma unroll
            for (int n = 0; n < 2; ++n) bv[bj][n] = *(const PG8_LAS f32x4*)(epi + 16384 + (tc0 + bj * HALF + 4 * n) * 4);
#pragma unroll
        for (int ai = 0; ai < 2; ++ai)
#pragma unroll
            for (int m = 0; m < 4; ++m) { const f32x4 sp = *(const PG8_LAS f32x4*)(epi + ((ai * HALF + wr * 64 + m * 16 + fr) * 16 + 4 * fq) * 4);
                float s = (sp[0] + sp[1]) + (sp[2] + sp[3]); s += shfl_x(s, 16, fq * 16 + fr); s += shfl_x(s, 32, fq * 16 + fr);
                const float r = __builtin_amdgcn_rsqf(s * (1.0f / (float)D_MODEL) + RMS_EPS);
#pragma unroll
                for (int bj = 0; bj < 2; ++bj)
#pragma unroll
                    for (int n = 0; n < 2; ++n) acc[ai][bj][m][n] = acc[ai][bj][m][n] * r + bv[bj][n];
                asm volatile("" : "+v"(acc[ai][0][m][0]), "+v"(acc[ai][0][m][1]), "+v"(acc[ai][1][m][0]), "+v"(acc[ai][1][m][1])); }
#pragma unroll
        for (int ai = 0; ai < 2; ++ai) {
            if (fr >= 14) {
                PG8_LAS float* hp = halo + ((ai * 2 + wr) * 2 + (fr - 14)) * 256 + tc0;
#pragma unroll
                for (int bj = 0; bj < 2; ++bj)
#pragma unroll
                    for (int n = 0; n < 2; ++n) *(PG8_LAS f32x4*)(hp + bj * HALF + 4 * n) = acc[ai][bj][3][n];
            }
        }
        if (wr == 0 && fr < 2) { float* hp = rawh + ((size_t)u.pm * 2 + fr) * N_UP + col0;
#pragma unroll
            for (int bj = 0; bj < 2; ++bj)
#pragma unroll
                for (int n = 0; n < 2; ++n) *(PG8_GAS f32x4*)(hp + bj * HALF + 4 * n) = acc[0][bj][0][n]; }
        if (wr == 1 && fr >= 14) { float* tp = rawt + ((size_t)u.pm * 2 + (fr - 14)) * N_UP + col0;
#pragma unroll
            for (int bj = 0; bj < 2; ++bj)
#pragma unroll
                for (int n = 0; n < 2; ++n) *(PG8_GAS f32x4*)(tp + bj * HALF + 4 * n) = acc[1][bj][3][n]; }
        asm volatile("s_waitcnt lgkmcnt(0)" ::: "memory"); __builtin_amdgcn_s_barrier(); asm volatile("" ::: "memory");
        const bool f15 = (fr == 15), f14 = (fr >= 14);
        unsigned gp[2][4][2];
#pragma unroll
        for (int n = 0; n < 2; ++n) {
            f32x4 w0[2], w1[2], w2[2], cbv[2];
#pragma unroll
            for (int bj = 0; bj < 2; ++bj) { const int c = tc0 + bj * HALF + 4 * n;
                w0[bj] = *(const PG8_LAS f32x4*)(vecs + c); w1[bj] = *(const PG8_LAS f32x4*)(vecs + 256 + c); w2[bj] = *(const PG8_LAS f32x4*)(vecs + 512 + c); cbv[bj] = *(const PG8_LAS f32x4*)(vecs + 768 + c); }
#pragma unroll
            for (int ai = 0; ai < 2; ++ai) {
                f32x4 prev[2];
                {   const int pai = (wr == 1) ? ai : ai - 1, pwr = (wr == 1) ? 0 : 1;
                    const bool has = (pai >= 0);
                    const PG8_LAS float* hp = halo + ((pai * 2 + pwr) * 2 + (fr & 1)) * 256 + tc0 + 4 * n;
#pragma unroll
                    for (int bj = 0; bj < 2; ++bj) prev[bj] = (has && fr >= 14) ? *(const PG8_LAS f32x4*)(hp + bj * HALF) : (f32x4){0.f, 0.f, 0.f, 0.f}; }
#pragma unroll
                for (int m = 0; m < 4; ++m) {
                    f32x4 cu[2];
#pragma unroll
                    for (int bj = 0; bj < 2; ++bj) { const f32x4 cur = acc[ai][bj][m][n], pv = prev[bj];
                        float o0 = cbv[bj][0] + w2[bj][0] * cur[0], o1 = cbv[bj][1] + w2[bj][1] * cur[1], o2 = cbv[bj][2] + w2[bj][2] * cur[2], o3 = cbv[bj][3] + w2[bj][3] * cur[3];
                        const float p0 = f14 ? pv[0] : cur[0], p1 = f14 ? pv[1] : cur[1], p2 = f14 ? pv[2] : cur[2], p3 = f14 ? pv[3] : cur[3];
                        const float q0 = f15 ? pv[0] : cur[0], q1 = f15 ? pv[1] : cur[1], q2 = f15 ? pv[2] : cur[2], q3 = f15 ? pv[3] : cur[3];
                        asm("s_nop 1\n\t"
                            "v_fmac_f32_dpp %0, %4, %8 row_ror:2 row_mask:0xf bank_mask:0xf\n\t"
                            "v_fmac_f32_dpp %1, %5, %9 row_ror:2 row_mask:0xf bank_mask:0xf\n\t"
                            "v_fmac_f32_dpp %2, %6, %10 row_ror:2 row_mask:0xf bank_mask:0xf\n\t"
                            "v_fmac_f32_dpp %3, %7, %11 row_ror:2 row_mask:0xf bank_mask:0xf\n\t"
                            "v_fmac_f32_dpp %0, %12, %16 row_ror:1 row_mask:0xf bank_mask:0xf\n\t"
                            "v_fmac_f32_dpp %1, %13, %17 row_ror:1 row_mask:0xf bank_mask:0xf\n\t"
                            "v_fmac_f32_dpp %2, %14, %18 row_ror:1 row_mask:0xf bank_mask:0xf\n\t"
                            "v_fmac_f32_dpp %3, %15, %19 row_ror:1 row_mask:0xf bank_mask:0xf"
                            : "+v"(o0), "+v"(o1), "+v"(o2), "+v"(o3)
                            : "v"(p0), "v"(p1), "v"(p2), "v"(p3), "v"(w0[bj][0]), "v"(w0[bj][1]), "v"(w0[bj][2]), "v"(w0[bj][3]),
                              "v"(q0), "v"(q1), "v"(q2), "v"(q3), "v"(w1[bj][0]), "v"(w1[bj][1]), "v"(w1[bj][2]), "v"(w1[bj][3]));
                        cu[bj] = (f32x4){o0, o1, o2, o3}; prev[bj] = cur; }
                    f32x4 g;
#pragma unroll
                    for (int j = 0; j < 4; ++j) g[j] = cu[0][j] * cu[1][j] * __builtin_amdgcn_rcpf(1.0f + __builtin_amdgcn_exp2f(cu[0][j]));
                    const unsigned p0 = cvt_pk_bf16(g[0], g[1]), p1 = cvt_pk_bf16(g[2], g[3]);
                    if (n == 0) { gp[ai][m][0] = p0; gp[ai][m][1] = p1; }
                    else { u32x4 w; w.x = gp[ai][m][0]; w.y = gp[ai][m][1]; w.z = p0; w.w = p1;
                        *(PG8_GAS u32x4*)(G + (size_t)(row0 + ai * HALF + m * 16) * N_FF + u.pn * HALF + tc0) = w; }
                }
            }
        }
    }
};
template <class Epi, class Sched, bool ALIGN_EPI = false, bool SP2 = false>
__device__ __forceinline__ void gemm_phase(PG8_LAS unsigned char* lds, const Gemm g, const Sched& S, const Epi& E, const int tid) {
    const int wid = __builtin_amdgcn_readfirstlane(tid >> 6), lane = tid & 63, wr = wid >> 2, wc = wid & 3, fr = lane & 15, fq = lane >> 4;
    const int K = g.K, nt = K / BK;
    unsigned voffA[2], voffB[2];
#pragma unroll
    for (int i = 0; i < 2; ++i) { int R, C; stage_rc(tid * 16 + i * 8192, R, C); const int Rb = Epi::PERM ? ((R & ~31) + perm32(R & 31)) : R;
        voffA[i] = (unsigned)(R * K + C) * 2u; voffB[i] = (unsigned)(Rb * K + C) * 2u; }
    const size_t kstep = (size_t)(BK * 2);
    const size_t hstep = (size_t)HALF * K * 2;
    const size_t tstep = 2 * hstep;
    const unsigned ldsw = (unsigned)wid * 1024u;
    const int aoff = lds_byte(wr * 64 + fr, fq * 8), boff = lds_byte(wc * 32 + fr, fq * 8);
#define PG8_SA(b, h) (((b) * 2 + (h)) * HTB)
#define PG8_SB(b, h) ((4 + (b) * 2 + (h)) * HTB)
#define PG8_STAGE(bufoff, gbase, voff) do { const char* gb_ = (const char*)(gbase); asm volatile("" : "+s"(gb_));     \
        _Pragma("unroll") for (int _i = 0; _i < 2; ++_i) { unsigned vo_ = (voff)[_i]; asm volatile("" : "+v"(vo_)); \
        __builtin_amdgcn_global_load_lds((const unsigned*)(gb_ + vo_), (PG8_LAS unsigned*)(lds + (bufoff) + ldsw + _i * 8192), 16, 0, 0); } } while (0)
#define PG8_LDA(dst, b, h) do { _Pragma("unroll") for (int m = 0; m < 4; ++m) _Pragma("unroll") for (int k = 0; k < 2; ++k) dst[m][k] = *(const PG8_LAS bf16x8*)(lds + PG8_SA(b, h) + aoff + m * 2048 + k * 1024); } while (0)
#define PG8_LDB(dst, b, h) do { _Pragma("unroll") for (int n = 0; n < 2; ++n) _Pragma("unroll") for (int k = 0; k < 2; ++k) dst[n][k] = *(const PG8_LAS bf16x8*)(lds + PG8_SB(b, h) + boff + n * 2048 + k * 1024); } while (0)
#define PG8_MMA(ai, bj, At, Bt) do { __builtin_amdgcn_s_setprio(1); _Pragma("unroll") for (int m = 0; m < 4; ++m) _Pragma("unroll") for (int n = 0; n < 2; ++n) _Pragma("unroll") for (int k = 0; k < 2; ++k) \
        acc[ai][bj][m][n] = __builtin_amdgcn_mfma_f32_16x16x32_bf16(Bt[n][k], At[m][k], acc[ai][bj][m][n], 0, 0, 0); __builtin_amdgcn_s_setprio(0); } while (0)
#define PG8_WAIT_V(n) asm volatile("s_waitcnt vmcnt(" #n ")" ::: "memory")
#define PG8_WAIT_L(n) asm volatile("s_waitcnt lgkmcnt(" #n ")" ::: "memory")
#define PG8_BAR __builtin_amdgcn_s_barrier()
#define PG8_SCHED __builtin_amdgcn_sched_barrier(0)
    Unit cur, nxt; int ui = 0;
    if (!S.next(0, cur)) return;
    f32x4 acc[2][2][4][2];
#pragma unroll
    for (int a = 0; a < 2; ++a)
#pragma unroll
        for (int b = 0; b < 2; ++b)
#pragma unroll
            for (int m = 0; m < 4; ++m)
#pragma unroll
                for (int n = 0; n < 2; ++n) acc[a][b][m][n] = (f32x4){0.f, 0.f, 0.f, 0.f};
    bf16x8 At[4][2], B0[2][2], B1[2][2];
    const char* cA = (const char*)g.A + (size_t)cur.pm * tstep; const char* cB = (const char*)g.Bt + (size_t)cur.pn * tstep;
    S.a_ready(cur);
    if constexpr (SP2) {
        PG8_STAGE(PG8_SB(0, 0), cB, voffB); PG8_STAGE(PG8_SB(0, 1), cB + hstep, voffB); PG8_STAGE(PG8_SA(0, 0), cA, voffA); PG8_STAGE(PG8_SA(0, 1), cA + hstep, voffA);
        if (wr == 1) PG8_BAR;
        PG8_WAIT_V(2); PG8_BAR;
        PG8_STAGE(PG8_SB(1, 0), cB + kstep, voffB); PG8_STAGE(PG8_SA(1, 0), cA + kstep, voffA); PG8_STAGE(PG8_SB(1, 1), cB + hstep + kstep, voffB);
        PG8_WAIT_V(6); PG8_BAR;
    } else {
        PG8_STAGE(PG8_SB(0, 0), cB, voffB); PG8_STAGE(PG8_SA(0, 0), cA, voffA); PG8_STAGE(PG8_SB(0, 1), cB + hstep, voffB); PG8_STAGE(PG8_SA(0, 1), cA + hstep, voffA);
        if (wr == 1) PG8_BAR;
        PG8_WAIT_V(4); PG8_BAR;
        PG8_STAGE(PG8_SB(1, 0), cB + kstep, voffB); PG8_STAGE(PG8_SA(1, 0), cA + kstep, voffA); PG8_STAGE(PG8_SB(1, 1), cB + hstep + kstep, voffB);
        PG8_WAIT_V(6); PG8_BAR;
    }
    for (;;) {
        const bool has_next = S.next(ui + 1, nxt);
        const char* nA = has_next ? (const char*)g.A + (size_t)nxt.pm * tstep : cA; const char* nB = has_next ? (const char*)g.Bt + (size_t)nxt.pn * tstep : cB;
#define PG8_WAIT_VN(n) asm volatile("s_waitcnt vmcnt(%0)" :: "n"(n) : "memory")
#define PG8_TRIP(a1, a2, b2, a3, b3, PF, FA) do { \
              \
            PG8_LDB(B0, 0, 0); PG8_LDB(B1, 0, 1); PG8_SCHED; PG8_LDA(At, 0, 0); PG8_STAGE(PG8_SA(1, 1), (a1) + hstep, voffA); \
            if (FA) PG8_WAIT_VN(8 + Epi::NST); else PG8_WAIT_V(8); PG8_WAIT_L(0); PG8_BAR; PG8_MMA(0, 0, At, B0); PG8_MMA(0, 1, At, B1); PG8_BAR; PG8_SCHED; \
              \
            PG8_LDA(At, 0, 1); PG8_STAGE(PG8_SB(0, 0), (b2), voffB); PG8_STAGE(PG8_SB(0, 1), (b2) + hstep, voffB); PG8_STAGE(PG8_SA(0, 0), (a2), voffA); \
            if (FA) PG8_WAIT_VN(8 + Epi::NST); else PG8_WAIT_V(8); PG8_WAIT_L(0); PG8_BAR; PG8_MMA(1, 0, At, B0); PG8_MMA(1, 1, At, B1); PG8_BAR; PG8_SCHED; \
            if (PF) { int lane_p; asm volatile("v_mbcnt_lo_u32_b32 %0, -1, 0\n\tv_mbcnt_hi_u32_b32 %0, -1, %0" : "=v"(lane_p)); E.prefetch(lds + EPI_LDS_OFF, cur, wid, lane_p); } \
              \
            PG8_LDB(B0, 1, 0); PG8_LDB(B1, 1, 1); PG8_SCHED; PG8_LDA(At, 1, 0); PG8_STAGE(PG8_SA(0, 1), (a2) + hstep, voffA); \
            if (PF) PG8_WAIT_VN(8 + Epi::NPF); else PG8_WAIT_V(8); PG8_WAIT_L(0); PG8_BAR; PG8_MMA(0, 0, At, B0); PG8_MMA(0, 1, At, B1); PG8_BAR; PG8_SCHED; \
              \
            PG8_LDA(At, 1, 1); PG8_STAGE(PG8_SB(1, 0), (b3), voffB); PG8_STAGE(PG8_SB(1, 1), (b3) + hstep, voffB); PG8_STAGE(PG8_SA(1, 0), (a3), voffA); \
            if (PF) PG8_WAIT_VN(8 + Epi::NPF); else PG8_WAIT_V(8); PG8_WAIT_L(0); PG8_BAR; PG8_MMA(1, 0, At, B0); PG8_MMA(1, 1, At, B1); PG8_BAR; PG8_SCHED; } while (0)
        static_assert(SP2, "this build keeps only the two-blocks-per-barrier K-loop");
        for (int t = 0; t < nt; t += 2) {
            const bool last = (t == nt - 2);
            const char* a1 = cA + (size_t)(t + 1) * kstep;
            const char* a2 = last ? nA : cA + (size_t)(t + 2) * kstep; const char* b2 = last ? nB : cB + (size_t)(t + 2) * kstep;
            if (last && has_next) S.a_ready(nxt);
            const bool pfl = last && (Epi::NPF > 0), fa = (t == 0) && (ui > 0) && (Epi::NST > 0);
            PG8_TRIP(a1, a2, b2, a2 + kstep, b2 + kstep, pfl, fa);
        }
#undef PG8_TRIP
#undef PG8_WAIT_VN
        if constexpr (ALIGN_EPI) { if (wr == 0) PG8_BAR; }
        if constexpr (Epi::NPF > 0) { asm volatile("s_waitcnt vmcnt(8)" ::: "memory"); PG8_BAR; asm volatile("" ::: "memory"); }
        if constexpr (!Epi::AFTER_DRAIN) { int lane_e; asm volatile("v_mbcnt_lo_u32_b32 %0, -1, 0\n\tv_mbcnt_hi_u32_b32 %0, -1, %0" : "=v"(lane_e));
            const int fr_e = lane_e & 15, fq_e = lane_e >> 4; int wr_e = wr, wc_e = wc; asm volatile("" : "+s"(wr_e), "+s"(wc_e));
            E(acc, lds + EPI_LDS_OFF, cur, wr_e, wc_e, fr_e, fq_e);
            S.done(cur); }
        if (!has_next) break;
#pragma unroll
        for (int a = 0; a < 2; ++a)
#pragma unroll
            for (int b = 0; b < 2; ++b)
#pragma unroll
                for (int m = 0; m < 4; ++m)
#pragma unroll
                    for (int n = 0; n < 2; ++n) acc[a][b][m][n] = (f32x4){0.f, 0.f, 0.f, 0.f};
        cur = nxt; cA = nA; cB = nB; ++ui;
        if constexpr (ALIGN_EPI) { if (wr == 1) PG8_BAR; }
    }
    PG8_WAIT_V(0);
    if constexpr (!ALIGN_EPI) { if (wr == 0) PG8_BAR; }
    PG8_BAR;
    if constexpr (Epi::AFTER_DRAIN) { E.fused(acc, cur, wr, wc, fr, fq, lds, wid, lane); S.done(cur); }
#undef PG8_SA
#undef PG8_SB
#undef PG8_STAGE
#undef PG8_LDA
#undef PG8_LDB
#undef PG8_MMA
#undef PG8_WAIT_V
#undef PG8_WAIT_L
#undef PG8_BAR
#undef PG8_SCHED
}
}

constexpr int NWAVES = 8;
#ifndef MK_PER_PHASE
#define MK_PER_PHASE 0
#endif
constexpr int NB = 16, SEQ = 4096, D = 1024, DEPTH = 4, M = NB * SEQ;
constexpr int NIN = 3840, NINW = 3584, FF = 2816, NUP = 5632, NMOD = 6144;
constexpr float EPS = 1e-6f;
constexpr int N_PHASES = 2 + 6 * DEPTH + 1;

constexpr size_t MiB = 1u << 20;
constexpr size_t WS_CTL = 0, CTL_ZERO_BYTES = 4 * MiB;
constexpr size_t WS_MOD = 2 * MiB;
constexpr size_t WS_SMALL = 4 * MiB;
constexpr size_t WS_STAT = 12 * MiB;
constexpr size_t WS_RAWH = 16 * MiB, WS_RAWT = 28 * MiB;
constexpr size_t WS_WIN = 40 * MiB;
constexpr size_t WS_WOUT = 70 * MiB;
constexpr size_t WS_WUP = 78 * MiB;
constexpr size_t WS_WDN = 122 * MiB;
constexpr size_t WS_XN = 144 * MiB;
constexpr size_t WS_O = 272 * MiB;
constexpr size_t WS_P = 400 * MiB;
constexpr size_t WS_XB = 880 * MiB;
constexpr size_t WS_END = 1008 * MiB;
constexpr int SM_LB = 0;
constexpr int SM_CW = SM_LB + 4 * 512;
constexpr int SM_CB = SM_CW + 4 * 3 * NUP;
constexpr int SM_GS1 = SM_CB + 4 * NUP;
constexpr int SM_GS2 = SM_GS1 + 4 * 16 * D;
constexpr int SM_GT1 = SM_GS2 + 4 * 16 * D;
constexpr int SM_GT2 = SM_GT1 + 4 * 16 * D;
constexpr int SM_B1 = SM_GT2 + 4 * 16 * D;
constexpr int SM_B2 = SM_B1 + 4 * 16 * NIN;
constexpr int SM_END = SM_B2 + 4 * 16 * NUP;
static_assert((size_t)SM_END * 4 <= 8 * MiB, "small vectors fit");
constexpr int GROUP_WGS = 32;
constexpr size_t GB_GROUP_SHIFT = (size_t)(M / 8) * (NIN - FF) * 2;
#ifndef SKEW_TICKS
#define SKEW_TICKS 0u
#endif
constexpr int CW_BAR = 4096;

constexpr int LDS_BYTES = 163840;
constexpr int RING_BYTES = 131072, HALO_OFF = RING_BYTES, HALO_BYTES = 12288, LDSCTL_OFF = LDS_BYTES - 512, MISC_OFF = LDSCTL_OFF + 320;
static_assert(MISC_OFF + 128 <= LDS_BYTES && HALO_OFF + HALO_BYTES <= LDSCTL_OFF, "LDS map");

#define GAS __attribute__((address_space(1)))
#define LAS __attribute__((address_space(3)))
typedef unsigned short bf16;
typedef unsigned v4u __attribute__((ext_vector_type(4)));
typedef unsigned v2u __attribute__((ext_vector_type(2)));
typedef float f32x4 __attribute__((ext_vector_type(4)));
#define LDS_WAIT() asm volatile("s_waitcnt lgkmcnt(0)" ::: "memory")
__device__ __forceinline__ unsigned f2bf(float f) { unsigned u = __builtin_bit_cast(unsigned, f); return (u + 0x7fffu + ((u >> 16) & 1u)) >> 16; }
__device__ __forceinline__ unsigned pk2(float lo, float hi) { return f2bf(lo) | (f2bf(hi) << 16); }
__device__ __forceinline__ float bf2f(unsigned h) { return __builtin_bit_cast(float, h << 16); }
__device__ __forceinline__ float shfl_idx(float v, int src_lane) { return __builtin_bit_cast(float, __builtin_amdgcn_ds_bpermute(src_lane << 2, __builtin_bit_cast(int, v))); }
__device__ __forceinline__ float shfl_xor_l(float v, int mask, int lane) { return shfl_idx(v, lane ^ mask); }
__device__ __forceinline__ float wave_sum(float v, int lane) {
#pragma unroll
    for (int o = 1; o < 64; o <<= 1) v += shfl_xor_l(v, o, lane);
    return v;
}
__device__ __forceinline__ float sigmoid_f(float x) { return 1.0f / (1.0f + __expf(-x)); }
#define XB_TMO      128
#define XB_XCNT(j)  (256  + 64 * (j))
#define XB_XSUB(j)  (1280 + 64 * (j))
#define XB_XGEN(j)  (2304 + 64 * (j))
#define XB_TOP      3328
#define XB_TOPGEN   3392
#define XCD_BAR_WORDS 3456
#define XB_SPIN_CAP (1u << 18)

__device__ __forceinline__ unsigned xb_ld(unsigned* p)              { return __hip_atomic_load(p, __ATOMIC_RELAXED, __HIP_MEMORY_SCOPE_AGENT); }
__device__ __forceinline__ unsigned xb_add(unsigned* p, unsigned v) { return __hip_atomic_fetch_add(p, v, __ATOMIC_RELAXED, __HIP_MEMORY_SCOPE_AGENT); }
__device__ __forceinline__ unsigned xb_xcc_id() { return (unsigned)__builtin_amdgcn_s_getreg((3 << 11) | 20) & 0xFu; }
#define XB_SPIN(cond, bar) do { unsigned _sp = 0; while (cond) { __builtin_amdgcn_s_sleep(1); \
    if ((++_sp & 255u) == 0u) { if (xb_ld(&(bar)[XB_TMO])) break; if (_sp > XB_SPIN_CAP) { atomicAdd(&(bar)[XB_TMO], 1u); break; } } } } while (0)

struct XcdBarrier {
    unsigned* bar; unsigned x; unsigned total;
    volatile LAS unsigned* st;
};

__device__ __forceinline__ XcdBarrier xcd_barrier_post(unsigned* bar, volatile LAS unsigned* st, unsigned total) {
    XcdBarrier b; b.bar = bar; b.x = xb_xcc_id(); b.st = st; b.total = total;
    if (threadIdx.x == 0) (void)xb_add(&bar[XB_XCNT(b.x)], 1u);
    return b;
}
__device__ __forceinline__ void xcd_barrier_complete(unsigned* bar, unsigned x, const unsigned G, unsigned& nloc, unsigned& nx) {
    unsigned sum, cnt, mine, sp = 0u;
    for (;;) {
        sum = 0u; cnt = 0u; mine = 0u;
#pragma unroll
        for (unsigned j = 0; j < 16; ++j) { const unsigned c = xb_ld(&bar[XB_XCNT(j)]); sum += c; cnt += (c > 0u) ? 1u : 0u; mine = (j == x) ? c : mine; }
        if (sum == G) break;
        __builtin_amdgcn_s_sleep(1);
        if ((++sp & 255u) == 0u) { if (xb_ld(&bar[XB_TMO])) break; if (sp > XB_SPIN_CAP) { atomicAdd(&bar[XB_TMO], 1u); break; } }
    }
    nloc = mine > 0u ? mine : 1u; nx = cnt > 0u ? cnt : 1u;
}

__device__ __forceinline__ void xcd_barrier(const XcdBarrier& b, const bool is_t0  ) {
    asm volatile("s_waitcnt vmcnt(0)" ::: "memory");
    __syncthreads();
    if (is_t0) {
        unsigned* bar = b.bar;
        __builtin_amdgcn_s_waitcnt(0);
        unsigned nloc = b.st[0], nx = b.st[1];
        if (nloc == 0u) { xcd_barrier_complete(bar, b.x, b.total, nloc, nx); b.st[0] = nloc; b.st[1] = nx; }
        const unsigned old = xb_add(&bar[XB_XSUB(b.x)], 1u);
        const unsigned gen = old / nloc;
        if (old + 1u == (gen + 1u) * nloc) {
            __builtin_amdgcn_fence(__ATOMIC_RELEASE, "agent");
            asm volatile("s_waitcnt vmcnt(0)" ::: "memory");
            const unsigned og = xb_add(&bar[XB_TOP], 1u);
            const unsigned tg = og / nx;
            if (og + 1u == (tg + 1u) * nx) xb_add(&bar[XB_TOPGEN], 1u);
            else XB_SPIN(xb_ld(&bar[XB_TOPGEN]) == tg, bar);
            __builtin_amdgcn_fence(__ATOMIC_ACQUIRE, "agent");
            xb_add(&bar[XB_XGEN(b.x)], 1u);
            asm volatile("s_waitcnt vmcnt(0)" ::: "memory");
        } else {
            XB_SPIN(xb_ld(&bar[XB_XGEN(b.x)]) == gen, bar);
            __builtin_amdgcn_fence(__ATOMIC_ACQUIRE, "agent");
            asm volatile("s_waitcnt vmcnt(0)" ::: "memory");
        }
    }
    __syncthreads();
}


struct Frame {
    LAS unsigned char* lds;
    volatile LAS unsigned* MISC;
    unsigned* ctl;
    int tid, lane, wave, vcu, G;
    const float *x, *c, *ln1_g, *ln2_g, *w_ada, *b_ada, *w_in, *lb_params, *w_gk, *b_gk, *gn_a, *gn_b, *w_out, *w_up, *conv_w, *conv_b, *w_down, *lnf_g;
    float* out;
    unsigned char* ws;
    __device__ __forceinline__ float* MOD() const { return (float*)(ws + WS_MOD); }
    __device__ __forceinline__ float* SMALL() const { return (float*)(ws + WS_SMALL); }
    __device__ __forceinline__ float* STAT() const { return (float*)(ws + WS_STAT); }
    __device__ __forceinline__ float* RAWH() const { return (float*)(ws + WS_RAWH); }
    __device__ __forceinline__ float* RAWT() const { return (float*)(ws + WS_RAWT); }
    __device__ __forceinline__ bf16* WIN() const { return (bf16*)(ws + WS_WIN); }
    __device__ __forceinline__ bf16* WOUT() const { return (bf16*)(ws + WS_WOUT); }
    __device__ __forceinline__ bf16* WUP() const { return (bf16*)(ws + WS_WUP); }
    __device__ __forceinline__ bf16* WDN() const { return (bf16*)(ws + WS_WDN); }
    __device__ __forceinline__ bf16* XN() const { return (bf16*)(ws + WS_XN); }
    __device__ __forceinline__ bf16* O() const { return (bf16*)(ws + WS_O); }
    __device__ __forceinline__ bf16* P() const { return (bf16*)(ws + WS_P); }
    __device__ __forceinline__ bf16* XB() const { return (bf16*)(ws + WS_XB); }
    __device__ __forceinline__ bf16* Gb() const { return (bf16*)(ws + WS_P + (size_t)(blockIdx.x & 7) * GB_GROUP_SHIFT); }
};

__device__ __forceinline__ void tr_item(const float* W, int Nsrc, int K, bf16* WT, int kb, int sn0, int dn0, float scale, LAS float* scr, int lane) {
    const int k0 = 64 * kb;
#pragma unroll 8
    for (int i = 0; i < 32; ++i) { const int kk = 2 * i + (lane >> 5); scr[kk * 33 + (lane & 31)] = W[(size_t)(k0 + kk) * Nsrc + sn0 + (lane & 31)]; }
    LDS_WAIT(); asm volatile("" ::: "memory");
    const int c = lane & 7;
#pragma unroll
    for (int j = 0; j < 4; ++j) { const int n = (lane >> 3) + 8 * j; const LAS float* s = scr + (8 * c) * 33 + n;
        v4u o; o.x = pk2(s[0 * 33] * scale, s[1 * 33] * scale); o.y = pk2(s[2 * 33] * scale, s[3 * 33] * scale); o.z = pk2(s[4 * 33] * scale, s[5 * 33] * scale); o.w = pk2(s[6 * 33] * scale, s[7 * 33] * scale);
        *(GAS v4u*)(WT + (size_t)(dn0 + n) * K + k0 + 8 * c) = o; }
    LDS_WAIT(); asm volatile("" ::: "memory");
}
__host__ __device__ __forceinline__ int up_orig(int np) { return ((np & 255) >> 7) * FF + 128 * (np >> 8) + (np & 127); }

__device__ __forceinline__ void p0a(Frame& F) {
    const int gw = F.vcu * NWAVES + F.wave, NGW = F.G * NWAVES, gt = F.vcu * (NWAVES * 64) + F.tid, NGT = F.G * NWAVES * 64;
    {
        LAS float* cond = (LAS float*)F.lds;
        for (int e = F.tid; e < 16 * 1024; e += NWAVES * 64) { const int b = e >> 10, d = e & 1023; const float cv = F.c[b * 1024 + d]; cond[d * 16 + b] = cv * sigmoid_f(cv); }
        __syncthreads();
        for (int it = gw; it < DEPTH * 384; it += NGW) {
            const int cb = it % 384, l = it / 384, e = cb * 16 + (F.lane & 15), dq = F.lane >> 4;
            const float* w = F.w_ada + ((size_t)l * 1024 + dq) * NMOD + e;
            float acc[16];
#pragma unroll
            for (int b = 0; b < 16; ++b) acc[b] = 0.f;
#pragma unroll 1
            for (int d0 = 0; d0 < 256; d0 += 16) {
                float wv[16];
#pragma unroll
                for (int u = 0; u < 16; ++u) wv[u] = w[(size_t)(4 * (d0 + u)) * NMOD];
#pragma unroll
                for (int u = 0; u < 16; ++u) { const LAS f32x4* cp = (const LAS f32x4*)(cond + (4 * (d0 + u) + dq) * 16);
#pragma unroll
                    for (int q = 0; q < 4; ++q) { const f32x4 cq = cp[q]; acc[4 * q] += cq[0] * wv[u]; acc[4 * q + 1] += cq[1] * wv[u]; acc[4 * q + 2] += cq[2] * wv[u]; acc[4 * q + 3] += cq[3] * wv[u]; } }
            }
            const float bb = F.b_ada[l * NMOD + e];
#pragma unroll
            for (int b = 0; b < 16; ++b) { float v = acc[b]; v += shfl_xor_l(v, 16, F.lane); v += shfl_xor_l(v, 32, F.lane); if (dq == 0) F.MOD()[(size_t)(l * 16 + b) * NMOD + e] = v + bb; }
        }
        __syncthreads();
    }
    for (int i = gt; i < 512; i += NGT) {
        const float p0 = F.lb_params[i], p1 = F.lb_params[512 + i], p2 = F.lb_params[1024 + i], p3 = F.lb_params[1536 + i];
        const float mx = fmaxf(fmaxf(p0, p1), fmaxf(p2, p3)); const float e0 = __expf(p0 - mx), e1 = __expf(p1 - mx), e2 = __expf(p2 - mx), e3 = __expf(p3 - mx);
        const float inv = 1.0f / (e0 + e1 + e2 + e3);
        F.SMALL()[SM_LB + i] = 0.f; F.SMALL()[SM_LB + 512 + i] = e1 * inv; F.SMALL()[SM_LB + 1024 + i] = (e1 + e2) * inv; F.SMALL()[SM_LB + 1536 + i] = (e1 + e2 + e3) * inv;
    }
    for (int i = gt; i < DEPTH * 3 * NUP; i += NGT) { const int np = i % NUP, lj = i / NUP; F.SMALL()[SM_CW + i] = F.conv_w[(size_t)lj * NUP + up_orig(np)] * (((np & 255) < 128) ? -1.4426950408889634f : -0.6931471805599453f); }
    for (int i = gt; i < DEPTH * NUP; i += NGT) { const int np = i % NUP, l = i / NUP; F.SMALL()[SM_CB + i] = F.conv_b[(size_t)l * NUP + up_orig(np)] * (((np & 255) < 128) ? -1.4426950408889634f : -0.6931471805599453f); }
    for (int i = gt; i < DEPTH * 256 * 1024; i += NGT) {
        const int k = i & 1023, n = (i >> 10) & 255, l = i >> 18;
        const float* wi = F.w_in + ((size_t)l * 1024 + k) * 3600 + NINW; const float* wg = F.w_gk + (size_t)l * 16 * 256 + n;
        float s = 0.f;
#pragma unroll
        for (int r = 0; r < 16; ++r) s += wi[r] * wg[r * 256];
        F.WIN()[((size_t)l * NIN + NINW + n) * 1024 + k] = (bf16)f2bf(s);
    }
    {   LAS float* scr = (LAS float*)(F.lds + F.wave * 16384);
        constexpr int I_IN = 16 * 112, I_OUT = 16 * 32, I_UP = 16 * 176, I_DN = 44 * 32, I_L = I_IN + I_OUT + I_UP + I_DN;
        for (int it = gw; it < DEPTH * I_L; it += NGW) {
            const int l = it / I_L; int r = it % I_L;
            if (r < I_IN) { const int kb = r / 112, nb = r % 112; tr_item(F.w_in + (size_t)l * 1024 * 3600, 3600, 1024, F.WIN() + (size_t)l * NIN * 1024, kb, 32 * nb, 32 * nb, (nb >= 64 && nb < 72) ? 0.125f : 1.0f, scr, F.lane); continue; } r -= I_IN;
            if (r < I_OUT) { const int kb = r / 32, nb = r % 32; tr_item(F.w_out + (size_t)l * 1024 * 1024, 1024, 1024, F.WOUT() + (size_t)l * 1024 * 1024, kb, 32 * nb, 32 * nb, 1.0f, scr, F.lane); continue; } r -= I_OUT;
            if (r < I_UP) { const int kb = r / 176, nb = r % 176; tr_item(F.w_up + (size_t)l * 1024 * NUP, NUP, 1024, F.WUP() + (size_t)l * NUP * 1024, kb, up_orig(32 * nb), 32 * nb, 1.0f, scr, F.lane); continue; } r -= I_UP;
            { const int kb = r / 32, nb = r % 32; tr_item(F.w_down + (size_t)l * FF * 1024, 1024, FF, F.WDN() + (size_t)l * 1024 * FF, kb, 32 * nb, 32 * nb, 1.0f, scr, F.lane); }
        }
    }
}

__device__ __forceinline__ void p0b(Frame& F) {
    const int gw = F.vcu * NWAVES + F.wave, NGW = F.G * NWAVES, gt = F.vcu * (NWAVES * 64) + F.tid, NGT = F.G * NWAVES * 64;
    {   typedef short b8_t __attribute__((ext_vector_type(8)));
        constexpr int NB1 = NIN / 16, NB2 = NUP / 16, NBL = NB1 + NB2;
        const int m = F.lane & 15, g = F.lane >> 4;
        for (int it = gw; it < DEPTH * NBL; it += NGW) {
            const int l = it / NBL, r = it % NBL, which = r >= NB1, n0 = 16 * (which ? r - NB1 : r), ncols = which ? NUP : NIN;
            const bf16* wrow = (which ? F.WUP() + (size_t)l * NUP * 1024 : F.WIN() + (size_t)l * NIN * 1024) + (size_t)(n0 + m) * 1024 + 8 * g;
            const float* shp = F.MOD() + (size_t)(l * 16 + m) * NMOD + (which ? 3072 : 0) + 8 * g;
            f32x4 acc = {0.f, 0.f, 0.f, 0.f};
#pragma unroll 4
            for (int ks = 0; ks < 32; ++ks) {
                const b8_t bw = *(const GAS b8_t*)(wrow + 32 * ks);
                const f32x4 s0 = *(const GAS f32x4*)(shp + 32 * ks), s1 = *(const GAS f32x4*)(shp + 32 * ks + 4);
                unsigned hi[4], lo[4];
#pragma unroll
                for (int q = 0; q < 2; ++q) { const f32x4 s = q ? s1 : s0;
                    hi[2 * q] = pk2(s[0], s[1]); hi[2 * q + 1] = pk2(s[2], s[3]);
                    lo[2 * q] = pk2(s[0] - bf2f(hi[2 * q] & 0xffffu), s[1] - bf2f(hi[2 * q] >> 16)); lo[2 * q + 1] = pk2(s[2] - bf2f(hi[2 * q + 1] & 0xffffu), s[3] - bf2f(hi[2 * q + 1] >> 16)); }
                acc = __builtin_amdgcn_mfma_f32_16x16x32_bf16(__builtin_bit_cast(b8_t, (v4u){hi[0], hi[1], hi[2], hi[3]}), bw, acc, 0, 0, 0);
                acc = __builtin_amdgcn_mfma_f32_16x16x32_bf16(__builtin_bit_cast(b8_t, (v4u){lo[0], lo[1], lo[2], lo[3]}), bw, acc, 0, 0, 0);
            }
            float* outp = F.SMALL() + (which ? SM_B2 + l * 16 * NUP : SM_B1 + l * 16 * NIN);
            const int n = n0 + m; const float extra = (which == 0 && n >= NINW) ? F.b_gk[l * 256 + n - NINW] : 0.f;
#pragma unroll
            for (int j = 0; j < 4; ++j) outp[(4 * g + j) * ncols + n] = acc[j] + extra;
        }
    }
    for (int i = gt; i < DEPTH * 16 * D; i += NGT) { const int d = i & 1023, lb = i >> 10, l = lb >> 4; const float* mod = F.MOD() + (size_t)lb * NMOD;
        F.SMALL()[SM_GS1 + i] = F.ln1_g[l * D + d] * (1.0f + mod[1024 + d]); F.SMALL()[SM_GT1 + i] = mod[2048 + d];
        F.SMALL()[SM_GS2 + i] = F.ln2_g[l * D + d] * (1.0f + mod[4096 + d]); F.SMALL()[SM_GT2 + i] = mod[5120 + d]; }
    for (int row0 = 4 * gw; row0 < M; row0 += 4 * NGW) {
        const int b = row0 / SEQ; const float* mod = F.MOD() + (size_t)b * NMOD + 1024;
        f32x4 v[4][4];
#pragma unroll
        for (int r = 0; r < 4; ++r)
#pragma unroll
            for (int j = 0; j < 4; ++j) v[r][j] = ((const GAS f32x4*)(F.x + (size_t)(row0 + r) * D) + F.lane)[64 * j];
        f32x4 gsv[4];
#pragma unroll
        for (int j = 0; j < 4; ++j) { const int d = 256 * j + 4 * F.lane; const f32x4 g = *(const f32x4*)(F.ln1_g + d), sc = *(const f32x4*)(mod + d); gsv[j] = g * (sc + 1.0f); }
#pragma unroll
        for (int r = 0; r < 4; ++r) { GAS v2u* o8 = (GAS v2u*)(F.XN() + (size_t)(row0 + r) * D) + F.lane; GAS v2u* x8 = (GAS v2u*)(F.XB() + (size_t)(row0 + r) * D) + F.lane; float ss = 0.f;
#pragma unroll
            for (int j = 0; j < 4; ++j) { const f32x4 x = v[r][j]; ss += (x[0] * x[0] + x[1] * x[1]) + (x[2] * x[2] + x[3] * x[3]); const f32x4 y = x * gsv[j];
                v2u w; w.x = pk2(y[0], y[1]); w.y = pk2(y[2], y[3]); o8[64 * j] = w;
                v2u xw; xw.x = pk2(x[0], x[1]); xw.y = pk2(x[2], x[3]); x8[64 * j] = xw; }
            ss = wave_sum(ss, F.lane);
            if (F.lane < 16) F.STAT()[(size_t)(row0 + r) * 16 + F.lane] = (F.lane == 0) ? ss : 0.f; }
    }
}

#ifndef MX_SPLIT
#define MX_SPLIT 1
#endif


typedef short bf16x8_t __attribute__((ext_vector_type(8)));
typedef short s16x4_t __attribute__((ext_vector_type(4)));
typedef float f32x2_t __attribute__((ext_vector_type(2)));
typedef __bf16 bf16x2_t __attribute__((ext_vector_type(2)));
#define MFMA16(a, b, c) __builtin_amdgcn_mfma_f32_16x16x32_bf16((a), (b), (c), 0, 0, 0)
#define LBAR() do { asm volatile("s_waitcnt lgkmcnt(0)" ::: "memory"); __builtin_amdgcn_s_barrier(); asm volatile("" ::: "memory"); } while (0)
__device__ __forceinline__ unsigned cvtpk(float lo, float hi) { f32x2_t v = {lo, hi}; bf16x2_t r = __builtin_convertvector(v, bf16x2_t); return __builtin_bit_cast(unsigned, r); }
__device__ __forceinline__ float bflo(unsigned u) { return __builtin_bit_cast(float, u << 16); }
__device__ __forceinline__ float bfhi(unsigned u) { return __builtin_bit_cast(float, u & 0xffff0000u); }
__device__ __forceinline__ s16x4_t tr16(const LAS unsigned char* p) { return __builtin_bit_cast(s16x4_t, __builtin_amdgcn_ds_read_tr16_b64_v4i16((LAS s16x4_t*)p)); }
constexpr float L2E = 1.4426950408889634f;


#ifndef MX_S_DELAY
#define MX_S_DELAY 25
#endif
template <int DK, bool IS_A>
__device__ __forceinline__ void mixer_pipe_stream(Frame& F, int l, int b, int h, const int n_lo, const int n_full, const int n_hi) {
    constexpr int DKW = DK / 4, PW = DKW / 2, RG = 64 / PW, RR = 64 / RG, RGREF = 32 / RR, NKS = DK / 32, NMT = DK / 16;
    constexpr int PQ = DK * 2 + 16, PT = 144, PV = 272, PO = 528;
    constexpr int BUF = 2 * 64 * PQ + 64 * PV, B_QH = 0, B_KH = 64 * PQ, B_VV = 2 * 64 * PQ;
    constexpr int L_SC = 2 * BUF, L_FAC = L_SC + 64 * PT, FACB = 3 * DK * 4, L_OB = L_FAC + 2 * FACB, L_END = L_OB + 64 * PO;
    static_assert(L_END <= LDSCTL_OFF, "mixer LDS map");
    LAS unsigned char* const lds = F.lds;
    const int w = F.wave;
    const bool producer = (w >= 4);
    const int pw = w - 4, cw = w;
    const int qc = IS_A ? 128 * h : 2048 + 64 * h, fc = IS_A ? 512 + 128 * h : 2304 + 64 * h, gkc = 3584 + 64 * h;
    const int vc = IS_A ? 1024 + 128 * h : 2560 + 128 * h, gc = IS_A ? 1536 + 128 * h : 3072 + 128 * h, oc = IS_A ? 128 * h : 512 + 128 * h;
    const float* gnp = (IS_A ? F.gn_a : F.gn_b) + l * 128;
#define MP_LANE() int lane; asm volatile("v_mbcnt_lo_u32_b32 %0, -1, 0\n\tv_mbcnt_hi_u32_b32 %0, -1, %0" : "=v"(lane))
    f32x4 S[NMT][2];
#pragma unroll
    for (int i = 0; i < NMT; ++i) { S[i][0] = (f32x4){0.f, 0.f, 0.f, 0.f}; S[i][1] = (f32x4){0.f, 0.f, 0.f, 0.f}; }
    v4u ogreg[4];
    unsigned q2[RR], f2[RR], k2[RR]; v4u vreg[4];
#define MP_LOAD_RAW(n) do { const size_t row0_ = (size_t)b * SEQ + (size_t)(n) * 64; \
        _Pragma("unroll") for (int j = 0; j < RR; ++j) { const GAS unsigned* pr = (const GAS unsigned*)(F.P() + (row0_ + rg * RR + j) * NIN); \
            q2[j] = pr[(qc >> 1) + pw * PW + cpl]; if (IS_A) { f2[j] = pr[(fc >> 1) + pw * PW + cpl]; } else { k2[j] = pr[(fc >> 1) + pw * PW + cpl]; f2[j] = pr[(gkc >> 1) + pw * PW + cpl]; } } \
        _Pragma("unroll") for (int i = 0; i < 4; ++i) { const int id = pw * 64 + lane + 256 * i; vreg[i] = *(const GAS v4u*)(F.P() + (row0_ + (id >> 4)) * NIN + vc + 8 * (id & 15)); } } while (0)
    if (producer) {
        MP_LANE(); const int cpl = lane % PW, rg = lane / PW, m = lane & 15, g = lane >> 4;
        MP_LOAD_RAW(n_lo);
        for (int tb = 0; tb < pw; ++tb)
#pragma unroll
            for (int j = 0; j < 4; ++j) *(LAS unsigned short*)(lds + L_SC + (16 * tb + 4 * g + j) * PT + 2 * (16 * pw + m)) = (unsigned short)0;
    }
    if (producer) {
#pragma unroll 1
    for (int i = n_lo - 1; i < n_hi; ++i) {
        const int bc = i & 1, bp = (i + 1) & 1;
        const bool c_on = (i >= n_lo), c_full = (i >= n_full), p_on = (i + 1 < n_hi), p_full = (i + 1 >= n_full);
            if (p_on) {
                MP_LANE(); const int cpl = lane % PW, rg = lane / PW;
                LAS unsigned char* const bufp = lds + bp * BUF;
                float cum[2][RR], kk[2][RR], lg[2];
#pragma unroll
                for (int c = 0; c < 2; ++c) { float run = IS_A ? 1.f : 0.f;
#pragma unroll
                    for (int j = 0; j < RR; ++j) { const float x = c ? bfhi(f2[j]) : bflo(f2[j]);
                        if (IS_A) { run *= 1.0f - x; kk[c][j] = x; }
                        else { run += (fminf(x, 0.f) * L2E - __builtin_amdgcn_logf(1.0f + __builtin_amdgcn_exp2f(-fabsf(x) * L2E))) * (1.0f / 16.0f); kk[c][j] = c ? bfhi(k2[j]) : bflo(k2[j]); }
                        cum[c][j] = run; }
                    lg[c] = IS_A ? __builtin_amdgcn_logf(run) : run; }
                float eb[2];
#pragma unroll
                for (int c = 0; c < 2; ++c) { float incl = lg[c];
#pragma unroll
                    for (int d = 1; d < RG; d <<= 1) { const float t = shfl_idx(incl, lane - d * PW); if (rg >= d) incl += t; }
                    const float base = incl - lg[c], tot = shfl_idx(incl, (RG - 1) * PW + cpl), refv = shfl_idx(base, RGREF * PW + cpl);
                    if (rg == 0) { LAS float* fp = (LAS float*)(lds + L_FAC + bp * FACB) + pw * DKW + 2 * cpl + c;
                        fp[0] = __builtin_amdgcn_exp2f(tot); fp[DK] = __builtin_amdgcn_exp2f(refv); fp[2 * DK] = __builtin_amdgcn_exp2f(tot - refv); }
                    eb[c] = IS_A ? __builtin_amdgcn_exp2f(base - refv) : base - refv; }
#pragma unroll
                for (int j = 0; j < RR; ++j) { const int t = rg * RR + j;
                    const float e10 = IS_A ? eb[0] * cum[0][j] : __builtin_amdgcn_exp2f(eb[0] + cum[0][j]), e11 = IS_A ? eb[1] * cum[1][j] : __builtin_amdgcn_exp2f(eb[1] + cum[1][j]);
                    const int wofs = t * PQ + ((2 * (pw * DKW + 2 * cpl)) ^ (IS_A ? 64 * ((t >> 4) & 3) : 0));
                    if (p_full) *(LAS unsigned*)(bufp + B_QH + wofs) = cvtpk(bflo(q2[j]) * e10, bfhi(q2[j]) * e11);
                    *(LAS unsigned*)(bufp + B_KH + wofs) = cvtpk(kk[0][j] * __builtin_amdgcn_rcpf(e10), kk[1][j] * __builtin_amdgcn_rcpf(e11)); }
#pragma unroll
                for (int i2 = 0; i2 < 4; ++i2) { const int id = pw * 64 + lane + 256 * i2; *(LAS v4u*)(bufp + B_VV + (id >> 4) * PV + 16 * (id & 15)) = vreg[i2]; }
                if (i + 2 < n_hi) MP_LOAD_RAW(i + 2);
            }
        LBAR();
            if (p_on && p_full) {
                if (MX_S_DELAY) __builtin_amdgcn_s_sleep(MX_S_DELAY);
                MP_LANE(); const int m = lane & 15, g = lane >> 4, sb = pw;
                const LAS unsigned char* const bufp = lds + bp * BUF;
                bf16x8_t kf[NKS];
#pragma unroll
                for (int ks = 0; ks < NKS; ++ks) kf[ks] = *(const LAS bf16x8_t*)(bufp + B_KH + (16 * sb + m) * PQ + 64 * (IS_A ? (ks ^ sb) : ks) + 16 * g);
                for (int tb = sb; tb < 4; ++tb) { f32x4 acc = {0.f, 0.f, 0.f, 0.f};
#pragma unroll
                    for (int ks = 0; ks < NKS; ++ks) { const bf16x8_t a = *(const LAS bf16x8_t*)(bufp + B_QH + (16 * tb + m) * PQ + 64 * (IS_A ? (ks ^ tb) : ks) + 16 * g); acc = MFMA16(a, kf[ks], acc); }
#pragma unroll
                    for (int j = 0; j < 4; ++j) { const int t = 16 * tb + 4 * g + j, s = 16 * sb + m; const float val = (s <= t) ? acc[j] : 0.f;
                        *(LAS unsigned short*)(lds + L_SC + t * PT + 2 * s) = (unsigned short)f2bf(val); } }
            }
        LBAR();
    }
    } else {
#pragma unroll 1
    for (int i = n_lo - 1; i < n_hi; ++i) {
        const int bc = i & 1, bp = (i + 1) & 1;
        const bool c_on = (i >= n_lo), c_full = (i >= n_full), p_on = (i + 1 < n_hi), p_full = (i + 1 >= n_full);
        if (c_on) {
            MP_LANE(); const int m = lane & 15, g = lane >> 4, q4 = (lane & 15) >> 2, p4 = lane & 3, dv0 = 32 * cw;
            const LAS unsigned char* const bufc = lds + bc * BUF; const LAS unsigned char* const facp = lds + L_FAC + bc * FACB;
            const size_t row0 = (size_t)b * SEQ + (size_t)i * 64;
            if (c_full) { const int ctid = cw * 64 + lane;
#pragma unroll
                for (int i2 = 0; i2 < 4; ++i2) ogreg[i2] = *(const GAS v4u*)(F.P() + (row0 + (ctid >> 2)) * NIN + gc + 32 * (ctid & 3) + 8 * i2); }
            bf16x8_t vB[2][2];
#pragma unroll
            for (int ks2 = 0; ks2 < 2; ++ks2)
#pragma unroll
                for (int n2 = 0; n2 < 2; ++n2) { const LAS unsigned char* vp = bufc + B_VV + (32 * ks2 + 8 * g + q4) * PV + 2 * (dv0 + 16 * n2 + 4 * p4);
                    const s16x4_t lo = tr16(vp), hi = tr16(vp + 4 * PV); vB[ks2][n2] = __builtin_shufflevector(lo, hi, 0, 1, 2, 3, 4, 5, 6, 7); }
#define MX_SCHED() __builtin_amdgcn_sched_barrier(0)
#define MX_LDQ(dst, sg_) do { _Pragma("unroll") for (int mt = 0; mt < 4; ++mt) { const LAS unsigned char* qp = bufc + B_QH + (16 * mt + m) * PQ + 2 * (32 * (IS_A ? ((sg_) ^ mt) : (sg_)) + 4 * g); \
        const s16x4_t lo = *(const LAS s16x4_t*)qp, hi = *(const LAS s16x4_t*)(qp + 32); dst[mt] = __builtin_shufflevector(lo, hi, 0, 1, 2, 3, 4, 5, 6, 7); } } while (0)
#define MX_LDK(dst, mtile_) do { _Pragma("unroll") for (int ks2 = 0; ks2 < 2; ++ks2) { const LAS unsigned char* kp = bufc + B_KH + (32 * ks2 + 8 * g + q4) * PQ + 2 * (16 * (IS_A ? ((mtile_) ^ (2 * (2 * ks2 + (g >> 1)))) : (mtile_)) + 4 * p4); \
        const s16x4_t lo = tr16(kp), hi = tr16(kp + 4 * PQ); dst[ks2] = __builtin_shufflevector(lo, hi, 0, 1, 2, 3, 4, 5, 6, 7); } } while (0)
            if (c_full) {
                f32x4 o[4][2];
                bf16x8_t sc[6], qa[2][4];
                {   int k = 0;
#pragma unroll
                    for (int mt = 0; mt < 4; ++mt)
#pragma unroll
                        for (int ks2 = 0; ks2 < 2; ++ks2) if (2 * ks2 <= mt) sc[k++] = *(const LAS bf16x8_t*)(lds + L_SC + (16 * mt + m) * PT + 64 * ks2 + 16 * g); }
                MX_LDQ(qa[0], 0);
                f32x4 ea = *(const LAS f32x4*)(facp + 4 * (DK + 4 * g)), eb4 = *(const LAS f32x4*)(facp + 4 * (DK + 16 + 4 * g));
                MX_SCHED();
                {   int k = 0;
#pragma unroll
                    for (int mt = 0; mt < 4; ++mt) { o[mt][0] = (f32x4){0.f, 0.f, 0.f, 0.f}; o[mt][1] = (f32x4){0.f, 0.f, 0.f, 0.f};
#pragma unroll
                        for (int ks2 = 0; ks2 < 2; ++ks2) if (2 * ks2 <= mt) { o[mt][0] = MFMA16(sc[k], vB[ks2][0], o[mt][0]); o[mt][1] = MFMA16(sc[k], vB[ks2][1], o[mt][1]); ++k; } } }
#pragma unroll
                for (int sg = 0; sg < NKS; ++sg) {
                    bf16x8_t sB[2];
#pragma unroll
                    for (int n2 = 0; n2 < 2; ++n2) { const f32x4 sa = S[2 * sg][n2] * ea, sb4 = S[2 * sg + 1][n2] * eb4;
                        sB[n2] = __builtin_bit_cast(bf16x8_t, (v4u){cvtpk(sa[0], sa[1]), cvtpk(sa[2], sa[3]), cvtpk(sb4[0], sb4[1]), cvtpk(sb4[2], sb4[3])}); }
                    if (sg + 1 < NKS) { MX_LDQ(qa[(sg + 1) & 1], sg + 1); ea = *(const LAS f32x4*)(facp + 4 * (DK + 32 * (sg + 1) + 4 * g)); eb4 = *(const LAS f32x4*)(facp + 4 * (DK + 32 * (sg + 1) + 16 + 4 * g)); }
                    MX_SCHED();
#pragma unroll
                    for (int mt = 0; mt < 4; ++mt) { o[mt][0] = MFMA16(qa[sg & 1][mt], sB[0], o[mt][0]); o[mt][1] = MFMA16(qa[sg & 1][mt], sB[1], o[mt][1]); }
                    MX_SCHED();
                }
#pragma unroll
                for (int mt = 0; mt < 4; ++mt)
#pragma unroll
                    for (int n2 = 0; n2 < 2; ++n2)
#pragma unroll
                        for (int j = 0; j < 4; ++j) *(LAS float*)(lds + L_OB + (16 * mt + 4 * g + j) * PO + 4 * (dv0 + 16 * n2 + m)) = o[mt][n2][j];
            }
            {   bf16x8_t ka[2][2]; f32x4 d4[2], l4[2];
                MX_LDK(ka[0], 0); d4[0] = *(const LAS f32x4*)(facp + 4 * (4 * g)); l4[0] = *(const LAS f32x4*)(facp + 4 * (2 * DK + 4 * g));
#pragma unroll
                for (int mtile = 0; mtile < NMT; ++mtile) { const int cb_ = mtile & 1, nb_ = cb_ ^ 1;
                    if (mtile + 1 < NMT) { MX_LDK(ka[nb_], mtile + 1); d4[nb_] = *(const LAS f32x4*)(facp + 4 * (16 * (mtile + 1) + 4 * g)); l4[nb_] = *(const LAS f32x4*)(facp + 4 * (2 * DK + 16 * (mtile + 1) + 4 * g)); }
                    MX_SCHED();
#pragma unroll
                    for (int n2 = 0; n2 < 2; ++n2) { f32x4 u4 = {0.f, 0.f, 0.f, 0.f}; u4 = MFMA16(ka[cb_][0], vB[0][n2], u4); u4 = MFMA16(ka[cb_][1], vB[1][n2], u4); S[mtile][n2] = S[mtile][n2] * d4[cb_] + u4 * l4[cb_]; }
                    MX_SCHED();
                }
            }
#undef MX_SCHED
#undef MX_LDQ
#undef MX_LDK
        }
        LBAR();
        if (c_on && c_full) {
            MP_LANE(); const int ctid = cw * 64 + lane, nt = ctid >> 2, ndq = ctid & 3;
            const size_t row0 = (size_t)b * SEQ + (size_t)i * 64;
            f32x4 ov[8]; float ss = 0.f;
#pragma unroll
            for (int i2 = 0; i2 < 8; ++i2) { ov[i2] = *(const LAS f32x4*)(lds + L_OB + nt * PO + 128 * ndq + 16 * i2); ss += (ov[i2][0] * ov[i2][0] + ov[i2][1] * ov[i2][1]) + (ov[i2][2] * ov[i2][2] + ov[i2][3] * ov[i2][3]); }
            ss += shfl_xor_l(ss, 1, lane); ss += shfl_xor_l(ss, 2, lane);
            const float rn = __builtin_amdgcn_rsqf(ss * (1.0f / 128.0f) + EPS);
            bf16* op = F.O() + (row0 + nt) * D + oc + 32 * ndq;
#pragma unroll
            for (int i4 = 0; i4 < 4; ++i4) { unsigned ow[4];
#pragma unroll
                for (int hh = 0; hh < 2; ++hh) { const int i2 = 2 * i4 + hh; const f32x4 gn4 = *(const GAS f32x4*)(gnp + 32 * ndq + 4 * i2); const unsigned g01 = ogreg[i4][2 * hh], g23 = ogreg[i4][2 * hh + 1];
                    const float ga = bflo(g01), gb = bfhi(g01), gcc = bflo(g23), gd = bfhi(g23);
                    const float r0 = ov[i2][0] * rn * gn4[0] * ga, r1 = ov[i2][1] * rn * gn4[1] * gb, r2 = ov[i2][2] * rn * gn4[2] * gcc, r3 = ov[i2][3] * rn * gn4[3] * gd;
                    ow[2 * hh] = cvtpk(r0, r1); ow[2 * hh + 1] = cvtpk(r2, r3); }
                *(GAS v4u*)(op + 8 * i4) = (v4u){ow[0], ow[1], ow[2], ow[3]}; }
                }
        LBAR();
    }
    }
#undef MP_LOAD_RAW
#undef MP_LANE
}
#ifndef MX_N0
#define MX_N0 38
#endif
#ifndef MX_N0B
#define MX_N0B MX_N0
#endif
__device__ __forceinline__ void mixer_phase_pipe(Frame& F, int l) {
#if MX_SPLIT
    {
        for (int it = blockIdx.x; it < 256; it += F.G) { const int j = it >> 3, b = 2 * (it & 7) + (j & 1), h = (j >> 1) & 3, seg = (j >> 3) & 1;
            if (j < 16) mixer_pipe_stream<128, true>(F, l, b, h, 0, seg ? MX_N0 : 0, seg ? SEQ / 64 : MX_N0);
            else mixer_pipe_stream<64, false>(F, l, b, h, 0, seg ? MX_N0B : 0, seg ? SEQ / 64 : MX_N0B); } }
#else
    for (int it = blockIdx.x; it < 128; it += F.G) { const int s = it & 63;
        if (it < 64) mixer_pipe_stream<128, true>(F, l, s >> 2, s & 3, 0, 0, SEQ / 64);
        else mixer_pipe_stream<64, false>(F, l, s >> 2, s & 3, 0, 0, SEQ / 64); }
#endif
}
__device__ __forceinline__ void fix_phase(Frame& F, int l) {
    const int gt = ((int)blockIdx.x >> 3) * (NWAVES * 64) + F.tid, NGT = GROUP_WGS * NWAVES * 64;
    const GAS float* cw = (const GAS float*)(F.SMALL() + SM_CW + l * 3 * NUP); const GAS float* cb = (const GAS float*)(F.SMALL() + SM_CB + l * NUP);
    for (int i = gt; i < GROUP_WGS * FF; i += NGT) { const int pm = GROUP_WGS * ((int)blockIdx.x & 7) + i / FF, f = i % FF; if ((pm & 15) == 0) continue;
        const int ca = 256 * (f >> 7) + (f & 127), cv = ca + 128;
        const GAS float* T = (const GAS float*)(F.RAWT() + (size_t)(pm - 1) * 2 * NUP); const GAS float* H = (const GAS float*)(F.RAWH() + (size_t)pm * 2 * NUP);
        const float a_m2 = T[ca], a_m1 = T[NUP + ca], a_0 = H[ca], a_1 = H[NUP + ca], v_m2 = T[cv], v_m1 = T[NUP + cv], v_0 = H[cv], v_1 = H[NUP + cv];
        const float wa0 = cw[ca], wa1 = cw[NUP + ca], wa2 = cw[2 * NUP + ca], wv0 = cw[cv], wv1 = cw[NUP + cv], wv2 = cw[2 * NUP + cv], ba = cb[ca], bv = cb[cv];
        const float ca0 = ba + wa0 * a_m2 + wa1 * a_m1 + wa2 * a_0, cv0 = bv + wv0 * v_m2 + wv1 * v_m1 + wv2 * v_0;
        const float ca1 = ba + wa0 * a_m1 + wa1 * a_0 + wa2 * a_1, cv1 = bv + wv0 * v_m1 + wv1 * v_0 + wv2 * v_1;
        GAS bf16* g = (GAS bf16*)(F.Gb() + (size_t)pm * 256 * FF + f);
        g[0] = (bf16)f2bf(ca0 * cv0 * __builtin_amdgcn_rcpf(1.0f + __builtin_amdgcn_exp2f(ca0))); g[FF] = (bf16)f2bf(ca1 * cv1 * __builtin_amdgcn_rcpf(1.0f + __builtin_amdgcn_exp2f(ca1))); }
}

__device__ __forceinline__ void final_phase(Frame& F) {
    const int gw = ((int)blockIdx.x >> 3) * NWAVES + F.wave, NGW = GROUP_WGS * NWAVES, rbase = ((int)blockIdx.x & 7) * (M / 8);
    f32x4 gv[4];
#pragma unroll
    for (int j = 0; j < 4; ++j) gv[j] = *(const GAS f32x4*)(F.lnf_g + 256 * j + 4 * F.lane);
    for (int row0 = rbase + 4 * gw; row0 < rbase + M / 8; row0 += 4 * NGW) {
        f32x4 v[4][4]; float ssr[4];
#pragma unroll
        for (int r = 0; r < 4; ++r) { ssr[r] = (F.lane < 16) ? *(const GAS float*)(F.STAT() + (size_t)(row0 + r) * 16 + F.lane) : 0.f;
#pragma unroll
            for (int j = 0; j < 4; ++j) { const v2u xw = ((const GAS v2u*)(F.XB() + (size_t)(row0 + r) * D) + F.lane)[64 * j]; v[r][j] = (f32x4){bf2f(xw.x & 0xffffu), bf2f(xw.x >> 16), bf2f(xw.y & 0xffffu), bf2f(xw.y >> 16)}; } }
#pragma unroll
        for (int r = 0; r < 4; ++r) { const float rs = __builtin_amdgcn_rsqf(wave_sum(ssr[r], F.lane) * (1.0f / (float)D) + EPS);
#pragma unroll
            for (int j = 0; j < 4; ++j) ((GAS f32x4*)(F.out + (size_t)(row0 + r) * D) + F.lane)[64 * j] = v[r][j] * rs * gv[j]; }
    }
}

struct Args { const float* in[18]; float* out; unsigned char* ws; int ph_lo, ph_hi; };
__global__ void __launch_bounds__(NWAVES * 64, 2) fwd(Args args) {
    extern __shared__ __attribute__((aligned(16))) unsigned char lds[];
    Frame F;
    F.lds = (LAS unsigned char*)lds; F.MISC = (volatile LAS unsigned*)(F.lds + MISC_OFF);
    F.tid = threadIdx.x; F.lane = F.tid & 63; F.wave = __builtin_amdgcn_readfirstlane(F.tid >> 6);
    F.G = gridDim.x; { const int bx = blockIdx.x; F.vcu = (F.G % 8 == 0) ? (bx % 8) * (F.G / 8) + bx / 8 : bx; }
    unsigned char* ws = args.ws;
    F.ctl = (unsigned*)(ws + WS_CTL); F.ws = ws;
    F.x = args.in[0]; F.c = args.in[1]; F.ln1_g = args.in[2]; F.ln2_g = args.in[3]; F.w_ada = args.in[4]; F.b_ada = args.in[5]; F.w_in = args.in[6]; F.lb_params = args.in[7];
    F.w_gk = args.in[8]; F.b_gk = args.in[9]; F.gn_a = args.in[10]; F.gn_b = args.in[11]; F.w_out = args.in[12]; F.w_up = args.in[13]; F.conv_w = args.in[14]; F.conv_b = args.in[15];
    F.w_down = args.in[16]; F.lnf_g = args.in[17]; F.out = args.out;
    for (int u = F.tid; u < (LDS_BYTES - LDSCTL_OFF) / 4; u += NWAVES * 64) ((LAS unsigned*)(F.lds + LDSCTL_OFF))[u] = 0u;
    __syncthreads();
    const int lo = args.ph_lo, hi = args.ph_hi;
    XcdBarrier bar; bar.bar = F.ctl + CW_BAR; bar.x = 0; bar.st = nullptr; bar.total = 0;
    if (hi - lo > 1) { bar = xcd_barrier_post(F.ctl + CW_BAR, F.MISC + 8, gridDim.x); (void)xcd_barrier_post(F.ctl + CW_BAR + 4096 * (1 + (blockIdx.x & 7u)), F.MISC + 10, GROUP_WGS); }
#define IN(k) (lo <= (k) && (k) < hi)
#define SEAM(k) do { if (IN(k) && IN((k) + 1)) { int l0_; asm volatile("v_mbcnt_lo_u32_b32 %0, -1, 0\n\tv_mbcnt_hi_u32_b32 %0, -1, %0" : "=v"(l0_)); \
        if ((k) < 2) xcd_barrier(bar, F.wave == 0 && l0_ == 0); \
        else { XcdBarrier gb_; gb_.bar = F.ctl + CW_BAR + 4096 * (1 + (blockIdx.x & 7u)); gb_.x = xb_xcc_id(); gb_.total = GROUP_WGS; gb_.st = F.MISC + 10; xcd_barrier(gb_, F.wave == 0 && l0_ == 0); } } } while (0)
    if (IN(0)) p0a(F);
    SEAM(0);
#ifdef PROBE_P0A2
    p0a(F); SEAM(0);
#endif
    if (IN(1)) p0b(F);
    SEAM(1);
#ifdef PROBE_P0B2
    p0b(F); SEAM(1);
#endif
    if (IN(1) && IN(2) && SKEW_TICKS > 0) {
        int l0_; asm volatile("v_mbcnt_lo_u32_b32 %0, -1, 0\n\tv_mbcnt_hi_u32_b32 %0, -1, %0" : "=v"(l0_));
        if (F.wave == 0 && l0_ == 0) { const unsigned long long t0 = __builtin_amdgcn_s_memrealtime(), dt = (unsigned long long)(blockIdx.x & 7u) * SKEW_TICKS;
            while (__builtin_amdgcn_s_memrealtime() - t0 < dt) __builtin_amdgcn_s_sleep(8); }
        __syncthreads();
    }
    for (int l = 0; l < DEPTH; ++l) {
        const int pb = 2 + 6 * l;
#define LAUNDER_TID() do { int l_; asm volatile("v_mbcnt_lo_u32_b32 %0, -1, 0\n\tv_mbcnt_hi_u32_b32 %0, -1, %0" : "=v"(l_)); F.lane = l_; F.tid = F.wave * 64 + l_; asm volatile("" : "+s"(F.ws)); } while (0)
        if (IN(pb)) {
            LAUNDER_TID();
            pg8::Gemm g{F.XN(), F.WIN() + (size_t)l * NIN * 1024, M, NIN, D}; pg8::StaticOrder S; S.init(M, NIN, F.G, (int)blockIdx.x);
            pg8::EpiIn E{F.P(), F.SMALL() + SM_B1 + l * 16 * NIN, F.STAT(), F.SMALL() + SM_LB + l * 512};
            pg8::gemm_phase<pg8::EpiIn, pg8::StaticOrder, true, true>(F.lds, g, S, E, F.tid);
        }
        SEAM(pb);
        if (IN(pb + 1)) { LAUNDER_TID(); mixer_phase_pipe(F, l); }
        SEAM(pb + 1);
        if (IN(pb + 2)) {
            LAUNDER_TID();
            pg8::Gemm g{F.O(), F.WOUT() + (size_t)l * 1024 * 1024, M, D, D}; pg8::StaticOrder S; S.init(M, D, F.G, (int)blockIdx.x);
            pg8::EpiXUpd E{F.XB(), F.XN(), F.SMALL() + SM_GT1 + l * 16 * D, F.SMALL() + SM_GS2 + l * 16 * D, F.STAT()};
            pg8::gemm_phase<pg8::EpiXUpd, pg8::StaticOrder, true, true>(F.lds, g, S, E, F.tid);
        }
        SEAM(pb + 2);
        if (IN(pb + 3)) {
            LAUNDER_TID();
            pg8::Gemm g{F.XN(), F.WUP() + (size_t)l * NUP * 1024, M, NUP, D}; pg8::StaticOrder S; S.init(M, NUP, F.G, (int)blockIdx.x);
            pg8::EpiUp E{F.Gb(), F.SMALL() + SM_B2 + l * 16 * NUP, F.STAT(), F.SMALL() + SM_CW + l * 3 * NUP, F.SMALL() + SM_CB + l * NUP, F.RAWH(), F.RAWT(), (LAS float*)(F.lds + HALO_OFF)};
            pg8::gemm_phase<pg8::EpiUp, pg8::StaticOrder, true, true>(F.lds, g, S, E, F.tid);
        }
        SEAM(pb + 3);
        if (IN(pb + 4)) { LAUNDER_TID(); fix_phase(F, l); }
        SEAM(pb + 4);
        if (IN(pb + 5)) {
            LAUNDER_TID();
            pg8::Gemm g{F.Gb(), F.WDN() + (size_t)l * 1024 * FF, M, D, FF}; pg8::StaticOrder S; S.init(M, D, F.G, (int)blockIdx.x);
            pg8::EpiXUpd E{F.XB(), l + 1 < DEPTH ? F.XN() : (bf16*)nullptr, F.SMALL() + SM_GT2 + l * 16 * D, F.SMALL() + SM_GS1 + (l + 1 < DEPTH ? l + 1 : l) * 16 * D, F.STAT()};
            pg8::gemm_phase<pg8::EpiXUpd, pg8::StaticOrder, true, true>(F.lds, g, S, E, F.tid);
        }
        SEAM(pb + 5);
    }
    if (IN(N_PHASES - 1)) { LAUNDER_TID(); final_phase(F); }
#undef IN
#undef SEAM
}

extern "C" void kernel_launch(void* const* d_in, const int* in_sizes, int n_in, void* d_out, int out_size, void* d_ws, size_t ws_size, hipStream_t stream) {
    static int grid = 0;
    if (grid == 0) {
        if (n_in != 18 || in_sizes[0] != M * D || out_size != M * D || ws_size < WS_END) { fprintf(stderr, "kernel_launch: unexpected shapes / workspace (n_in %d, in0 %d, out %d, ws %zu < %zu); nothing launched\n", n_in, n_in > 0 ? in_sizes[0] : -1, out_size, ws_size, (size_t)WS_END); grid = -1; return; }
        int dev = 0, cus = 0, per_cu = 0;
        if (hipGetDevice(&dev) != hipSuccess || hipDeviceGetAttribute(&cus, hipDeviceAttributeMultiprocessorCount, dev) != hipSuccess) { grid = -1; return; }
        if (hipFuncSetAttribute((const void*)fwd, hipFuncAttributeMaxDynamicSharedMemorySize, LDS_BYTES) != hipSuccess) { fprintf(stderr, "kernel_launch: hipFuncSetAttribute failed\n"); grid = -1; return; }
        if (hipOccupancyMaxActiveBlocksPerMultiprocessor(&per_cu, (const void*)fwd, NWAVES * 64, LDS_BYTES) != hipSuccess || per_cu < 1) { fprintf(stderr, "kernel_launch: occupancy query says %d\n", per_cu); }
        (void)hipGetLastError();
        if (cus != 8 * GROUP_WGS) { fprintf(stderr, "kernel_launch: %d CUs, this build is laid out for %d; nothing launched\n", cus, 8 * GROUP_WGS); grid = -1; return; }
        grid = cus;
    }
    if (grid < 0) return;
    if (hipMemsetAsync((char*)d_ws + WS_CTL, 0, CTL_ZERO_BYTES, stream) != hipSuccess) return;
    Args a{};
    for (int i = 0; i < 18; ++i) a.in[i] = (const float*)d_in[i];
    a.out = (float*)d_out; a.ws = (unsigned char*)d_ws;
#if MK_PER_PHASE
    for (int p = 0; p < N_PHASES; ++p) { a.ph_lo = p; a.ph_hi = p + 1; hipLaunchKernelGGL(fwd, dim3(grid), dim3(NWAVES * 64), LDS_BYTES, stream, a); }
#else
    a.ph_lo = 0; a.ph_hi = N_PHASES; hipLaunchKernelGGL(fwd, dim3(grid), dim3(NWAVES * 64), LDS_BYTES, stream, a);
#endif
}
```
